# Optimizing an MI355X kernel written in HIP

```python
import jax
import jax.numpy as jnp
from jax import lax
import numpy as np

D_MODEL = 1024
BATCH = 16
SEQ = 2048
DEPTH = 2

HEAD_DIM = 64
ROT_DIM = HEAD_DIM // 4
ROPE_THETA = 500000.0
NORM_EPS = 1e-5
ATTN_QBLOCK = 128
A_HEADS = D_MODEL // HEAD_DIM
A_GROUPS = 4
A_QPG = A_HEADS // A_GROUPS
CMP_LEN = 32
CMP_STRIDE = 16
CMP_HID = 2 * HEAD_DIM
SEL_LEN = 64
SEL_TOPN = 16
SEL_QCHUNK = 32
A_WINDOW = 512
A_PROJ = A_HEADS * HEAD_DIM + 6 * A_GROUPS * HEAD_DIM + 3 * A_HEADS
B_HEADS = D_MODEL // HEAD_DIM
B_QPG = 8
B_KV_HEADS = B_HEADS // B_QPG
B_WINDOW = 128
N_EXPERTS = 32
TOP_K = 4
D_FF = D_MODEL
SWIGLU_LIMIT = 7.0
SWIGLU_ALPHA = 1.702
MOE_BLOCK = 256
N_A_LAYERS = DEPTH // 2
N_B_LAYERS = DEPTH - N_A_LAYERS

kernel_name = 'hybrid_nsa_yoco_swa_sink_moe'


def rms_norm(x, g):
    x32 = x.astype(jnp.float32)
    y = x32 * lax.rsqrt(jnp.mean(x32 * x32, axis=-1, keepdims=True) + NORM_EPS)
    return (y * g.astype(jnp.float32)).astype(x.dtype)


def ada_mod(c_act, w, b, n):
    m = c_act @ w + b
    return jnp.split(m[:, None, :], n, axis=-1)


def rope_cos_sin(pos):
    inv = ROPE_THETA ** (-jnp.arange(0, ROT_DIM, 2, dtype=jnp.float32) / ROT_DIM)
    ang = pos.astype(jnp.float32)[..., None] * inv
    return jnp.cos(ang), jnp.sin(ang)


def apply_rope(x, cos, sin):
    shp = cos.shape[:2] + (1,) * (x.ndim - 3) + cos.shape[-1:]
    cos = cos.reshape(shp).astype(x.dtype)
    sin = sin.reshape(shp).astype(x.dtype)
    half = ROT_DIM // 2
    x1 = x[..., :half]
    x2 = x[..., half:ROT_DIM]
    return jnp.concatenate([x1 * cos - x2 * sin, x2 * cos + x1 * sin, x[..., ROT_DIM:]], axis=-1)


def masked_softmax(s, mask, sink=None):
    s = jnp.where(mask, s.astype(jnp.float32), -jnp.inf)
    m = jnp.max(s, axis=-1, keepdims=True)
    if sink is not None:
        sink = sink.astype(jnp.float32)
        m = jnp.maximum(m, sink)
    m = jnp.where(jnp.isfinite(m), m, 0.0)
    p = jnp.exp(s - m)
    den = jnp.sum(p, axis=-1, keepdims=True)
    if sink is not None:
        den = den + jnp.exp(sink - m)
    return p / jnp.maximum(den, jnp.finfo(jnp.float32).tiny)


def banded_attention(q, k, v, window, sinks=None):
    B, S, G, QPG, dh = q.shape
    QB = ATTN_QBLOCK
    nb = S // QB
    span = QB + window
    scale = dh ** -0.5
    pad = ((0, 0), (window, 0), (0, 0), (0, 0))
    kp = jnp.pad(k, pad)
    vp = jnp.pad(v, pad)
    qb = q.reshape(B, nb, QB, G, QPG, dh).swapaxes(0, 1)
    sink = None if sinks is None else sinks.reshape(G, QPG)[None, :, :, None, None]

    def block(args):
        q_blk, bi = args
        s0 = bi * QB
        k_blk = lax.dynamic_slice_in_dim(kp, s0, span, axis=1)
        v_blk = lax.dynamic_slice_in_dim(vp, s0, span, axis=1)
        s = jnp.einsum('bqghd,bkgd->bghqk', q_blk, k_blk) * scale
        qpos = s0 + jnp.arange(QB)
        kpos = s0 - window + jnp.arange(span)
        mask = ((kpos[None, :] <= qpos[:, None]) & (kpos[None, :] > qpos[:, None] - window)
                & (kpos[None, :] >= 0))
        p = masked_softmax(s, mask, sink)
        return jnp.einsum('bghqk,bkgd->bqghd', p.astype(v.dtype), v_blk)

    o = lax.map(block, (qb, jnp.arange(nb)))
    return o.swapaxes(0, 1).reshape(B, S, G, QPG, dh)


def selected_block_attention(q, k, v, sel):
    B, S, G, QPG, dh = q.shape
    n_top = sel.shape[-1]
    n_blk = S // SEL_LEN
    n_chunk = S // SEL_QCHUNK
    scale = dh ** -0.5
    kb = k.transpose(0, 2, 1, 3).reshape(B, G, n_blk, SEL_LEN, dh)
    vb = v.transpose(0, 2, 1, 3).reshape(B, G, n_blk, SEL_LEN, dh)
    qc = q.reshape(B, n_chunk, SEL_QCHUNK, G, QPG, dh).transpose(1, 0, 3, 4, 2, 5)
    sc = sel.reshape(B, G, n_chunk, SEL_QCHUNK, n_top).transpose(2, 0, 1, 3, 4)
    b_ix = jnp.arange(B)[:, None, None, None]
    g_ix = jnp.arange(G)[None, :, None, None]
    nk = n_top * SEL_LEN

    def chunk(args):
        q_blk, s_blk, ci = args
        k_g = kb[b_ix, g_ix, s_blk]
        v_g = vb[b_ix, g_ix, s_blk]
        s = jnp.einsum('bghqd,bgqnld->bghqnl', q_blk, k_g) * scale
        kpos = s_blk[..., None] * SEL_LEN + jnp.arange(SEL_LEN)
        qpos = ci * SEL_QCHUNK + jnp.arange(SEL_QCHUNK)
        mask = kpos <= qpos[:, None, None]
        p = masked_softmax(s.reshape(B, G, QPG, SEL_QCHUNK, nk),
                           mask.reshape(B, G, 1, SEL_QCHUNK, nk))
        return jnp.einsum('bghqk,bgqkd->bghqd', p.astype(v.dtype),
                          v_g.reshape(B, G, SEL_QCHUNK, nk, dh))

    o = lax.map(chunk, (qc, sc, jnp.arange(n_chunk)))
    return o.transpose(1, 0, 4, 2, 3, 5).reshape(B, S, G, QPG, dh)


def compress_blocks(blk, pe, w1, w2):
    z = jnp.einsum('bnlgd,lde->bnge', blk + pe[:, None, :], w1)
    return jax.nn.gelu(z) @ w2


def nsa_mixer(h, positions, cos, sin, w_in, cmp_pe, cmp_w1, cmp_w2, w_out):
    B, S, _ = h.shape
    HD = A_HEADS * HEAD_DIM
    KD = A_GROUPS * HEAD_DIM
    proj = h @ w_in
    q = proj[..., :HD].reshape(B, S, A_GROUPS, A_QPG, HEAD_DIM)
    kv = proj[..., HD:HD + 6 * KD].reshape(B, S, 6, A_GROUPS, HEAD_DIM)
    gate = jax.nn.sigmoid(proj[..., HD + 6 * KD:].reshape(B, S, A_GROUPS, A_QPG, 3))
    k_c_raw, v_c_raw = kv[:, :, 0], kv[:, :, 1]
    k_s, v_s = kv[:, :, 2], kv[:, :, 3]
    k_w, v_w = kv[:, :, 4], kv[:, :, 5]
    q = apply_rope(q, cos, sin)
    k_s = apply_rope(k_s, cos, sin)
    k_w = apply_rope(k_w, cos, sin)
    scale = HEAD_DIM ** -0.5
    t = np.arange(S)
    n_cmp = (S - CMP_LEN) // CMP_STRIDE + 1
    blk_idx = np.arange(n_cmp)[:, None] * CMP_STRIDE + np.arange(CMP_LEN)[None, :]
    k_c = compress_blocks(k_c_raw[:, blk_idx], cmp_pe[0], cmp_w1[0], cmp_w2[0])
    v_c = compress_blocks(v_c_raw[:, blk_idx], cmp_pe[1], cmp_w1[1], cmp_w2[1])
    end_pos = blk_idx[:, -1]
    ccos, csin = rope_cos_sin(positions[:, end_pos])
    k_c = apply_rope(k_c, ccos, csin)
    s_c = jnp.einsum('bsghd,bngd->bghsn', q, k_c) * scale
    p_c = masked_softmax(s_c, end_pos[None, :] <= t[:, None])
    o_c = jnp.einsum('bghsn,bngd->bsghd', p_c.astype(v_c.dtype), v_c)
    n_sel = S // SEL_LEN
    n_top = min(SEL_TOPN, n_sel)
    cmp_lo = np.arange(n_cmp) * CMP_STRIDE
    sel_lo = np.arange(n_sel) * SEL_LEN
    cover = ((cmp_lo[:, None] < sel_lo[None, :] + SEL_LEN)
             & (sel_lo[None, :] < cmp_lo[:, None] + CMP_LEN)).astype(np.float32)
    imp = jnp.einsum('bghsn,nj->bgsj', p_c, jnp.asarray(cover))
    cur = t // SEL_LEN
    j = np.arange(n_sel)
    forced = (j[None] == 0) | (j[None] == cur[:, None]) | (j[None] == cur[:, None] - 1)
    causal = j[None] <= cur[:, None]
    imp = jnp.where(forced, jnp.inf, jnp.where(causal, imp, -jnp.inf))
    _, sel = lax.top_k(imp, n_top)
    o_s = selected_block_attention(q, k_s, v_s, sel)
    o_w = banded_attention(q, k_w, v_w, A_WINDOW)
    o = gate[..., 0:1] * o_c + gate[..., 1:2] * o_s + gate[..., 2:3] * o_w
    return o.reshape(B, S, HD) @ w_out


def shared_kv(h, c_act, cos, sin, kv_norm_g, kv_mod_w, kv_mod_b, kv_w, kv_b):
    B, S, _ = h.shape
    shift, scale = ada_mod(c_act, kv_mod_w, kv_mod_b, 2)
    hn = rms_norm(h, kv_norm_g) * (1 + scale) + shift
    kv = (hn @ kv_w + kv_b).reshape(B, S, 2, B_KV_HEADS, HEAD_DIM)
    return apply_rope(kv[:, :, 0], cos, sin), kv[:, :, 1]


def sink_swa_mixer(h, cos, sin, k_sh, v_sh, w_q, b_q, sinks, w_out, b_out):
    B, S, _ = h.shape
    q = (h @ w_q + b_q).reshape(B, S, B_KV_HEADS, B_QPG, HEAD_DIM)
    q = apply_rope(q, cos, sin)
    o = banded_attention(q, k_sh, v_sh, B_WINDOW, sinks)
    return o.reshape(B, S, B_HEADS * HEAD_DIM) @ w_out + b_out


def moe_ffn(h, router_w, router_b, w_gate_up, b_gate_up, w_down, b_down):
    B, S, D = h.shape
    T = B * S
    TK = T * TOP_K
    xt = h.reshape(T, D)
    logits = (xt @ router_w + router_b).astype(jnp.float32)
    top_v, top_i = lax.top_k(logits, TOP_K)
    wts = jax.nn.softmax(top_v, axis=-1).astype(h.dtype)
    e = top_i.reshape(TK)
    order = jnp.argsort(e)
    e_sorted = e[order]
    counts = jnp.bincount(e, length=N_EXPERTS)
    start = jnp.cumsum(counts) - counts
    pad_counts = (counts + MOE_BLOCK - 1) // MOE_BLOCK * MOE_BLOCK
    pad_end = jnp.cumsum(pad_counts)
    pad_start = pad_end - pad_counts
    slot_sorted = (pad_start[e_sorted] + jnp.arange(TK) - start[e_sorted]).astype(jnp.int32)
    n_slots = TK + N_EXPERTS * MOE_BLOCK
    n_blk = n_slots // MOE_BLOCK
    tok_of_slot = jnp.zeros((n_slots,), jnp.int32).at[slot_sorted].set((order // TOP_K).astype(jnp.int32))
    slot = jnp.zeros((TK,), jnp.int32).at[order].set(slot_sorted).reshape(T, TOP_K)
    blk_start = jnp.arange(n_blk) * MOE_BLOCK
    blk_expert = jnp.minimum(jnp.sum(pad_end[None, :] <= blk_start[:, None], axis=1), N_EXPERTS - 1)

    def expert_block(args):
        tok, ex = args
        xb = xt[tok]
        gu = xb @ w_gate_up[ex] + b_gate_up[ex]
        glu = jnp.minimum(gu[:, :D_FF], SWIGLU_LIMIT)
        lin = jnp.clip(gu[:, D_FF:], -SWIGLU_LIMIT, SWIGLU_LIMIT)
        act = glu * jax.nn.sigmoid(SWIGLU_ALPHA * glu) * (lin + 1.0)
        return act @ w_down[ex] + b_down[ex]

    out = lax.map(expert_block, (tok_of_slot.reshape(n_blk, MOE_BLOCK), blk_expert))
    out = out.reshape(n_slots, D)
    y = jnp.zeros_like(xt)
    for kk in range(TOP_K):
        y = y + wts[:, kk:kk + 1] * out[slot[:, kk]]
    return y.reshape(B, S, D)


def setup_inputs(seed: int = 0) -> dict:
    key = jax.random.key(seed)
    ks = jax.random.split(key, 32)
    f32 = jnp.float32
    D = D_MODEL
    HD = HEAD_DIM

    def nrm(k, shape, s):
        return jax.random.normal(k, shape, f32) * s

    x = nrm(ks[0], (BATCH, SEQ, D), 1.0)
    c = nrm(ks[1], (BATCH, D), 1.0)
    offset = jax.random.randint(ks[2], (BATCH, 1), 0, 1024, dtype=jnp.int32)
    positions = offset + jnp.arange(SEQ, dtype=jnp.int32)[None, :]
    mod_w = nrm(ks[3], (DEPTH, 2, D, 3 * D), 0.5 * D ** -0.5)
    mod_b = nrm(ks[4], (DEPTH, 2, 3 * D), 0.02)
    norm_g = 1.0 + nrm(ks[5], (DEPTH, 2, D), 0.02)
    final_norm_g = 1.0 + nrm(ks[6], (D,), 0.02)
    a_w_in = nrm(ks[7], (N_A_LAYERS, D, A_PROJ), D ** -0.5)
    a_cmp_pe = nrm(ks[8], (N_A_LAYERS, 2, CMP_LEN, HD), 0.1)
    a_cmp_w1 = nrm(ks[9], (N_A_LAYERS, 2, CMP_LEN, HD, CMP_HID), (CMP_LEN * HD) ** -0.5)
    a_cmp_w2 = nrm(ks[10], (N_A_LAYERS, 2, CMP_HID, HD), CMP_HID ** -0.5)
    a_w_out = nrm(ks[11], (N_A_LAYERS, A_HEADS * HD, D), (A_HEADS * HD) ** -0.5)
    kv_norm_g = 1.0 + nrm(ks[12], (D,), 0.02)
    kv_mod_w = nrm(ks[13], (D, 2 * D), 0.5 * D ** -0.5)
    kv_mod_b = nrm(ks[14], (2 * D,), 0.02)
    kv_w = nrm(ks[15], (D, 2 * B_KV_HEADS * HD), D ** -0.5)
    kv_b = nrm(ks[16], (2 * B_KV_HEADS * HD,), 0.02)
    b_w_q = nrm(ks[17], (N_B_LAYERS, D, B_HEADS * HD), D ** -0.5)
    b_b_q = nrm(ks[18], (N_B_LAYERS, B_HEADS * HD), 0.02)
    b_sinks = nrm(ks[19], (N_B_LAYERS, B_HEADS), 1.0)
    b_w_out = nrm(ks[20], (N_B_LAYERS, B_HEADS * HD, D), (B_HEADS * HD) ** -0.5)
    b_b_out = nrm(ks[21], (N_B_LAYERS, D), 0.02)
    router_w = nrm(ks[22], (DEPTH, D, N_EXPERTS), D ** -0.5)
    router_b = nrm(ks[23], (DEPTH, N_EXPERTS), 0.01)
    w_gate_up = nrm(ks[24], (DEPTH, N_EXPERTS, D, 2 * D_FF), D ** -0.5)
    b_gate_up = nrm(ks[25], (DEPTH, N_EXPERTS, 2 * D_FF), 0.01)
    w_down = nrm(ks[26], (DEPTH, N_EXPERTS, D_FF, D), D_FF ** -0.5)
    b_down = nrm(ks[27], (DEPTH, N_EXPERTS, D), 0.01)
    return {'x': x, 'c': c, 'positions': positions, 'mod_w': mod_w, 'mod_b': mod_b,
            'norm_g': norm_g, 'final_norm_g': final_norm_g, 'a_w_in': a_w_in,
            'a_cmp_pe': a_cmp_pe, 'a_cmp_w1': a_cmp_w1, 'a_cmp_w2': a_cmp_w2,
            'a_w_out': a_w_out, 'kv_norm_g': kv_norm_g, 'kv_mod_w': kv_mod_w,
            'kv_mod_b': kv_mod_b, 'kv_w': kv_w, 'kv_b': kv_b, 'b_w_q': b_w_q,
            'b_b_q': b_b_q, 'b_sinks': b_sinks, 'b_w_out': b_w_out, 'b_b_out': b_b_out,
            'router_w': router_w, 'router_b': router_b, 'w_gate_up': w_gate_up,
            'b_gate_up': b_gate_up, 'w_down': w_down, 'b_down': b_down}


def reference(x, c, positions, mod_w, mod_b, norm_g, final_norm_g, a_w_in, a_cmp_pe,
              a_cmp_w1, a_cmp_w2, a_w_out, kv_norm_g, kv_mod_w, kv_mod_b, kv_w, kv_b,
              b_w_q, b_b_q, b_sinks, b_w_out, b_b_out, router_w, router_b, w_gate_up,
              b_gate_up, w_down, b_down):
    c_act = jax.nn.silu(c)
    cos, sin = rope_cos_sin(positions)
    h = x
    k_sh = None
    v_sh = None
    for layer in range(DEPTH):
        if layer == N_A_LAYERS:
            k_sh, v_sh = shared_kv(h, c_act, cos, sin, kv_norm_g, kv_mod_w, kv_mod_b, kv_w, kv_b)
        shift, scale, gate = ada_mod(c_act, mod_w[layer, 0], mod_b[layer, 0], 3)
        hn = rms_norm(h, norm_g[layer, 0]) * (1 + scale) + shift
        if layer < N_A_LAYERS:
            i = layer
            mix = nsa_mixer(hn, positions, cos, sin, a_w_in[i], a_cmp_pe[i], a_cmp_w1[i],
                            a_cmp_w2[i], a_w_out[i])
        else:
            i = layer - N_A_LAYERS
            mix = sink_swa_mixer(hn, cos, sin, k_sh, v_sh, b_w_q[i], b_b_q[i], b_sinks[i],
                                 b_w_out[i], b_b_out[i])
        h = h + gate * mix
        shift, scale, gate = ada_mod(c_act, mod_w[layer, 1], mod_b[layer, 1], 3)
        hn = rms_norm(h, norm_g[layer, 1]) * (1 + scale) + shift
        h = h + gate * moe_ffn(hn, router_w[layer], router_b[layer], w_gate_up[layer],
                               b_gate_up[layer], w_down[layer], b_down[layer])
    return rms_norm(h, final_norm_g)
```

```cpp
#include <hip/hip_runtime.h>
#include <cstdio>
#include <cstdint>

#define DI __device__ __forceinline__
#define LAS __attribute__((address_space(3)))
#define GAS __attribute__((address_space(1)))
typedef unsigned short bf16_t;
typedef short bf16x8 __attribute__((ext_vector_type(8)));
typedef short s16x4 __attribute__((ext_vector_type(4)));
typedef float f32x2 __attribute__((ext_vector_type(2)));
typedef float f32x4 __attribute__((ext_vector_type(4)));
typedef float f32x16 __attribute__((ext_vector_type(16)));
typedef unsigned u32x4 __attribute__((ext_vector_type(4)));
typedef unsigned u32x2 __attribute__((ext_vector_type(2)));

constexpr int NB = 16, SEQ = 2048, T = NB * SEQ, D = 1024, HD = 64;
constexpr int NEXP = 32, TOPK = 4;
constexpr int A_PROJ = 2608;
constexpr float NORM_EPS = 1e-5f;
constexpr float QSCALE = 0.125f * 1.4426950408889634f;
constexpr float LOG2E = 1.4426950408889634f;
constexpr int NWAVES = 8, NTHR = 512, GRID = 256;

constexpr size_t MiB = (size_t)1 << 20;
constexpr size_t WS_CTL = 0, CTL_ZERO_BYTES = 1 * MiB;
constexpr size_t WS_MODV = 1 * MiB;
constexpr size_t WS_ROPE = 2 * MiB;
constexpr size_t WS_CMPB = 4 * MiB;
constexpr size_t WS_CW1T = 5 * MiB;
constexpr size_t WS_CW2T = 6 * MiB;
constexpr size_t WS_WINT = 7 * MiB;
constexpr size_t WS_WAOT = 13 * MiB;
constexpr size_t WS_WBQT = 15 * MiB;
constexpr size_t WS_WBOT = 17 * MiB;
constexpr size_t WS_WKVT = 19 * MiB;
constexpr size_t WS_KC = 20 * MiB;
constexpr size_t WS_VCT = 21 * MiB;
constexpr size_t WS_TOKSLOT = 22 * MiB;
constexpr size_t WS_GATES = 24 * MiB;
constexpr size_t WS_LIST = 32 * MiB;
constexpr size_t WS_LISTW = 36 * MiB;
constexpr size_t WS_VT = 40 * MiB;
constexpr size_t WS_WGUT = 72 * MiB;
constexpr size_t WS_WDNT = 328 * MiB;
constexpr size_t WS_H = 456 * MiB;
constexpr size_t WS_HN = 584 * MiB;
constexpr size_t WS_HN2 = 648 * MiB;
constexpr size_t WS_Q = 712 * MiB;
constexpr size_t WS_KV = 776 * MiB;
constexpr size_t WS_O = 840 * MiB;
constexpr size_t WS_ACT = 904 * MiB;
constexpr size_t WS_OUTB = 1161 * MiB;
constexpr size_t WS_END = 1417 * MiB;
constexpr int CW_BAR = 1024;
constexpr int CW_CNT = 8192;

constexpr int LDS_BYTES = 163840;
constexpr int MISC_OFF = LDS_BYTES - 1024;
constexpr int EXT_OFF = MISC_OFF + 64;

DI unsigned pk2(float lo, float hi) {
    typedef __bf16 bf2 __attribute__((ext_vector_type(2)));
    f32x2 v = {lo, hi}; bf2 b = __builtin_convertvector(v, bf2); return __builtin_bit_cast(unsigned, b);
}
DI float bf_lo(unsigned u) { return __uint_as_float(u << 16); }
DI float bf_hi(unsigned u) { return __uint_as_float(u & 0xffff0000u); }
DI float ex2(float x) { return __builtin_amdgcn_exp2f(x); }
DI float rcpf(float x) { return __builtin_amdgcn_rcpf(x); }
DI float wave_sum(float v) {
#pragma unroll
    for (int o = 1; o < 64; o <<= 1) v += __shfl_xor(v, o);
    return v;
}
DI int crow(int reg, int h) { return (reg & 3) + 8 * (reg >> 2) + 4 * h; }
#define MFMA32(a, b, c) __builtin_amdgcn_mfma_f32_32x32x16_bf16((a), (b), (c), 0, 0, 0)
#define LDS_WAIT() asm volatile("s_waitcnt lgkmcnt(0)" ::: "memory")
#define VM_WAIT() asm volatile("s_waitcnt vmcnt(0)" ::: "memory")

#define XB_TMO      128
#define XB_XCNT(j)  (256  + 64 * (j))
#define XB_XSUB(j)  (1280 + 64 * (j))
#define XB_XGEN(j)  (2304 + 64 * (j))
#define XB_TOP      3328
#define XB_TOPGEN   3392
#define XCD_BAR_WORDS 3456
#define XB_SPIN_CAP (1u << 21)

DI unsigned xb_ld(unsigned* p)              { return __hip_atomic_load(p, __ATOMIC_RELAXED, __HIP_MEMORY_SCOPE_AGENT); }
DI unsigned xb_add(unsigned* p, unsigned v) { return __hip_atomic_fetch_add(p, v, __ATOMIC_RELAXED, __HIP_MEMORY_SCOPE_AGENT); }
DI unsigned xb_xcc_id() { return (unsigned)__builtin_amdgcn_s_getreg((3 << 11) | 20) & 0xFu; }
#define XB_SPIN(cond, bar) do { unsigned _sp = 0; while (cond) { __builtin_amdgcn_s_sleep(1); \
    if ((++_sp & 255u) == 0u) { if (xb_ld(&(bar)[XB_TMO])) break; if (_sp > XB_SPIN_CAP) { atomicAdd(&(bar)[XB_TMO], 1u); break; } } } } while (0)

struct XcdBarrier { unsigned* bar; unsigned x; volatile LAS unsigned* st; };

DI XcdBarrier xcd_barrier_post(unsigned* bar, volatile LAS unsigned* st) {
    XcdBarrier b; b.bar = bar; b.x = xb_xcc_id(); b.st = st;
    if (threadIdx.x == 0) (void)xb_add(&bar[XB_XCNT(b.x)], 1u);
    return b;
}
DI void xcd_barrier_complete(unsigned* bar, unsigned x, unsigned& nloc, unsigned& nx) {
    const unsigned G = gridDim.x * gridDim.y * gridDim.z;
    unsigned sum, cnt, mine, sp = 0u;
    for (;;) {
        sum = 0u; cnt = 0u; mine = 0u;
#pragma unroll
        for (unsigned j = 0; j < 16; ++j) { const unsigned c = xb_ld(&bar[XB_XCNT(j)]); sum += c; cnt += (c > 0u) ? 1u : 0u; mine = (j == x) ? c : mine; }
        if (sum == G) break;
        __builtin_amdgcn_s_sleep(1);
        if ((++sp & 255u) == 0u) { if (xb_ld(&bar[XB_TMO])) break; if (sp > XB_SPIN_CAP) { atomicAdd(&bar[XB_TMO], 1u); break; } }
    }
    nloc = mine > 0u ? mine : 1u; nx = cnt > 0u ? cnt : 1u;
}
DI void xcd_barrier(const XcdBarrier& b) {
    asm volatile("s_waitcnt vmcnt(0)" ::: "memory");
    __syncthreads();
    if (threadIdx.x == 0) {
        unsigned* bar = b.bar;
        __builtin_amdgcn_s_waitcnt(0);
        unsigned nloc = b.st[0], nx = b.st[1];
        if (nloc == 0u) { xcd_barrier_complete(bar, b.x, nloc, nx); b.st[0] = nloc; b.st[1] = nx; }
        const unsigned old = xb_add(&bar[XB_XSUB(b.x)], 1u);
        const unsigned gen = old / nloc;
        if (old + 1u == (gen + 1u) * nloc) {
            __builtin_amdgcn_fence(__ATOMIC_RELEASE, "agent");
            asm volatile("s_waitcnt vmcnt(0)" ::: "memory");
            const unsigned og = xb_add(&bar[XB_TOP], 1u);
            const unsigned tg = og / nx;
            if (og + 1u == (tg + 1u) * nx) xb_add(&bar[XB_TOPGEN], 1u);
            else XB_SPIN(xb_ld(&bar[XB_TOPGEN]) == tg, bar);
            __builtin_amdgcn_fence(__ATOMIC_ACQUIRE, "agent");
            xb_add(&bar[XB_XGEN(b.x)], 1u);
            asm volatile("s_waitcnt vmcnt(0)" ::: "memory");
        } else {
            XB_SPIN(xb_ld(&bar[XB_XGEN(b.x)]) == gen, bar);
            __builtin_amdgcn_fence(__ATOMIC_ACQUIRE, "agent");
            asm volatile("s_waitcnt vmcnt(0)" ::: "memory");
        }
    }
    __syncthreads();
}

struct Args { const void* in[28]; float* out; unsigned char* ws; int ph_lo, ph_hi; };

typedef const __attribute__((address_space(4))) unsigned char* KPtr;
struct Frame {
    LAS unsigned char* lds; KPtr kp; int tid, lane, wave, vcu, bx;
    DI void* arg(int i) const { return *(void* const __attribute__((address_space(4)))*)(kp + 8 * i); }
    DI unsigned char* wsp() const { return (unsigned char*)arg(29); }
    DI unsigned* ctl() const { return (unsigned*)(wsp() + WS_CTL); }
    DI float* out() const { return (float*)arg(28); }
    DI const float* x() const { return (const float*)arg(0); }
    DI const float* c() const { return (const float*)arg(1); }
    DI const int* positions() const { return (const int*)arg(2); }
    DI const float* mod_w() const { return (const float*)arg(3); }
    DI const float* mod_b() const { return (const float*)arg(4); }
    DI const float* norm_g() const { return (const float*)arg(5); }
    DI const float* final_g() const { return (const float*)arg(6); }
    DI const float* a_w_in() const { return (const float*)arg(7); }
    DI const float* cmp_pe() const { return (const float*)arg(8); }
    DI const float* cmp_w1() const { return (const float*)arg(9); }
    DI const float* cmp_w2() const { return (const float*)arg(10); }
    DI const float* a_w_out() const { return (const float*)arg(11); }
    DI const float* kv_norm_g() const { return (const float*)arg(12); }
    DI const float* kv_mod_w() const { return (const float*)arg(13); }
    DI const float* kv_mod_b() const { return (const float*)arg(14); }
    DI const float* kv_w() const { return (const float*)arg(15); }
    DI const float* kv_b() const { return (const float*)arg(16); }
    DI const float* b_w_q() const { return (const float*)arg(17); }
    DI const float* b_b_q() const { return (const float*)arg(18); }
    DI const float* b_sinks() const { return (const float*)arg(19); }
    DI const float* b_w_out() const { return (const float*)arg(20); }
    DI const float* b_b_out() const { return (const float*)arg(21); }
    DI const float* router_w() const { return (const float*)arg(22); }
    DI const float* router_b() const { return (const float*)arg(23); }
    DI const float* w_gate_up() const { return (const float*)arg(24); }
    DI const float* b_gate_up() const { return (const float*)arg(25); }
    DI const float* w_down() const { return (const float*)arg(26); }
    DI const float* b_down() const { return (const float*)arg(27); }
    DI float* MODV() const { return (float*)(wsp() + WS_MODV); }
    DI float* ROPE() const { return (float*)(wsp() + WS_ROPE); }
    DI float* CMPB() const { return (float*)(wsp() + WS_CMPB); }
    DI float* GATES() const { return (float*)(wsp() + WS_GATES); }
    DI float* LISTW() const { return (float*)(wsp() + WS_LISTW); }
    DI float* H() const { return (float*)(wsp() + WS_H); }
    DI bf16_t* CW1T() const { return (bf16_t*)(wsp() + WS_CW1T); }
    DI bf16_t* CW2T() const { return (bf16_t*)(wsp() + WS_CW2T); }
    DI bf16_t* WINT() const { return (bf16_t*)(wsp() + WS_WINT); }
    DI bf16_t* WAOT() const { return (bf16_t*)(wsp() + WS_WAOT); }
    DI bf16_t* WBQT() const { return (bf16_t*)(wsp() + WS_WBQT); }
    DI bf16_t* WBOT() const { return (bf16_t*)(wsp() + WS_WBOT); }
    DI bf16_t* WKVT() const { return (bf16_t*)(wsp() + WS_WKVT); }
    DI bf16_t* KC() const { return (bf16_t*)(wsp() + WS_KC); }
    DI bf16_t* VCT() const { return (bf16_t*)(wsp() + WS_VCT); }
    DI bf16_t* VT() const { return (bf16_t*)(wsp() + WS_VT); }
    DI bf16_t* WGUT() const { return (bf16_t*)(wsp() + WS_WGUT); }
    DI bf16_t* WDNT() const { return (bf16_t*)(wsp() + WS_WDNT); }
    DI bf16_t* HN() const { return (bf16_t*)(wsp() + WS_HN); }
    DI bf16_t* HN2() const { return (bf16_t*)(wsp() + WS_HN2); }
    DI bf16_t* Q() const { return (bf16_t*)(wsp() + WS_Q); }
    DI bf16_t* KV() const { return (bf16_t*)(wsp() + WS_KV); }
    DI bf16_t* O() const { return (bf16_t*)(wsp() + WS_O); }
    DI bf16_t* ACT() const { return (bf16_t*)(wsp() + WS_ACT); }
    DI bf16_t* OUTB() const { return (bf16_t*)(wsp() + WS_OUTB); }
    DI unsigned* TOKSLOT() const { return (unsigned*)(wsp() + WS_TOKSLOT); }
    DI unsigned* LIST() const { return (unsigned*)(wsp() + WS_LIST); }
};
DI int vcu_of(int bx) { return (bx & 7) * (GRID / 8) + (bx >> 3); }
DI int fresh_lane() { int l; asm volatile("v_mbcnt_lo_u32_b32 %0, -1, 0\n\tv_mbcnt_hi_u32_b32 %0, -1, %0" : "=&v"(l)); return l; }
DI Frame make_frame(LAS unsigned char* lds, int wave_sgpr) {
    Frame F; F.lds = lds;
    KPtr kp = (KPtr)__builtin_amdgcn_kernarg_segment_ptr(); asm volatile("" : "+s"(kp)); F.kp = kp;
    int wv = wave_sgpr; asm volatile("" : "+s"(wv)); F.wave = wv; F.lane = fresh_lane(); F.tid = wv * 64 + F.lane;
    int bx = (int)blockIdx.x; asm volatile("" : "+s"(bx)); F.bx = bx; F.vcu = vcu_of(bx);
    return F;
}
DI void transpose_item(const float* W, int ld, int K, bf16_t* WT, int drow0, int k0, int n0, LAS float* scr, int lane) {
#pragma unroll 8
    for (int i = 0; i < 32; ++i) { const int kk = 2 * i + (lane >> 5); scr[kk * 33 + (lane & 31)] = W[(size_t)(k0 + kk) * ld + n0 + (lane & 31)]; }
    LDS_WAIT(); asm volatile("" ::: "memory");
    const int c = lane & 7;
#pragma unroll
    for (int j = 0; j < 4; ++j) { const int n = (lane >> 3) + 8 * j; const LAS float* s = scr + (8 * c) * 33 + n;
        u32x4 o; o.x = pk2(s[0 * 33], s[1 * 33]); o.y = pk2(s[2 * 33], s[3 * 33]); o.z = pk2(s[4 * 33], s[5 * 33]); o.w = pk2(s[6 * 33], s[7 * 33]);
        *(u32x4*)(WT + (size_t)(drow0 + n) * K + k0 + 8 * c) = o; }
    LDS_WAIT(); asm volatile("" ::: "memory");
}

DI void p0_prologue(Frame& F) {
    const int gw = F.bx * NWAVES + F.wave, NGW = GRID * NWAVES, lane = F.lane;
    const int gtid = F.bx * NTHR + F.tid, NGT = GRID * NTHR;
    LAS float* cact = (LAS float*)(F.lds + 73728);
    const bool modblk = (F.bx >= 32 && F.bx < 60);
    if (modblk) {
        for (int idx = F.tid; idx < NB * D; idx += NTHR) { const int b = idx / D, k = idx % D; const float v = F.c()[idx]; cact[k * 16 + b] = v / (1.f + __expf(-v)); }
    }
    __syncthreads();
    if (gw >= 256 && gw < 480) {
        const int it = gw - 256; const float* W; const float* bias; float* outp; int ld;
        int chunk;
        if (it < 192) { const int set = it / 48; chunk = it % 48; W = F.mod_w() + (size_t)set * D * 3072; ld = 3072; bias = F.mod_b() + set * 3072; outp = F.MODV() + (size_t)set * 16 * 3072; }
        else { chunk = it - 192; W = F.kv_mod_w(); ld = 2048; bias = F.kv_mod_b(); outp = F.MODV() + (size_t)4 * 16 * 3072; }
        const int col = chunk * 64 + lane;
        float acc[16];
#pragma unroll
        for (int b = 0; b < 16; ++b) acc[b] = 0.f;
#pragma unroll 4
        for (int k = 0; k < D; ++k) {
            const float w = W[(size_t)k * ld + col];
            const LAS f32x4* cp = (const LAS f32x4*)(cact + k * 16);
            const f32x4 c0 = cp[0], c1 = cp[1], c2 = cp[2], c3 = cp[3];
            acc[0] += c0.x * w; acc[1] += c0.y * w; acc[2] += c0.z * w; acc[3] += c0.w * w;
            acc[4] += c1.x * w; acc[5] += c1.y * w; acc[6] += c1.z * w; acc[7] += c1.w * w;
            acc[8] += c2.x * w; acc[9] += c2.y * w; acc[10] += c2.z * w; acc[11] += c2.w * w;
            acc[12] += c3.x * w; acc[13] += c3.y * w; acc[14] += c3.z * w; acc[15] += c3.w * w;
        }
        const float bv = bias[col];
#pragma unroll
        for (int b = 0; b < 16; ++b) outp[(size_t)b * ld + col] = acc[b] + bv;
    }
    if (gw < 256) {
        const int kv = gw / 128, e = gw % 128; float s = 0.f;
        for (int j = 0; j < 32; ++j) { const int k = lane + 64 * j; s += F.cmp_pe()[kv * 2048 + k] * F.cmp_w1()[((size_t)kv * 2048 + k) * 128 + e]; }
        s = wave_sum(s);
        if (lane == 0) F.CMPB()[gw] = s;
    }
    for (int idx = gtid; idx < T * 8; idx += NGT) {
        const int tok = idx >> 3, i = idx & 7;
        const float inv = (float)pow(500000.0, -(double)(2 * i) / 16.0);
        const float ang = (float)F.positions()[tok] * inv;
        double a = (double)ang; const double twopi = 6.283185307179586476925286766559;
        a -= twopi * rint(a / twopi);
        const float ar = (float)a;
        F.ROPE()[(size_t)tok * 16 + i] = cosf(ar); F.ROPE()[(size_t)tok * 16 + 8 + i] = sinf(ar);
    }
    for (int idx = gtid; idx < 256 * D; idx += NGT) {
        const int row = idx / D, k = idx % D;
        const float v = row < 48 ? F.a_w_in()[(size_t)k * A_PROJ + 2560 + row] : 0.f;
        F.WINT()[(size_t)(2048 + row) * D + k] = (bf16_t)(pk2(v, 0.f) & 0xffffu);
    }
    LAS float* scr = (LAS float*)(F.lds + F.wave * 8704);
    constexpr int J0 = 65536, J1 = 32768, J2 = 1280, J3 = 512, J6 = 128, J7 = 256, J8 = 8;
    constexpr int NITEMS = J0 + J1 + J2 + 3 * J3 + J6 + J7 + J8;
    for (int it = gw; it < NITEMS; it += NGW) {
        int r = it;
        if (r < J0) { const int mat = r >> 10, q = r & 1023, kb = q >> 6, nb = q & 63;
            transpose_item(F.w_gate_up() + (size_t)mat * D * 2048, 2048, D, F.WGUT() + (size_t)mat * 2048 * D, 32 * nb, 64 * kb, 32 * nb, scr, lane); continue; }
        r -= J0;
        if (r < J1) { const int mat = r >> 9, q = r & 511, kb = q >> 5, nb = q & 31;
            transpose_item(F.w_down() + (size_t)mat * D * D, D, D, F.WDNT() + (size_t)mat * D * D, 32 * nb, 64 * kb, 32 * nb, scr, lane); continue; }
        r -= J1;
        if (r < J2) { const int kb = r / 80, nb = r % 80, n0 = 32 * nb;
            const int dr = n0 < 1792 ? n0 : (n0 < 2048 ? 2304 + (n0 - 1792) : (n0 < 2304 ? 1792 + (n0 - 2048) : 2560 + (n0 - 2304)));
            transpose_item(F.a_w_in(), A_PROJ, D, F.WINT(), dr, 64 * kb, n0, scr, lane); continue; }
        r -= J2;
        if (r < J3) { const int kb = r >> 5, nb = r & 31; transpose_item(F.a_w_out(), D, D, F.WAOT(), 32 * nb, 64 * kb, 32 * nb, scr, lane); continue; }
        r -= J3;
        if (r < J3) { const int kb = r >> 5, nb = r & 31; transpose_item(F.b_w_q(), D, D, F.WBQT(), 32 * nb, 64 * kb, 32 * nb, scr, lane); continue; }
        r -= J3;
        if (r < J3) { const int kb = r >> 5, nb = r & 31; transpose_item(F.b_w_out(), D, D, F.WBOT(), 32 * nb, 64 * kb, 32 * nb, scr, lane); continue; }
        r -= J3;
        if (r < J6) { const int kb = r >> 3, nb = r & 7; transpose_item(F.kv_w(), 256, D, F.WKVT(), 32 * nb, 64 * kb, 32 * nb, scr, lane); continue; }
        r -= J6;
        if (r < J7) { const int kv = r >> 7, q = r & 127, kb = q >> 2, nb = q & 3;
            transpose_item(F.cmp_w1() + (size_t)kv * 2048 * 128, 128, 2048, F.CW1T() + (size_t)kv * 128 * 2048, 32 * nb, 64 * kb, 32 * nb, scr, lane); continue; }
        r -= J7;
        { const int kv = r >> 2, q = r & 3, kb = q >> 1, nb = q & 1;
            transpose_item(F.cmp_w2() + (size_t)kv * 128 * 64, 64, 128, F.CW2T() + (size_t)kv * 64 * 128, 32 * nb, 64 * kb, 32 * nb, scr, lane); }
    }
}

DI void load_mod(const float* g, const float* scale, const float* shift, int lane, f32x4 (&A)[4], f32x4 (&Bv)[4]) {
#pragma unroll
    for (int j = 0; j < 4; ++j) { const int c = 4 * lane + 256 * j;
        const f32x4 gg = *(const f32x4*)(g + c), sc = *(const f32x4*)(scale + c), sh = *(const f32x4*)(shift + c);
        A[j] = gg * (sc + 1.f); Bv[j] = sh; }
}
DI float row_ss(const f32x4 (&v)[4]) {
    float s = 0.f;
#pragma unroll
    for (int j = 0; j < 4; ++j) s += (v[j].x * v[j].x + v[j].y * v[j].y) + (v[j].z * v[j].z + v[j].w * v[j].w);
    return wave_sum(s);
}
DI void store_bf16_row(bf16_t* dst, int lane, const f32x4 (&y)[4]) {
#pragma unroll
    for (int j = 0; j < 4; ++j) { u32x2 o; o.x = pk2(y[j].x, y[j].y); o.y = pk2(y[j].z, y[j].w); *(u32x2*)(dst + 4 * lane + 256 * j) = o; }
}

DI void norm_plain_phase(Frame& F) {
    const int gw = F.bx * NWAVES + F.wave, lane = F.lane, b = gw >> 7;
    const float* mv = F.MODV() + ((size_t)0 * 16 + b) * 3072;
    f32x4 A[4], Bv[4]; load_mod(F.norm_g(), mv + 1024, mv, lane, A, Bv);
    for (int rr = 0; rr < 16; ++rr) {
        const size_t row = (size_t)gw * 16 + rr;
        f32x4 v[4];
#pragma unroll
        for (int j = 0; j < 4; ++j) v[j] = *(const f32x4*)(F.x() + row * D + 4 * lane + 256 * j);
        const float rstd = 1.0f / sqrtf(row_ss(v) * (1.f / D) + NORM_EPS);
        f32x4 y[4];
#pragma unroll
        for (int j = 0; j < 4; ++j) y[j] = v[j] * rstd * A[j] + Bv[j];
        store_bf16_row(F.HN() + row * D, lane, y);
    }
}

constexpr int RT_IMG = 0, RT_LGS = 147456, RT_PE = 149504, RT_PW = 151552, RT_LCNT = 153600, RT_LBASE = 153728;

DI void norm_router_phase(Frame& F, int layer) {
    const int gw = F.bx * NWAVES + F.wave, lane = F.lane, tid = F.tid, b = gw >> 7;
    LAS float* img = (LAS float*)(F.lds + RT_IMG);
    LAS float* lgs = (LAS float*)(F.lds + RT_LGS) + F.wave * 64;
    LAS unsigned* pend_e = (LAS unsigned*)(F.lds + RT_PE);
    LAS float* pend_w = (LAS float*)(F.lds + RT_PW);
    LAS unsigned* lcnt = (LAS unsigned*)(F.lds + RT_LCNT);
    LAS unsigned* lbase = (LAS unsigned*)(F.lds + RT_LBASE);
    const float* rw = F.router_w() + (size_t)layer * D * NEXP;
    for (int idx = tid; idx < D * NEXP; idx += NTHR) { const int col = idx >> 5, e = idx & 31;
        const int rho = (col & 3) * 64 + ((col >> 2) & 63) + 256 * (col >> 8); img[rho * 36 + e] = rw[idx]; }
    if (tid < 32) lcnt[tid] = 0u;
    __syncthreads();
    const int set = layer * 2 + 1;
    const float* mv = F.MODV() + ((size_t)set * 16 + b) * 3072;
    f32x4 A[4], Bv[4]; load_mod(F.norm_g() + (layer * 2 + 1) * D, mv + 1024, mv, lane, A, Bv);
    const float* rb = F.router_b() + layer * NEXP;
    for (int rp = 0; rp < 8; ++rp) {
        const size_t row0 = (size_t)gw * 16 + rp * 2;
        f32x4 y0[4], y1[4];
        {
            f32x4 v0[4], v1[4];
#pragma unroll
            for (int j = 0; j < 4; ++j) { v0[j] = *(const f32x4*)(F.H() + row0 * D + 4 * lane + 256 * j); v1[j] = *(const f32x4*)(F.H() + (row0 + 1) * D + 4 * lane + 256 * j); }
            const float r0 = 1.0f / sqrtf(row_ss(v0) * (1.f / D) + NORM_EPS), r1 = 1.0f / sqrtf(row_ss(v1) * (1.f / D) + NORM_EPS);
#pragma unroll
            for (int j = 0; j < 4; ++j) { y0[j] = v0[j] * r0 * A[j] + Bv[j]; y1[j] = v1[j] * r1 * A[j] + Bv[j]; }
        }
        store_bf16_row(F.HN() + row0 * D, lane, y0); store_bf16_row(F.HN() + (row0 + 1) * D, lane, y1);
        float l0[32], l1[32];
#pragma unroll
        for (int e = 0; e < 32; ++e) { l0[e] = 0.f; l1[e] = 0.f; }
#pragma unroll
        for (int j = 0; j < 4; ++j)
#pragma unroll
            for (int i = 0; i < 4; ++i) {
                const float a0 = y0[j][i], a1 = y1[j][i];
                const LAS f32x4* wp = (const LAS f32x4*)(img + (i * 64 + lane + 256 * j) * 36);
#pragma unroll
                for (int e4 = 0; e4 < 8; ++e4) { const f32x4 w = wp[e4];
                    l0[4 * e4 + 0] += a0 * w.x; l0[4 * e4 + 1] += a0 * w.y; l0[4 * e4 + 2] += a0 * w.z; l0[4 * e4 + 3] += a0 * w.w;
                    l1[4 * e4 + 0] += a1 * w.x; l1[4 * e4 + 1] += a1 * w.y; l1[4 * e4 + 2] += a1 * w.z; l1[4 * e4 + 3] += a1 * w.w; }
            }
#define RS_STEP(N, OFF) { const bool up = (lane & (OFF)) != 0; _Pragma("unroll") for (int k = 0; k < (N); ++k) { \
            const float s0 = up ? l0[k] : l0[k + (N)], k0 = up ? l0[k + (N)] : l0[k]; l0[k] = k0 + __shfl_xor(s0, (OFF)); \
            const float s1 = up ? l1[k] : l1[k + (N)], k1 = up ? l1[k + (N)] : l1[k]; l1[k] = k1 + __shfl_xor(s1, (OFF)); } }
        RS_STEP(16, 32) RS_STEP(8, 16) RS_STEP(4, 8) RS_STEP(2, 4) RS_STEP(1, 2)
#undef RS_STEP
        float g0 = l0[0] + __shfl_xor(l0[0], 1), g1 = l1[0] + __shfl_xor(l1[0], 1);
        const int e_own = lane >> 1; const float rbv = rb[e_own];
        if ((lane & 1) == 0) { lgs[e_own] = g0 + rbv; lgs[32 + e_own] = g1 + rbv; }
        LDS_WAIT(); asm volatile("" ::: "memory");
        if (lane < 2) {
            float v[32];
#pragma unroll
            for (int e = 0; e < 32; ++e) v[e] = lgs[lane * 32 + e];
            float tv[4]; int ti[4];
#pragma unroll
            for (int k = 0; k < 4; ++k) {
                float best = -INFINITY; int bi = 0;
#pragma unroll
                for (int e = 0; e < 32; ++e) { const bool gt = v[e] > best; best = gt ? v[e] : best; bi = gt ? e : bi; }
                tv[k] = best; ti[k] = bi;
#pragma unroll
                for (int e = 0; e < 32; ++e) v[e] = (e == bi) ? -INFINITY : v[e];
            }
            const float e1 = __expf(tv[1] - tv[0]), e2 = __expf(tv[2] - tv[0]), e3 = __expf(tv[3] - tv[0]);
            const float inv = 1.f / (1.f + e1 + e2 + e3);
            const float w[4] = {inv, e1 * inv, e2 * inv, e3 * inv};
            const int tl = F.wave * 16 + rp * 2 + lane;
#pragma unroll
            for (int k = 0; k < 4; ++k) {
                const unsigned pl = __hip_atomic_fetch_add(lcnt + ti[k], 1u, __ATOMIC_RELAXED, __HIP_MEMORY_SCOPE_WORKGROUP);
                pend_e[tl * 4 + k] = ((unsigned)ti[k] << 16) | pl; pend_w[tl * 4 + k] = w[k];
            }
        }
        LDS_WAIT(); asm volatile("" ::: "memory");
    }
    __syncthreads();
    unsigned* gcnt = F.ctl() + CW_CNT + 64 * layer;
    if (tid < 32) lbase[tid] = __hip_atomic_fetch_add(gcnt + tid, lcnt[tid], __ATOMIC_RELAXED, __HIP_MEMORY_SCOPE_AGENT);
    __syncthreads();
    {
        const int tl = tid >> 2, k = tid & 3; const unsigned pe = pend_e[tid]; const unsigned e = pe >> 16, pos = lbase[e] + (pe & 0xffffu);
        const unsigned token = (unsigned)(F.bx * 128 + tl);
        F.LIST()[(size_t)e * T + pos] = token; F.LISTW()[(size_t)e * T + pos] = pend_w[tid]; F.TOKSLOT()[(size_t)token * 4 + k] = (e << 16) | pos;
    }
    __syncthreads();
}

DI void load_expert_tables(Frame& F, int layer, int npn) {
    LAS unsigned* ext = (LAS unsigned*)(F.lds + EXT_OFF);
    if (F.tid < 32) ext[F.tid] = __hip_atomic_load(F.ctl() + CW_CNT + 64 * layer + F.tid, __ATOMIC_RELAXED, __HIP_MEMORY_SCOPE_AGENT);
    __syncthreads();
    if (F.tid == 0) { unsigned o = 0, u = 0; for (int e = 0; e < 32; ++e) { const unsigned c = ext[e]; ext[32 + e] = o; ext[64 + e] = u; o += c; u += ((c + 255u) >> 8) * (unsigned)npn; } ext[96] = u; }
    __syncthreads();
}

template <bool FINAL> DI void combine_phase(Frame& F, int layer) {
    load_expert_tables(F, layer, 1);
    const LAS unsigned* offs = (const LAS unsigned*)(F.lds + EXT_OFF) + 32;
    const int gw = F.bx * NWAVES + F.wave, lane = F.lane, b = gw >> 7;
    const float* gate = F.MODV() + ((size_t)(layer * 2 + 1) * 16 + b) * 3072 + 2048;
    f32x4 G[4];
#pragma unroll
    for (int j = 0; j < 4; ++j) G[j] = *(const f32x4*)(gate + 4 * lane + 256 * j);
    f32x4 A1[4], B1[4], A2[4], B2[4];
    if (FINAL) {
#pragma unroll
        for (int j = 0; j < 4; ++j) A1[j] = *(const f32x4*)(F.final_g() + 4 * lane + 256 * j);
    } else {
        const float* m2 = F.MODV() + ((size_t)2 * 16 + b) * 3072; load_mod(F.norm_g() + 2 * D, m2 + 1024, m2, lane, A1, B1);
        const float* m4 = F.MODV() + (size_t)4 * 16 * 3072 + (size_t)b * 2048; load_mod(F.kv_norm_g(), m4 + 1024, m4, lane, A2, B2);
    }
    for (int rr = 0; rr < 16; ++rr) {
        const size_t row = (size_t)gw * 16 + rr;
        const u32x4 ts = *(const u32x4*)(F.TOKSLOT() + row * 4);
        const unsigned sl[4] = {offs[ts.x >> 16] + (ts.x & 0xffffu), offs[ts.y >> 16] + (ts.y & 0xffffu), offs[ts.z >> 16] + (ts.z & 0xffffu), offs[ts.w >> 16] + (ts.w & 0xffffu)};
        f32x4 y[4];
#pragma unroll
        for (int j = 0; j < 4; ++j) y[j] = (f32x4){0.f, 0.f, 0.f, 0.f};
#pragma unroll
        for (int k = 0; k < 4; ++k)
#pragma unroll
            for (int j = 0; j < 4; ++j) { const u32x2 o = *(const u32x2*)(F.OUTB() + (size_t)sl[k] * D + 4 * lane + 256 * j);
                y[j].x += bf_lo(o.x); y[j].y += bf_hi(o.x); y[j].z += bf_lo(o.y); y[j].w += bf_hi(o.y); }
        f32x4 h[4];
#pragma unroll
        for (int j = 0; j < 4; ++j) h[j] = *(const f32x4*)(F.H() + row * D + 4 * lane + 256 * j) + G[j] * y[j];
        const float rstd = 1.0f / sqrtf(row_ss(h) * (1.f / D) + NORM_EPS);
        if (FINAL) {
#pragma unroll
            for (int j = 0; j < 4; ++j) *(f32x4*)(F.out() + row * D + 4 * lane + 256 * j) = h[j] * rstd * A1[j];
        } else {
#pragma unroll
            for (int j = 0; j < 4; ++j) *(f32x4*)(F.H() + row * D + 4 * lane + 256 * j) = h[j];
            f32x4 ya[4], yb[4];
#pragma unroll
            for (int j = 0; j < 4; ++j) { const f32x4 n = h[j] * rstd; ya[j] = n * A1[j] + B1[j]; yb[j] = n * A2[j] + B2[j]; }
            store_bf16_row(F.HN() + row * D, lane, ya); store_bf16_row(F.HN2() + row * D, lane, yb);
        }
    }
}
namespace pg8 {
constexpr int BM = 256, BK = 64, HALF = 128, HTB = HALF * BK * 2, STAGE_BYTES = 8 * HTB, KD = 1024;
DI int lds_byte(int r, int c) { const int st = (r >> 4) * 2 + (c >> 5), rr = r & 15, cc = c & 31, ob = rr * 64 + cc * 2; return st * 1024 + (ob ^ (((ob >> 9) & 1) << 5)); }
DI void stage_rc(int b, int& R, int& C) { const int st = b / 1024, sb = b % 1024, swz = sb ^ (((sb >> 9) & 1) << 5); R = (st >> 1) * 16 + swz / 64; C = (st & 1) * 32 + (swz % 64) / 2; }
DI int perm32(int rho) { const int n = rho >> 4, i = rho & 15; return 8 * (i >> 2) + 4 * n + (i & 3); }

struct Unit {
    const char* A;
    const char* B0;
    unsigned bh;
    int type, r0, c0, nvalid, aux;
};

template <class Pol>
DI void gemm_phase(LAS unsigned char* lds, const Pol& P, int wave_id, int lane_id) {
    const int wid = wave_id, lane = lane_id, tid = wid * 64 + lane, wr = wid >> 2, wc = wid & 3, fr = lane & 15, fq = lane >> 4;
    constexpr int K = KD, nt = K / BK;
    unsigned voffB[2];
#pragma unroll
    for (int i = 0; i < 2; ++i) { int R, C; stage_rc(tid * 16 + i * 8192, R, C); const int Rb = Pol::PERM ? ((R & ~31) + perm32(R & 31)) : R; voffB[i] = (unsigned)(Rb * K + C) * 2u; }
    const size_t kstep = (size_t)(BK * 2);
    const unsigned ldsw = (unsigned)wid * 1024u;
    const int aoff = lds_byte(wr * 64 + fr, fq * 8), boff = lds_byte(wc * 32 + fr, fq * 8);
#define PG8_SA(b, h) (((b) * 2 + (h)) * HTB)
#define PG8_SB(b, h) ((4 + (b) * 2 + (h)) * HTB)
#define PG8_STAGE_A(bufoff, gbase, va, h) do { _Pragma("unroll") for (int _i = 0; _i < 2; ++_i) \
        __builtin_amdgcn_global_load_lds((const unsigned*)((const char*)(gbase) + (va)[h][_i]), (LAS unsigned*)(lds + (bufoff) + ldsw + _i * 8192), 16, 0, 0); } while (0)
#define PG8_STAGE_B(bufoff, gbase) do { _Pragma("unroll") for (int _i = 0; _i < 2; ++_i) \
        __builtin_amdgcn_global_load_lds((const unsigned*)((const char*)(gbase) + voffB[_i]), (LAS unsigned*)(lds + (bufoff) + ldsw + _i * 8192), 16, 0, 0); } while (0)
#define PG8_LDA(dst, b, h) do { _Pragma("unroll") for (int m = 0; m < 4; ++m) _Pragma("unroll") for (int k = 0; k < 2; ++k) dst[m][k] = *(const LAS bf16x8*)(lds + PG8_SA(b, h) + aoff + m * 2048 + k * 1024); } while (0)
#define PG8_LDB(dst, b, h) do { _Pragma("unroll") for (int n = 0; n < 2; ++n) _Pragma("unroll") for (int k = 0; k < 2; ++k) dst[n][k] = *(const LAS bf16x8*)(lds + PG8_SB(b, h) + boff + n * 2048 + k * 1024); } while (0)
#define PG8_MMA(ai, bj, At, Bt) do { __builtin_amdgcn_s_setprio(1); _Pragma("unroll") for (int m = 0; m < 4; ++m) _Pragma("unroll") for (int n = 0; n < 2; ++n) _Pragma("unroll") for (int k = 0; k < 2; ++k) \
        acc[ai][bj][m][n] = __builtin_amdgcn_mfma_f32_16x16x32_bf16(Bt[n][k], At[m][k], acc[ai][bj][m][n], 0, 0, 0); __builtin_amdgcn_s_setprio(0); } while (0)
#define PG8_WAIT_V(n) asm volatile("s_waitcnt vmcnt(" #n ")" ::: "memory")
#define PG8_WAIT_L(n) asm volatile("s_waitcnt lgkmcnt(" #n ")" ::: "memory")
#define PG8_BAR __builtin_amdgcn_s_barrier()
#define PG8_SCHED __builtin_amdgcn_sched_barrier(0)
    Unit cur, nxt; int ui = 0;
    if (!P.next(0, cur)) return;
    unsigned vaC[2][2], vaN[2][2];
    P.aoff(cur, wid * 64, tid, vaC);
    bool has_next = P.next(1, nxt);
    if (has_next) P.aoff(nxt, wid * 64, tid, vaN);
    else { vaN[0][0] = vaC[0][0]; vaN[0][1] = vaC[0][1]; vaN[1][0] = vaC[1][0]; vaN[1][1] = vaC[1][1]; }
    if (Pol::GATHER) asm volatile("" : "+v"(vaC[0][0]), "+v"(vaC[0][1]), "+v"(vaC[1][0]), "+v"(vaC[1][1]), "+v"(vaN[0][0]), "+v"(vaN[0][1]), "+v"(vaN[1][0]), "+v"(vaN[1][1]));
    f32x4 acc[2][2][4][2];
#pragma unroll
    for (int a = 0; a < 2; ++a)
#pragma unroll
        for (int b = 0; b < 2; ++b)
#pragma unroll
            for (int m = 0; m < 4; ++m)
#pragma unroll
                for (int n = 0; n < 2; ++n) acc[a][b][m][n] = (f32x4){0.f, 0.f, 0.f, 0.f};
    bf16x8 At[4][2], B0[2][2], B1[2][2];
    const char* cA = cur.A; const char* cB = cur.B0; unsigned cbh = cur.bh;
    PG8_STAGE_B(PG8_SB(0, 0), cB); PG8_STAGE_A(PG8_SA(0, 0), cA, vaC, 0); PG8_STAGE_B(PG8_SB(0, 1), cB + cbh); PG8_STAGE_A(PG8_SA(0, 1), cA, vaC, 1);
    if (wr == 1) PG8_BAR;
    PG8_WAIT_V(4); PG8_BAR;
    PG8_STAGE_B(PG8_SB(1, 0), cB + kstep); PG8_STAGE_A(PG8_SA(1, 0), cA + kstep, vaC, 0); PG8_STAGE_B(PG8_SB(1, 1), cB + cbh + kstep);
    PG8_WAIT_V(6); PG8_BAR;
    for (;;) {
        const char* nA = has_next ? nxt.A : cA; const char* nB = has_next ? nxt.B0 : cB; const unsigned nbh = has_next ? nxt.bh : cbh;
        for (int t = 0; t < nt; t += 2) {
            const bool last = (t == nt - 2);
            const char* a1 = cA + (size_t)(t + 1) * kstep;
            const char* a2 = last ? nA : cA + (size_t)(t + 2) * kstep; const char* b2 = last ? nB : cB + (size_t)(t + 2) * kstep;
            const char* a3 = a2 + kstep; const char* b3 = b2 + kstep;
            const unsigned bh2 = last ? nbh : cbh;
            unsigned va2[2][2];
            if (Pol::GATHER) { va2[0][0] = last ? vaN[0][0] : vaC[0][0]; va2[0][1] = last ? vaN[0][1] : vaC[0][1]; va2[1][0] = last ? vaN[1][0] : vaC[1][0]; va2[1][1] = last ? vaN[1][1] : vaC[1][1]; }
            else { va2[0][0] = vaC[0][0]; va2[0][1] = vaC[0][1]; va2[1][0] = vaC[1][0]; va2[1][1] = vaC[1][1]; }
            PG8_LDB(B0, 0, 0); PG8_SCHED; PG8_LDA(At, 0, 0); PG8_STAGE_A(PG8_SA(1, 1), a1, vaC, 1);
            PG8_WAIT_L(8); PG8_BAR; PG8_WAIT_L(0); PG8_MMA(0, 0, At, B0); PG8_BAR; PG8_SCHED;
            PG8_LDB(B1, 0, 1); PG8_STAGE_B(PG8_SB(0, 0), b2);
            PG8_BAR; PG8_WAIT_L(0); PG8_MMA(0, 1, At, B1); PG8_BAR;
            PG8_LDA(At, 0, 1); PG8_STAGE_A(PG8_SA(0, 0), a2, va2, 0);
            PG8_BAR; PG8_WAIT_L(0); PG8_MMA(1, 0, At, B0); PG8_BAR; PG8_SCHED;
            PG8_STAGE_B(PG8_SB(0, 1), b2 + bh2);
            PG8_WAIT_V(6); PG8_BAR; PG8_MMA(1, 1, At, B1); PG8_BAR;
            PG8_LDB(B0, 1, 0); PG8_SCHED; PG8_LDA(At, 1, 0); PG8_STAGE_A(PG8_SA(0, 1), a2, va2, 1);
            PG8_WAIT_L(8); PG8_BAR; PG8_WAIT_L(0); PG8_MMA(0, 0, At, B0); PG8_BAR; PG8_SCHED;
            PG8_LDB(B1, 1, 1); PG8_STAGE_B(PG8_SB(1, 0), b3);
            PG8_BAR; PG8_WAIT_L(0); PG8_MMA(0, 1, At, B1); PG8_BAR;
            PG8_LDA(At, 1, 1); PG8_STAGE_A(PG8_SA(1, 0), a3, va2, 0);
            PG8_BAR; PG8_WAIT_L(0); PG8_MMA(1, 0, At, B0); PG8_BAR; PG8_SCHED;
            PG8_STAGE_B(PG8_SB(1, 1), b3 + bh2);
            PG8_WAIT_V(6); PG8_BAR; PG8_MMA(1, 1, At, B1); PG8_BAR;
        }
        P.epi(acc, cur, wr, wc, fr, fq);
        if (!has_next) break;
#pragma unroll
        for (int a = 0; a < 2; ++a)
#pragma unroll
            for (int b = 0; b < 2; ++b)
#pragma unroll
                for (int m = 0; m < 4; ++m)
#pragma unroll
                    for (int n = 0; n < 2; ++n) acc[a][b][m][n] = (f32x4){0.f, 0.f, 0.f, 0.f};
        cur = nxt; cA = nA; cB = nB; cbh = nbh; ++ui;
        vaC[0][0] = vaN[0][0]; vaC[0][1] = vaN[0][1]; vaC[1][0] = vaN[1][0]; vaC[1][1] = vaN[1][1];
        has_next = P.next(ui + 1, nxt);
        if (has_next) { P.aoff(nxt, wid * 64, tid, vaN);
            if (Pol::GATHER) asm volatile("" : "+v"(vaN[0][0]), "+v"(vaN[0][1]), "+v"(vaN[1][0]), "+v"(vaN[1][1])); }
    }
    PG8_WAIT_V(0);
    if (wr == 0) PG8_BAR;
    PG8_BAR;
#undef PG8_SA
#undef PG8_SB
#undef PG8_STAGE_A
#undef PG8_STAGE_B
#undef PG8_LDA
#undef PG8_LDB
#undef PG8_MMA
#undef PG8_WAIT_V
#undef PG8_WAIT_L
#undef PG8_BAR
#undef PG8_SCHED
}
DI void aoff_std(int tid, unsigned (&va)[2][2]) {
#pragma unroll
    for (int i = 0; i < 2; ++i) { int R, C; stage_rc(tid * 16 + i * 8192, R, C);
#pragma unroll
        for (int h = 0; h < 2; ++h) va[h][i] = (unsigned)((h * HALF + R) * KD + C) * 2u; }
}
}

typedef f32x4 AccT[2][2][4][2];

DI void rope8(f32x4& v0, f32x4& v1, const float* rope_row, int fq) {
    const f32x4 c0 = *(const f32x4*)(rope_row), c1 = *(const f32x4*)(rope_row + 4), s0 = *(const f32x4*)(rope_row + 8), s1 = *(const f32x4*)(rope_row + 12);
    f32x4 p0, p1;
#pragma unroll
    for (int i = 0; i < 4; ++i) { p0[i] = __shfl_xor(v0[i], 16); p1[i] = __shfl_xor(v1[i], 16); }
    const float sg = (fq == 0) ? -1.f : 1.f;
    v0 = v0 * c0 + p0 * (s0 * sg); v1 = v1 * c1 + p1 * (s1 * sg);
}
DI void store8_bf16(bf16_t* p, const f32x4& v0, const f32x4& v1) {
    u32x4 w; w.x = pk2(v0[0], v0[1]); w.y = pk2(v0[2], v0[3]); w.z = pk2(v1[0], v1[1]); w.w = pk2(v1[2], v1[3]); *(u32x4*)p = w;
}

struct PolProj0 {
    static constexpr bool PERM = true, GATHER = false;
    const bf16_t *HN, *WINT; bf16_t *Q, *KV, *VT; float* GATES; const float* ROPE; int vcu;
    DI bool next(int i, pg8::Unit& u) const {
        const int L = i * GRID + vcu; if (L >= 1408) return false;
        if (L < 1152) { const int pm = L / 9, pn = L % 9; u.type = 0; u.A = (const char*)(HN + (size_t)pm * 256 * D); u.B0 = (const char*)(WINT + (size_t)pn * 256 * D); u.bh = 128 * D * 2; u.r0 = pm * 256; u.c0 = pn * 256; u.aux = pn; u.nvalid = 256; }
        else { const int l2 = L - 1152, pm = l2 >> 7, pn = l2 & 127; u.type = 1; u.A = (const char*)(WINT + (size_t)(2304 + pm * 256) * D); u.B0 = (const char*)(HN + (size_t)pn * 256 * D); u.bh = 128 * D * 2; u.r0 = pm * 256; u.c0 = pn * 256; u.aux = 0; u.nvalid = 256; }
        return true;
    }
    DI void aoff(const pg8::Unit&, int, int tid, unsigned (&va)[2][2]) const { pg8::aoff_std(tid, va); }
    DI void epi(const AccT& acc, const pg8::Unit& u, int wr, int wc, int fr, int fq) const {
        const int pn = u.aux;
        if (u.type == 1) {
#pragma unroll
            for (int ai = 0; ai < 2; ++ai)
#pragma unroll
                for (int m = 0; m < 4; ++m) { const int row = u.r0 + ai * 128 + wr * 64 + m * 16 + fr;
#pragma unroll
                    for (int bj = 0; bj < 2; ++bj) store8_bf16(VT + (size_t)row * T + u.c0 + bj * 128 + wc * 32 + 8 * fq, acc[ai][bj][m][0], acc[ai][bj][m][1]); }
            return;
        }
        if (pn == 8) {
            if (wc < 2) {
#pragma unroll
                for (int ai = 0; ai < 2; ++ai)
#pragma unroll
                    for (int m = 0; m < 4; ++m) { const int row = u.r0 + ai * 128 + wr * 64 + m * 16 + fr; float* gp = GATES + (size_t)row * 64 + wc * 32 + 8 * fq;
                        f32x4 a = acc[ai][0][m][0], b = acc[ai][0][m][1];
#pragma unroll
                        for (int i = 0; i < 4; ++i) { a[i] = rcpf(1.f + ex2(-a[i] * LOG2E)); b[i] = rcpf(1.f + ex2(-b[i] * LOG2E)); }
                        *(f32x4*)gp = a; *(f32x4*)(gp + 4) = b; }
            }
            return;
        }
        const bool is_q = pn < 4, do_rope = (pn != 4 && pn != 5);
        bf16_t* dst = is_q ? Q + pn * 256 : KV + (pn - 4) * 256;
        const float sc = is_q ? QSCALE : 1.f;
        const bool rl = do_rope && ((wc & 1) == 0) && fq < 2;
#pragma unroll
        for (int ai = 0; ai < 2; ++ai)
#pragma unroll
            for (int m = 0; m < 4; ++m) { const int row = u.r0 + ai * 128 + wr * 64 + m * 16 + fr;
#pragma unroll
                for (int bj = 0; bj < 2; ++bj) { f32x4 v0 = acc[ai][bj][m][0], v1 = acc[ai][bj][m][1];
                    if (do_rope && (wc & 1) == 0) { f32x4 r0 = v0, r1 = v1; rope8(r0, r1, ROPE + (size_t)row * 16, fq); if (rl) { v0 = r0; v1 = r1; } }
                    v0 = v0 * sc; v1 = v1 * sc;
                    store8_bf16(dst + (size_t)row * D + bj * 128 + wc * 32 + 8 * fq, v0, v1); } }
    }
};

struct PolOut {
    static constexpr bool PERM = false, GATHER = false;
    const bf16_t *O, *WT; const float *base, *gate_mv, *bias; float* H; int vcu;
    DI bool next(int i, pg8::Unit& u) const {
        const int L = i * GRID + vcu; if (L >= 512) return false;
        const int pm = L >> 2, pn = L & 3; u.type = 0; u.A = (const char*)(O + (size_t)pm * 256 * D); u.B0 = (const char*)(WT + (size_t)pn * 256 * D); u.bh = 128 * D * 2; u.r0 = pm * 256; u.c0 = pn * 256; u.aux = 0; u.nvalid = 256;
        return true;
    }
    DI void aoff(const pg8::Unit&, int, int tid, unsigned (&va)[2][2]) const { pg8::aoff_std(tid, va); }
    DI void epi(const AccT& acc, const pg8::Unit& u, int wr, int wc, int fr, int fq) const {
        const int b = u.r0 >> 11; const float* gv = gate_mv + (size_t)b * 3072 + 2048;
#pragma unroll
        for (int bj = 0; bj < 2; ++bj)
#pragma unroll
            for (int n = 0; n < 2; ++n) { const int col = u.c0 + bj * 128 + wc * 32 + n * 16 + 4 * fq;
                const f32x4 g = *(const f32x4*)(gv + col); const f32x4 bs = bias ? *(const f32x4*)(bias + col) : (f32x4){0.f, 0.f, 0.f, 0.f};
#pragma unroll
                for (int ai = 0; ai < 2; ++ai)
#pragma unroll
                    for (int m = 0; m < 4; ++m) { const size_t off = (size_t)(u.r0 + ai * 128 + wr * 64 + m * 16 + fr) * D + col;
                        *(f32x4*)(H + off) = *(const f32x4*)(base + off) + g * (acc[ai][bj][m][n] + bs); } }
    }
};

DI bool moe_unit(const LAS unsigned* ext, int L, int npn, int& e, int& mt, int& pn, int& nvalid, unsigned& slot0) {
    if ((unsigned)L >= ext[96]) return false;
    int ee = 0;
    for (int k = 1; k < 32; ++k) ee = ((unsigned)L >= ext[64 + k]) ? k : ee;
    const int local = L - (int)ext[64 + ee]; mt = local / npn; pn = local % npn; e = ee;
    const int cnt = (int)ext[ee]; nvalid = cnt - mt * 256; nvalid = nvalid > 256 ? 256 : nvalid; slot0 = ext[32 + ee] + (unsigned)mt * 256u;
    return true;
}
struct PolGateUp {
    static constexpr bool PERM = true, GATHER = true;
    const bf16_t *HN, *WGUT; const float* bgu; const unsigned* LIST; bf16_t* ACT; const LAS unsigned* ext; int vcu;
    DI bool next(int i, pg8::Unit& u) const {
        int e, mt, pn, nv; unsigned s0;
        if (!moe_unit(ext, i * GRID + vcu, 8, e, mt, pn, nv, s0)) return false;
        u.type = mt; u.A = (const char*)HN; u.B0 = (const char*)(WGUT + ((size_t)e * 2048 + pn * 128) * D); u.bh = 1024u * D * 2u; u.r0 = (int)s0; u.c0 = pn * 128; u.nvalid = nv; u.aux = e;
        return true;
    }
    DI void aoff(const pg8::Unit& u, int wbase, int, unsigned (&va)[2][2]) const {
        const unsigned* lp = LIST + (size_t)u.aux * T + (size_t)u.type * 256;
        const int t = wbase | fresh_lane();
#pragma unroll
        for (int i = 0; i < 2; ++i) { int R, C; pg8::stage_rc(t * 16 + i * 8192, R, C);
#pragma unroll
            for (int h = 0; h < 2; ++h) { int r = h * 128 + R; r = r < u.nvalid ? r : u.nvalid - 1; const unsigned tok = lp[r]; va[h][i] = tok * (unsigned)(D * 2) + (unsigned)C * 2u; } }
    }
    DI void epi(const AccT& acc, const pg8::Unit& u, int wr, int wc, int fr, int fq) const {
        const int cb = u.c0 + wc * 32 + 8 * fq; const float* bp = bgu + (size_t)u.aux * 2048;
        const f32x4 bg0 = *(const f32x4*)(bp + cb), bg1 = *(const f32x4*)(bp + cb + 4), bl0 = *(const f32x4*)(bp + 1024 + cb), bl1 = *(const f32x4*)(bp + 1024 + cb + 4);
#pragma unroll
        for (int ai = 0; ai < 2; ++ai)
#pragma unroll
            for (int m = 0; m < 4; ++m) { const int rl = ai * 128 + wr * 64 + m * 16 + fr;
                f32x4 g0 = acc[ai][0][m][0] + bg0, g1 = acc[ai][0][m][1] + bg1, l0 = acc[ai][1][m][0] + bl0, l1 = acc[ai][1][m][1] + bl1, a0, a1;
#pragma unroll
                for (int i = 0; i < 4; ++i) {
                    const float x0 = fminf(g0[i], 7.f), x1 = fminf(g1[i], 7.f), y0 = fminf(fmaxf(l0[i], -7.f), 7.f), y1 = fminf(fmaxf(l1[i], -7.f), 7.f);
                    a0[i] = x0 * rcpf(1.f + ex2(-1.702f * LOG2E * x0)) * (y0 + 1.f); a1[i] = x1 * rcpf(1.f + ex2(-1.702f * LOG2E * x1)) * (y1 + 1.f); }
                if (rl < u.nvalid) store8_bf16(ACT + (size_t)(u.r0 + rl) * D + cb, a0, a1); }
    }
};
struct PolDown {
    static constexpr bool PERM = true, GATHER = false;
    const bf16_t *ACT, *WDNT; const float *bdn, *LISTW; bf16_t* OUTB; const LAS unsigned* ext; int vcu;
    DI bool next(int i, pg8::Unit& u) const {
        int e, mt, pn, nv; unsigned s0;
        if (!moe_unit(ext, i * GRID + vcu, 4, e, mt, pn, nv, s0)) return false;
        u.type = mt; u.A = (const char*)(ACT + (size_t)s0 * D); u.B0 = (const char*)(WDNT + ((size_t)e * 1024 + pn * 256) * D); u.bh = 128 * D * 2; u.r0 = (int)s0; u.c0 = pn * 256; u.nvalid = nv; u.aux = e;
        return true;
    }
    DI void aoff(const pg8::Unit&, int, int tid, unsigned (&va)[2][2]) const { pg8::aoff_std(tid, va); }
    DI void epi(const AccT& acc, const pg8::Unit& u, int wr, int wc, int fr, int fq) const {
        const float* bp = bdn + (size_t)u.aux * 1024; const float* wp = LISTW + (size_t)u.aux * T + (size_t)u.type * 256;
#pragma unroll
        for (int ai = 0; ai < 2; ++ai)
#pragma unroll
            for (int m = 0; m < 4; ++m) { const int rl = ai * 128 + wr * 64 + m * 16 + fr;
                if (rl < u.nvalid) { const float w = wp[rl];
#pragma unroll
                    for (int bj = 0; bj < 2; ++bj) { const int col = u.c0 + bj * 128 + wc * 32 + 8 * fq;
                        const f32x4 b0 = *(const f32x4*)(bp + col), b1 = *(const f32x4*)(bp + col + 4);
                        store8_bf16(OUTB + (size_t)(u.r0 + rl) * D + col, (acc[ai][bj][m][0] + b0) * w, (acc[ai][bj][m][1] + b1) * w); } } }
    }
};

struct PolProj1 {
    static constexpr bool PERM = true, GATHER = false;
    const bf16_t *HN, *HN2, *WBQT, *WKVT; const float *bq, *kvb, *ROPE; bf16_t *Q, *K1, *VT1; int vcu;
    DI bool next(int i, pg8::Unit& u) const {
        const int L = i * GRID + vcu; if (L >= 768) return false;
        u.bh = 128 * D * 2; u.nvalid = 256; u.aux = 0;
        if (L < 512) { const int pm = L >> 2, pn = L & 3; u.type = 0; u.A = (const char*)(HN + (size_t)pm * 256 * D); u.B0 = (const char*)(WBQT + (size_t)pn * 256 * D); u.r0 = pm * 256; u.c0 = pn * 256; }
        else if (L < 640) { const int pm = L - 512; u.type = 1; u.A = (const char*)(HN2 + (size_t)pm * 256 * D); u.B0 = (const char*)WKVT; u.r0 = pm * 256; u.c0 = 0; }
        else { const int pn = L - 640; u.type = 2; u.A = (const char*)WKVT; u.B0 = (const char*)(HN2 + (size_t)pn * 256 * D); u.r0 = 0; u.c0 = pn * 256; }
        return true;
    }
    DI void aoff(const pg8::Unit&, int, int tid, unsigned (&va)[2][2]) const { pg8::aoff_std(tid, va); }
    DI void epi(const AccT& acc, const pg8::Unit& u, int wr, int wc, int fr, int fq) const {
        if (u.type == 2) {
#pragma unroll
            for (int m = 0; m < 4; ++m) { const int vrow = wr * 64 + m * 16 + fr; const float bs = kvb[128 + vrow];
#pragma unroll
                for (int bj = 0; bj < 2; ++bj) store8_bf16(VT1 + (size_t)vrow * T + u.c0 + bj * 128 + wc * 32 + 8 * fq, acc[1][bj][m][0] + bs, acc[1][bj][m][1] + bs); }
            return;
        }
        const bool isq = (u.type == 0); const bool rl = ((wc & 1) == 0) && fq < 2; const float sc = isq ? QSCALE : 1.f;
#pragma unroll
        for (int bj = 0; bj < 2; ++bj) {
            if (!isq && bj == 1) continue;
            const int ct = bj * 128 + wc * 32 + 8 * fq; const float* bp = isq ? bq + u.c0 + ct : kvb + ct;
            const f32x4 b0 = *(const f32x4*)bp, b1 = *(const f32x4*)(bp + 4);
#pragma unroll
            for (int ai = 0; ai < 2; ++ai)
#pragma unroll
                for (int m = 0; m < 4; ++m) { const int row = u.r0 + ai * 128 + wr * 64 + m * 16 + fr;
                    f32x4 v0 = acc[ai][bj][m][0] + b0, v1 = acc[ai][bj][m][1] + b1;
                    if ((wc & 1) == 0) { f32x4 r0 = v0, r1 = v1; rope8(r0, r1, ROPE + (size_t)row * 16, fq); if (rl) { v0 = r0; v1 = r1; } }
                    v0 = v0 * sc; v1 = v1 * sc;
                    if (isq) store8_bf16(Q + (size_t)row * D + u.c0 + ct, v0, v1); else store8_bf16(K1 + (size_t)row * 128 + ct, v0, v1); } }
    }
};
DI float gelu_tanh(float z) {
    const float u = 0.7978845608028654f * (z + 0.044715f * z * z * z);
    const float e = ex2(2.f * LOG2E * u);
    const float th = 1.f - 2.f * rcpf(e + 1.f);
    return 0.5f * z * (1.f + th);
}
DI void compress_phase(Frame& F) {
    const int lane = F.lane, r = lane & 31, h = lane >> 5, quad = F.wave >> 2, q = F.wave & 3;
    const int rb = F.bx * 2 + quad, kv = rb >> 8, rem = rb & 255, b = rem >> 4, g = (rem >> 2) & 3, nb = rem & 3;
    const int n = nb * 32 + r, nn = n < 126 ? n : 126;
    LAS unsigned char* hid = F.lds + quad * (32 * 272);
    const bf16_t* w1p = F.CW1T() + ((size_t)kv * 128 + 32 * q + r) * 2048 + 8 * h;
    const bf16_t* xp = F.KV() + ((size_t)(b * SEQ + 16 * nn)) * D + kv * 256 + g * 64 + 8 * h;
    f32x16 acc;
#pragma unroll
    for (int i = 0; i < 16; ++i) acc[i] = 0.f;
#pragma unroll 4
    for (int ks = 0; ks < 128; ++ks) {
        const bf16x8 a = *(const bf16x8*)(w1p + 16 * ks);
        const bf16x8 bb = *(const bf16x8*)(xp + (size_t)(ks >> 2) * D + (ks & 3) * 16);
        acc = MFMA32(a, bb, acc);
    }
    {
        const float* cb = F.CMPB() + kv * 128 + 32 * q;
#pragma unroll
        for (int q4 = 0; q4 < 4; ++q4) {
            float v[4];
#pragma unroll
            for (int i = 0; i < 4; ++i) v[i] = gelu_tanh(acc[4 * q4 + i] + cb[8 * q4 + 4 * h + i]);
            u32x2 o; o.x = pk2(v[0], v[1]); o.y = pk2(v[2], v[3]);
            *(LAS u32x2*)(hid + r * 272 + (32 * q + 8 * q4 + 4 * h) * 2) = o;
        }
    }
    __syncthreads();
    if (q < 2) {
        const int db = q;
        f32x16 o2;
#pragma unroll
        for (int i = 0; i < 16; ++i) o2[i] = 0.f;
        const bf16_t* w2p = F.CW2T() + ((size_t)kv * 64 + 32 * db + r) * 128 + 8 * h;
#pragma unroll
        for (int s = 0; s < 8; ++s) {
            const bf16x8 a = *(const bf16x8*)(w2p + 16 * s);
            const bf16x8 bb = *(const LAS bf16x8*)(hid + r * 272 + (16 * s + 8 * h) * 2);
            o2 = MFMA32(a, bb, o2);
        }
        const bool valid = n < 127;
        if (kv == 0) {
            if (db == 0) {
                const float* rp = F.ROPE() + (size_t)(b * SEQ + 16 * nn + 31) * 16 + 4 * h;
                const f32x4 c = *(const f32x4*)rp, sn = *(const f32x4*)(rp + 8);
#pragma unroll
                for (int i = 0; i < 4; ++i) { const float x1 = o2[i], x2 = o2[4 + i]; o2[i] = x1 * c[i] - x2 * sn[i]; o2[4 + i] = x2 * c[i] + x1 * sn[i]; }
            }
            bf16_t* kp = F.KC() + ((size_t)((b * 4 + g) * 128 + n)) * 64 + 32 * db + 4 * h;
#pragma unroll
            for (int q4 = 0; q4 < 4; ++q4) { u32x2 o; o.x = valid ? pk2(o2[4 * q4], o2[4 * q4 + 1]) : 0u; o.y = valid ? pk2(o2[4 * q4 + 2], o2[4 * q4 + 3]) : 0u; *(u32x2*)(kp + 8 * q4) = o; }
        } else {
#pragma unroll
            for (int i = 0; i < 16; ++i) { const int d = 32 * db + crow(i, h);
                F.VCT()[((size_t)((b * 4 + g) * 64 + d)) * 128 + n] = valid ? (bf16_t)(pk2(o2[i], 0.f) & 0xffffu) : (bf16_t)0; }
        }
    }
    __syncthreads();
}

constexpr int AT_KT = 0, AT_VT = 18432, AT_KC = 35840, AT_VC = 54272, AT_IMPP = 71168, AT_IMPS = 103936, AT_SELM = 112128;
#define NEG_INF (-INFINITY)

DI void tile_step(const LAS unsigned char* kt, const LAS unsigned char* vt, const bf16x8 (&qf)[4], f32x16 (&O)[2], float& m, float& l, int lo, int hi, bool needmask, int r, int h) {
    f32x16 s0, s1;
#pragma unroll
    for (int i = 0; i < 16; ++i) { s0[i] = 0.f; s1[i] = 0.f; }
    const LAS unsigned char* kp = kt + r * 144 + h * 16;
#pragma unroll
    for (int s = 0; s < 4; ++s) {
        const bf16x8 a0 = *(const LAS bf16x8*)(kp + s * 32), a1 = *(const LAS bf16x8*)(kp + 32 * 144 + s * 32);
        s0 = MFMA32(a0, qf[s], s0); s1 = MFMA32(a1, qf[s], s1);
    }
    __builtin_amdgcn_sched_barrier(0);
    if (needmask) {
#pragma unroll
        for (int i = 0; i < 16; ++i) { const int kk = crow(i, h);
            s0[i] = (kk > lo && kk <= hi) ? s0[i] : NEG_INF; s1[i] = (kk + 32 > lo && kk + 32 <= hi) ? s1[i] : NEG_INF; }
    }
    float mx = NEG_INF;
#pragma unroll
    for (int i = 0; i < 16; ++i) mx = fmaxf(mx, fmaxf(s0[i], s1[i]));
    mx = fmaxf(mx, __shfl_xor(mx, 32));
    const float mn = fmaxf(m, mx), mu = (mn == NEG_INF) ? 0.f : mn;
    const float alpha = ex2(m - mu);
    float ls = 0.f;
#pragma unroll
    for (int i = 0; i < 16; ++i) { s0[i] = ex2(s0[i] - mu); s1[i] = ex2(s1[i] - mu); ls += s0[i] + s1[i]; }
    l = l * alpha + ls; m = mn;
#pragma unroll
    for (int i = 0; i < 16; ++i) { O[0][i] *= alpha; O[1][i] *= alpha; }
    bf16x8 pb[2][2];
#pragma unroll
    for (int s2 = 0; s2 < 2; ++s2) {
        u32x4 p0, p1;
        p0.x = pk2(s0[8 * s2 + 0], s0[8 * s2 + 1]); p0.y = pk2(s0[8 * s2 + 2], s0[8 * s2 + 3]); p0.z = pk2(s0[8 * s2 + 4], s0[8 * s2 + 5]); p0.w = pk2(s0[8 * s2 + 6], s0[8 * s2 + 7]);
        p1.x = pk2(s1[8 * s2 + 0], s1[8 * s2 + 1]); p1.y = pk2(s1[8 * s2 + 2], s1[8 * s2 + 3]); p1.z = pk2(s1[8 * s2 + 4], s1[8 * s2 + 5]); p1.w = pk2(s1[8 * s2 + 6], s1[8 * s2 + 7]);
        pb[0][s2] = __builtin_bit_cast(bf16x8, p0); pb[1][s2] = __builtin_bit_cast(bf16x8, p1);
    }
    __builtin_amdgcn_sched_barrier(0);
    const LAS unsigned char* vp = vt + r * 136 + h * 8;
#pragma unroll
    for (int db = 0; db < 2; ++db)
#pragma unroll
        for (int kb = 0; kb < 2; ++kb)
#pragma unroll
            for (int s2 = 0; s2 < 2; ++s2) {
                const LAS unsigned char* a = vp + db * 32 * 136 + kb * 64 + s2 * 32;
                const s16x4 lo4 = *(const LAS s16x4*)a, hi4 = *(const LAS s16x4*)(a + 16);
                const bf16x8 va = __builtin_shufflevector(lo4, hi4, 0, 1, 2, 3, 4, 5, 6, 7);
                O[db] = MFMA32(va, pb[kb][s2], O[db]);
            }
}

#define AT_WRITE(buf, kreg, vreg) do { *(LAS u32x4*)(lds + AT_KT + (buf) * 9216 + (tid >> 3) * 144 + (tid & 7) * 16) = (kreg); \
        LAS u32x2* _vp = (LAS u32x2*)(lds + AT_VT + (buf) * 8704 + (tid >> 3) * 136 + (tid & 7) * 16); _vp[0] = (u32x2){(vreg).x, (vreg).y}; _vp[1] = (u32x2){(vreg).z, (vreg).w}; } while (0)

DI void nsa_attn_phase(Frame& F) {
    LAS unsigned char* lds = F.lds;
    const int tid = F.tid, lane = F.lane, wave = F.wave, r = lane & 31, h = lane >> 5, hh = wave & 3, th = wave >> 2;
    const int bg = F.bx & 63, b = bg >> 2, g = bg & 3, s4 = F.bx >> 6;
    LAS float* impP = (LAS float*)(lds + AT_IMPP);
    LAS float* impS = (LAS float*)(lds + AT_IMPS);
    LAS unsigned* selm = (LAS unsigned*)(lds + AT_SELM);
    const int head = g * 4 + hh, tl = th * 32 + r;
    for (int ui = 0; ui < 8; ++ui) {
        const int pp = s4 + 4 * (ui >> 1), qt = (ui & 1) ? 31 - pp : pp;
        const int t = qt * 64 + tl; const size_t tokrow = (size_t)b * SEQ + t;
        bf16x8 qf[4];
#pragma unroll
        for (int s = 0; s < 4; ++s) qf[s] = *(const bf16x8*)(F.Q() + tokrow * D + head * 64 + 16 * s + 8 * h);
        const float gc = F.GATES()[tokrow * 64 + head * 3 + 0], gs = F.GATES()[tokrow * 64 + head * 3 + 1], gw = F.GATES()[tokrow * 64 + head * 3 + 2];
#pragma unroll
        for (int i = 0; i < 2; ++i) { const int idx = tid + 512 * i, row = idx >> 3, ch = idx & 7;
            *(LAS u32x4*)(lds + AT_KC + row * 144 + ch * 16) = *(const u32x4*)(F.KC() + ((size_t)((b * 4 + g) * 128 + row)) * 64 + ch * 8); }
#pragma unroll
        for (int i = 0; i < 2; ++i) { const int idx = tid + 512 * i, d = idx >> 4, ch = idx & 15;
            const u32x4 v = *(const u32x4*)(F.VCT() + ((size_t)((b * 4 + g) * 64 + d)) * 128 + ch * 8);
            LAS u32x2* vp = (LAS u32x2*)(lds + AT_VC + d * 264 + ch * 16); vp[0] = (u32x2){v.x, v.y}; vp[1] = (u32x2){v.z, v.w}; }
        if (tid < 64) selm[tid] = 0u;
        __syncthreads();
        f32x16 Ot[2];
#pragma unroll
        for (int i = 0; i < 16; ++i) { Ot[0][i] = 0.f; Ot[1][i] = 0.f; }
#ifndef NO_CMP
        {
            const int nmax = (t - 31) >> 4;
            float mrun = NEG_INF, lrun = 0.f;
#pragma unroll 1
            for (int kb = 0; kb < 4; ++kb) {
                f32x16 sc;
#pragma unroll
                for (int i = 0; i < 16; ++i) sc[i] = 0.f;
#pragma unroll
                for (int s = 0; s < 4; ++s) { const bf16x8 a = *(const LAS bf16x8*)(lds + AT_KC + (kb * 32 + r) * 144 + s * 32 + h * 16); sc = MFMA32(a, qf[s], sc); }
                float bm = NEG_INF;
#pragma unroll
                for (int i = 0; i < 16; ++i) { const int nn = kb * 32 + crow(i, h); sc[i] = (nn <= nmax) ? sc[i] : NEG_INF; bm = fmaxf(bm, sc[i]); }
                const float mn = fmaxf(mrun, bm), mu = (mn == NEG_INF) ? 0.f : mn;
                float ls = 0.f;
#pragma unroll
                for (int i = 0; i < 16; ++i) ls += ex2(sc[i] - mu);
                lrun = lrun * ex2(mrun - mu) + ls; mrun = mn;
            }
            float mu, inv;
            { const float mo = __shfl_xor(mrun, 32), lo_ = __shfl_xor(lrun, 32); const float mt = fmaxf(mrun, mo); mu = (mt == NEG_INF) ? 0.f : mt;
              const float lt = lrun * ex2(mrun - mu) + lo_ * ex2(mo - mu); inv = lt > 0.f ? 1.f / lt : 0.f; }
            f32x16 Oc[2];
#pragma unroll
            for (int i = 0; i < 16; ++i) { Oc[0][i] = 0.f; Oc[1][i] = 0.f; }
            LAS float* ip = impP + ((hh * 64 + tl) * 32);
            float carry = 0.f;
#pragma unroll 1
            for (int kb = 0; kb < 4; ++kb) {
                f32x16 sc;
#pragma unroll
                for (int i = 0; i < 16; ++i) sc[i] = 0.f;
#pragma unroll
                for (int s = 0; s < 4; ++s) { const bf16x8 a = *(const LAS bf16x8*)(lds + AT_KC + (kb * 32 + r) * 144 + s * 32 + h * 16); sc = MFMA32(a, qf[s], sc); }
#pragma unroll
                for (int i = 0; i < 16; ++i) { const int nn = kb * 32 + crow(i, h); sc[i] = (nn <= nmax) ? ex2(sc[i] - mu) * inv : 0.f; }
                float Lo[4];
#pragma unroll
                for (int q4 = 0; q4 < 4; ++q4) Lo[q4] = __shfl_xor(sc[4 * q4 + 3], 32);
#pragma unroll
                for (int q4 = 0; q4 < 4; ++q4) {
                    const float G = (sc[4 * q4] + sc[4 * q4 + 1]) + (sc[4 * q4 + 2] + sc[4 * q4 + 3]);
                    const float prev0 = (q4 > 0) ? Lo[q4 > 0 ? q4 - 1 : 0] : carry;
                    const float Lp = (h == 1) ? Lo[q4] : prev0;
                    ip[8 * kb + 2 * q4 + h] = G + Lp;
                }
                carry = Lo[3];
#pragma unroll
                for (int s2 = 0; s2 < 2; ++s2) {
                    u32x4 p;
                    p.x = pk2(sc[8 * s2 + 0], sc[8 * s2 + 1]); p.y = pk2(sc[8 * s2 + 2], sc[8 * s2 + 3]); p.z = pk2(sc[8 * s2 + 4], sc[8 * s2 + 5]); p.w = pk2(sc[8 * s2 + 6], sc[8 * s2 + 7]);
                    const bf16x8 pb = __builtin_bit_cast(bf16x8, p);
#pragma unroll
                    for (int db = 0; db < 2; ++db) {
                        const LAS unsigned char* a = lds + AT_VC + (db * 32 + r) * 264 + (kb * 32 + 16 * s2 + 4 * h) * 2;
                        const s16x4 lo4 = *(const LAS s16x4*)a, hi4 = *(const LAS s16x4*)(a + 16);
                        const bf16x8 va = __builtin_shufflevector(lo4, hi4, 0, 1, 2, 3, 4, 5, 6, 7);
                        Oc[db] = MFMA32(va, pb, Oc[db]);
                    }
                }
            }
#pragma unroll
            for (int i = 0; i < 16; ++i) { Ot[0][i] = gc * Oc[0][i]; Ot[1][i] = gc * Oc[1][i]; }
        }
#endif
        __syncthreads();
        {
            const int tok = tid >> 3, sub = tid & 7;
#pragma unroll
            for (int jj = 0; jj < 4; ++jj) { const int j = sub * 4 + jj;
                impS[tok * 32 + j] = ((impP[(0 * 64 + tok) * 32 + j] + impP[(1 * 64 + tok) * 32 + j]) + impP[(2 * 64 + tok) * 32 + j]) + impP[(3 * 64 + tok) * 32 + j]; }
        }
        __syncthreads();
#ifndef NO_TOPK
        {
            const int tok = tid >> 3, sub = tid & 7;
            if (qt < 16) { if (sub == 0) selm[tok] = (2u << qt) - 1u; }
            else {
                float vj[4]; int rank[4];
#pragma unroll
                for (int jj = 0; jj < 4; ++jj) { vj[jj] = impS[tok * 32 + sub * 4 + jj]; rank[jj] = 0; }
#pragma unroll 1
                for (int i = 1; i <= qt - 2; ++i) { const float vi = impS[tok * 32 + i];
#pragma unroll
                    for (int jj = 0; jj < 4; ++jj) { const int j = sub * 4 + jj; rank[jj] += ((vi > vj[jj]) || (vi == vj[jj] && i < j)) ? 1 : 0; } }
                unsigned bits = 0u;
#pragma unroll
                for (int jj = 0; jj < 4; ++jj) { const int j = sub * 4 + jj;
                    const bool forced = (j == 0 || j == qt || j == qt - 1);
                    const bool sel = forced || (j <= qt - 2 && rank[jj] < 13);
                    bits |= sel ? (1u << j) : 0u; }
                if (bits) __hip_atomic_fetch_or(selm + tok, bits, __ATOMIC_RELAXED, __HIP_MEMORY_SCOPE_WORKGROUP);
            }
        }
#endif
        __syncthreads();
        LAS float* park = (LAS float*)(lds + AT_KC) + wave * 2048 + lane;
#pragma unroll
        for (int i = 0; i < 16; ++i) { park[i * 64] = Ot[0][i]; park[(16 + i) * 64] = Ot[1][i]; }
        const unsigned myselm = selm[tl];
        unsigned need;
        { unsigned w = selm[lane];
#pragma unroll
            for (int o = 1; o < 64; o <<= 1) w |= (unsigned)__shfl_xor((int)w, o);
            need = (unsigned)__builtin_amdgcn_readfirstlane((int)w) & ((2u << qt) - 1u); }
#ifndef NO_SEL
        {
            f32x16 O[2];
#pragma unroll
            for (int i = 0; i < 16; ++i) { O[0][i] = 0.f; O[1][i] = 0.f; }
            float m = NEG_INF, l = 0.f;
            const bf16_t* kbase = F.KV() + ((size_t)b * SEQ + (tid >> 3)) * D + 512 + g * 64 + (tid & 7) * 8;
            const bf16_t* vbase = F.VT() + ((size_t)(g * 64 + (tid >> 3))) * T + (size_t)b * SEQ + (tid & 7) * 8;
            int j = __builtin_ctz(need); int buf = 0;
            u32x4 kr = *(const u32x4*)(kbase + (size_t)(64 * j) * D), vr = *(const u32x4*)(vbase + 64 * j);
            AT_WRITE(0, kr, vr);
            __syncthreads();
            for (;;) {
                const unsigned rest = need & ~((2u << j) - 1u); const int jn = rest ? __builtin_ctz(rest) : -1;
                if (jn >= 0) { kr = *(const u32x4*)(kbase + (size_t)(64 * jn) * D); vr = *(const u32x4*)(vbase + 64 * jn); }
                const bool allow = (myselm >> j) & 1u;
                const int hi = allow ? ((j == qt) ? tl : 63) : -1;
                const bool nm = !__all(hi >= 63);
                tile_step(lds + AT_KT + buf * 9216, lds + AT_VT + buf * 8704, qf, O, m, l, -1, hi, nm, r, h);
                if (jn >= 0) AT_WRITE(buf ^ 1, kr, vr);
                __syncthreads();
                if (jn < 0) break;
                j = jn; buf ^= 1;
            }
            l += __shfl_xor(l, 32);
            const float sc = l > 0.f ? gs / l : 0.f;
#pragma unroll
            for (int i = 0; i < 16; ++i) { park[i * 64] += sc * O[0][i]; park[(16 + i) * 64] += sc * O[1][i]; }
        }
#endif
#ifndef NO_SWA
        {
            f32x16 O[2];
#pragma unroll
            for (int i = 0; i < 16; ++i) { O[0][i] = 0.f; O[1][i] = 0.f; }
            float m = NEG_INF, l = 0.f;
            const bf16_t* kbase = F.KV() + ((size_t)b * SEQ + (tid >> 3)) * D + 768 + g * 64 + (tid & 7) * 8;
            const bf16_t* vbase = F.VT() + ((size_t)(256 + g * 64 + (tid >> 3))) * T + (size_t)b * SEQ + (tid & 7) * 8;
            const int j0 = qt > 8 ? qt - 8 : 0;
            int j = j0, buf = 0;
            u32x4 kr = *(const u32x4*)(kbase + (size_t)(64 * j) * D), vr = *(const u32x4*)(vbase + 64 * j);
            AT_WRITE(0, kr, vr);
            __syncthreads();
            for (;;) {
                const int jn = (j < qt) ? j + 1 : -1;
                if (jn >= 0) { kr = *(const u32x4*)(kbase + (size_t)(64 * jn) * D); vr = *(const u32x4*)(vbase + 64 * jn); }
                const int hi = 64 * (qt - j) + tl, lo = hi - 512;
                const bool nm = (j == qt) || (j == qt - 8);
                tile_step(lds + AT_KT + buf * 9216, lds + AT_VT + buf * 8704, qf, O, m, l, lo, hi, nm, r, h);
                if (jn >= 0) AT_WRITE(buf ^ 1, kr, vr);
                __syncthreads();
                if (jn < 0) break;
                j = jn; buf ^= 1;
            }
            l += __shfl_xor(l, 32);
            const float sc = l > 0.f ? gw / l : 0.f;
#pragma unroll
            for (int i = 0; i < 16; ++i) { Ot[0][i] = park[i * 64] + sc * O[0][i]; Ot[1][i] = park[(16 + i) * 64] + sc * O[1][i]; }
        }
#endif
        {
            bf16_t* op = F.O() + tokrow * D + head * 64 + 4 * h;
#pragma unroll
            for (int db = 0; db < 2; ++db)
#pragma unroll
                for (int q4 = 0; q4 < 4; ++q4) { u32x2 o; o.x = pk2(Ot[db][4 * q4], Ot[db][4 * q4 + 1]); o.y = pk2(Ot[db][4 * q4 + 2], Ot[db][4 * q4 + 3]); *(u32x2*)(op + db * 32 + 8 * q4) = o; }
        }
        __syncthreads();
    }
}

DI void swa_sink_phase(Frame& F) {
    LAS unsigned char* lds = F.lds;
    const int tid = F.tid, lane = F.lane, wave = F.wave, r = lane & 31, h = lane >> 5;
    for (int ui = 0; ui < 8; ++ui) {
        const int u = ui * GRID + F.vcu, q32 = u & 63, kvh = (u >> 6) & 1, b = u >> 7;
        const int head = kvh * 8 + wave, t = q32 * 32 + r; const size_t tokrow = (size_t)b * SEQ + t;
        bf16x8 qf[4];
#pragma unroll
        for (int s = 0; s < 4; ++s) qf[s] = *(const bf16x8*)(F.Q() + tokrow * D + head * 64 + 16 * s + 8 * h);
        f32x16 O[2];
#pragma unroll
        for (int i = 0; i < 16; ++i) { O[0][i] = 0.f; O[1][i] = 0.f; }
        float m = F.b_sinks()[head] * LOG2E, l = (h == 0) ? 1.f : 0.f;
        const bf16_t* kbase = F.KV() + ((size_t)b * SEQ + (tid >> 3)) * 128 + kvh * 64 + (tid & 7) * 8;
        const bf16_t* vbase = F.VT() + ((size_t)(kvh * 64 + (tid >> 3))) * T + (size_t)b * SEQ + (tid & 7) * 8;
        const int klo = 32 * q32 - 127, j0 = (klo > 0 ? klo : 0) >> 6, j1 = (32 * q32 + 31) >> 6;
        int j = j0, buf = 0;
        u32x4 kr = *(const u32x4*)(kbase + (size_t)(64 * j) * 128), vr = *(const u32x4*)(vbase + 64 * j);
        AT_WRITE(0, kr, vr);
        __syncthreads();
        for (;;) {
            const int jn = (j < j1) ? j + 1 : -1;
            if (jn >= 0) { kr = *(const u32x4*)(kbase + (size_t)(64 * jn) * 128); vr = *(const u32x4*)(vbase + 64 * jn); }
            const int hi = t - 64 * j, lo = hi - 128;
            tile_step(lds + AT_KT + buf * 9216, lds + AT_VT + buf * 8704, qf, O, m, l, lo, hi, true, r, h);
            if (jn >= 0) AT_WRITE(buf ^ 1, kr, vr);
            __syncthreads();
            if (jn < 0) break;
            j = jn; buf ^= 1;
        }
        l += __shfl_xor(l, 32);
        const float sc = 1.f / l;
        bf16_t* op = F.O() + tokrow * D + head * 64 + 4 * h;
#pragma unroll
        for (int db = 0; db < 2; ++db)
#pragma unroll
            for (int q4 = 0; q4 < 4; ++q4) { u32x2 o; o.x = pk2(O[db][4 * q4] * sc, O[db][4 * q4 + 1] * sc); o.y = pk2(O[db][4 * q4 + 2] * sc, O[db][4 * q4 + 3] * sc); *(u32x2*)(op + db * 32 + 8 * q4) = o; }
    }
}
#ifndef N_LAUNCHES
#define N_LAUNCHES 1
#endif
constexpr int N_PHASES = 17;
__global__ void __launch_bounds__(NTHR, 2) fwd_kernel(Args args) {
    extern __shared__ __attribute__((aligned(16))) unsigned char lds_raw[];
    LAS unsigned char* const lds = (LAS unsigned char*)lds_raw;
    const int wave0 = __builtin_amdgcn_readfirstlane((int)(threadIdx.x >> 6));
    for (int u = threadIdx.x; u < 256; u += NTHR) ((LAS unsigned*)(lds + MISC_OFF))[u] = 0u;
    __syncthreads();
#if N_LAUNCHES == 1
    { Frame F = make_frame(lds, wave0); (void)xcd_barrier_post(F.ctl() + CW_BAR, (volatile LAS unsigned*)(lds + MISC_OFF)); }
#define IN(k) true
#define SEAM(k) do { Frame Fb = make_frame(lds, wave0); XcdBarrier _b; _b.bar = Fb.ctl() + CW_BAR; _b.x = xb_xcc_id(); _b.st = (volatile LAS unsigned*)(lds + MISC_OFF); xcd_barrier(_b); } while (0)
#else
#ifdef ONLY_PHASE
#define IN(k) ((k) == ONLY_PHASE && args.ph_lo <= (k) && (k) < args.ph_hi)
#else
#define IN(k) (args.ph_lo <= (k) && (k) < args.ph_hi)
#endif
#define SEAM(k) do { } while (0)
#endif
    const LAS unsigned* ext = (const LAS unsigned*)(lds + EXT_OFF);

    if (IN(0)) { Frame F = make_frame(lds, wave0); p0_prologue(F); } SEAM(0);
    if (IN(1)) { Frame F = make_frame(lds, wave0); norm_plain_phase(F); } SEAM(1);
    if (IN(2)) { Frame F = make_frame(lds, wave0); PolProj0 P{F.HN(), F.WINT(), F.Q(), F.KV(), F.VT(), F.GATES(), F.ROPE(), F.vcu}; pg8::gemm_phase(lds, P, F.wave, F.lane); } SEAM(2);
    if (IN(3)) { Frame F = make_frame(lds, wave0); compress_phase(F); } SEAM(3);
    if (IN(4)) { Frame F = make_frame(lds, wave0); nsa_attn_phase(F); } SEAM(4);
    if (IN(5)) { Frame F = make_frame(lds, wave0); PolOut P{F.O(), F.WAOT(), F.x(), F.MODV() + (size_t)0 * 16 * 3072, nullptr, F.H(), F.vcu}; pg8::gemm_phase(lds, P, F.wave, F.lane); } SEAM(5);
    if (IN(6)) { Frame F = make_frame(lds, wave0); norm_router_phase(F, 0); } SEAM(6);
    if (IN(7)) { Frame F = make_frame(lds, wave0); load_expert_tables(F, 0, 8); PolGateUp P{F.HN(), F.WGUT(), F.b_gate_up(), F.LIST(), F.ACT(), ext, F.vcu}; pg8::gemm_phase(lds, P, F.wave, F.lane); } SEAM(7);
    if (IN(8)) { Frame F = make_frame(lds, wave0); load_expert_tables(F, 0, 4); PolDown P{F.ACT(), F.WDNT(), F.b_down(), F.LISTW(), F.OUTB(), ext, F.vcu}; pg8::gemm_phase(lds, P, F.wave, F.lane); } SEAM(8);
    if (IN(9)) { Frame F = make_frame(lds, wave0); combine_phase<false>(F, 0); } SEAM(9);
    if (IN(10)) { Frame F = make_frame(lds, wave0); PolProj1 P{F.HN(), F.HN2(), F.WBQT(), F.WKVT(), F.b_b_q(), F.kv_b(), F.ROPE(), F.Q(), F.KV(), F.VT(), F.vcu}; pg8::gemm_phase(lds, P, F.wave, F.lane); } SEAM(10);
    if (IN(11)) { Frame F = make_frame(lds, wave0); swa_sink_phase(F); } SEAM(11);
    if (IN(12)) { Frame F = make_frame(lds, wave0); PolOut P{F.O(), F.WBOT(), F.H(), F.MODV() + (size_t)2 * 16 * 3072, F.b_b_out(), F.H(), F.vcu}; pg8::gemm_phase(lds, P, F.wave, F.lane); } SEAM(12);
    if (IN(13)) { Frame F = make_frame(lds, wave0); norm_router_phase(F, 1); } SEAM(13);
    if (IN(14)) { Frame F = make_frame(lds, wave0); load_expert_tables(F, 1, 8); PolGateUp P{F.HN(), F.WGUT() + (size_t)32 * 2048 * D, F.b_gate_up() + 32 * 2048, F.LIST(), F.ACT(), ext, F.vcu}; pg8::gemm_phase(lds, P, F.wave, F.lane); } SEAM(14);
    if (IN(15)) { Frame F = make_frame(lds, wave0); load_expert_tables(F, 1, 4); PolDown P{F.ACT(), F.WDNT() + (size_t)32 * D * D, F.b_down() + 32 * 1024, F.LISTW(), F.OUTB(), ext, F.vcu}; pg8::gemm_phase(lds, P, F.wave, F.lane); } SEAM(15);
    if (IN(16)) { Frame F = make_frame(lds, wave0); combine_phase<true>(F, 1); }
#undef IN
#undef SEAM
}

extern "C" void kernel_launch(void* const* d_in, const int* in_sizes, int n_in, void* d_out, int out_size, void* d_ws, size_t ws_size, hipStream_t stream) {
    static int ready = 0;
    if (ready == 0) {
        if (n_in != 28 || out_size != T * D || ws_size < WS_END) { fprintf(stderr, "kernel_launch: unexpected shapes (n_in %d out %d ws %zu)\n", n_in, out_size, ws_size); ready = -1; return; }
        int dev = 0, cus = 0, per_cu = 0;
        if (hipGetDevice(&dev) != hipSuccess || hipDeviceGetAttribute(&cus, hipDeviceAttributeMultiprocessorCount, dev) != hipSuccess) { ready = -1; return; }
        if (hipFuncSetAttribute((const void*)fwd_kernel, hipFuncAttributeMaxDynamicSharedMemorySize, LDS_BYTES) != hipSuccess) { fprintf(stderr, "kernel_launch: hipFuncSetAttribute failed\n"); ready = -1; return; }
        if (hipOccupancyMaxActiveBlocksPerMultiprocessor(&per_cu, (const void*)fwd_kernel, NTHR, LDS_BYTES) != hipSuccess || per_cu < 1) fprintf(stderr, "kernel_launch: occupancy query reports %d\n", per_cu);
        (void)hipGetLastError();
        if (cus < GRID) { fprintf(stderr, "kernel_launch: needs %d CUs, device has %d\n", GRID, cus); ready = -1; return; }
        ready = 1;
    }
    if (ready < 0) return;
    (void)hipMemsetAsync((char*)d_ws + WS_CTL, 0, CTL_ZERO_BYTES, stream);
    Args a{};
    for (int i = 0; i < 28; ++i) a.in[i] = d_in[i];
    a.out = (float*)d_out; a.ws = (unsigned char*)d_ws;
    if (N_LAUNCHES == 1) {
        a.ph_lo = 0; a.ph_hi = N_PHASES;
        hipLaunchKernelGGL(fwd_kernel, dim3(GRID), dim3(NTHR), LDS_BYTES, stream, a);
    } else {
        for (int p = 0; p < N_PHASES; ++p) { a.ph_lo = p; a.ph_hi = p + 1; hipLaunchKernelGGL(fwd_kernel, dim3(GRID), dim3(NTHR), LDS_BYTES, stream, a); }
    }
}
```

```cpp
#include <hip/hip_runtime.h>
#include <cstdio>
#include <cstdint>

#define DI __device__ __forceinline__
#define LAS __attribute__((address_space(3)))
#define GAS __attribute__((address_space(1)))
typedef unsigned short bf16_t;
typedef short bf16x8 __attribute__((ext_vector_type(8)));
typedef short s16x4 __attribute__((ext_vector_type(4)));
typedef float f32x2 __attribute__((ext_vector_type(2)));
typedef float f32x4 __attribute__((ext_vector_type(4)));
typedef float f32x16 __attribute__((ext_vector_type(16)));
typedef unsigned u32x4 __attribute__((ext_vector_type(4)));
typedef unsigned u32x2 __attribute__((ext_vector_type(2)));

constexpr int NB = 16, SEQ = 2048, T = NB * SEQ, D = 1024, HD = 64;
constexpr int NEXP = 32, TOPK = 4;
constexpr int A_PROJ = 2608;
constexpr float NORM_EPS = 1e-5f;
constexpr float QSCALE = 0.125f * 1.4426950408889634f;
constexpr float LOG2E = 1.4426950408889634f;
constexpr int NWAVES = 8, NTHR = 512, GRID = 256;

constexpr size_t MiB = (size_t)1 << 20;
constexpr size_t WS_CTL = 0, CTL_ZERO_BYTES = 1 * MiB;
constexpr size_t WS_MODV = 1 * MiB;
constexpr size_t WS_ROPE = 2 * MiB;
constexpr size_t WS_CMPB = 4 * MiB;
constexpr size_t WS_CW1T = 5 * MiB;
constexpr size_t WS_CW2T = 6 * MiB;
constexpr size_t WS_WINT = 7 * MiB;
constexpr size_t WS_WAOT = 13 * MiB;
constexpr size_t WS_WBQT = 15 * MiB;
constexpr size_t WS_WBOT = 17 * MiB;
constexpr size_t WS_WKVT = 19 * MiB;
constexpr size_t WS_KC = 20 * MiB;
constexpr size_t WS_VCT = 21 * MiB;
constexpr size_t WS_TOKSLOT = 22 * MiB;
constexpr size_t WS_GATES = 24 * MiB;
constexpr size_t WS_LIST = 32 * MiB;
constexpr size_t WS_LISTW = 36 * MiB;
constexpr size_t WS_VT = 40 * MiB;
constexpr size_t WS_WGUT = 72 * MiB;
constexpr size_t WS_WDNT = 328 * MiB;
constexpr size_t WS_H = 456 * MiB;
constexpr size_t WS_HN = 584 * MiB;
constexpr size_t WS_HN2 = 648 * MiB;
constexpr size_t WS_Q = 712 * MiB;
constexpr size_t WS_KV = 776 * MiB;
constexpr size_t WS_O = 840 * MiB;
constexpr size_t WS_ACT = 904 * MiB;
constexpr size_t WS_OUTB = 1161 * MiB;
constexpr size_t WS_END = 1417 * MiB;
constexpr int CW_BAR = 1024;
constexpr int CW_CNT = 8192;

constexpr int LDS_BYTES = 163840;
constexpr int MISC_OFF = LDS_BYTES - 1024;
constexpr int EXT_OFF = MISC_OFF + 64;

DI unsigned pk2(float lo, float hi) {
    typedef __bf16 bf2 __attribute__((ext_vector_type(2)));
    f32x2 v = {lo, hi}; bf2 b = __builtin_convertvector(v, bf2); return __builtin_bit_cast(unsigned, b);
}
DI float bf_lo(unsigned u) { return __uint_as_float(u << 16); }
DI float bf_hi(unsigned u) { return __uint_as_float(u & 0xffff0000u); }
DI float ex2(float x) { return __builtin_amdgcn_exp2f(x); }
DI float rcpf(float x) { return __builtin_amdgcn_rcpf(x); }
DI float wave_sum(float v) {
#pragma unroll
    for (int o = 1; o < 64; o <<= 1) v += __shfl_xor(v, o);
    return v;
}
DI int crow(int reg, int h) { return (reg & 3) + 8 * (reg >> 2) + 4 * h; }
#define MFMA32(a, b, c) __builtin_amdgcn_mfma_f32_32x32x16_bf16((a), (b), (c), 0, 0, 0)
#define LDS_WAIT() asm volatile("s_waitcnt lgkmcnt(0)" ::: "memory")
#define VM_WAIT() asm volatile("s_waitcnt vmcnt(0)" ::: "memory")

#define XB_TMO      128
#define XB_XCNT(j)  (256  + 64 * (j))
#define XB_XSUB(j)  (1280 + 64 * (j))
#define XB_XGEN(j)  (2304 + 64 * (j))
#define XB_TOP      3328
#define XB_TOPGEN   3392
#define XCD_BAR_WORDS 3456
#define XB_SPIN_CAP (1u << 21)

DI unsigned xb_ld(unsigned* p)              { return __hip_atomic_load(p, __ATOMIC_RELAXED, __HIP_MEMORY_SCOPE_AGENT); }
DI unsigned xb_add(unsigned* p, unsigned v) { return __hip_atomic_fetch_add(p, v, __ATOMIC_RELAXED, __HIP_MEMORY_SCOPE_AGENT); }
DI unsigned xb_xcc_id() { return (unsigned)__builtin_amdgcn_s_getreg((3 << 11) | 20) & 0xFu; }
#define XB_SPIN(cond, bar) do { unsigned _sp = 0; while (cond) { __builtin_amdgcn_s_sleep(1); \
    if ((++_sp & 255u) == 0u) { if (xb_ld(&(bar)[XB_TMO])) break; if (_sp > XB_SPIN_CAP) { atomicAdd(&(bar)[XB_TMO], 1u); break; } } } } while (0)

struct XcdBarrier { unsigned* bar; unsigned x; volatile LAS unsigned* st; };

DI XcdBarrier xcd_barrier_post(unsigned* bar, volatile LAS unsigned* st) {
    XcdBarrier b; b.bar = bar; b.x = xb_xcc_id(); b.st = st;
    if (threadIdx.x == 0) (void)xb_add(&bar[XB_XCNT(b.x)], 1u);
    return b;
}
DI void xcd_barrier_complete(unsigned* bar, unsigned x, unsigned& nloc, unsigned& nx) {
    const unsigned G = gridDim.x * gridDim.y * gridDim.z;
    unsigned sum, cnt, mine, sp = 0u;
    for (;;) {
        sum = 0u; cnt = 0u; mine = 0u;
#pragma unroll
        for (unsigned j = 0; j < 16; ++j) { const unsigned c = xb_ld(&bar[XB_XCNT(j)]); sum += c; cnt += (c > 0u) ? 1u : 0u; mine = (j == x) ? c : mine; }
        if (sum == G) break;
        __builtin_amdgcn_s_sleep(1);
        if ((++sp & 255u) == 0u) { if (xb_ld(&bar[XB_TMO])) break; if (sp > XB_SPIN_CAP) { atomicAdd(&bar[XB_TMO], 1u); break; } }
    }
    nloc = mine > 0u ? mine : 1u; nx = cnt > 0u ? cnt : 1u;
}
DI void xcd_barrier(const XcdBarrier& b) {
    asm volatile("s_waitcnt vmcnt(0)" ::: "memory");
    __syncthreads();
    if (threadIdx.x == 0) {
        unsigned* bar = b.bar;
        __builtin_amdgcn_s_waitcnt(0);
        unsigned nloc = b.st[0], nx = b.st[1];
        if (nloc == 0u) { xcd_barrier_complete(bar, b.x, nloc, nx); b.st[0] = nloc; b.st[1] = nx; }
        const unsigned old = xb_add(&bar[XB_XSUB(b.x)], 1u);
        const unsigned gen = old / nloc;
        if (old + 1u == (gen + 1u) * nloc) {
            __builtin_amdgcn_fence(__ATOMIC_RELEASE, "agent");
            asm volatile("s_waitcnt vmcnt(0)" ::: "memory");
            const unsigned og = xb_add(&bar[XB_TOP], 1u);
            const unsigned tg = og / nx;
            if (og + 1u == (tg + 1u) * nx) xb_add(&bar[XB_TOPGEN], 1u);
            else XB_SPIN(xb_ld(&bar[XB_TOPGEN]) == tg, bar);
            __builtin_amdgcn_fence(__ATOMIC_ACQUIRE, "agent");
            xb_add(&bar[XB_XGEN(b.x)], 1u);
            asm volatile("s_waitcnt vmcnt(0)" ::: "memory");
        } else {
            XB_SPIN(xb_ld(&bar[XB_XGEN(b.x)]) == gen, bar);
            __builtin_amdgcn_fence(__ATOMIC_ACQUIRE, "agent");
            asm volatile("s_waitcnt vmcnt(0)" ::: "memory");
        }
    }
    __syncthreads();
}

struct Args { const void* in[28]; float* out; unsigned char* ws; int ph_lo, ph_hi; };

typedef const __attribute__((address_space(4))) unsigned char* KPtr;
struct Frame {
    LAS unsigned char* lds; KPtr kp; int tid, lane, wave, vcu, bx;
    DI void* arg(int i) const { return *(void* const __attribute__((address_space(4)))*)(kp + 8 * i); }
    DI unsigned char* wsp() const { return (unsigned char*)arg(29); }
    DI unsigned* ctl() const { return (unsigned*)(wsp() + WS_CTL); }
    DI float* out() const { return (float*)arg(28); }
    DI const float* x() const { return (const float*)arg(0); }
    DI const float* c() const { return (const float*)arg(1); }
    DI const int* positions() const { return (const int*)arg(2); }
    DI const float* mod_w() const { return (const float*)arg(3); }
    DI const float* mod_b() const { return (const float*)arg(4); }
    DI const float* norm_g() const { return (const float*)arg(5); }
    DI const float* final_g() const { return (const float*)arg(6); }
    DI const float* a_w_in() const { return (const float*)arg(7); }
    DI const float* cmp_pe() const { return (const float*)arg(8); }
    DI const float* cmp_w1() const { return (const float*)arg(9); }
    DI const float* cmp_w2() const { return (const float*)arg(10); }
    DI const float* a_w_out() const { return (const float*)arg(11); }
    DI const float* kv_norm_g() const { return (const float*)arg(12); }
    DI const float* kv_mod_w() const { return (const float*)arg(13); }
    DI const float* kv_mod_b() const { return (const float*)arg(14); }
    DI const float* kv_w() const { return (const float*)arg(15); }
    DI const float* kv_b() const { return (const float*)arg(16); }
    DI const float* b_w_q() const { return (const float*)arg(17); }
    DI const float* b_b_q() const { return (const float*)arg(18); }
    DI const float* b_sinks() const { return (const float*)arg(19); }
    DI const float* b_w_out() const { return (const float*)arg(20); }
    DI const float* b_b_out() const { return (const float*)arg(21); }
    DI const float* router_w() const { return (const float*)arg(22); }
    DI const float* router_b() const { return (const float*)arg(23); }
    DI const float* w_gate_up() const { return (const float*)arg(24); }
    DI const float* b_gate_up() const { return (const float*)arg(25); }
    DI const float* w_down() const { return (const float*)arg(26); }
    DI const float* b_down() const { return (const float*)arg(27); }
    DI float* MODV() const { return (float*)(wsp() + WS_MODV); }
    DI float* ROPE() const { return (float*)(wsp() + WS_ROPE); }
    DI float* CMPB() const { return (float*)(wsp() + WS_CMPB); }
    DI float* GATES() const { return (float*)(wsp() + WS_GATES); }
    DI float* LISTW() const { return (float*)(wsp() + WS_LISTW); }
    DI float* H() const { return (float*)(wsp() + WS_H); }
    DI bf16_t* CW1T() const { return (bf16_t*)(wsp() + WS_CW1T); }
    DI bf16_t* CW2T() const { return (bf16_t*)(wsp() + WS_CW2T); }
    DI bf16_t* WINT() const { return (bf16_t*)(wsp() + WS_WINT); }
    DI bf16_t* WAOT() const { return (bf16_t*)(wsp() + WS_WAOT); }
    DI bf16_t* WBQT() const { return (bf16_t*)(wsp() + WS_WBQT); }
    DI bf16_t* WBOT() const { return (bf16_t*)(wsp() + WS_WBOT); }
    DI bf16_t* WKVT() const { return (bf16_t*)(wsp() + WS_WKVT); }
    DI bf16_t* KC() const { return (bf16_t*)(wsp() + WS_KC); }
    DI bf16_t* VCT() const { return (bf16_t*)(wsp() + WS_VCT); }
    DI bf16_t* VT() const { return (bf16_t*)(wsp() + WS_VT); }
    DI bf16_t* WGUT() const { return (bf16_t*)(wsp() + WS_WGUT); }
    DI bf16_t* WDNT() const { return (bf16_t*)(wsp() + WS_WDNT); }
    DI bf16_t* HN() const { return (bf16_t*)(wsp() + WS_HN); }
    DI bf16_t* HN2() const { return (bf16_t*)(wsp() + WS_HN2); }
    DI bf16_t* Q() const { return (bf16_t*)(wsp() + WS_Q); }
    DI bf16_t* KV() const { return (bf16_t*)(wsp() + WS_KV); }
    DI bf16_t* O() const { return (bf16_t*)(wsp() + WS_O); }
    DI bf16_t* ACT() const { return (bf16_t*)(wsp() + WS_ACT); }
    DI bf16_t* OUTB() const { return (bf16_t*)(wsp() + WS_OUTB); }
    DI unsigned* TOKSLOT() const { return (unsigned*)(wsp() + WS_TOKSLOT); }
    DI unsigned* LIST() const { return (unsigned*)(wsp() + WS_LIST); }
};
DI int vcu_of(int bx) { return (bx & 7) * (GRID / 8) + (bx >> 3); }
DI int fresh_lane() { int l; asm volatile("v_mbcnt_lo_u32_b32 %0, -1, 0\n\tv_mbcnt_hi_u32_b32 %0, -1, %0" : "=&v"(l)); return l; }
DI Frame make_frame(LAS unsigned char* lds, int wave_sgpr) {
    Frame F; F.lds = lds;
    KPtr kp = (KPtr)__builtin_amdgcn_kernarg_segment_ptr(); asm volatile("" : "+s"(kp)); F.kp = kp;
    int wv = wave_sgpr; asm volatile("" : "+s"(wv)); F.wave = wv; F.lane = fresh_lane(); F.tid = wv * 64 + F.lane;
    int bx = (int)blockIdx.x; asm volatile("" : "+s"(bx)); F.bx = bx; F.vcu = vcu_of(bx);
    return F;
}
DI void transpose_item(const float* W, int ld, int K, bf16_t* WT, int drow0, int k0, int n0, LAS float* scr, int lane) {
    f32x4 v[16];
    const float* src = W + (size_t)(k0 + (lane >> 4)) * ld + n0 + 4 * (lane & 15);
#pragma unroll
    for (int i = 0; i < 16; ++i) v[i] = *(const f32x4*)(src + (size_t)(4 * i) * ld);
    LAS float* wp = scr + (lane >> 4) * 65 + 4 * (lane & 15);
#pragma unroll
    for (int i = 0; i < 16; ++i) { LAS float* q = wp + (4 * i) * 65; q[0] = v[i].x; q[1] = v[i].y; q[2] = v[i].z; q[3] = v[i].w; }
    LDS_WAIT(); asm volatile("" ::: "memory");
    const int c = lane & 7;
#pragma unroll
    for (int j = 0; j < 8; ++j) { const int n = (lane >> 3) + 8 * j; const LAS float* s = scr + (8 * c) * 65 + n;
        u32x4 o; o.x = pk2(s[0 * 65], s[1 * 65]); o.y = pk2(s[2 * 65], s[3 * 65]); o.z = pk2(s[4 * 65], s[5 * 65]); o.w = pk2(s[6 * 65], s[7 * 65]);
        *(u32x4*)(WT + (size_t)(drow0 + n) * K + k0 + 8 * c) = o; }
    LDS_WAIT(); asm volatile("" ::: "memory");
}

DI void p0_prologue(Frame& F) {
    const int gw = F.bx * NWAVES + F.wave, NGW = GRID * NWAVES, lane = F.lane;
    const int gtid = F.bx * NTHR + F.tid, NGT = GRID * NTHR;
    LAS float* cact = (LAS float*)(F.lds + 73728);
    const bool modblk = (F.bx >= 32 && F.bx < 60);
    if (modblk) {
        for (int idx = F.tid; idx < NB * D; idx += NTHR) { const int b = idx / D, k = idx % D; const float v = F.c()[idx]; cact[k * 16 + b] = v / (1.f + __expf(-v)); }
    }
    __syncthreads();
    if (gw >= 256 && gw < 480) {
        const int it = gw - 256; const float* W; const float* bias; float* outp; int ld;
        int chunk;
        if (it < 192) { const int set = it / 48; chunk = it % 48; W = F.mod_w() + (size_t)set * D * 3072; ld = 3072; bias = F.mod_b() + set * 3072; outp = F.MODV() + (size_t)set * 16 * 3072; }
        else { chunk = it - 192; W = F.kv_mod_w(); ld = 2048; bias = F.kv_mod_b(); outp = F.MODV() + (size_t)4 * 16 * 3072; }
        const int col = chunk * 64 + lane;
        float acc[16];
#pragma unroll
        for (int b = 0; b < 16; ++b) acc[b] = 0.f;
#pragma unroll 4
        for (int k = 0; k < D; ++k) {
            const float w = W[(size_t)k * ld + col];
            const LAS f32x4* cp = (const LAS f32x4*)(cact + k * 16);
            const f32x4 c0 = cp[0], c1 = cp[1], c2 = cp[2], c3 = cp[3];
            acc[0] += c0.x * w; acc[1] += c0.y * w; acc[2] += c0.z * w; acc[3] += c0.w * w;
            acc[4] += c1.x * w; acc[5] += c1.y * w; acc[6] += c1.z * w; acc[7] += c1.w * w;
            acc[8] += c2.x * w; acc[9] += c2.y * w; acc[10] += c2.z * w; acc[11] += c2.w * w;
            acc[12] += c3.x * w; acc[13] += c3.y * w; acc[14] += c3.z * w; acc[15] += c3.w * w;
        }
        const float bv = bias[col];
#pragma unroll
        for (int b = 0; b < 16; ++b) outp[(size_t)b * ld + col] = acc[b] + bv;
    }
    if (gw < 256) {
        const int kv = gw / 128, e = gw % 128; float s = 0.f;
        for (int j = 0; j < 32; ++j) { const int k = lane + 64 * j; s += F.cmp_pe()[kv * 2048 + k] * F.cmp_w1()[((size_t)kv * 2048 + k) * 128 + e]; }
        s = wave_sum(s);
        if (lane == 0) F.CMPB()[gw] = s;
    }
    for (int idx = gtid; idx < T * 8; idx += NGT) {
        const int tok = idx >> 3, i = idx & 7;
        const float inv = (float)pow(500000.0, -(double)(2 * i) / 16.0);
        const float ang = (float)F.positions()[tok] * inv;
        double a = (double)ang; const double twopi = 6.283185307179586476925286766559;
        a -= twopi * rint(a / twopi);
        const float ar = (float)a;
        F.ROPE()[(size_t)tok * 16 + i] = cosf(ar); F.ROPE()[(size_t)tok * 16 + 8 + i] = sinf(ar);
    }
    for (int idx = gtid; idx < 256 * D; idx += NGT) {
        const int row = idx / D, k = idx % D;
        const float v = row < 48 ? F.a_w_in()[(size_t)k * A_PROJ + 2560 + row] : 0.f;
        F.WINT()[(size_t)(2048 + row) * D + k] = (bf16_t)(pk2(v, 0.f) & 0xffffu);
    }
    __syncthreads();
    LAS float* scr = (LAS float*)(F.lds + F.wave * 16640);
    constexpr int J0 = 32768, J1 = 16384, J2 = 640, J3 = 256, J6 = 64, J7 = 128, J8 = 4;
    constexpr int NITEMS = J0 + J1 + J2 + 3 * J3 + J6 + J7 + J8;
    for (int it = gw; it < NITEMS; it += NGW) {
        int r = it;
        if (r < J0) { const int mat = r >> 9, q = r & 511, kb = q >> 5, nb = q & 31;
            transpose_item(F.w_gate_up() + (size_t)mat * D * 2048, 2048, D, F.WGUT() + (size_t)mat * 2048 * D, 64 * nb, 64 * kb, 64 * nb, scr, lane); continue; }
        r -= J0;
        if (r < J1) { const int mat = r >> 8, q = r & 255, kb = q >> 4, nb = q & 15;
            transpose_item(F.w_down() + (size_t)mat * D * D, D, D, F.WDNT() + (size_t)mat * D * D, 64 * nb, 64 * kb, 64 * nb, scr, lane); continue; }
        r -= J1;
        if (r < J2) { const int kb = r / 40, nb = r % 40, n0 = 64 * nb;
            const int dr = n0 < 1792 ? n0 : (n0 < 2048 ? 2304 + (n0 - 1792) : (n0 < 2304 ? 1792 + (n0 - 2048) : 2560 + (n0 - 2304)));
            transpose_item(F.a_w_in(), A_PROJ, D, F.WINT(), dr, 64 * kb, n0, scr, lane); continue; }
        r -= J2;
        if (r < J3) { const int kb = r >> 4, nb = r & 15; transpose_item(F.a_w_out(), D, D, F.WAOT(), 64 * nb, 64 * kb, 64 * nb, scr, lane); continue; }
        r -= J3;
        if (r < J3) { const int kb = r >> 4, nb = r & 15; transpose_item(F.b_w_q(), D, D, F.WBQT(), 64 * nb, 64 * kb, 64 * nb, scr, lane); continue; }
        r -= J3;
        if (r < J3) { const int kb = r >> 4, nb = r & 15; transpose_item(F.b_w_out(), D, D, F.WBOT(), 64 * nb, 64 * kb, 64 * nb, scr, lane); continue; }
        r -= J3;
        if (r < J6) { const int kb = r >> 2, nb = r & 3; transpose_item(F.kv_w(), 256, D, F.WKVT(), 64 * nb, 64 * kb, 64 * nb, scr, lane); continue; }
        r -= J6;
        if (r < J7) { const int kv = r >> 6, q = r & 63, kb = q >> 1, nb = q & 1;
            transpose_item(F.cmp_w1() + (size_t)kv * 2048 * 128, 128, 2048, F.CW1T() + (size_t)kv * 128 * 2048, 64 * nb, 64 * kb, 64 * nb, scr, lane); continue; }
        r -= J7;
        { const int kv = r >> 1, kb = r & 1;
            transpose_item(F.cmp_w2() + (size_t)kv * 128 * 64, 64, 128, F.CW2T() + (size_t)kv * 64 * 128, 0, 64 * kb, 0, scr, lane); }
    }
}

DI void load_mod(const float* g, const float* scale, const float* shift, int lane, f32x4 (&A)[4], f32x4 (&Bv)[4]) {
#pragma unroll
    for (int j = 0; j < 4; ++j) { const int c = 4 * lane + 256 * j;
        const f32x4 gg = *(const f32x4*)(g + c), sc = *(const f32x4*)(scale + c), sh = *(const f32x4*)(shift + c);
        A[j] = gg * (sc + 1.f); Bv[j] = sh; }
}
DI float row_ss(const f32x4 (&v)[4]) {
    float s = 0.f;
#pragma unroll
    for (int j = 0; j < 4; ++j) s += (v[j].x * v[j].x + v[j].y * v[j].y) + (v[j].z * v[j].z + v[j].w * v[j].w);
    return wave_sum(s);
}
DI void store_bf16_row(bf16_t* dst, int lane, const f32x4 (&y)[4]) {
#pragma unroll
    for (int j = 0; j < 4; ++j) { u32x2 o; o.x = pk2(y[j].x, y[j].y); o.y = pk2(y[j].z, y[j].w); *(u32x2*)(dst + 4 * lane + 256 * j) = o; }
}

DI void norm_plain_phase(Frame& F) {
    const int gw = F.bx * NWAVES + F.wave, lane = F.lane, b = gw >> 7;
    const float* mv = F.MODV() + ((size_t)0 * 16 + b) * 3072;
    f32x4 A[4], Bv[4]; load_mod(F.norm_g(), mv + 1024, mv, lane, A, Bv);
    for (int rr = 0; rr < 16; ++rr) {
        const size_t row = (size_t)gw * 16 + rr;
        f32x4 v[4];
#pragma unroll
        for (int j = 0; j < 4; ++j) v[j] = *(const f32x4*)(F.x() + row * D + 4 * lane + 256 * j);
        const float rstd = 1.0f / sqrtf(row_ss(v) * (1.f / D) + NORM_EPS);
        f32x4 y[4];
#pragma unroll
        for (int j = 0; j < 4; ++j) y[j] = v[j] * rstd * A[j] + Bv[j];
        store_bf16_row(F.HN() + row * D, lane, y);
    }
}

constexpr int RT_IMG = 0, RT_LGS = 147456, RT_PE = 149504, RT_PW = 151552, RT_LCNT = 153600, RT_LBASE = 153728;

DI void norm_router_phase(Frame& F, int layer) {
    const int gw = F.bx * NWAVES + F.wave, lane = F.lane, tid = F.tid, b = gw >> 7;
    LAS float* img = (LAS float*)(F.lds + RT_IMG);
    LAS float* lgs = (LAS float*)(F.lds + RT_LGS) + F.wave * 64;
    LAS unsigned* pend_e = (LAS unsigned*)(F.lds + RT_PE);
    LAS float* pend_w = (LAS float*)(F.lds + RT_PW);
    LAS unsigned* lcnt = (LAS unsigned*)(F.lds + RT_LCNT);
    LAS unsigned* lbase = (LAS unsigned*)(F.lds + RT_LBASE);
    const float* rw = F.router_w() + (size_t)layer * D * NEXP;
    for (int idx = tid; idx < D * NEXP; idx += NTHR) { const int col = idx >> 5, e = idx & 31;
        const int rho = (col & 3) * 64 + ((col >> 2) & 63) + 256 * (col >> 8); img[rho * 36 + e] = rw[idx]; }
    if (tid < 32) lcnt[tid] = 0u;
    __syncthreads();
    const int set = layer * 2 + 1;
    const float* mv = F.MODV() + ((size_t)set * 16 + b) * 3072;
    f32x4 A[4], Bv[4]; load_mod(F.norm_g() + (layer * 2 + 1) * D, mv + 1024, mv, lane, A, Bv);
    const float* rb = F.router_b() + layer * NEXP;
    for (int rp = 0; rp < 8; ++rp) {
        const size_t row0 = (size_t)gw * 16 + rp * 2;
        f32x4 y0[4], y1[4];
        {
            f32x4 v0[4], v1[4];
#pragma unroll
            for (int j = 0; j < 4; ++j) { v0[j] = *(const f32x4*)(F.H() + row0 * D + 4 * lane + 256 * j); v1[j] = *(const f32x4*)(F.H() + (row0 + 1) * D + 4 * lane + 256 * j); }
            const float r0 = 1.0f / sqrtf(row_ss(v0) * (1.f / D) + NORM_EPS), r1 = 1.0f / sqrtf(row_ss(v1) * (1.f / D) + NORM_EPS);
#pragma unroll
            for (int j = 0; j < 4; ++j) { y0[j] = v0[j] * r0 * A[j] + Bv[j]; y1[j] = v1[j] * r1 * A[j] + Bv[j]; }
        }
        store_bf16_row(F.HN() + row0 * D, lane, y0); store_bf16_row(F.HN() + (row0 + 1) * D, lane, y1);
        float l0[32], l1[32];
#pragma unroll
        for (int e = 0; e < 32; ++e) { l0[e] = 0.f; l1[e] = 0.f; }
#pragma unroll
        for (int j = 0; j < 4; ++j)
#pragma unroll
            for (int i = 0; i < 4; ++i) {
                const float a0 = y0[j][i], a1 = y1[j][i];
                const LAS f32x4* wp = (const LAS f32x4*)(img + (i * 64 + lane + 256 * j) * 36);
#pragma unroll
                for (int e4 = 0; e4 < 8; ++e4) { const f32x4 w = wp[e4];
                    l0[4 * e4 + 0] += a0 * w.x; l0[4 * e4 + 1] += a0 * w.y; l0[4 * e4 + 2] += a0 * w.z; l0[4 * e4 + 3] += a0 * w.w;
                    l1[4 * e4 + 0] += a1 * w.x; l1[4 * e4 + 1] += a1 * w.y; l1[4 * e4 + 2] += a1 * w.z; l1[4 * e4 + 3] += a1 * w.w; }
            }
#define RS_STEP(N, OFF) { const bool up = (lane & (OFF)) != 0; _Pragma("unroll") for (int k = 0; k < (N); ++k) { \
            const float s0 = up ? l0[k] : l0[k + (N)], k0 = up ? l0[k + (N)] : l0[k]; l0[k] = k0 + __shfl_xor(s0, (OFF)); \
            const float s1 = up ? l1[k] : l1[k + (N)], k1 = up ? l1[k + (N)] : l1[k]; l1[k] = k1 + __shfl_xor(s1, (OFF)); } }
        RS_STEP(16, 32) RS_STEP(8, 16) RS_STEP(4, 8) RS_STEP(2, 4) RS_STEP(1, 2)
#undef RS_STEP
        float g0 = l0[0] + __shfl_xor(l0[0], 1), g1 = l1[0] + __shfl_xor(l1[0], 1);
        const int e_own = lane >> 1; const float rbv = rb[e_own];
        if ((lane & 1) == 0) { lgs[e_own] = g0 + rbv; lgs[32 + e_own] = g1 + rbv; }
        LDS_WAIT(); asm volatile("" ::: "memory");
        if (lane < 2) {
            float v[32];
#pragma unroll
            for (int e = 0; e < 32; ++e) v[e] = lgs[lane * 32 + e];
            float tv[4]; int ti[4];
#pragma unroll
            for (int k = 0; k < 4; ++k) {
                float best = -INFINITY; int bi = 0;
#pragma unroll
                for (int e = 0; e < 32; ++e) { const bool gt = v[e] > best; best = gt ? v[e] : best; bi = gt ? e : bi; }
                tv[k] = best; ti[k] = bi;
#pragma unroll
                for (int e = 0; e < 32; ++e) v[e] = (e == bi) ? -INFINITY : v[e];
            }
            const float e1 = __expf(tv[1] - tv[0]), e2 = __expf(tv[2] - tv[0]), e3 = __expf(tv[3] - tv[0]);
            const float inv = 1.f / (1.f + e1 + e2 + e3);
            const float w[4] = {inv, e1 * inv, e2 * inv, e3 * inv};
            const int tl = F.wave * 16 + rp * 2 + lane;
#pragma unroll
            for (int k = 0; k < 4; ++k) {
                const unsigned pl = __hip_atomic_fetch_add(lcnt + ti[k], 1u, __ATOMIC_RELAXED, __HIP_MEMORY_SCOPE_WORKGROUP);
                pend_e[tl * 4 + k] = ((unsigned)ti[k] << 16) | pl; pend_w[tl * 4 + k] = w[k];
            }
        }
        LDS_WAIT(); asm volatile("" ::: "memory");
    }
    __syncthreads();
    unsigned* gcnt = F.ctl() + CW_CNT + 64 * layer;
    if (tid < 32) lbase[tid] = __hip_atomic_fetch_add(gcnt + tid, lcnt[tid], __ATOMIC_RELAXED, __HIP_MEMORY_SCOPE_AGENT);
    __syncthreads();
    {
        const int tl = tid >> 2, k = tid & 3; const unsigned pe = pend_e[tid]; const unsigned e = pe >> 16, pos = lbase[e] + (pe & 0xffffu);
        const unsigned token = (unsigned)(F.bx * 128 + tl);
        F.LIST()[(size_t)e * T + pos] = token; F.LISTW()[(size_t)e * T + pos] = pend_w[tid]; F.TOKSLOT()[(size_t)token * 4 + k] = (e << 16) | pos;
    }
    __syncthreads();
}

DI void load_expert_tables(Frame& F, int layer, int npn) {
    LAS unsigned* ext = (LAS unsigned*)(F.lds + EXT_OFF);
    if (F.tid < 32) ext[F.tid] = __hip_atomic_load(F.ctl() + CW_CNT + 64 * layer + F.tid, __ATOMIC_RELAXED, __HIP_MEMORY_SCOPE_AGENT);
    __syncthreads();
    if (F.tid == 0) { unsigned o = 0, u = 0; for (int e = 0; e < 32; ++e) { const unsigned c = ext[e]; ext[32 + e] = o; ext[64 + e] = u; o += c; u += ((c + 255u) >> 8) * (unsigned)npn; } ext[96] = u; }
    __syncthreads();
}

template <bool FINAL> DI void combine_phase(Frame& F, int layer) {
    load_expert_tables(F, layer, 1);
    const LAS unsigned* offs = (const LAS unsigned*)(F.lds + EXT_OFF) + 32;
    const int gw = F.bx * NWAVES + F.wave, lane = F.lane, b = gw >> 7;
    const float* gate = F.MODV() + ((size_t)(layer * 2 + 1) * 16 + b) * 3072 + 2048;
    f32x4 G[4];
#pragma unroll
    for (int j = 0; j < 4; ++j) G[j] = *(const f32x4*)(gate + 4 * lane + 256 * j);
    f32x4 A1[4], B1[4], A2[4], B2[4];
    if (FINAL) {
#pragma unroll
        for (int j = 0; j < 4; ++j) A1[j] = *(const f32x4*)(F.final_g() + 4 * lane + 256 * j);
    } else {
        const float* m2 = F.MODV() + ((size_t)2 * 16 + b) * 3072; load_mod(F.norm_g() + 2 * D, m2 + 1024, m2, lane, A1, B1);
        const float* m4 = F.MODV() + (size_t)4 * 16 * 3072 + (size_t)b * 2048; load_mod(F.kv_norm_g(), m4 + 1024, m4, lane, A2, B2);
    }
    for (int rr = 0; rr < 16; ++rr) {
        const size_t row = (size_t)gw * 16 + rr;
        const u32x4 ts = *(const u32x4*)(F.TOKSLOT() + row * 4);
        const unsigned sl[4] = {offs[ts.x >> 16] + (ts.x & 0xffffu), offs[ts.y >> 16] + (ts.y & 0xffffu), offs[ts.z >> 16] + (ts.z & 0xffffu), offs[ts.w >> 16] + (ts.w & 0xffffu)};
        f32x4 y[4];
#pragma unroll
        for (int j = 0; j < 4; ++j) y[j] = (f32x4){0.f, 0.f, 0.f, 0.f};
#pragma unroll
        for (int k = 0; k < 4; ++k)
#pragma unroll
            for (int j = 0; j < 4; ++j) { const u32x2 o = *(const u32x2*)(F.OUTB() + (size_t)sl[k] * D + 4 * lane + 256 * j);
                y[j].x += bf_lo(o.x); y[j].y += bf_hi(o.x); y[j].z += bf_lo(o.y); y[j].w += bf_hi(o.y); }
        f32x4 h[4];
#pragma unroll
        for (int j = 0; j < 4; ++j) h[j] = *(const f32x4*)(F.H() + row * D + 4 * lane + 256 * j) + G[j] * y[j];
        const float rstd = 1.0f / sqrtf(row_ss(h) * (1.f / D) + NORM_EPS);
        if (FINAL) {
#pragma unroll
            for (int j = 0; j < 4; ++j) *(f32x4*)(F.out() + row * D + 4 * lane + 256 * j) = h[j] * rstd * A1[j];
        } else {
#pragma unroll
            for (int j = 0; j < 4; ++j) *(f32x4*)(F.H() + row * D + 4 * lane + 256 * j) = h[j];
            f32x4 ya[4], yb[4];
#pragma unroll
            for (int j = 0; j < 4; ++j) { const f32x4 n = h[j] * rstd; ya[j] = n * A1[j] + B1[j]; yb[j] = n * A2[j] + B2[j]; }
            store_bf16_row(F.HN() + row * D, lane, ya); store_bf16_row(F.HN2() + row * D, lane, yb);
        }
    }
}
namespace pg8 {
constexpr int BM = 256, BK = 64, HALF = 128, HTB = HALF * BK * 2, STAGE_BYTES = 8 * HTB, KD = 1024;
DI int lds_byte(int r, int c) { const int st = (r >> 4) * 2 + (c >> 5), rr = r & 15, cc = c & 31, ob = rr * 64 + cc * 2; return st * 1024 + (ob ^ (((ob >> 9) & 1) << 5)); }
DI void stage_rc(int b, int& R, int& C) { const int st = b / 1024, sb = b % 1024, swz = sb ^ (((sb >> 9) & 1) << 5); R = (st >> 1) * 16 + swz / 64; C = (st & 1) * 32 + (swz % 64) / 2; }
DI int perm32(int rho) { const int n = rho >> 4, i = rho & 15; return 8 * (i >> 2) + 4 * n + (i & 3); }

struct Unit {
    const char* A;
    const char* B0;
    unsigned bh;
    int type, r0, c0, nvalid, aux;
};

template <class Pol>
DI void gemm_phase(LAS unsigned char* lds, const Pol& P, int wave_id, int lane_id) {
    const int wid = wave_id, lane = lane_id, tid = wid * 64 + lane, wr = wid >> 2, wc = wid & 3, fr = lane & 15, fq = lane >> 4;
    constexpr int K = KD, nt = K / BK;
    unsigned voffB[2];
#pragma unroll
    for (int i = 0; i < 2; ++i) { int R, C; stage_rc(tid * 16 + i * 8192, R, C); const int Rb = Pol::PERM ? ((R & ~31) + perm32(R & 31)) : R; voffB[i] = (unsigned)(Rb * K + C) * 2u; }
    const size_t kstep = (size_t)(BK * 2);
    const unsigned ldsw = (unsigned)wid * 1024u;
    const int aoff = lds_byte(wr * 64 + fr, fq * 8), boff = lds_byte(wc * 32 + fr, fq * 8);
#define PG8_SA(b, h) (((b) * 2 + (h)) * HTB)
#define PG8_SB(b, h) ((4 + (b) * 2 + (h)) * HTB)
#define PG8_STAGE_A(bufoff, gbase, va, h) do { _Pragma("unroll") for (int _i = 0; _i < 2; ++_i) \
        __builtin_amdgcn_global_load_lds((const unsigned*)((const char*)(gbase) + (va)[h][_i]), (LAS unsigned*)(lds + (bufoff) + ldsw + _i * 8192), 16, 0, 0); } while (0)
#define PG8_STAGE_B(bufoff, gbase) do { _Pragma("unroll") for (int _i = 0; _i < 2; ++_i) \
        __builtin_amdgcn_global_load_lds((const unsigned*)((const char*)(gbase) + voffB[_i]), (LAS unsigned*)(lds + (bufoff) + ldsw + _i * 8192), 16, 0, 0); } while (0)
#define PG8_LDA(dst, b, h) do { _Pragma("unroll") for (int m = 0; m < 4; ++m) _Pragma("unroll") for (int k = 0; k < 2; ++k) dst[m][k] = *(const LAS bf16x8*)(lds + PG8_SA(b, h) + aoff + m * 2048 + k * 1024); } while (0)
#define PG8_LDB(dst, b, h) do { _Pragma("unroll") for (int n = 0; n < 2; ++n) _Pragma("unroll") for (int k = 0; k < 2; ++k) dst[n][k] = *(const LAS bf16x8*)(lds + PG8_SB(b, h) + boff + n * 2048 + k * 1024); } while (0)
#define PG8_MMA(ai, bj, At, Bt) do { __builtin_amdgcn_s_setprio(1); _Pragma("unroll") for (int m = 0; m < 4; ++m) _Pragma("unroll") for (int n = 0; n < 2; ++n) _Pragma("unroll") for (int k = 0; k < 2; ++k) \
        acc[ai][bj][m][n] = __builtin_amdgcn_mfma_f32_16x16x32_bf16(Bt[n][k], At[m][k], acc[ai][bj][m][n], 0, 0, 0); __builtin_amdgcn_s_setprio(0); } while (0)
#define PG8_WAIT_V(n) asm volatile("s_waitcnt vmcnt(" #n ")" ::: "memory")
#define PG8_WAIT_L(n) asm volatile("s_waitcnt lgkmcnt(" #n ")" ::: "memory")
#define PG8_BAR __builtin_amdgcn_s_barrier()
#define PG8_SCHED __builtin_amdgcn_sched_barrier(0)
    Unit cur, nxt; int ui = 0;
    if (!P.next(0, cur)) return;
    unsigned vaC[2][2], vaN[2][2];
    P.aoff(cur, wid * 64, tid, vaC);
    bool has_next = P.next(1, nxt);
    if (has_next) P.aoff(nxt, wid * 64, tid, vaN);
    else { vaN[0][0] = vaC[0][0]; vaN[0][1] = vaC[0][1]; vaN[1][0] = vaC[1][0]; vaN[1][1] = vaC[1][1]; }
    if (Pol::GATHER) asm volatile("" : "+v"(vaC[0][0]), "+v"(vaC[0][1]), "+v"(vaC[1][0]), "+v"(vaC[1][1]), "+v"(vaN[0][0]), "+v"(vaN[0][1]), "+v"(vaN[1][0]), "+v"(vaN[1][1]));
    f32x4 acc[2][2][4][2];
#pragma unroll
    for (int a = 0; a < 2; ++a)
#pragma unroll
        for (int b = 0; b < 2; ++b)
#pragma unroll
            for (int m = 0; m < 4; ++m)
#pragma unroll
                for (int n = 0; n < 2; ++n) acc[a][b][m][n] = (f32x4){0.f, 0.f, 0.f, 0.f};
    bf16x8 At[4][2], B0[2][2], B1[2][2];
    const char* cA = cur.A; const char* cB = cur.B0; unsigned cbh = cur.bh;
    PG8_STAGE_B(PG8_SB(0, 0), cB); PG8_STAGE_A(PG8_SA(0, 0), cA, vaC, 0); PG8_STAGE_B(PG8_SB(0, 1), cB + cbh); PG8_STAGE_A(PG8_SA(0, 1), cA, vaC, 1);
    if (wr == 1) PG8_BAR;
    PG8_WAIT_V(4); PG8_BAR;
    PG8_STAGE_B(PG8_SB(1, 0), cB + kstep); PG8_STAGE_A(PG8_SA(1, 0), cA + kstep, vaC, 0); PG8_STAGE_B(PG8_SB(1, 1), cB + cbh + kstep);
    PG8_WAIT_V(6); PG8_BAR;
    for (;;) {
        const char* nA = has_next ? nxt.A : cA; const char* nB = has_next ? nxt.B0 : cB; const unsigned nbh = has_next ? nxt.bh : cbh;
        for (int t = 0; t < nt; t += 2) {
            const bool last = (t == nt - 2);
            const char* a1 = cA + (size_t)(t + 1) * kstep;
            const char* a2 = last ? nA : cA + (size_t)(t + 2) * kstep; const char* b2 = last ? nB : cB + (size_t)(t + 2) * kstep;
            const char* a3 = a2 + kstep; const char* b3 = b2 + kstep;
            const unsigned bh2 = last ? nbh : cbh;
            unsigned va2[2][2];
            if (Pol::GATHER) { va2[0][0] = last ? vaN[0][0] : vaC[0][0]; va2[0][1] = last ? vaN[0][1] : vaC[0][1]; va2[1][0] = last ? vaN[1][0] : vaC[1][0]; va2[1][1] = last ? vaN[1][1] : vaC[1][1]; }
            else { va2[0][0] = vaC[0][0]; va2[0][1] = vaC[0][1]; va2[1][0] = vaC[1][0]; va2[1][1] = vaC[1][1]; }
            PG8_LDB(B0, 0, 0); PG8_SCHED; PG8_LDA(At, 0, 0); PG8_STAGE_A(PG8_SA(1, 1), a1, vaC, 1);
            PG8_WAIT_L(8); PG8_BAR; PG8_WAIT_L(0); PG8_MMA(0, 0, At, B0); PG8_BAR; PG8_SCHED;
            PG8_LDB(B1, 0, 1); PG8_STAGE_B(PG8_SB(0, 0), b2);
            PG8_BAR; PG8_WAIT_L(0); PG8_MMA(0, 1, At, B1); PG8_BAR;
            PG8_LDA(At, 0, 1); PG8_STAGE_A(PG8_SA(0, 0), a2, va2, 0);
            PG8_BAR; PG8_WAIT_L(0); PG8_MMA(1, 0, At, B0); PG8_BAR; PG8_SCHED;
            PG8_STAGE_B(PG8_SB(0, 1), b2 + bh2);
            PG8_WAIT_V(6); PG8_BAR; PG8_MMA(1, 1, At, B1); PG8_BAR;
            PG8_LDB(B0, 1, 0); PG8_SCHED; PG8_LDA(At, 1, 0); PG8_STAGE_A(PG8_SA(0, 1), a2, va2, 1);
            PG8_WAIT_L(8); PG8_BAR; PG8_WAIT_L(0); PG8_MMA(0, 0, At, B0); PG8_BAR; PG8_SCHED;
            PG8_LDB(B1, 1, 1); PG8_STAGE_B(PG8_SB(1, 0), b3);
            PG8_BAR; PG8_WAIT_L(0); PG8_MMA(0, 1, At, B1); PG8_BAR;
            PG8_LDA(At, 1, 1); PG8_STAGE_A(PG8_SA(1, 0), a3, va2, 0);
            PG8_BAR; PG8_WAIT_L(0); PG8_MMA(1, 0, At, B0); PG8_BAR; PG8_SCHED;
            PG8_STAGE_B(PG8_SB(1, 1), b3 + bh2);
            PG8_WAIT_V(6); PG8_BAR; PG8_MMA(1, 1, At, B1); PG8_BAR;
        }
        P.epi(acc, cur, wr, wc, fr, fq);
        if (!has_next) break;
#pragma unroll
        for (int a = 0; a < 2; ++a)
#pragma unroll
            for (int b = 0; b < 2; ++b)
#pragma unroll
                for (int m = 0; m < 4; ++m)
#pragma unroll
                    for (int n = 0; n < 2; ++n) acc[a][b][m][n] = (f32x4){0.f, 0.f, 0.f, 0.f};
        cur = nxt; cA = nA; cB = nB; cbh = nbh; ++ui;
        vaC[0][0] = vaN[0][0]; vaC[0][1] = vaN[0][1]; vaC[1][0] = vaN[1][0]; vaC[1][1] = vaN[1][1];
        has_next = P.next(ui + 1, nxt);
        if (has_next) { P.aoff(nxt, wid * 64, tid, vaN);
            if (Pol::GATHER) asm volatile("" : "+v"(vaN[0][0]), "+v"(vaN[0][1]), "+v"(vaN[1][0]), "+v"(vaN[1][1])); }
    }
    PG8_WAIT_V(0);
    if (wr == 0) PG8_BAR;
    PG8_BAR;
#undef PG8_SA
#undef PG8_SB
#undef PG8_STAGE_A
#undef PG8_STAGE_B
#undef PG8_LDA
#undef PG8_LDB
#undef PG8_MMA
#undef PG8_WAIT_V
#undef PG8_WAIT_L
#undef PG8_BAR
#undef PG8_SCHED
}
DI void aoff_std(int tid, unsigned (&va)[2][2]) {
#pragma unroll
    for (int i = 0; i < 2; ++i) { int R, C; stage_rc(tid * 16 + i * 8192, R, C);
#pragma unroll
        for (int h = 0; h < 2; ++h) va[h][i] = (unsigned)((h * HALF + R) * KD + C) * 2u; }
}
}

typedef f32x4 AccT[2][2][4][2];

DI void rope8(f32x4& v0, f32x4& v1, const float* rope_row, int fq) {
    const f32x4 c0 = *(const f32x4*)(rope_row), c1 = *(const f32x4*)(rope_row + 4), s0 = *(const f32x4*)(rope_row + 8), s1 = *(const f32x4*)(rope_row + 12);
    f32x4 p0, p1;
#pragma unroll
    for (int i = 0; i < 4; ++i) { p0[i] = __shfl_xor(v0[i], 16); p1[i] = __shfl_xor(v1[i], 16); }
    const float sg = (fq == 0) ? -1.f : 1.f;
    v0 = v0 * c0 + p0 * (s0 * sg); v1 = v1 * c1 + p1 * (s1 * sg);
}
DI void store8_bf16(bf16_t* p, const f32x4& v0, const f32x4& v1) {
    u32x4 w; w.x = pk2(v0[0], v0[1]); w.y = pk2(v0[2], v0[3]); w.z = pk2(v1[0], v1[1]); w.w = pk2(v1[2], v1[3]); *(u32x4*)p = w;
}

struct PolProj0 {
    static constexpr bool PERM = true, GATHER = false;
    const bf16_t *HN, *WINT; bf16_t *Q, *KV, *VT; float* GATES; const float* ROPE; int vcu;
    DI bool next(int i, pg8::Unit& u) const {
        const int L = i * GRID + vcu; if (L >= 1408) return false;
        if (L < 1152) { const int pm = L / 9, pn = L % 9; u.type = 0; u.A = (const char*)(HN + (size_t)pm * 256 * D); u.B0 = (const char*)(WINT + (size_t)pn * 256 * D); u.bh = 128 * D * 2; u.r0 = pm * 256; u.c0 = pn * 256; u.aux = pn; u.nvalid = 256; }
        else { const int l2 = L - 1152, pm = l2 >> 7, pn = l2 & 127; u.type = 1; u.A = (const char*)(WINT + (size_t)(2304 + pm * 256) * D); u.B0 = (const char*)(HN + (size_t)pn * 256 * D); u.bh = 128 * D * 2; u.r0 = pm * 256; u.c0 = pn * 256; u.aux = 0; u.nvalid = 256; }
        return true;
    }
    DI void aoff(const pg8::Unit&, int, int tid, unsigned (&va)[2][2]) const { pg8::aoff_std(tid, va); }
    DI void epi(const AccT& acc, const pg8::Unit& u, int wr, int wc, int fr, int fq) const {
        const int pn = u.aux;
        if (u.type == 1) {
#pragma unroll
            for (int ai = 0; ai < 2; ++ai)
#pragma unroll
                for (int m = 0; m < 4; ++m) { const int row = u.r0 + ai * 128 + wr * 64 + m * 16 + fr;
#pragma unroll
                    for (int bj = 0; bj < 2; ++bj) store8_bf16(VT + (size_t)row * T + u.c0 + bj * 128 + wc * 32 + 8 * fq, acc[ai][bj][m][0], acc[ai][bj][m][1]); }
            return;
        }
        if (pn == 8) {
            if (wc < 2) {
#pragma unroll
                for (int ai = 0; ai < 2; ++ai)
#pragma unroll
                    for (int m = 0; m < 4; ++m) { const int row = u.r0 + ai * 128 + wr * 64 + m * 16 + fr; float* gp = GATES + (size_t)row * 64 + wc * 32 + 8 * fq;
                        f32x4 a = acc[ai][0][m][0], b = acc[ai][0][m][1];
#pragma unroll
                        for (int i = 0; i < 4; ++i) { a[i] = rcpf(1.f + ex2(-a[i] * LOG2E)); b[i] = rcpf(1.f + ex2(-b[i] * LOG2E)); }
                        *(f32x4*)gp = a; *(f32x4*)(gp + 4) = b; }
            }
            return;
        }
        const bool is_q = pn < 4, do_rope = (pn != 4 && pn != 5);
        bf16_t* dst = is_q ? Q + pn * 256 : KV + (pn - 4) * 256;
        const float sc = is_q ? QSCALE : 1.f;
        const bool rl = do_rope && ((wc & 1) == 0) && fq < 2;
#pragma unroll
        for (int ai = 0; ai < 2; ++ai)
#pragma unroll
            for (int m = 0; m < 4; ++m) { const int row = u.r0 + ai * 128 + wr * 64 + m * 16 + fr;
#pragma unroll
                for (int bj = 0; bj < 2; ++bj) { f32x4 v0 = acc[ai][bj][m][0], v1 = acc[ai][bj][m][1];
                    if (do_rope && (wc & 1) == 0) { f32x4 r0 = v0, r1 = v1; rope8(r0, r1, ROPE + (size_t)row * 16, fq); if (rl) { v0 = r0; v1 = r1; } }
                    v0 = v0 * sc; v1 = v1 * sc;
                    store8_bf16(dst + (size_t)row * D + bj * 128 + wc * 32 + 8 * fq, v0, v1); } }
    }
};

struct PolOut {
    static constexpr bool PERM = false, GATHER = false;
    const bf16_t *O, *WT; const float *base, *gate_mv, *bias; float* H; int vcu;
    DI bool next(int i, pg8::Unit& u) const {
        const int L = i * GRID + vcu; if (L >= 512) return false;
        const int pm = L >> 2, pn = L & 3; u.type = 0; u.A = (const char*)(O + (size_t)pm * 256 * D); u.B0 = (const char*)(WT + (size_t)pn * 256 * D); u.bh = 128 * D * 2; u.r0 = pm * 256; u.c0 = pn * 256; u.aux = 0; u.nvalid = 256;
        return true;
    }
    DI void aoff(const pg8::Unit&, int, int tid, unsigned (&va)[2][2]) const { pg8::aoff_std(tid, va); }
    DI void epi(const AccT& acc, const pg8::Unit& u, int wr, int wc, int fr, int fq) const {
        const int b = u.r0 >> 11; const float* gv = gate_mv + (size_t)b * 3072 + 2048;
#pragma unroll
        for (int bj = 0; bj < 2; ++bj)
#pragma unroll
            for (int n = 0; n < 2; ++n) { const int col = u.c0 + bj * 128 + wc * 32 + n * 16 + 4 * fq;
                const f32x4 g = *(const f32x4*)(gv + col); const f32x4 bs = bias ? *(const f32x4*)(bias + col) : (f32x4){0.f, 0.f, 0.f, 0.f};
#pragma unroll
                for (int ai = 0; ai < 2; ++ai)
#pragma unroll
                    for (int m = 0; m < 4; ++m) { const size_t off = (size_t)(u.r0 + ai * 128 + wr * 64 + m * 16 + fr) * D + col;
                        *(f32x4*)(H + off) = *(const f32x4*)(base + off) + g * (acc[ai][bj][m][n] + bs); } }
    }
};

DI bool moe_unit(const LAS unsigned* ext, int L, int npn, int& e, int& mt, int& pn, int& nvalid, unsigned& slot0) {
    if ((unsigned)L >= ext[96]) return false;
    int ee = 0;
    for (int k = 1; k < 32; ++k) ee = ((unsigned)L >= ext[64 + k]) ? k : ee;
    const int local = L - (int)ext[64 + ee]; mt = local / npn; pn = local % npn; e = ee;
    const int cnt = (int)ext[ee]; nvalid = cnt - mt * 256; nvalid = nvalid > 256 ? 256 : nvalid; slot0 = ext[32 + ee] + (unsigned)mt * 256u;
    return true;
}
struct PolGateUp {
    static constexpr bool PERM = true, GATHER = true;
    const bf16_t *HN, *WGUT; const float* bgu; const unsigned* LIST; bf16_t* ACT; const LAS unsigned* ext; int vcu;
    DI bool next(int i, pg8::Unit& u) const {
        int e, mt, pn, nv; unsigned s0;
        if (!moe_unit(ext, i * GRID + vcu, 8, e, mt, pn, nv, s0)) return false;
        u.type = mt; u.A = (const char*)HN; u.B0 = (const char*)(WGUT + ((size_t)e * 2048 + pn * 128) * D); u.bh = 1024u * D * 2u; u.r0 = (int)s0; u.c0 = pn * 128; u.nvalid = nv; u.aux = e;
        return true;
    }
    DI void aoff(const pg8::Unit& u, int wbase, int, unsigned (&va)[2][2]) const {
        const unsigned* lp = LIST + (size_t)u.aux * T + (size_t)u.type * 256;
        const int t = wbase | fresh_lane();
#pragma unroll
        for (int i = 0; i < 2; ++i) { int R, C; pg8::stage_rc(t * 16 + i * 8192, R, C);
#pragma unroll
            for (int h = 0; h < 2; ++h) { int r = h * 128 + R; r = r < u.nvalid ? r : u.nvalid - 1; const unsigned tok = lp[r]; va[h][i] = tok * (unsigned)(D * 2) + (unsigned)C * 2u; } }
    }
    DI void epi(const AccT& acc, const pg8::Unit& u, int wr, int wc, int fr, int fq) const {
        const int cb = u.c0 + wc * 32 + 8 * fq; const float* bp = bgu + (size_t)u.aux * 2048;
        const f32x4 bg0 = *(const f32x4*)(bp + cb), bg1 = *(const f32x4*)(bp + cb + 4), bl0 = *(const f32x4*)(bp + 1024 + cb), bl1 = *(const f32x4*)(bp + 1024 + cb + 4);
#pragma unroll
        for (int ai = 0; ai < 2; ++ai)
#pragma unroll
            for (int m = 0; m < 4; ++m) { const int rl = ai * 128 + wr * 64 + m * 16 + fr;
                f32x4 g0 = acc[ai][0][m][0] + bg0, g1 = acc[ai][0][m][1] + bg1, l0 = acc[ai][1][m][0] + bl0, l1 = acc[ai][1][m][1] + bl1, a0, a1;
#pragma unroll
                for (int i = 0; i < 4; ++i) {
                    const float x0 = fminf(g0[i], 7.f), x1 = fminf(g1[i], 7.f), y0 = fminf(fmaxf(l0[i], -7.f), 7.f), y1 = fminf(fmaxf(l1[i], -7.f), 7.f);
                    a0[i] = x0 * rcpf(1.f + ex2(-1.702f * LOG2E * x0)) * (y0 + 1.f); a1[i] = x1 * rcpf(1.f + ex2(-1.702f * LOG2E * x1)) * (y1 + 1.f); }
                if (rl < u.nvalid) store8_bf16(ACT + (size_t)(u.r0 + rl) * D + cb, a0, a1); }
    }
};
struct PolDown {
    static constexpr bool PERM = true, GATHER = false;
    const bf16_t *ACT, *WDNT; const float *bdn, *LISTW; bf16_t* OUTB; const LAS unsigned* ext; int vcu;
    DI bool next(int i, pg8::Unit& u) const {
        int e, mt, pn, nv; unsigned s0;
        if (!moe_unit(ext, i * GRID + vcu, 4, e, mt, pn, nv, s0)) return false;
        u.type = mt; u.A = (const char*)(ACT + (size_t)s0 * D); u.B0 = (const char*)(WDNT + ((size_t)e * 1024 + pn * 256) * D); u.bh = 128 * D * 2; u.r0 = (int)s0; u.c0 = pn * 256; u.nvalid = nv; u.aux = e;
        return true;
    }
    DI void aoff(const pg8::Unit&, int, int tid, unsigned (&va)[2][2]) const { pg8::aoff_std(tid, va); }
    DI void epi(const AccT& acc, const pg8::Unit& u, int wr, int wc, int fr, int fq) const {
        const float* bp = bdn + (size_t)u.aux * 1024; const float* wp = LISTW + (size_t)u.aux * T + (size_t)u.type * 256;
#pragma unroll
        for (int ai = 0; ai < 2; ++ai)
#pragma unroll
            for (int m = 0; m < 4; ++m) { const int rl = ai * 128 + wr * 64 + m * 16 + fr;
                if (rl < u.nvalid) { const float w = wp[rl];
#pragma unroll
                    for (int bj = 0; bj < 2; ++bj) { const int col = u.c0 + bj * 128 + wc * 32 + 8 * fq;
                        const f32x4 b0 = *(const f32x4*)(bp + col), b1 = *(const f32x4*)(bp + col + 4);
                        store8_bf16(OUTB + (size_t)(u.r0 + rl) * D + col, (acc[ai][bj][m][0] + b0) * w, (acc[ai][bj][m][1] + b1) * w); } } }
    }
};

struct PolProj1 {
    static constexpr bool PERM = true, GATHER = false;
    const bf16_t *HN, *HN2, *WBQT, *WKVT; const float *bq, *kvb, *ROPE; bf16_t *Q, *K1, *VT1; int vcu;
    DI bool next(int i, pg8::Unit& u) const {
        const int L = i * GRID + vcu; if (L >= 768) return false;
        u.bh = 128 * D * 2; u.nvalid = 256; u.aux = 0;
        if (L < 512) { const int pm = L >> 2, pn = L & 3; u.type = 0; u.A = (const char*)(HN + (size_t)pm * 256 * D); u.B0 = (const char*)(WBQT + (size_t)pn * 256 * D); u.r0 = pm * 256; u.c0 = pn * 256; }
        else if (L < 640) { const int pm = L - 512; u.type = 1; u.A = (const char*)(HN2 + (size_t)pm * 256 * D); u.B0 = (const char*)WKVT; u.r0 = pm * 256; u.c0 = 0; }
        else { const int pn = L - 640; u.type = 2; u.A = (const char*)WKVT; u.B0 = (const char*)(HN2 + (size_t)pn * 256 * D); u.r0 = 0; u.c0 = pn * 256; }
        return true;
    }
    DI void aoff(const pg8::Unit&, int, int tid, unsigned (&va)[2][2]) const { pg8::aoff_std(tid, va); }
    DI void epi(const AccT& acc, const pg8::Unit& u, int wr, int wc, int fr, int fq) const {
        if (u.type == 2) {
#pragma unroll
            for (int m = 0; m < 4; ++m) { const int vrow = wr * 64 + m * 16 + fr; const float bs = kvb[128 + vrow];
#pragma unroll
                for (int bj = 0; bj < 2; ++bj) store8_bf16(VT1 + (size_t)vrow * T + u.c0 + bj * 128 + wc * 32 + 8 * fq, acc[1][bj][m][0] + bs, acc[1][bj][m][1] + bs); }
            return;
        }
        const bool isq = (u.type == 0); const bool rl = ((wc & 1) == 0) && fq < 2; const float sc = isq ? QSCALE : 1.f;
#pragma unroll
        for (int bj = 0; bj < 2; ++bj) {
            if (!isq && bj == 1) continue;
            const int ct = bj * 128 + wc * 32 + 8 * fq; const float* bp = isq ? bq + u.c0 + ct : kvb + ct;
            const f32x4 b0 = *(const f32x4*)bp, b1 = *(const f32x4*)(bp + 4);
#pragma unroll
            for (int ai = 0; ai < 2; ++ai)
#pragma unroll
                for (int m = 0; m < 4; ++m) { const int row = u.r0 + ai * 128 + wr * 64 + m * 16 + fr;
                    f32x4 v0 = acc[ai][bj][m][0] + b0, v1 = acc[ai][bj][m][1] + b1;
                    if ((wc & 1) == 0) { f32x4 r0 = v0, r1 = v1; rope8(r0, r1, ROPE + (size_t)row * 16, fq); if (rl) { v0 = r0; v1 = r1; } }
                    v0 = v0 * sc; v1 = v1 * sc;
                    if (isq) store8_bf16(Q + (size_t)row * D + u.c0 + ct, v0, v1); else store8_bf16(K1 + (size_t)row * 128 + ct, v0, v1); } }
    }
};
DI float gelu_tanh(float z) {
    const float u = 0.7978845608028654f * (z + 0.044715f * z * z * z);
    const float e = ex2(2.f * LOG2E * u);
    const float th = 1.f - 2.f * rcpf(e + 1.f);
    return 0.5f * z * (1.f + th);
}
DI void compress_phase(Frame& F) {
    const int lane = F.lane, r = lane & 31, h = lane >> 5, quad = F.wave >> 2, q = F.wave & 3;
    const int rb = F.bx * 2 + quad, kv = rb >> 8, rem = rb & 255, b = rem >> 4, g = (rem >> 2) & 3, nb = rem & 3;
    const int n = nb * 32 + r, nn = n < 126 ? n : 126;
    LAS unsigned char* hid = F.lds + quad * (32 * 272);
    const bf16_t* w1p = F.CW1T() + ((size_t)kv * 128 + 32 * q + r) * 2048 + 8 * h;
    const bf16_t* xp = F.KV() + ((size_t)(b * SEQ + 16 * nn)) * D + kv * 256 + g * 64 + 8 * h;
    f32x16 acc;
#pragma unroll
    for (int i = 0; i < 16; ++i) acc[i] = 0.f;
#pragma unroll 4
    for (int ks = 0; ks < 128; ++ks) {
        const bf16x8 a = *(const bf16x8*)(w1p + 16 * ks);
        const bf16x8 bb = *(const bf16x8*)(xp + (size_t)(ks >> 2) * D + (ks & 3) * 16);
        acc = MFMA32(a, bb, acc);
    }
    {
        const float* cb = F.CMPB() + kv * 128 + 32 * q;
#pragma unroll
        for (int q4 = 0; q4 < 4; ++q4) {
            float v[4];
#pragma unroll
            for (int i = 0; i < 4; ++i) v[i] = gelu_tanh(acc[4 * q4 + i] + cb[8 * q4 + 4 * h + i]);
            u32x2 o; o.x = pk2(v[0], v[1]); o.y = pk2(v[2], v[3]);
            *(LAS u32x2*)(hid + r * 272 + (32 * q + 8 * q4 + 4 * h) * 2) = o;
        }
    }
    __syncthreads();
    if (q < 2) {
        const int db = q;
        f32x16 o2;
#pragma unroll
        for (int i = 0; i < 16; ++i) o2[i] = 0.f;
        const bf16_t* w2p = F.CW2T() + ((size_t)kv * 64 + 32 * db + r) * 128 + 8 * h;
#pragma unroll
        for (int s = 0; s < 8; ++s) {
            const bf16x8 a = *(const bf16x8*)(w2p + 16 * s);
            const bf16x8 bb = *(const LAS bf16x8*)(hid + r * 272 + (16 * s + 8 * h) * 2);
            o2 = MFMA32(a, bb, o2);
        }
        const bool valid = n < 127;
        if (kv == 0) {
            if (db == 0) {
                const float* rp = F.ROPE() + (size_t)(b * SEQ + 16 * nn + 31) * 16 + 4 * h;
                const f32x4 c = *(const f32x4*)rp, sn = *(const f32x4*)(rp + 8);
#pragma unroll
                for (int i = 0; i < 4; ++i) { const float x1 = o2[i], x2 = o2[4 + i]; o2[i] = x1 * c[i] - x2 * sn[i]; o2[4 + i] = x2 * c[i] + x1 * sn[i]; }
            }
            bf16_t* kp = F.KC() + ((size_t)((b * 4 + g) * 128 + n)) * 64 + 32 * db + 4 * h;
#pragma unroll
            for (int q4 = 0; q4 < 4; ++q4) { u32x2 o; o.x = valid ? pk2(o2[4 * q4], o2[4 * q4 + 1]) : 0u; o.y = valid ? pk2(o2[4 * q4 + 2], o2[4 * q4 + 3]) : 0u; *(u32x2*)(kp + 8 * q4) = o; }
        } else {
#pragma unroll
            for (int i = 0; i < 16; ++i) { const int d = 32 * db + crow(i, h);
                F.VCT()[((size_t)((b * 4 + g) * 64 + d)) * 128 + n] = valid ? (bf16_t)(pk2(o2[i], 0.f) & 0xffffu) : (bf16_t)0; }
        }
    }
    __syncthreads();
}

constexpr int AT_KT = 0, AT_VT = 18432, AT_KC = 35840, AT_VC = 54272, AT_IMPP = 71168, AT_IMPS = 103936, AT_SELM = 112128;
#define NEG_INF (-INFINITY)

DI void tile_step(const LAS unsigned char* kt, const LAS unsigned char* vt, const bf16x8 (&qf)[4], f32x16 (&O)[2], float& m, float& l, int lo, int hi, bool needmask, int r, int h) {
    f32x16 s0, s1;
#pragma unroll
    for (int i = 0; i < 16; ++i) { s0[i] = 0.f; s1[i] = 0.f; }
    const LAS unsigned char* kp = kt + r * 144 + h * 16;
#pragma unroll
    for (int s = 0; s < 4; ++s) {
        const bf16x8 a0 = *(const LAS bf16x8*)(kp + s * 32), a1 = *(const LAS bf16x8*)(kp + 32 * 144 + s * 32);
        s0 = MFMA32(a0, qf[s], s0); s1 = MFMA32(a1, qf[s], s1);
    }
    __builtin_amdgcn_sched_barrier(0);
    if (needmask) {
#pragma unroll
        for (int i = 0; i < 16; ++i) { const int kk = crow(i, h);
            s0[i] = (kk > lo && kk <= hi) ? s0[i] : NEG_INF; s1[i] = (kk + 32 > lo && kk + 32 <= hi) ? s1[i] : NEG_INF; }
    }
    float mx = NEG_INF;
#pragma unroll
    for (int i = 0; i < 16; ++i) mx = fmaxf(mx, fmaxf(s0[i], s1[i]));
    mx = fmaxf(mx, __shfl_xor(mx, 32));
    const float mn = fmaxf(m, mx), mu = (mn == NEG_INF) ? 0.f : mn;
    const float alpha = ex2(m - mu);
    float ls = 0.f;
#pragma unroll
    for (int i = 0; i < 16; ++i) { s0[i] = ex2(s0[i] - mu); s1[i] = ex2(s1[i] - mu); ls += s0[i] + s1[i]; }
    l = l * alpha + ls; m = mn;
#pragma unroll
    for (int i = 0; i < 16; ++i) { O[0][i] *= alpha; O[1][i] *= alpha; }
    bf16x8 pb[2][2];
#pragma unroll
    for (int s2 = 0; s2 < 2; ++s2) {
        u32x4 p0, p1;
        p0.x = pk2(s0[8 * s2 + 0], s0[8 * s2 + 1]); p0.y = pk2(s0[8 * s2 + 2], s0[8 * s2 + 3]); p0.z = pk2(s0[8 * s2 + 4], s0[8 * s2 + 5]); p0.w = pk2(s0[8 * s2 + 6], s0[8 * s2 + 7]);
        p1.x = pk2(s1[8 * s2 + 0], s1[8 * s2 + 1]); p1.y = pk2(s1[8 * s2 + 2], s1[8 * s2 + 3]); p1.z = pk2(s1[8 * s2 + 4], s1[8 * s2 + 5]); p1.w = pk2(s1[8 * s2 + 6], s1[8 * s2 + 7]);
        pb[0][s2] = __builtin_bit_cast(bf16x8, p0); pb[1][s2] = __builtin_bit_cast(bf16x8, p1);
    }
    __builtin_amdgcn_sched_barrier(0);
    const LAS unsigned char* vp = vt + r * 136 + h * 8;
#pragma unroll
    for (int db = 0; db < 2; ++db)
#pragma unroll
        for (int kb = 0; kb < 2; ++kb)
#pragma unroll
            for (int s2 = 0; s2 < 2; ++s2) {
                const LAS unsigned char* a = vp + db * 32 * 136 + kb * 64 + s2 * 32;
                const s16x4 lo4 = *(const LAS s16x4*)a, hi4 = *(const LAS s16x4*)(a + 16);
                const bf16x8 va = __builtin_shufflevector(lo4, hi4, 0, 1, 2, 3, 4, 5, 6, 7);
                O[db] = MFMA32(va, pb[kb][s2], O[db]);
            }
}

#define AT_WRITE(buf, kreg, vreg) do { *(LAS u32x4*)(lds + AT_KT + (buf) * 9216 + (tid >> 3) * 144 + (tid & 7) * 16) = (kreg); \
        LAS u32x2* _vp = (LAS u32x2*)(lds + AT_VT + (buf) * 8704 + (tid >> 3) * 136 + (tid & 7) * 16); _vp[0] = (u32x2){(vreg).x, (vreg).y}; _vp[1] = (u32x2){(vreg).z, (vreg).w}; } while (0)

DI void nsa_attn_phase(Frame& F) {
    LAS unsigned char* lds = F.lds;
    const int tid = F.tid, lane = F.lane, wave = F.wave, r = lane & 31, h = lane >> 5, hh = wave & 3, th = wave >> 2;
    const int bg = F.bx & 63, b = bg >> 2, g = bg & 3, s4 = F.bx >> 6;
    LAS float* impP = (LAS float*)(lds + AT_IMPP);
    LAS float* impS = (LAS float*)(lds + AT_IMPS);
    LAS unsigned* selm = (LAS unsigned*)(lds + AT_SELM);
    const int head = g * 4 + hh, tl = th * 32 + r;
    for (int ui = 0; ui < 8; ++ui) {
        const int pp = s4 + 4 * (ui >> 1), qt = (ui & 1) ? 31 - pp : pp;
        const int t = qt * 64 + tl; const size_t tokrow = (size_t)b * SEQ + t;
        bf16x8 qf[4];
#pragma unroll
        for (int s = 0; s < 4; ++s) qf[s] = *(const bf16x8*)(F.Q() + tokrow * D + head * 64 + 16 * s + 8 * h);
        const float gc = F.GATES()[tokrow * 64 + head * 3 + 0], gs = F.GATES()[tokrow * 64 + head * 3 + 1], gw = F.GATES()[tokrow * 64 + head * 3 + 2];
#pragma unroll
        for (int i = 0; i < 2; ++i) { const int idx = tid + 512 * i, row = idx >> 3, ch = idx & 7;
            *(LAS u32x4*)(lds + AT_KC + row * 144 + ch * 16) = *(const u32x4*)(F.KC() + ((size_t)((b * 4 + g) * 128 + row)) * 64 + ch * 8); }
#pragma unroll
        for (int i = 0; i < 2; ++i) { const int idx = tid + 512 * i, d = idx >> 4, ch = idx & 15;
            const u32x4 v = *(const u32x4*)(F.VCT() + ((size_t)((b * 4 + g) * 64 + d)) * 128 + ch * 8);
            LAS u32x2* vp = (LAS u32x2*)(lds + AT_VC + d * 264 + ch * 16); vp[0] = (u32x2){v.x, v.y}; vp[1] = (u32x2){v.z, v.w}; }
        if (tid < 64) selm[tid] = 0u;
        __syncthreads();
        f32x16 Ot[2];
#pragma unroll
        for (int i = 0; i < 16; ++i) { Ot[0][i] = 0.f; Ot[1][i] = 0.f; }
#ifndef NO_CMP
        {
            const int nmax = (t - 31) >> 4;
            float mrun = NEG_INF, lrun = 0.f;
#pragma unroll 1
            for (int kb = 0; kb < 4; ++kb) {
                f32x16 sc;
#pragma unroll
                for (int i = 0; i < 16; ++i) sc[i] = 0.f;
#pragma unroll
                for (int s = 0; s < 4; ++s) { const bf16x8 a = *(const LAS bf16x8*)(lds + AT_KC + (kb * 32 + r) * 144 + s * 32 + h * 16); sc = MFMA32(a, qf[s], sc); }
                float bm = NEG_INF;
#pragma unroll
                for (int i = 0; i < 16; ++i) { const int nn = kb * 32 + crow(i, h); sc[i] = (nn <= nmax) ? sc[i] : NEG_INF; bm = fmaxf(bm, sc[i]); }
                const float mn = fmaxf(mrun, bm), mu = (mn == NEG_INF) ? 0.f : mn;
                float ls = 0.f;
#pragma unroll
                for (int i = 0; i < 16; ++i) ls += ex2(sc[i] - mu);
                lrun = lrun * ex2(mrun - mu) + ls; mrun = mn;
            }
            float mu, inv;
            { const float mo = __shfl_xor(mrun, 32), lo_ = __shfl_xor(lrun, 32); const float mt = fmaxf(mrun, mo); mu = (mt == NEG_INF) ? 0.f : mt;
              const float lt = lrun * ex2(mrun - mu) + lo_ * ex2(mo - mu); inv = lt > 0.f ? 1.f / lt : 0.f; }
            f32x16 Oc[2];
#pragma unroll
            for (int i = 0; i < 16; ++i) { Oc[0][i] = 0.f; Oc[1][i] = 0.f; }
            LAS float* ip = impP + ((hh * 64 + tl) * 32);
            float carry = 0.f;
#pragma unroll 1
            for (int kb = 0; kb < 4; ++kb) {
                f32x16 sc;
#pragma unroll
                for (int i = 0; i < 16; ++i) sc[i] = 0.f;
#pragma unroll
                for (int s = 0; s < 4; ++s) { const bf16x8 a = *(const LAS bf16x8*)(lds + AT_KC + (kb * 32 + r) * 144 + s * 32 + h * 16); sc = MFMA32(a, qf[s], sc); }
#pragma unroll
                for (int i = 0; i < 16; ++i) { const int nn = kb * 32 + crow(i, h); sc[i] = (nn <= nmax) ? ex2(sc[i] - mu) * inv : 0.f; }
                float Lo[4];
#pragma unroll
                for (int q4 = 0; q4 < 4; ++q4) Lo[q4] = __shfl_xor(sc[4 * q4 + 3], 32);
#pragma unroll
                for (int q4 = 0; q4 < 4; ++q4) {
                    const float G = (sc[4 * q4] + sc[4 * q4 + 1]) + (sc[4 * q4 + 2] + sc[4 * q4 + 3]);
                    const float prev0 = (q4 > 0) ? Lo[q4 > 0 ? q4 - 1 : 0] : carry;
                    const float Lp = (h == 1) ? Lo[q4] : prev0;
                    ip[8 * kb + 2 * q4 + h] = G + Lp;
                }
                carry = Lo[3];
#pragma unroll
                for (int s2 = 0; s2 < 2; ++s2) {
                    u32x4 p;
                    p.x = pk2(sc[8 * s2 + 0], sc[8 * s2 + 1]); p.y = pk2(sc[8 * s2 + 2], sc[8 * s2 + 3]); p.z = pk2(sc[8 * s2 + 4], sc[8 * s2 + 5]); p.w = pk2(sc[8 * s2 + 6], sc[8 * s2 + 7]);
                    const bf16x8 pb = __builtin_bit_cast(bf16x8, p);
#pragma unroll
                    for (int db = 0; db < 2; ++db) {
                        const LAS unsigned char* a = lds + AT_VC + (db * 32 + r) * 264 + (kb * 32 + 16 * s2 + 4 * h) * 2;
                        const s16x4 lo4 = *(const LAS s16x4*)a, hi4 = *(const LAS s16x4*)(a + 16);
                        const bf16x8 va = __builtin_shufflevector(lo4, hi4, 0, 1, 2, 3, 4, 5, 6, 7);
                        Oc[db] = MFMA32(va, pb, Oc[db]);
                    }
                }
            }
#pragma unroll
            for (int i = 0; i < 16; ++i) { Ot[0][i] = gc * Oc[0][i]; Ot[1][i] = gc * Oc[1][i]; }
        }
#endif
        __syncthreads();
        {
            const int tok = tid >> 3, sub = tid & 7;
#pragma unroll
            for (int jj = 0; jj < 4; ++jj) { const int j = sub * 4 + jj;
                impS[tok * 32 + j] = ((impP[(0 * 64 + tok) * 32 + j] + impP[(1 * 64 + tok) * 32 + j]) + impP[(2 * 64 + tok) * 32 + j]) + impP[(3 * 64 + tok) * 32 + j]; }
        }
        __syncthreads();
#ifndef NO_TOPK
        {
            const int tok = tid >> 3, sub = tid & 7;
            if (qt < 16) { if (sub == 0) selm[tok] = (2u << qt) - 1u; }
            else {
                float vj[4]; int rank[4];
#pragma unroll
                for (int jj = 0; jj < 4; ++jj) { vj[jj] = impS[tok * 32 + sub * 4 + jj]; rank[jj] = 0; }
#pragma unroll 1
                for (int i = 1; i <= qt - 2; ++i) { const float vi = impS[tok * 32 + i];
#pragma unroll
                    for (int jj = 0; jj < 4; ++jj) { const int j = sub * 4 + jj; rank[jj] += ((vi > vj[jj]) || (vi == vj[jj] && i < j)) ? 1 : 0; } }
                unsigned bits = 0u;
#pragma unroll
                for (int jj = 0; jj < 4; ++jj) { const int j = sub * 4 + jj;
                    const bool forced = (j == 0 || j == qt || j == qt - 1);
                    const bool sel = forced || (j <= qt - 2 && rank[jj] < 13);
                    bits |= sel ? (1u << j) : 0u; }
                if (bits) __hip_atomic_fetch_or(selm + tok, bits, __ATOMIC_RELAXED, __HIP_MEMORY_SCOPE_WORKGROUP);
            }
        }
#endif
        __syncthreads();
        LAS float* park = (LAS float*)(lds + AT_KC) + wave * 2048 + lane;
#pragma unroll
        for (int i = 0; i < 16; ++i) { park[i * 64] = Ot[0][i]; park[(16 + i) * 64] = Ot[1][i]; }
        const unsigned myselm = selm[tl];
        unsigned need;
        { unsigned w = selm[lane];
#pragma unroll
            for (int o = 1; o < 64; o <<= 1) w |= (unsigned)__shfl_xor((int)w, o);
            need = (unsigned)__builtin_amdgcn_readfirstlane((int)w) & ((2u << qt) - 1u); }
#ifndef NO_SEL
        {
            f32x16 O[2];
#pragma unroll
            for (int i = 0; i < 16; ++i) { O[0][i] = 0.f; O[1][i] = 0.f; }
            float m = NEG_INF, l = 0.f;
            const bf16_t* kbase = F.KV() + ((size_t)b * SEQ + (tid >> 3)) * D + 512 + g * 64 + (tid & 7) * 8;
            const bf16_t* vbase = F.VT() + ((size_t)(g * 64 + (tid >> 3))) * T + (size_t)b * SEQ + (tid & 7) * 8;
            int j = __builtin_ctz(need); int buf = 0;
            u32x4 kr = *(const u32x4*)(kbase + (size_t)(64 * j) * D), vr = *(const u32x4*)(vbase + 64 * j);
            AT_WRITE(0, kr, vr);
            __syncthreads();
            for (;;) {
                const unsigned rest = need & ~((2u << j) - 1u); const int jn = rest ? __builtin_ctz(rest) : -1;
                if (jn >= 0) { kr = *(const u32x4*)(kbase + (size_t)(64 * jn) * D); vr = *(const u32x4*)(vbase + 64 * jn); }
                const bool allow = (myselm >> j) & 1u;
                const int hi = allow ? ((j == qt) ? tl : 63) : -1;
                const bool nm = !__all(hi >= 63);
                tile_step(lds + AT_KT + buf * 9216, lds + AT_VT + buf * 8704, qf, O, m, l, -1, hi, nm, r, h);
                if (jn >= 0) AT_WRITE(buf ^ 1, kr, vr);
                __syncthreads();
                if (jn < 0) break;
                j = jn; buf ^= 1;
            }
            l += __shfl_xor(l, 32);
            const float sc = l > 0.f ? gs / l : 0.f;
#pragma unroll
            for (int i = 0; i < 16; ++i) { park[i * 64] += sc * O[0][i]; park[(16 + i) * 64] += sc * O[1][i]; }
        }
#endif
#ifndef NO_SWA
        {
            f32x16 O[2];
#pragma unroll
            for (int i = 0; i < 16; ++i) { O[0][i] = 0.f; O[1][i] = 0.f; }
            float m = NEG_INF, l = 0.f;
            const bf16_t* kbase = F.KV() + ((size_t)b * SEQ + (tid >> 3)) * D + 768 + g * 64 + (tid & 7) * 8;
            const bf16_t* vbase = F.VT() + ((size_t)(256 + g * 64 + (tid >> 3))) * T + (size_t)b * SEQ + (tid & 7) * 8;
            const int j0 = qt > 8 ? qt - 8 : 0;
            int j = j0, buf = 0;
            u32x4 kr = *(const u32x4*)(kbase + (size_t)(64 * j) * D), vr = *(const u32x4*)(vbase + 64 * j);
            AT_WRITE(0, kr, vr);
            __syncthreads();
            for (;;) {
                const int jn = (j < qt) ? j + 1 : -1;
                if (jn >= 0) { kr = *(const u32x4*)(kbase + (size_t)(64 * jn) * D); vr = *(const u32x4*)(vbase + 64 * jn); }
                const int hi = 64 * (qt - j) + tl, lo = hi - 512;
                const bool nm = (j == qt) || (j == qt - 8);
                tile_step(lds + AT_KT + buf * 9216, lds + AT_VT + buf * 8704, qf, O, m, l, lo, hi, nm, r, h);
                if (jn >= 0) AT_WRITE(buf ^ 1, kr, vr);
                __syncthreads();
                if (jn < 0) break;
                j = jn; buf ^= 1;
            }
            l += __shfl_xor(l, 32);
            const float sc = l > 0.f ? gw / l : 0.f;
#pragma unroll
            for (int i = 0; i < 16; ++i) { Ot[0][i] = park[i * 64] + sc * O[0][i]; Ot[1][i] = park[(16 + i) * 64] + sc * O[1][i]; }
        }
#endif
        {
            bf16_t* op = F.O() + tokrow * D + head * 64 + 4 * h;
#pragma unroll
            for (int db = 0; db < 2; ++db)
#pragma unroll
                for (int q4 = 0; q4 < 4; ++q4) { u32x2 o; o.x = pk2(Ot[db][4 * q4], Ot[db][4 * q4 + 1]); o.y = pk2(Ot[db][4 * q4 + 2], Ot[db][4 * q4 + 3]); *(u32x2*)(op + db * 32 + 8 * q4) = o; }
        }
        __syncthreads();
    }
}

DI void swa_sink_phase(Frame& F) {
    LAS unsigned char* lds = F.lds;
    const int tid = F.tid, lane = F.lane, wave = F.wave, r = lane & 31, h = lane >> 5;
    for (int ui = 0; ui < 8; ++ui) {
        const int u = ui * GRID + F.vcu, q32 = u & 63, kvh = (u >> 6) & 1, b = u >> 7;
        const int head = kvh * 8 + wave, t = q32 * 32 + r; const size_t tokrow = (size_t)b * SEQ + t;
        bf16x8 qf[4];
#pragma unroll
        for (int s = 0; s < 4; ++s) qf[s] = *(const bf16x8*)(F.Q() + tokrow * D + head * 64 + 16 * s + 8 * h);
        f32x16 O[2];
#pragma unroll
        for (int i = 0; i < 16; ++i) { O[0][i] = 0.f; O[1][i] = 0.f; }
        float m = F.b_sinks()[head] * LOG2E, l = (h == 0) ? 1.f : 0.f;
        const bf16_t* kbase = F.KV() + ((size_t)b * SEQ + (tid >> 3)) * 128 + kvh * 64 + (tid & 7) * 8;
        const bf16_t* vbase = F.VT() + ((size_t)(kvh * 64 + (tid >> 3))) * T + (size_t)b * SEQ + (tid & 7) * 8;
        const int klo = 32 * q32 - 127, j0 = (klo > 0 ? klo : 0) >> 6, j1 = (32 * q32 + 31) >> 6;
        int j = j0, buf = 0;
        u32x4 kr = *(const u32x4*)(kbase + (size_t)(64 * j) * 128), vr = *(const u32x4*)(vbase + 64 * j);
        AT_WRITE(0, kr, vr);
        __syncthreads();
        for (;;) {
            const int jn = (j < j1) ? j + 1 : -1;
            if (jn >= 0) { kr = *(const u32x4*)(kbase + (size_t)(64 * jn) * 128); vr = *(const u32x4*)(vbase + 64 * jn); }
            const int hi = t - 64 * j, lo = hi - 128;
            tile_step(lds + AT_KT + buf * 9216, lds + AT_VT + buf * 8704, qf, O, m, l, lo, hi, true, r, h);
            if (jn >= 0) AT_WRITE(buf ^ 1, kr, vr);
            __syncthreads();
            if (jn < 0) break;
            j = jn; buf ^= 1;
        }
        l += __shfl_xor(l, 32);
        const float sc = 1.f / l;
        bf16_t* op = F.O() + tokrow * D + head * 64 + 4 * h;
#pragma unroll
        for (int db = 0; db < 2; ++db)
#pragma unroll
            for (int q4 = 0; q4 < 4; ++q4) { u32x2 o; o.x = pk2(O[db][4 * q4] * sc, O[db][4 * q4 + 1] * sc); o.y = pk2(O[db][4 * q4 + 2] * sc, O[db][4 * q4 + 3] * sc); *(u32x2*)(op + db * 32 + 8 * q4) = o; }
    }
}
#ifndef N_LAUNCHES
#define N_LAUNCHES 1
#endif
constexpr int N_PHASES = 17;
__global__ void __launch_bounds__(NTHR, 2) fwd_kernel(Args args) {
    extern __shared__ __attribute__((aligned(16))) unsigned char lds_raw[];
    LAS unsigned char* const lds = (LAS unsigned char*)lds_raw;
    const int wave0 = __builtin_amdgcn_readfirstlane((int)(threadIdx.x >> 6));
    for (int u = threadIdx.x; u < 256; u += NTHR) ((LAS unsigned*)(lds + MISC_OFF))[u] = 0u;
    __syncthreads();
#if N_LAUNCHES == 1
    { Frame F = make_frame(lds, wave0); (void)xcd_barrier_post(F.ctl() + CW_BAR, (volatile LAS unsigned*)(lds + MISC_OFF)); }
#define IN(k) true
#define SEAM(k) do { Frame Fb = make_frame(lds, wave0); XcdBarrier _b; _b.bar = Fb.ctl() + CW_BAR; _b.x = xb_xcc_id(); _b.st = (volatile LAS unsigned*)(lds + MISC_OFF); xcd_barrier(_b); } while (0)
#else
#ifdef ONLY_PHASE
#define IN(k) ((k) == ONLY_PHASE && args.ph_lo <= (k) && (k) < args.ph_hi)
#else
#define IN(k) (args.ph_lo <= (k) && (k) < args.ph_hi)
#endif
#define SEAM(k) do { } while (0)
#endif
    const LAS unsigned* ext = (const LAS unsigned*)(lds + EXT_OFF);
#ifndef REPEAT_MASK
#define REPEAT_MASK 0
#endif
#define PH(k, ...) do { if (IN(k)) { __VA_ARGS__ } if ((((REPEAT_MASK) >> (k)) & 1) && IN(k)) { __VA_ARGS__ } } while (0)

    PH(0, Frame F = make_frame(lds, wave0); p0_prologue(F);); SEAM(0);
    PH(1, Frame F = make_frame(lds, wave0); norm_plain_phase(F);); SEAM(1);
    PH(2, Frame F = make_frame(lds, wave0); PolProj0 P{F.HN(), F.WINT(), F.Q(), F.KV(), F.VT(), F.GATES(), F.ROPE(), F.vcu}; pg8::gemm_phase(lds, P, F.wave, F.lane);); SEAM(2);
    PH(3, Frame F = make_frame(lds, wave0); compress_phase(F);); SEAM(3);
    PH(4, Frame F = make_frame(lds, wave0); nsa_attn_phase(F);); SEAM(4);
    PH(5, Frame F = make_frame(lds, wave0); PolOut P{F.O(), F.WAOT(), F.x(), F.MODV() + (size_t)0 * 16 * 3072, nullptr, F.H(), F.vcu}; pg8::gemm_phase(lds, P, F.wave, F.lane);); SEAM(5);
    PH(6, Frame F = make_frame(lds, wave0); norm_router_phase(F, 0);); SEAM(6);
    PH(7, Frame F = make_frame(lds, wave0); load_expert_tables(F, 0, 8); PolGateUp P{F.HN(), F.WGUT(), F.b_gate_up(), F.LIST(), F.ACT(), ext, F.vcu}; pg8::gemm_phase(lds, P, F.wave, F.lane);); SEAM(7);
    PH(8, Frame F = make_frame(lds, wave0); load_expert_tables(F, 0, 4); PolDown P{F.ACT(), F.WDNT(), F.b_down(), F.LISTW(), F.OUTB(), ext, F.vcu}; pg8::gemm_phase(lds, P, F.wave, F.lane);); SEAM(8);
    PH(9, Frame F = make_frame(lds, wave0); combine_phase<false>(F, 0);); SEAM(9);
    PH(10, Frame F = make_frame(lds, wave0); PolProj1 P{F.HN(), F.HN2(), F.WBQT(), F.WKVT(), F.b_b_q(), F.kv_b(), F.ROPE(), F.Q(), F.KV(), F.VT(), F.vcu}; pg8::gemm_phase(lds, P, F.wave, F.lane);); SEAM(10);
    PH(11, Frame F = make_frame(lds, wave0); swa_sink_phase(F);); SEAM(11);
    PH(12, Frame F = make_frame(lds, wave0); PolOut P{F.O(), F.WBOT(), F.H(), F.MODV() + (size_t)2 * 16 * 3072, F.b_b_out(), F.H(), F.vcu}; pg8::gemm_phase(lds, P, F.wave, F.lane);); SEAM(12);
    PH(13, Frame F = make_frame(lds, wave0); norm_router_phase(F, 1);); SEAM(13);
    PH(14, Frame F = make_frame(lds, wave0); load_expert_tables(F, 1, 8); PolGateUp P{F.HN(), F.WGUT() + (size_t)32 * 2048 * D, F.b_gate_up() + 32 * 2048, F.LIST(), F.ACT(), ext, F.vcu}; pg8::gemm_phase(lds, P, F.wave, F.lane);); SEAM(14);
    PH(15, Frame F = make_frame(lds, wave0); load_expert_tables(F, 1, 4); PolDown P{F.ACT(), F.WDNT() + (size_t)32 * D * D, F.b_down() + 32 * 1024, F.LISTW(), F.OUTB(), ext, F.vcu}; pg8::gemm_phase(lds, P, F.wave, F.lane);); SEAM(15);
    PH(16, Frame F = make_frame(lds, wave0); combine_phase<true>(F, 1););
#undef IN
#undef SEAM
}

extern "C" void kernel_launch(void* const* d_in, const int* in_sizes, int n_in, void* d_out, int out_size, void* d_ws, size_t ws_size, hipStream_t stream) {
    static int ready = 0;
    if (ready == 0) {
        if (n_in != 28 || out_size != T * D || ws_size < WS_END) { fprintf(stderr, "kernel_launch: unexpected shapes (n_in %d out %d ws %zu)\n", n_in, out_size, ws_size); ready = -1; return; }
        int dev = 0, cus = 0, per_cu = 0;
        if (hipGetDevice(&dev) != hipSuccess || hipDeviceGetAttribute(&cus, hipDeviceAttributeMultiprocessorCount, dev) != hipSuccess) { ready = -1; return; }
        if (hipFuncSetAttribute((const void*)fwd_kernel, hipFuncAttributeMaxDynamicSharedMemorySize, LDS_BYTES) != hipSuccess) { fprintf(stderr, "kernel_launch: hipFuncSetAttribute failed\n"); ready = -1; return; }
        if (hipOccupancyMaxActiveBlocksPerMultiprocessor(&per_cu, (const void*)fwd_kernel, NTHR, LDS_BYTES) != hipSuccess || per_cu < 1) fprintf(stderr, "kernel_launch: occupancy query reports %d\n", per_cu);
        (void)hipGetLastError();
        if (cus < GRID) { fprintf(stderr, "kernel_launch: needs %d CUs, device has %d\n", GRID, cus); ready = -1; return; }
        ready = 1;
    }
    if (ready < 0) return;
    (void)hipMemsetAsync((char*)d_ws + WS_CTL, 0, CTL_ZERO_BYTES, stream);
    Args a{};
    for (int i = 0; i < 28; ++i) a.in[i] = d_in[i];
    a.out = (float*)d_out; a.ws = (unsigned char*)d_ws;
    if (N_LAUNCHES == 1) {
        a.ph_lo = 0; a.ph_hi = N_PHASES;
        hipLaunchKernelGGL(fwd_kernel, dim3(GRID), dim3(NTHR), LDS_BYTES, stream, a);
    } else {
        for (int p = 0; p < N_PHASES; ++p) { a.ph_lo = p; a.ph_hi = p + 1; hipLaunchKernelGGL(fwd_kernel, dim3(GRID), dim3(NTHR), LDS_BYTES, stream, a); }
    }
}
```

```cpp
#include <hip/hip_runtime.h>
#include <cstdio>
#include <cstdint>

#define DI __device__ __forceinline__
#define LAS __attribute__((address_space(3)))
#define GAS __attribute__((address_space(1)))
typedef unsigned short bf16_t;
typedef short bf16x8 __attribute__((ext_vector_type(8)));
typedef short s16x4 __attribute__((ext_vector_type(4)));
typedef float f32x2 __attribute__((ext_vector_type(2)));
typedef float f32x4 __attribute__((ext_vector_type(4)));
typedef float f32x16 __attribute__((ext_vector_type(16)));
typedef unsigned u32x4 __attribute__((ext_vector_type(4)));
typedef unsigned u32x2 __attribute__((ext_vector_type(2)));

constexpr int NB = 16, SEQ = 2048, T = NB * SEQ, D = 1024, HD = 64;
constexpr int NEXP = 32, TOPK = 4;
constexpr int A_PROJ = 2608;
constexpr float NORM_EPS = 1e-5f;
constexpr float QSCALE = 0.125f * 1.4426950408889634f;
constexpr float LOG2E = 1.4426950408889634f;
constexpr int NWAVES = 8, NTHR = 512, GRID = 256;

constexpr size_t MiB = (size_t)1 << 20;
constexpr size_t WS_CTL = 0, CTL_ZERO_BYTES = 1 * MiB;
constexpr size_t WS_MODV = 1 * MiB;
constexpr size_t WS_ROPE = 2 * MiB;
constexpr size_t WS_CMPB = 4 * MiB;
constexpr size_t WS_CW1T = 5 * MiB;
constexpr size_t WS_CW2T = 6 * MiB;
constexpr size_t WS_WINT = 7 * MiB;
constexpr size_t WS_WAOT = 13 * MiB;
constexpr size_t WS_WBQT = 15 * MiB;
constexpr size_t WS_WBOT = 17 * MiB;
constexpr size_t WS_WKVT = 19 * MiB;
constexpr size_t WS_KC = 20 * MiB;
constexpr size_t WS_VCT = 21 * MiB;
constexpr size_t WS_TOKSLOT = 22 * MiB;
constexpr size_t WS_GATES = 24 * MiB;
constexpr size_t WS_LIST = 32 * MiB;
constexpr size_t WS_LISTW = 36 * MiB;
constexpr size_t WS_VT = 40 * MiB;
constexpr size_t WS_WGUT = 72 * MiB;
constexpr size_t WS_WDNT = 328 * MiB;
constexpr size_t WS_H = 456 * MiB;
constexpr size_t WS_HN = 584 * MiB;
constexpr size_t WS_HN2 = 648 * MiB;
constexpr size_t WS_Q = 712 * MiB;
constexpr size_t WS_KV = 776 * MiB;
constexpr size_t WS_O = 840 * MiB;
constexpr size_t WS_ACT = 904 * MiB;
constexpr size_t WS_OUTB = 1161 * MiB;
constexpr size_t WS_END = 1417 * MiB;
constexpr int CW_BAR = 1024;
constexpr int CW_CNT = 8192;

constexpr int LDS_BYTES = 163840;
constexpr int MISC_OFF = LDS_BYTES - 1024;
constexpr int EXT_OFF = MISC_OFF + 64;

DI unsigned pk2(float lo, float hi) {
    typedef __bf16 bf2 __attribute__((ext_vector_type(2)));
    f32x2 v = {lo, hi}; bf2 b = __builtin_convertvector(v, bf2); return __builtin_bit_cast(unsigned, b);
}
DI float bf_lo(unsigned u) { return __uint_as_float(u << 16); }
DI float bf_hi(unsigned u) { return __uint_as_float(u & 0xffff0000u); }
DI float ex2(float x) { return __builtin_amdgcn_exp2f(x); }
DI float rcpf(float x) { return __builtin_amdgcn_rcpf(x); }
DI float wave_sum(float v) {
#pragma unroll
    for (int o = 1; o < 64; o <<= 1) v += __shfl_xor(v, o);
    return v;
}
DI int crow(int reg, int h) { return (reg & 3) + 8 * (reg >> 2) + 4 * h; }
#define MFMA32(a, b, c) __builtin_amdgcn_mfma_f32_32x32x16_bf16((a), (b), (c), 0, 0, 0)
#define LDS_WAIT() asm volatile("s_waitcnt lgkmcnt(0)" ::: "memory")
#define VM_WAIT() asm volatile("s_waitcnt vmcnt(0)" ::: "memory")

#define XB_TMO      128
#define XB_XCNT(j)  (256  + 64 * (j))
#define XB_XSUB(j)  (1280 + 64 * (j))
#define XB_XGEN(j)  (2304 + 64 * (j))
#define XB_TOP      3328
#define XB_TOPGEN   3392
#define XCD_BAR_WORDS 3456
#define XB_SPIN_CAP (1u << 21)

DI unsigned xb_ld(unsigned* p)              { return __hip_atomic_load(p, __ATOMIC_RELAXED, __HIP_MEMORY_SCOPE_AGENT); }
DI unsigned xb_add(unsigned* p, unsigned v) { return __hip_atomic_fetch_add(p, v, __ATOMIC_RELAXED, __HIP_MEMORY_SCOPE_AGENT); }
DI unsigned xb_xcc_id() { return (unsigned)__builtin_amdgcn_s_getreg((3 << 11) | 20) & 0xFu; }
#define XB_SPIN(cond, bar) do { unsigned _sp = 0; while (cond) { __builtin_amdgcn_s_sleep(1); \
    if ((++_sp & 255u) == 0u) { if (xb_ld(&(bar)[XB_TMO])) break; if (_sp > XB_SPIN_CAP) { atomicAdd(&(bar)[XB_TMO], 1u); break; } } } } while (0)

struct XcdBarrier { unsigned* bar; unsigned x; volatile LAS unsigned* st; };

DI XcdBarrier xcd_barrier_post(unsigned* bar, volatile LAS unsigned* st) {
    XcdBarrier b; b.bar = bar; b.x = xb_xcc_id(); b.st = st;
    if (threadIdx.x == 0) (void)xb_add(&bar[XB_XCNT(b.x)], 1u);
    return b;
}
DI void xcd_barrier_complete(unsigned* bar, unsigned x, unsigned& nloc, unsigned& nx) {
    const unsigned G = gridDim.x * gridDim.y * gridDim.z;
    unsigned sum, cnt, mine, sp = 0u;
    for (;;) {
        sum = 0u; cnt = 0u; mine = 0u;
#pragma unroll
        for (unsigned j = 0; j < 16; ++j) { const unsigned c = xb_ld(&bar[XB_XCNT(j)]); sum += c; cnt += (c > 0u) ? 1u : 0u; mine = (j == x) ? c : mine; }
        if (sum == G) break;
        __builtin_amdgcn_s_sleep(1);
        if ((++sp & 255u) == 0u) { if (xb_ld(&bar[XB_TMO])) break; if (sp > XB_SPIN_CAP) { atomicAdd(&bar[XB_TMO], 1u); break; } }
    }
    nloc = mine > 0u ? mine : 1u; nx = cnt > 0u ? cnt : 1u;
}
DI void xcd_barrier(const XcdBarrier& b) {
    asm volatile("s_waitcnt vmcnt(0)" ::: "memory");
    __syncthreads();
    if (threadIdx.x == 0) {
        unsigned* bar = b.bar;
        __builtin_amdgcn_s_waitcnt(0);
        unsigned nloc = b.st[0], nx = b.st[1];
        if (nloc == 0u) { xcd_barrier_complete(bar, b.x, nloc, nx); b.st[0] = nloc; b.st[1] = nx; }
        const unsigned old = xb_add(&bar[XB_XSUB(b.x)], 1u);
        const unsigned gen = old / nloc;
        if (old + 1u == (gen + 1u) * nloc) {
            __builtin_amdgcn_fence(__ATOMIC_RELEASE, "agent");
            asm volatile("s_waitcnt vmcnt(0)" ::: "memory");
            const unsigned og = xb_add(&bar[XB_TOP], 1u);
            const unsigned tg = og / nx;
            if (og + 1u == (tg + 1u) * nx) xb_add(&bar[XB_TOPGEN], 1u);
            else XB_SPIN(xb_ld(&bar[XB_TOPGEN]) == tg, bar);
            __builtin_amdgcn_fence(__ATOMIC_ACQUIRE, "agent");
            xb_add(&bar[XB_XGEN(b.x)], 1u);
            asm volatile("s_waitcnt vmcnt(0)" ::: "memory");
        } else {
            XB_SPIN(xb_ld(&bar[XB_XGEN(b.x)]) == gen, bar);
            __builtin_amdgcn_fence(__ATOMIC_ACQUIRE, "agent");
            asm volatile("s_waitcnt vmcnt(0)" ::: "memory");
        }
    }
    __syncthreads();
}

struct Args { const void* in[28]; float* out; unsigned char* ws; int ph_lo, ph_hi; };

typedef const __attribute__((address_space(4))) unsigned char* KPtr;
struct Frame {
    LAS unsigned char* lds; KPtr kp; int tid, lane, wave, vcu, bx;
    DI void* arg(int i) const { return *(void* const __attribute__((address_space(4)))*)(kp + 8 * i); }
    DI unsigned char* wsp() const { return (unsigned char*)arg(29); }
    DI unsigned* ctl() const { return (unsigned*)(wsp() + WS_CTL); }
    DI float* out() const { return (float*)arg(28); }
    DI const float* x() const { return (const float*)arg(0); }
    DI const float* c() const { return (const float*)arg(1); }
    DI const int* positions() const { return (const int*)arg(2); }
    DI const float* mod_w() const { return (const float*)arg(3); }
    DI const float* mod_b() const { return (const float*)arg(4); }
    DI const float* norm_g() const { return (const float*)arg(5); }
    DI const float* final_g() const { return (const float*)arg(6); }
    DI const float* a_w_in() const { return (const float*)arg(7); }
    DI const float* cmp_pe() const { return (const float*)arg(8); }
    DI const float* cmp_w1() const { return (const float*)arg(9); }
    DI const float* cmp_w2() const { return (const float*)arg(10); }
    DI const float* a_w_out() const { return (const float*)arg(11); }
    DI const float* kv_norm_g() const { return (const float*)arg(12); }
    DI const float* kv_mod_w() const { return (const float*)arg(13); }
    DI const float* kv_mod_b() const { return (const float*)arg(14); }
    DI const float* kv_w() const { return (const float*)arg(15); }
    DI const float* kv_b() const { return (const float*)arg(16); }
    DI const float* b_w_q() const { return (const float*)arg(17); }
    DI const float* b_b_q() const { return (const float*)arg(18); }
    DI const float* b_sinks() const { return (const float*)arg(19); }
    DI const float* b_w_out() const { return (const float*)arg(20); }
    DI const float* b_b_out() const { return (const float*)arg(21); }
    DI const float* router_w() const { return (const float*)arg(22); }
    DI const float* router_b() const { return (const float*)arg(23); }
    DI const float* w_gate_up() const { return (const float*)arg(24); }
    DI const float* b_gate_up() const { return (const float*)arg(25); }
    DI const float* w_down() const { return (const float*)arg(26); }
    DI const float* b_down() const { return (const float*)arg(27); }
    DI float* MODV() const { return (float*)(wsp() + WS_MODV); }
    DI float* ROPE() const { return (float*)(wsp() + WS_ROPE); }
    DI float* CMPB() const { return (float*)(wsp() + WS_CMPB); }
    DI float* GATES() const { return (float*)(wsp() + WS_GATES); }
    DI float* LISTW() const { return (float*)(wsp() + WS_LISTW); }
    DI float* H() const { return (float*)(wsp() + WS_H); }
    DI bf16_t* CW1T() const { return (bf16_t*)(wsp() + WS_CW1T); }
    DI bf16_t* CW2T() const { return (bf16_t*)(wsp() + WS_CW2T); }
    DI bf16_t* WINT() const { return (bf16_t*)(wsp() + WS_WINT); }
    DI bf16_t* WAOT() const { return (bf16_t*)(wsp() + WS_WAOT); }
    DI bf16_t* WBQT() const { return (bf16_t*)(wsp() + WS_WBQT); }
    DI bf16_t* WBOT() const { return (bf16_t*)(wsp() + WS_WBOT); }
    DI bf16_t* WKVT() const { return (bf16_t*)(wsp() + WS_WKVT); }
    DI bf16_t* KC() const { return (bf16_t*)(wsp() + WS_KC); }
    DI bf16_t* VCT() const { return (bf16_t*)(wsp() + WS_VCT); }
    DI bf16_t* VT() const { return (bf16_t*)(wsp() + WS_VT); }
    DI bf16_t* WGUT() const { return (bf16_t*)(wsp() + WS_WGUT); }
    DI bf16_t* WDNT() const { return (bf16_t*)(wsp() + WS_WDNT); }
    DI bf16_t* HN() const { return (bf16_t*)(wsp() + WS_HN); }
    DI bf16_t* HN2() const { return (bf16_t*)(wsp() + WS_HN2); }
    DI bf16_t* Q() const { return (bf16_t*)(wsp() + WS_Q); }
    DI bf16_t* KV() const { return (bf16_t*)(wsp() + WS_KV); }
    DI bf16_t* O() const { return (bf16_t*)(wsp() + WS_O); }
    DI bf16_t* ACT() const { return (bf16_t*)(wsp() + WS_ACT); }
    DI bf16_t* OUTB() const { return (bf16_t*)(wsp() + WS_OUTB); }
    DI unsigned* TOKSLOT() const { return (unsigned*)(wsp() + WS_TOKSLOT); }
    DI unsigned* LIST() const { return (unsigned*)(wsp() + WS_LIST); }
};
DI int vcu_of(int bx) { return (bx & 7) * (GRID / 8) + (bx >> 3); }
DI int fresh_lane() { int l; asm volatile("v_mbcnt_lo_u32_b32 %0, -1, 0\n\tv_mbcnt_hi_u32_b32 %0, -1, %0" : "=&v"(l)); return l; }
DI Frame make_frame(LAS unsigned char* lds, int wave_sgpr) {
    Frame F; F.lds = lds;
    KPtr kp = (KPtr)__builtin_amdgcn_kernarg_segment_ptr(); asm volatile("" : "+s"(kp)); F.kp = kp;
    int wv = wave_sgpr; asm volatile("" : "+s"(wv)); F.wave = wv; F.lane = fresh_lane(); F.tid = wv * 64 + F.lane;
    int bx = (int)blockIdx.x; asm volatile("" : "+s"(bx)); F.bx = bx; F.vcu = vcu_of(bx);
    return F;
}
DI void transpose_item(const float* W, int ld, int K, bf16_t* WT, int drow0, int k0, int n0, LAS float* scr, int lane) {
    f32x4 v[16];
    const float* src = W + (size_t)(k0 + (lane >> 4)) * ld + n0 + 4 * (lane & 15);
#pragma unroll
    for (int i = 0; i < 16; ++i) v[i] = *(const f32x4*)(src + (size_t)(4 * i) * ld);
    LAS float* wp = scr + (lane >> 4) * 65 + 4 * (lane & 15);
#pragma unroll
    for (int i = 0; i < 16; ++i) { LAS float* q = wp + (4 * i) * 65; q[0] = v[i].x; q[1] = v[i].y; q[2] = v[i].z; q[3] = v[i].w; }
    LDS_WAIT(); asm volatile("" ::: "memory");
    const int c = lane & 7;
#pragma unroll
    for (int j = 0; j < 8; ++j) { const int n = (lane >> 3) + 8 * j; const LAS float* s = scr + (8 * c) * 65 + n;
        u32x4 o; o.x = pk2(s[0 * 65], s[1 * 65]); o.y = pk2(s[2 * 65], s[3 * 65]); o.z = pk2(s[4 * 65], s[5 * 65]); o.w = pk2(s[6 * 65], s[7 * 65]);
        *(u32x4*)(WT + (size_t)(drow0 + n) * K + k0 + 8 * c) = o; }
    LDS_WAIT(); asm volatile("" ::: "memory");
}

DI void p0_prologue(Frame& F) {
    const int gw = F.bx * NWAVES + F.wave, NGW = GRID * NWAVES, lane = F.lane;
    const int gtid = F.bx * NTHR + F.tid, NGT = GRID * NTHR;
    LAS float* cact = (LAS float*)(F.lds + 73728);
    const bool modblk = (F.bx >= 32 && F.bx < 60);
    if (modblk) {
        for (int idx = F.tid; idx < NB * D; idx += NTHR) { const int b = idx / D, k = idx % D; const float v = F.c()[idx]; cact[k * 16 + b] = v / (1.f + __expf(-v)); }
    }
    __syncthreads();
    if (gw >= 256 && gw < 480) {
        const int it = gw - 256; const float* W; const float* bias; float* outp; int ld;
        int chunk;
        if (it < 192) { const int set = it / 48; chunk = it % 48; W = F.mod_w() + (size_t)set * D * 3072; ld = 3072; bias = F.mod_b() + set * 3072; outp = F.MODV() + (size_t)set * 16 * 3072; }
        else { chunk = it - 192; W = F.kv_mod_w(); ld = 2048; bias = F.kv_mod_b(); outp = F.MODV() + (size_t)4 * 16 * 3072; }
        const int col = chunk * 64 + lane;
        float acc[16];
#pragma unroll
        for (int b = 0; b < 16; ++b) acc[b] = 0.f;
#pragma unroll 4
        for (int k = 0; k < D; ++k) {
            const float w = W[(size_t)k * ld + col];
            const LAS f32x4* cp = (const LAS f32x4*)(cact + k * 16);
            const f32x4 c0 = cp[0], c1 = cp[1], c2 = cp[2], c3 = cp[3];
            acc[0] += c0.x * w; acc[1] += c0.y * w; acc[2] += c0.z * w; acc[3] += c0.w * w;
            acc[4] += c1.x * w; acc[5] += c1.y * w; acc[6] += c1.z * w; acc[7] += c1.w * w;
            acc[8] += c2.x * w; acc[9] += c2.y * w; acc[10] += c2.z * w; acc[11] += c2.w * w;
            acc[12] += c3.x * w; acc[13] += c3.y * w; acc[14] += c3.z * w; acc[15] += c3.w * w;
        }
        const float bv = bias[col];
#pragma unroll
        for (int b = 0; b < 16; ++b) outp[(size_t)b * ld + col] = acc[b] + bv;
    }
    if (gw < 256) {
        const int kv = gw / 128, e = gw % 128; float s = 0.f;
        for (int j = 0; j < 32; ++j) { const int k = lane + 64 * j; s += F.cmp_pe()[kv * 2048 + k] * F.cmp_w1()[((size_t)kv * 2048 + k) * 128 + e]; }
        s = wave_sum(s);
        if (lane == 0) F.CMPB()[gw] = s;
    }
    for (int idx = gtid; idx < T * 8; idx += NGT) {
        const int tok = idx >> 3, i = idx & 7;
        const float inv = (float)pow(500000.0, -(double)(2 * i) / 16.0);
        const float ang = (float)F.positions()[tok] * inv;
        double a = (double)ang; const double twopi = 6.283185307179586476925286766559;
        a -= twopi * rint(a / twopi);
        const float ar = (float)a;
        F.ROPE()[(size_t)tok * 16 + i] = cosf(ar); F.ROPE()[(size_t)tok * 16 + 8 + i] = sinf(ar);
    }
    for (int idx = gtid; idx < 256 * D; idx += NGT) {
        const int row = idx / D, k = idx % D;
        const float v = row < 48 ? F.a_w_in()[(size_t)k * A_PROJ + 2560 + row] : 0.f;
        F.WINT()[(size_t)(2048 + row) * D + k] = (bf16_t)(pk2(v, 0.f) & 0xffffu);
    }
    __syncthreads();
    LAS float* scr = (LAS float*)(F.lds + F.wave * 16640);
    constexpr int J0 = 32768, J1 = 16384, J2 = 640, J3 = 256, J6 = 64, J7 = 128, J8 = 4;
    constexpr int NITEMS = J0 + J1 + J2 + 3 * J3 + J6 + J7 + J8;
    for (int it = gw; it < NITEMS; it += NGW) {
        int r = it;
        if (r < J0) { const int mat = r >> 9, q = r & 511, kb = q >> 5, nb = q & 31;
            transpose_item(F.w_gate_up() + (size_t)mat * D * 2048, 2048, D, F.WGUT() + (size_t)mat * 2048 * D, 64 * nb, 64 * kb, 64 * nb, scr, lane); continue; }
        r -= J0;
        if (r < J1) { const int mat = r >> 8, q = r & 255, kb = q >> 4, nb = q & 15;
            transpose_item(F.w_down() + (size_t)mat * D * D, D, D, F.WDNT() + (size_t)mat * D * D, 64 * nb, 64 * kb, 64 * nb, scr, lane); continue; }
        r -= J1;
        if (r < J2) { const int kb = r / 40, nb = r % 40, n0 = 64 * nb;
            const int dr = n0 < 1792 ? n0 : (n0 < 2048 ? 2304 + (n0 - 1792) : (n0 < 2304 ? 1792 + (n0 - 2048) : 2560 + (n0 - 2304)));
            transpose_item(F.a_w_in(), A_PROJ, D, F.WINT(), dr, 64 * kb, n0, scr, lane); continue; }
        r -= J2;
        if (r < J3) { const int kb = r >> 4, nb = r & 15; transpose_item(F.a_w_out(), D, D, F.WAOT(), 64 * nb, 64 * kb, 64 * nb, scr, lane); continue; }
        r -= J3;
        if (r < J3) { const int kb = r >> 4, nb = r & 15; transpose_item(F.b_w_q(), D, D, F.WBQT(), 64 * nb, 64 * kb, 64 * nb, scr, lane); continue; }
        r -= J3;
        if (r < J3) { const int kb = r >> 4, nb = r & 15; transpose_item(F.b_w_out(), D, D, F.WBOT(), 64 * nb, 64 * kb, 64 * nb, scr, lane); continue; }
        r -= J3;
        if (r < J6) { const int kb = r >> 2, nb = r & 3; transpose_item(F.kv_w(), 256, D, F.WKVT(), 64 * nb, 64 * kb, 64 * nb, scr, lane); continue; }
        r -= J6;
        if (r < J7) { const int kv = r >> 6, q = r & 63, kb = q >> 1, nb = q & 1;
            transpose_item(F.cmp_w1() + (size_t)kv * 2048 * 128, 128, 2048, F.CW1T() + (size_t)kv * 128 * 2048, 64 * nb, 64 * kb, 64 * nb, scr, lane); continue; }
        r -= J7;
        { const int kv = r >> 1, kb = r & 1;
            transpose_item(F.cmp_w2() + (size_t)kv * 128 * 64, 64, 128, F.CW2T() + (size_t)kv * 64 * 128, 0, 64 * kb, 0, scr, lane); }
    }
}

DI void load_mod(const float* g, const float* scale, const float* shift, int lane, f32x4 (&A)[4], f32x4 (&Bv)[4]) {
#pragma unroll
    for (int j = 0; j < 4; ++j) { const int c = 4 * lane + 256 * j;
        const f32x4 gg = *(const f32x4*)(g + c), sc = *(const f32x4*)(scale + c), sh = *(const f32x4*)(shift + c);
        A[j] = gg * (sc + 1.f); Bv[j] = sh; }
}
DI float row_ss(const f32x4 (&v)[4]) {
    float s = 0.f;
#pragma unroll
    for (int j = 0; j < 4; ++j) s += (v[j].x * v[j].x + v[j].y * v[j].y) + (v[j].z * v[j].z + v[j].w * v[j].w);
    return wave_sum(s);
}
DI void store_bf16_row(bf16_t* dst, int lane, const f32x4 (&y)[4]) {
#pragma unroll
    for (int j = 0; j < 4; ++j) { u32x2 o; o.x = pk2(y[j].x, y[j].y); o.y = pk2(y[j].z, y[j].w); *(u32x2*)(dst + 4 * lane + 256 * j) = o; }
}

DI void norm_plain_phase(Frame& F) {
    const int gw = F.bx * NWAVES + F.wave, lane = F.lane, b = gw >> 7;
    const float* mv = F.MODV() + ((size_t)0 * 16 + b) * 3072;
    f32x4 A[4], Bv[4]; load_mod(F.norm_g(), mv + 1024, mv, lane, A, Bv);
    for (int rr = 0; rr < 16; ++rr) {
        const size_t row = (size_t)gw * 16 + rr;
        f32x4 v[4];
#pragma unroll
        for (int j = 0; j < 4; ++j) v[j] = *(const f32x4*)(F.x() + row * D + 4 * lane + 256 * j);
        const float rstd = 1.0f / sqrtf(row_ss(v) * (1.f / D) + NORM_EPS);
        f32x4 y[4];
#pragma unroll
        for (int j = 0; j < 4; ++j) y[j] = v[j] * rstd * A[j] + Bv[j];
        store_bf16_row(F.HN() + row * D, lane, y);
    }
}

constexpr int RT_IMG = 0, RT_LGS = 147456, RT_PE = 149504, RT_PW = 151552, RT_LCNT = 153600, RT_LBASE = 153728;

DI void norm_router_phase(Frame& F, int layer) {
    const int gw = F.bx * NWAVES + F.wave, lane = F.lane, tid = F.tid, b = gw >> 7;
    LAS float* img = (LAS float*)(F.lds + RT_IMG);
    LAS float* lgs = (LAS float*)(F.lds + RT_LGS) + F.wave * 64;
    LAS unsigned* pend_e = (LAS unsigned*)(F.lds + RT_PE);
    LAS float* pend_w = (LAS float*)(F.lds + RT_PW);
    LAS unsigned* lcnt = (LAS unsigned*)(F.lds + RT_LCNT);
    LAS unsigned* lbase = (LAS unsigned*)(F.lds + RT_LBASE);
    const float* rw = F.router_w() + (size_t)layer * D * NEXP;
    for (int idx = tid; idx < D * NEXP; idx += NTHR) { const int col = idx >> 5, e = idx & 31;
        const int rho = (col & 3) * 64 + ((col >> 2) & 63) + 256 * (col >> 8); img[rho * 36 + e] = rw[idx]; }
    if (tid < 32) lcnt[tid] = 0u;
    __syncthreads();
    const int set = layer * 2 + 1;
    const float* mv = F.MODV() + ((size_t)set * 16 + b) * 3072;
    f32x4 A[4], Bv[4]; load_mod(F.norm_g() + (layer * 2 + 1) * D, mv + 1024, mv, lane, A, Bv);
    const float* rb = F.router_b() + layer * NEXP;
    for (int rp = 0; rp < 8; ++rp) {
        const size_t row0 = (size_t)gw * 16 + rp * 2;
        f32x4 y0[4], y1[4];
        {
            f32x4 v0[4], v1[4];
#pragma unroll
            for (int j = 0; j < 4; ++j) { v0[j] = *(const f32x4*)(F.H() + row0 * D + 4 * lane + 256 * j); v1[j] = *(const f32x4*)(F.H() + (row0 + 1) * D + 4 * lane + 256 * j); }
            const float r0 = 1.0f / sqrtf(row_ss(v0) * (1.f / D) + NORM_EPS), r1 = 1.0f / sqrtf(row_ss(v1) * (1.f / D) + NORM_EPS);
#pragma unroll
            for (int j = 0; j < 4; ++j) { y0[j] = v0[j] * r0 * A[j] + Bv[j]; y1[j] = v1[j] * r1 * A[j] + Bv[j]; }
        }
        store_bf16_row(F.HN() + row0 * D, lane, y0); store_bf16_row(F.HN() + (row0 + 1) * D, lane, y1);
        float l0[32], l1[32];
#pragma unroll
        for (int e = 0; e < 32; ++e) { l0[e] = 0.f; l1[e] = 0.f; }
#pragma unroll
        for (int j = 0; j < 4; ++j)
#pragma unroll
            for (int i = 0; i < 4; ++i) {
                const float a0 = y0[j][i], a1 = y1[j][i];
                const LAS f32x4* wp = (const LAS f32x4*)(img + (i * 64 + lane + 256 * j) * 36);
#pragma unroll
                for (int e4 = 0; e4 < 8; ++e4) { const f32x4 w = wp[e4];
                    l0[4 * e4 + 0] += a0 * w.x; l0[4 * e4 + 1] += a0 * w.y; l0[4 * e4 + 2] += a0 * w.z; l0[4 * e4 + 3] += a0 * w.w;
                    l1[4 * e4 + 0] += a1 * w.x; l1[4 * e4 + 1] += a1 * w.y; l1[4 * e4 + 2] += a1 * w.z; l1[4 * e4 + 3] += a1 * w.w; }
            }
#define RS_STEP(N, OFF) { const bool up = (lane & (OFF)) != 0; _Pragma("unroll") for (int k = 0; k < (N); ++k) { \
            const float s0 = up ? l0[k] : l0[k + (N)], k0 = up ? l0[k + (N)] : l0[k]; l0[k] = k0 + __shfl_xor(s0, (OFF)); \
            const float s1 = up ? l1[k] : l1[k + (N)], k1 = up ? l1[k + (N)] : l1[k]; l1[k] = k1 + __shfl_xor(s1, (OFF)); } }
        RS_STEP(16, 32) RS_STEP(8, 16) RS_STEP(4, 8) RS_STEP(2, 4) RS_STEP(1, 2)
#undef RS_STEP
        float g0 = l0[0] + __shfl_xor(l0[0], 1), g1 = l1[0] + __shfl_xor(l1[0], 1);
        const int e_own = lane >> 1; const float rbv = rb[e_own];
        if ((lane & 1) == 0) { lgs[e_own] = g0 + rbv; lgs[32 + e_own] = g1 + rbv; }
        LDS_WAIT(); asm volatile("" ::: "memory");
        if (lane < 2) {
            float v[32];
#pragma unroll
            for (int e = 0; e < 32; ++e) v[e] = lgs[lane * 32 + e];
            float tv[4]; int ti[4];
#pragma unroll
            for (int k = 0; k < 4; ++k) {
                float best = -INFINITY; int bi = 0;
#pragma unroll
                for (int e = 0; e < 32; ++e) { const bool gt = v[e] > best; best = gt ? v[e] : best; bi = gt ? e : bi; }
                tv[k] = best; ti[k] = bi;
#pragma unroll
                for (int e = 0; e < 32; ++e) v[e] = (e == bi) ? -INFINITY : v[e];
            }
            const float e1 = __expf(tv[1] - tv[0]), e2 = __expf(tv[2] - tv[0]), e3 = __expf(tv[3] - tv[0]);
            const float inv = 1.f / (1.f + e1 + e2 + e3);
            const float w[4] = {inv, e1 * inv, e2 * inv, e3 * inv};
            const int tl = F.wave * 16 + rp * 2 + lane;
#pragma unroll
            for (int k = 0; k < 4; ++k) {
                const unsigned pl = __hip_atomic_fetch_add(lcnt + ti[k], 1u, __ATOMIC_RELAXED, __HIP_MEMORY_SCOPE_WORKGROUP);
                pend_e[tl * 4 + k] = ((unsigned)ti[k] << 16) | pl; pend_w[tl * 4 + k] = w[k];
            }
        }
        LDS_WAIT(); asm volatile("" ::: "memory");
    }
    __syncthreads();
    unsigned* gcnt = F.ctl() + CW_CNT + 64 * layer;
    if (tid < 32) lbase[tid] = __hip_atomic_fetch_add(gcnt + tid, lcnt[tid], __ATOMIC_RELAXED, __HIP_MEMORY_SCOPE_AGENT);
    __syncthreads();
    {
        const int tl = tid >> 2, k = tid & 3; const unsigned pe = pend_e[tid]; const unsigned e = pe >> 16, pos = lbase[e] + (pe & 0xffffu);
        const unsigned token = (unsigned)(F.bx * 128 + tl);
        F.LIST()[(size_t)e * T + pos] = token; F.LISTW()[(size_t)e * T + pos] = pend_w[tid]; F.TOKSLOT()[(size_t)token * 4 + k] = (e << 16) | pos;
    }
    __syncthreads();
}

DI void load_expert_tables(Frame& F, int layer, int npn) {
    LAS unsigned* ext = (LAS unsigned*)(F.lds + EXT_OFF);
    if (F.tid < 32) ext[F.tid] = __hip_atomic_load(F.ctl() + CW_CNT + 64 * layer + F.tid, __ATOMIC_RELAXED, __HIP_MEMORY_SCOPE_AGENT);
    __syncthreads();
    if (F.tid == 0) { unsigned o = 0, u = 0; for (int e = 0; e < 32; ++e) { const unsigned c = ext[e]; ext[32 + e] = o; ext[64 + e] = u; o += c; u += ((c + 255u) >> 8) * (unsigned)npn; } ext[96] = u; }
    __syncthreads();
}

template <bool FINAL> DI void combine_phase(Frame& F, int layer) {
    load_expert_tables(F, layer, 1);
    const LAS unsigned* offs = (const LAS unsigned*)(F.lds + EXT_OFF) + 32;
    const int gw = F.bx * NWAVES + F.wave, lane = F.lane, b = gw >> 7;
    const float* gate = F.MODV() + ((size_t)(layer * 2 + 1) * 16 + b) * 3072 + 2048;
    f32x4 G[4];
#pragma unroll
    for (int j = 0; j < 4; ++j) G[j] = *(const f32x4*)(gate + 4 * lane + 256 * j);
    f32x4 A1[4], B1[4], A2[4], B2[4];
    if (FINAL) {
#pragma unroll
        for (int j = 0; j < 4; ++j) A1[j] = *(const f32x4*)(F.final_g() + 4 * lane + 256 * j);
    } else {
        const float* m2 = F.MODV() + ((size_t)2 * 16 + b) * 3072; load_mod(F.norm_g() + 2 * D, m2 + 1024, m2, lane, A1, B1);
        const float* m4 = F.MODV() + (size_t)4 * 16 * 3072 + (size_t)b * 2048; load_mod(F.kv_norm_g(), m4 + 1024, m4, lane, A2, B2);
    }
    for (int rr = 0; rr < 16; ++rr) {
        const size_t row = (size_t)gw * 16 + rr;
        const u32x4 ts = *(const u32x4*)(F.TOKSLOT() + row * 4);
        const unsigned sl[4] = {offs[ts.x >> 16] + (ts.x & 0xffffu), offs[ts.y >> 16] + (ts.y & 0xffffu), offs[ts.z >> 16] + (ts.z & 0xffffu), offs[ts.w >> 16] + (ts.w & 0xffffu)};
        f32x4 y[4];
#pragma unroll
        for (int j = 0; j < 4; ++j) y[j] = (f32x4){0.f, 0.f, 0.f, 0.f};
#pragma unroll
        for (int k = 0; k < 4; ++k)
#pragma unroll
            for (int j = 0; j < 4; ++j) { const u32x2 o = *(const u32x2*)(F.OUTB() + (size_t)sl[k] * D + 4 * lane + 256 * j);
                y[j].x += bf_lo(o.x); y[j].y += bf_hi(o.x); y[j].z += bf_lo(o.y); y[j].w += bf_hi(o.y); }
        f32x4 h[4];
#pragma unroll
        for (int j = 0; j < 4; ++j) h[j] = *(const f32x4*)(F.H() + row * D + 4 * lane + 256 * j) + G[j] * y[j];
        const float rstd = 1.0f / sqrtf(row_ss(h) * (1.f / D) + NORM_EPS);
        if (FINAL) {
#pragma unroll
            for (int j = 0; j < 4; ++j) *(f32x4*)(F.out() + row * D + 4 * lane + 256 * j) = h[j] * rstd * A1[j];
        } else {
#pragma unroll
            for (int j = 0; j < 4; ++j) *(f32x4*)(F.H() + row * D + 4 * lane + 256 * j) = h[j];
            f32x4 ya[4], yb[4];
#pragma unroll
            for (int j = 0; j < 4; ++j) { const f32x4 n = h[j] * rstd; ya[j] = n * A1[j] + B1[j]; yb[j] = n * A2[j] + B2[j]; }
            store_bf16_row(F.HN() + row * D, lane, ya); store_bf16_row(F.HN2() + row * D, lane, yb);
        }
    }
}
namespace pg8 {
constexpr int BM = 256, BK = 64, HALF = 128, HTB = HALF * BK * 2, STAGE_BYTES = 8 * HTB, KD = 1024;
DI int lds_byte(int r, int c) { const int st = (r >> 4) * 2 + (c >> 5), rr = r & 15, cc = c & 31, ob = rr * 64 + cc * 2; return st * 1024 + (ob ^ (((ob >> 9) & 1) << 5)); }
DI void stage_rc(int b, int& R, int& C) { const int st = b / 1024, sb = b % 1024, swz = sb ^ (((sb >> 9) & 1) << 5); R = (st >> 1) * 16 + swz / 64; C = (st & 1) * 32 + (swz % 64) / 2; }
DI int perm32(int rho) { const int n = rho >> 4, i = rho & 15; return 8 * (i >> 2) + 4 * n + (i & 3); }

struct Unit {
    const char* A;
    const char* B0;
    unsigned bh;
    int type, r0, c0, nvalid, aux;
};

template <class Pol>
DI void gemm_phase(LAS unsigned char* lds, const Pol& P, int wave_id, int lane_id) {
    const int wid = wave_id, lane = lane_id, tid = wid * 64 + lane, wr = wid >> 2, wc = wid & 3, fr = lane & 15, fq = lane >> 4;
    constexpr int K = KD, nt = K / BK;
    unsigned voffB[2];
#pragma unroll
    for (int i = 0; i < 2; ++i) { int R, C; stage_rc(tid * 16 + i * 8192, R, C); const int Rb = Pol::PERM ? ((R & ~31) + perm32(R & 31)) : R; voffB[i] = (unsigned)(Rb * K + C) * 2u; }
    const size_t kstep = (size_t)(BK * 2);
    const unsigned ldsw = (unsigned)wid * 1024u;
    const int aoff = lds_byte(wr * 64 + fr, fq * 8), boff = lds_byte(wc * 32 + fr, fq * 8);
#define PG8_SA(b, h) (((b) * 2 + (h)) * HTB)
#define PG8_SB(b, h) ((4 + (b) * 2 + (h)) * HTB)
#define PG8_STAGE_A(bufoff, gbase, va, h) do { _Pragma("unroll") for (int _i = 0; _i < 2; ++_i) \
        __builtin_amdgcn_global_load_lds((const unsigned*)((const char*)(gbase) + (va)[h][_i]), (LAS unsigned*)(lds + (bufoff) + ldsw + _i * 8192), 16, 0, 0); } while (0)
#define PG8_STAGE_B(bufoff, gbase) do { _Pragma("unroll") for (int _i = 0; _i < 2; ++_i) \
        __builtin_amdgcn_global_load_lds((const unsigned*)((const char*)(gbase) + voffB[_i]), (LAS unsigned*)(lds + (bufoff) + ldsw + _i * 8192), 16, 0, 0); } while (0)
#define PG8_LDA(dst, b, h) do { _Pragma("unroll") for (int m = 0; m < 4; ++m) _Pragma("unroll") for (int k = 0; k < 2; ++k) dst[m][k] = *(const LAS bf16x8*)(lds + PG8_SA(b, h) + aoff + m * 2048 + k * 1024); } while (0)
#define PG8_LDB(dst, b, h) do { _Pragma("unroll") for (int n = 0; n < 2; ++n) _Pragma("unroll") for (int k = 0; k < 2; ++k) dst[n][k] = *(const LAS bf16x8*)(lds + PG8_SB(b, h) + boff + n * 2048 + k * 1024); } while (0)
#define PG8_MMA(ai, bj, At, Bt) do { __builtin_amdgcn_s_setprio(1); _Pragma("unroll") for (int m = 0; m < 4; ++m) _Pragma("unroll") for (int n = 0; n < 2; ++n) _Pragma("unroll") for (int k = 0; k < 2; ++k) \
        acc[ai][bj][m][n] = __builtin_amdgcn_mfma_f32_16x16x32_bf16(Bt[n][k], At[m][k], acc[ai][bj][m][n], 0, 0, 0); __builtin_amdgcn_s_setprio(0); } while (0)
#define PG8_WAIT_V(n) asm volatile("s_waitcnt vmcnt(" #n ")" ::: "memory")
#define PG8_WAIT_L(n) asm volatile("s_waitcnt lgkmcnt(" #n ")" ::: "memory")
#define PG8_BAR __builtin_amdgcn_s_barrier()
#define PG8_SCHED __builtin_amdgcn_sched_barrier(0)
    Unit cur, nxt; int ui = 0;
    if (!P.next(0, cur)) return;
    unsigned vaC[2][2], vaN[2][2];
    P.aoff(cur, wid * 64, tid, vaC);
    bool has_next = P.next(1, nxt);
    if (has_next) P.aoff(nxt, wid * 64, tid, vaN);
    else { vaN[0][0] = vaC[0][0]; vaN[0][1] = vaC[0][1]; vaN[1][0] = vaC[1][0]; vaN[1][1] = vaC[1][1]; }
    if (Pol::GATHER) asm volatile("" : "+v"(vaC[0][0]), "+v"(vaC[0][1]), "+v"(vaC[1][0]), "+v"(vaC[1][1]), "+v"(vaN[0][0]), "+v"(vaN[0][1]), "+v"(vaN[1][0]), "+v"(vaN[1][1]));
    f32x4 acc[2][2][4][2];
    { const int l2 = fresh_lane(); P.init(acc, cur, wr, wc, l2 & 15, l2 >> 4); }
    bf16x8 At[4][2], B0[2][2], B1[2][2];
    const char* cA = cur.A; const char* cB = cur.B0; unsigned cbh = cur.bh;
    PG8_STAGE_B(PG8_SB(0, 0), cB); PG8_STAGE_A(PG8_SA(0, 0), cA, vaC, 0); PG8_STAGE_B(PG8_SB(0, 1), cB + cbh); PG8_STAGE_A(PG8_SA(0, 1), cA, vaC, 1);
    if (wr == 1) PG8_BAR;
    PG8_WAIT_V(4); PG8_BAR;
    PG8_STAGE_B(PG8_SB(1, 0), cB + kstep); PG8_STAGE_A(PG8_SA(1, 0), cA + kstep, vaC, 0); PG8_STAGE_B(PG8_SB(1, 1), cB + cbh + kstep);
    PG8_WAIT_V(6); PG8_BAR;
    for (;;) {
        const char* nA = has_next ? nxt.A : cA; const char* nB = has_next ? nxt.B0 : cB; const unsigned nbh = has_next ? nxt.bh : cbh;
        for (int t = 0; t < nt; t += 2) {
            const bool last = (t == nt - 2);
            const char* a1 = cA + (size_t)(t + 1) * kstep;
            const char* a2 = last ? nA : cA + (size_t)(t + 2) * kstep; const char* b2 = last ? nB : cB + (size_t)(t + 2) * kstep;
            const char* a3 = a2 + kstep; const char* b3 = b2 + kstep;
            const unsigned bh2 = last ? nbh : cbh;
            unsigned va2[2][2];
            if (Pol::GATHER) { va2[0][0] = last ? vaN[0][0] : vaC[0][0]; va2[0][1] = last ? vaN[0][1] : vaC[0][1]; va2[1][0] = last ? vaN[1][0] : vaC[1][0]; va2[1][1] = last ? vaN[1][1] : vaC[1][1]; }
            else { va2[0][0] = vaC[0][0]; va2[0][1] = vaC[0][1]; va2[1][0] = vaC[1][0]; va2[1][1] = vaC[1][1]; }
            PG8_LDB(B0, 0, 0); PG8_SCHED; PG8_LDA(At, 0, 0); PG8_STAGE_A(PG8_SA(1, 1), a1, vaC, 1);
            PG8_WAIT_L(8); PG8_BAR; PG8_WAIT_L(0); PG8_MMA(0, 0, At, B0); PG8_BAR; PG8_SCHED;
            PG8_LDB(B1, 0, 1); PG8_STAGE_B(PG8_SB(0, 0), b2);
            PG8_BAR; PG8_WAIT_L(0); PG8_MMA(0, 1, At, B1); PG8_BAR;
            PG8_LDA(At, 0, 1); PG8_STAGE_A(PG8_SA(0, 0), a2, va2, 0);
            PG8_BAR; PG8_WAIT_L(0); PG8_MMA(1, 0, At, B0); PG8_BAR; PG8_SCHED;
            PG8_STAGE_B(PG8_SB(0, 1), b2 + bh2);
            PG8_WAIT_V(6); PG8_BAR; PG8_MMA(1, 1, At, B1); PG8_BAR;
            PG8_LDB(B0, 1, 0); PG8_SCHED; PG8_LDA(At, 1, 0); PG8_STAGE_A(PG8_SA(0, 1), a2, va2, 1);
            PG8_WAIT_L(8); PG8_BAR; PG8_WAIT_L(0); PG8_MMA(0, 0, At, B0); PG8_BAR; PG8_SCHED;
            PG8_LDB(B1, 1, 1); PG8_STAGE_B(PG8_SB(1, 0), b3);
            PG8_BAR; PG8_WAIT_L(0); PG8_MMA(0, 1, At, B1); PG8_BAR;
            PG8_LDA(At, 1, 1); PG8_STAGE_A(PG8_SA(1, 0), a3, va2, 0);
            PG8_BAR; PG8_WAIT_L(0); PG8_MMA(1, 0, At, B0); PG8_BAR; PG8_SCHED;
            PG8_STAGE_B(PG8_SB(1, 1), b3 + bh2);
            PG8_WAIT_V(6); PG8_BAR; PG8_MMA(1, 1, At, B1); PG8_BAR;
        }
        { const int l2 = fresh_lane(); P.epi(acc, cur, wr, wc, l2 & 15, l2 >> 4); }
        if (!has_next) break;
        { const int l2 = fresh_lane(); P.init(acc, nxt, wr, wc, l2 & 15, l2 >> 4); }
        cur = nxt; cA = nA; cB = nB; cbh = nbh; ++ui;
        vaC[0][0] = vaN[0][0]; vaC[0][1] = vaN[0][1]; vaC[1][0] = vaN[1][0]; vaC[1][1] = vaN[1][1];
        has_next = P.next(ui + 1, nxt);
        if (has_next) { P.aoff(nxt, wid * 64, tid, vaN);
            if (Pol::GATHER) asm volatile("" : "+v"(vaN[0][0]), "+v"(vaN[0][1]), "+v"(vaN[1][0]), "+v"(vaN[1][1])); }
    }
    PG8_WAIT_V(0);
    if (wr == 0) PG8_BAR;
    PG8_BAR;
#undef PG8_SA
#undef PG8_SB
#undef PG8_STAGE_A
#undef PG8_STAGE_B
#undef PG8_LDA
#undef PG8_LDB
#undef PG8_MMA
#undef PG8_WAIT_V
#undef PG8_WAIT_L
#undef PG8_BAR
#undef PG8_SCHED
}
DI void aoff_std(int tid, unsigned (&va)[2][2]) {
#pragma unroll
    for (int i = 0; i < 2; ++i) { int R, C; stage_rc(tid * 16 + i * 8192, R, C);
#pragma unroll
        for (int h = 0; h < 2; ++h) va[h][i] = (unsigned)((h * HALF + R) * KD + C) * 2u; }
}
}

typedef f32x4 AccT[2][2][4][2];
DI void acc_zero(AccT& acc) {
#pragma unroll
    for (int a = 0; a < 2; ++a)
#pragma unroll
        for (int b = 0; b < 2; ++b)
#pragma unroll
            for (int m = 0; m < 4; ++m)
#pragma unroll
                for (int n = 0; n < 2; ++n) acc[a][b][m][n] = (f32x4){0.f, 0.f, 0.f, 0.f};
}
DI void acc_colbias(AccT& acc, const f32x4& b00, const f32x4& b01, const f32x4& b10, const f32x4& b11) {
#pragma unroll
    for (int a = 0; a < 2; ++a)
#pragma unroll
        for (int m = 0; m < 4; ++m) { acc[a][0][m][0] = b00; acc[a][0][m][1] = b01; acc[a][1][m][0] = b10; acc[a][1][m][1] = b11; }
}

DI void rope8(f32x4& v0, f32x4& v1, const float* rope_row, int fq) {
    const f32x4 c0 = *(const f32x4*)(rope_row), c1 = *(const f32x4*)(rope_row + 4), s0 = *(const f32x4*)(rope_row + 8), s1 = *(const f32x4*)(rope_row + 12);
    f32x4 p0, p1;
#pragma unroll
    for (int i = 0; i < 4; ++i) { p0[i] = __shfl_xor(v0[i], 16); p1[i] = __shfl_xor(v1[i], 16); }
    const float sg = (fq == 0) ? -1.f : 1.f;
    v0 = v0 * c0 + p0 * (s0 * sg); v1 = v1 * c1 + p1 * (s1 * sg);
}
DI void store8_bf16(bf16_t* p, const f32x4& v0, const f32x4& v1) {
    u32x4 w; w.x = pk2(v0[0], v0[1]); w.y = pk2(v0[2], v0[3]); w.z = pk2(v1[0], v1[1]); w.w = pk2(v1[2], v1[3]); *(u32x4*)p = w;
}
constexpr int ST_OFF = 131072, ST_STRIDE = 528;
DI void st_realign(int wr) { if (wr == 0) __builtin_amdgcn_s_barrier(); }
DI void st_restagger(int wr) { if (wr == 1) __builtin_amdgcn_s_barrier(); }
DI void st_put(LAS unsigned char* lds, int rowl, int colb, const f32x4& v0, const f32x4& v1) {
    u32x4 w; w.x = pk2(v0[0], v0[1]); w.y = pk2(v0[2], v0[3]); w.z = pk2(v1[0], v1[1]); w.w = pk2(v1[2], v1[3]);
    *(LAS u32x4*)(lds + ST_OFF + rowl * ST_STRIDE + colb) = w;
}
template <int ROWB> DI void st_flush(LAS unsigned char* lds, int tid, bf16_t* out_pass, size_t ld, int nvalid_rel) {
    asm volatile("s_waitcnt lgkmcnt(0)" ::: "memory"); __builtin_amdgcn_s_barrier(); asm volatile("" ::: "memory");
    if (ROWB == 512) {
#pragma unroll
        for (int k = 0; k < 2; ++k) { const int rowl = (tid >> 5) + 16 * k, c = tid & 31, rel = 64 * (rowl >> 4) + (rowl & 15);
            const u32x4 v = *(const LAS u32x4*)(lds + ST_OFF + rowl * ST_STRIDE + c * 16);
            if (rel < nvalid_rel) *(u32x4*)(out_pass + (size_t)rel * ld + c * 8) = v; }
    } else {
        const int rowl = tid >> 4, c = tid & 15, rel = 64 * (rowl >> 4) + (rowl & 15);
        const u32x4 v = *(const LAS u32x4*)(lds + ST_OFF + rowl * ST_STRIDE + c * 16);
        if (rel < nvalid_rel) *(u32x4*)(out_pass + (size_t)rel * ld + c * 8) = v;
    }
    asm volatile("s_waitcnt lgkmcnt(0)" ::: "memory"); __builtin_amdgcn_s_barrier(); asm volatile("" ::: "memory");
}

struct PolProj0 {
    static constexpr bool PERM = true, GATHER = false;
    const bf16_t *HN, *WINT; bf16_t *Q, *KV, *VT; float* GATES; const float* ROPE; int vcu; LAS unsigned char* lds;
    DI bool next(int i, pg8::Unit& u) const {
        const int L = i * GRID + vcu; if (L >= 1408) return false;
        if (L < 1152) { const int pm = L / 9, pn = L % 9; u.type = 0; u.A = (const char*)(HN + (size_t)pm * 256 * D); u.B0 = (const char*)(WINT + (size_t)pn * 256 * D); u.bh = 128 * D * 2; u.r0 = pm * 256; u.c0 = pn * 256; u.aux = pn; u.nvalid = 256; }
        else { const int l2 = L - 1152, pm = l2 >> 7, pn = l2 & 127; u.type = 1; u.A = (const char*)(WINT + (size_t)(2304 + pm * 256) * D); u.B0 = (const char*)(HN + (size_t)pn * 256 * D); u.bh = 128 * D * 2; u.r0 = pm * 256; u.c0 = pn * 256; u.aux = 0; u.nvalid = 256; }
        return true;
    }
    DI void aoff(const pg8::Unit&, int, int tid, unsigned (&va)[2][2]) const { pg8::aoff_std(tid, va); }
    DI void init(AccT& acc, const pg8::Unit&, int, int, int, int) const { acc_zero(acc); }
    DI void epi(const AccT& acc, const pg8::Unit& u, int wr, int wc, int fr, int fq) const {
        const int pn = u.aux;
        const int tid = (wr * 4 + wc) * 64 + fq * 16 + fr, rowl = wr * 16 + fr;
        if (u.type == 1) {
            st_realign(wr);
#pragma unroll
            for (int ai = 0; ai < 2; ++ai)
#pragma unroll
                for (int m = 0; m < 4; ++m) {
#pragma unroll
                    for (int bj = 0; bj < 2; ++bj) st_put(lds, rowl, (bj * 128 + wc * 32 + 8 * fq) * 2, acc[ai][bj][m][0], acc[ai][bj][m][1]);
                    st_flush<512>(lds, tid, VT + (size_t)(u.r0 + ai * 128 + m * 16) * T + u.c0, T, 256); }
            st_restagger(wr);
            return;
        }
        if (pn == 8) {
            if (wc < 2) {
#pragma unroll
                for (int ai = 0; ai < 2; ++ai)
#pragma unroll
                    for (int m = 0; m < 4; ++m) { const int row = u.r0 + ai * 128 + wr * 64 + m * 16 + fr; float* gp = GATES + (size_t)row * 64 + wc * 32 + 8 * fq;
                        f32x4 a = acc[ai][0][m][0], b = acc[ai][0][m][1];
#pragma unroll
                        for (int i = 0; i < 4; ++i) { a[i] = rcpf(1.f + ex2(-a[i] * LOG2E)); b[i] = rcpf(1.f + ex2(-b[i] * LOG2E)); }
                        *(f32x4*)gp = a; *(f32x4*)(gp + 4) = b; }
            }
            return;
        }
        const bool is_q = pn < 4, do_rope = (pn != 4 && pn != 5);
        bf16_t* dst = is_q ? Q + pn * 256 : KV + (pn - 4) * 256;
        const float sc = is_q ? QSCALE : 1.f;
        const bool rl = do_rope && ((wc & 1) == 0) && fq < 2;
        st_realign(wr);
#pragma unroll
        for (int ai = 0; ai < 2; ++ai)
#pragma unroll
            for (int m = 0; m < 4; ++m) { const int row = u.r0 + ai * 128 + wr * 64 + m * 16 + fr;
#pragma unroll
                for (int bj = 0; bj < 2; ++bj) { f32x4 v0 = acc[ai][bj][m][0], v1 = acc[ai][bj][m][1];
                    if (do_rope && (wc & 1) == 0) { f32x4 r0 = v0, r1 = v1; rope8(r0, r1, ROPE + (size_t)row * 16, fq); if (rl) { v0 = r0; v1 = r1; } }
                    v0 = v0 * sc; v1 = v1 * sc;
                    st_put(lds, rowl, (bj * 128 + wc * 32 + 8 * fq) * 2, v0, v1); }
                st_flush<512>(lds, tid, dst + (size_t)(u.r0 + ai * 128 + m * 16) * D, D, 256); }
        st_restagger(wr);
    }
};

struct PolOut {
    static constexpr bool PERM = false, GATHER = false;
    const bf16_t *O, *WT; const float *base, *gate_mv, *bias; float* H; int vcu;
    DI bool next(int i, pg8::Unit& u) const {
        const int L = i * GRID + vcu; if (L >= 512) return false;
        const int pm = L >> 2, pn = L & 3; u.type = 0; u.A = (const char*)(O + (size_t)pm * 256 * D); u.B0 = (const char*)(WT + (size_t)pn * 256 * D); u.bh = 128 * D * 2; u.r0 = pm * 256; u.c0 = pn * 256; u.aux = 0; u.nvalid = 256;
        return true;
    }
    DI void aoff(const pg8::Unit&, int, int tid, unsigned (&va)[2][2]) const { pg8::aoff_std(tid, va); }
    DI void init(AccT& acc, const pg8::Unit& u, int, int wc, int, int fq) const {
        if (!bias) { acc_zero(acc); return; }
        const float* bp = bias + u.c0 + wc * 32 + 4 * fq;
        acc_colbias(acc, *(const f32x4*)bp, *(const f32x4*)(bp + 16), *(const f32x4*)(bp + 128), *(const f32x4*)(bp + 144));
    }
    DI void epi(const AccT& acc, const pg8::Unit& u, int wr, int wc, int fr, int fq) const {
        const int b = u.r0 >> 11; const float* gv = gate_mv + (size_t)b * 3072 + 2048;
#pragma unroll
        for (int bj = 0; bj < 2; ++bj)
#pragma unroll
            for (int n = 0; n < 2; ++n) { const int col = u.c0 + bj * 128 + wc * 32 + n * 16 + 4 * fq;
                const f32x4 g = *(const f32x4*)(gv + col);
#pragma unroll
                for (int ai = 0; ai < 2; ++ai)
#pragma unroll
                    for (int m = 0; m < 4; ++m) { const size_t off = (size_t)(u.r0 + ai * 128 + wr * 64 + m * 16 + fr) * D + col;
                        *(f32x4*)(H + off) = *(const f32x4*)(base + off) + g * acc[ai][bj][m][n]; } }
    }
};

DI bool moe_unit(const LAS unsigned* ext, int L, int npn, int& e, int& mt, int& pn, int& nvalid, unsigned& slot0) {
    if ((unsigned)L >= ext[96]) return false;
    int ee = 0;
    for (int k = 1; k < 32; ++k) ee = ((unsigned)L >= ext[64 + k]) ? k : ee;
    const int local = L - (int)ext[64 + ee]; mt = local / npn; pn = local % npn; e = ee;
    const int cnt = (int)ext[ee]; nvalid = cnt - mt * 256; nvalid = nvalid > 256 ? 256 : nvalid; slot0 = ext[32 + ee] + (unsigned)mt * 256u;
    return true;
}
template <bool NOEPI = false> struct PolGateUpT {
    static constexpr bool PERM = true, GATHER = true;
    const bf16_t *HN, *WGUT; const float* bgu; const unsigned* LIST; bf16_t* ACT; const LAS unsigned* ext; int vcu; LAS unsigned char* lds;
    DI bool next(int i, pg8::Unit& u) const {
        int e, mt, pn, nv; unsigned s0;
        if (!moe_unit(ext, i * GRID + vcu, 8, e, mt, pn, nv, s0)) return false;
        u.type = mt; u.A = (const char*)HN; u.B0 = (const char*)(WGUT + ((size_t)e * 2048 + pn * 128) * D); u.bh = 1024u * D * 2u; u.r0 = (int)s0; u.c0 = pn * 128; u.nvalid = nv; u.aux = e;
        return true;
    }
    DI void aoff(const pg8::Unit& u, int wbase, int, unsigned (&va)[2][2]) const {
        const unsigned* lp = LIST + (size_t)u.aux * T + (size_t)u.type * 256;
        const int t = wbase | fresh_lane();
#pragma unroll
        for (int i = 0; i < 2; ++i) { int R, C; pg8::stage_rc(t * 16 + i * 8192, R, C);
#pragma unroll
            for (int h = 0; h < 2; ++h) { int r = h * 128 + R; r = r < u.nvalid ? r : u.nvalid - 1; const unsigned tok = lp[r]; va[h][i] = tok * (unsigned)(D * 2) + (unsigned)C * 2u; } }
    }
    DI void init(AccT& acc, const pg8::Unit& u, int, int wc, int, int fq) const {
        const float* bp = bgu + (size_t)u.aux * 2048 + u.c0 + wc * 32 + 8 * fq;
        acc_colbias(acc, *(const f32x4*)bp, *(const f32x4*)(bp + 4), *(const f32x4*)(bp + 1024), *(const f32x4*)(bp + 1028));
    }
    DI void epi(const AccT& acc, const pg8::Unit& u, int wr, int wc, int fr, int fq) const {
        if (NOEPI) {
#pragma unroll
            for (int ai = 0; ai < 2; ++ai)
#pragma unroll
                for (int bj = 0; bj < 2; ++bj) asm volatile("" :: "v"(acc[ai][bj][0][0]), "v"(acc[ai][bj][0][1]), "v"(acc[ai][bj][1][0]), "v"(acc[ai][bj][1][1]), "v"(acc[ai][bj][2][0]), "v"(acc[ai][bj][2][1]), "v"(acc[ai][bj][3][0]), "v"(acc[ai][bj][3][1]));
            return;
        }
        st_realign(wr);
#pragma unroll
        for (int ai = 0; ai < 2; ++ai)
#pragma unroll
            for (int m = 0; m < 4; ++m) {
                const f32x4 g0 = acc[ai][0][m][0], g1 = acc[ai][0][m][1], l0 = acc[ai][1][m][0], l1 = acc[ai][1][m][1]; f32x4 a0, a1;
#pragma unroll
                for (int i = 0; i < 4; ++i) {
                    const float x0 = fminf(g0[i], 7.f), x1 = fminf(g1[i], 7.f), y0 = fminf(fmaxf(l0[i], -7.f), 7.f), y1 = fminf(fmaxf(l1[i], -7.f), 7.f);
                    a0[i] = x0 * rcpf(1.f + ex2(-1.702f * LOG2E * x0)) * (y0 + 1.f); a1[i] = x1 * rcpf(1.f + ex2(-1.702f * LOG2E * x1)) * (y1 + 1.f); }
                st_put(lds, wr * 16 + fr, (wc * 32 + 8 * fq) * 2, a0, a1);
                st_flush<256>(lds, (wr * 4 + wc) * 64 + fq * 16 + fr, ACT + (size_t)(u.r0 + ai * 128 + m * 16) * D + u.c0, D, u.nvalid - (ai * 128 + m * 16)); }
        st_restagger(wr);
    }
};
typedef PolGateUpT<false> PolGateUp;
template <bool NOEPI = false> struct PolDownT {
    static constexpr bool PERM = true, GATHER = false;
    const bf16_t *ACT, *WDNT; const float *bdn, *LISTW; bf16_t* OUTB; const LAS unsigned* ext; int vcu; LAS unsigned char* lds;
    DI bool next(int i, pg8::Unit& u) const {
        int e, mt, pn, nv; unsigned s0;
        if (!moe_unit(ext, i * GRID + vcu, 4, e, mt, pn, nv, s0)) return false;
        u.type = mt; u.A = (const char*)(ACT + (size_t)s0 * D); u.B0 = (const char*)(WDNT + ((size_t)e * 1024 + pn * 256) * D); u.bh = 128 * D * 2; u.r0 = (int)s0; u.c0 = pn * 256; u.nvalid = nv; u.aux = e;
        return true;
    }
    DI void aoff(const pg8::Unit&, int, int tid, unsigned (&va)[2][2]) const { pg8::aoff_std(tid, va); }
    DI void init(AccT& acc, const pg8::Unit& u, int, int wc, int, int fq) const {
        const float* bp = bdn + (size_t)u.aux * 1024 + u.c0 + wc * 32 + 8 * fq;
        acc_colbias(acc, *(const f32x4*)bp, *(const f32x4*)(bp + 4), *(const f32x4*)(bp + 128), *(const f32x4*)(bp + 132));
    }
    DI void epi(const AccT& acc, const pg8::Unit& u, int wr, int wc, int fr, int fq) const {
        if (NOEPI) {
#pragma unroll
            for (int ai = 0; ai < 2; ++ai)
#pragma unroll
                for (int bj = 0; bj < 2; ++bj) asm volatile("" :: "v"(acc[ai][bj][0][0]), "v"(acc[ai][bj][0][1]), "v"(acc[ai][bj][1][0]), "v"(acc[ai][bj][1][1]), "v"(acc[ai][bj][2][0]), "v"(acc[ai][bj][2][1]), "v"(acc[ai][bj][3][0]), "v"(acc[ai][bj][3][1]));
            return;
        }
        const float* wp = LISTW + (size_t)u.aux * T + (size_t)u.type * 256;
        st_realign(wr);
#pragma unroll
        for (int ai = 0; ai < 2; ++ai)
#pragma unroll
            for (int m = 0; m < 4; ++m) { const int rl = ai * 128 + wr * 64 + m * 16 + fr;
                const float w = wp[rl < u.nvalid ? rl : u.nvalid - 1];
#pragma unroll
                for (int bj = 0; bj < 2; ++bj) st_put(lds, wr * 16 + fr, (bj * 128 + wc * 32 + 8 * fq) * 2, acc[ai][bj][m][0] * w, acc[ai][bj][m][1] * w);
                st_flush<512>(lds, (wr * 4 + wc) * 64 + fq * 16 + fr, OUTB + (size_t)(u.r0 + ai * 128 + m * 16) * D + u.c0, D, u.nvalid - (ai * 128 + m * 16)); }
        st_restagger(wr);
    }
};

typedef PolDownT<false> PolDown;
struct PolProj1 {
    static constexpr bool PERM = true, GATHER = false;
    const bf16_t *HN, *HN2, *WBQT, *WKVT; const float *bq, *kvb, *ROPE; bf16_t *Q, *K1, *VT1; int vcu; LAS unsigned char* lds;
    DI bool next(int i, pg8::Unit& u) const {
        const int L = i * GRID + vcu; if (L >= 768) return false;
        u.bh = 128 * D * 2; u.nvalid = 256; u.aux = 0;
        if (L < 512) { const int pm = L >> 2, pn = L & 3; u.type = 0; u.A = (const char*)(HN + (size_t)pm * 256 * D); u.B0 = (const char*)(WBQT + (size_t)pn * 256 * D); u.r0 = pm * 256; u.c0 = pn * 256; }
        else if (L < 640) { const int pm = L - 512; u.type = 1; u.A = (const char*)(HN2 + (size_t)pm * 256 * D); u.B0 = (const char*)WKVT; u.r0 = pm * 256; u.c0 = 0; }
        else { const int pn = L - 640; u.type = 2; u.A = (const char*)WKVT; u.B0 = (const char*)(HN2 + (size_t)pn * 256 * D); u.r0 = 0; u.c0 = pn * 256; }
        return true;
    }
    DI void aoff(const pg8::Unit&, int, int tid, unsigned (&va)[2][2]) const { pg8::aoff_std(tid, va); }
    DI void init(AccT& acc, const pg8::Unit& u, int wr, int wc, int fr, int fq) const {
        if (u.type == 2) {
#pragma unroll
            for (int a = 0; a < 2; ++a)
#pragma unroll
                for (int m = 0; m < 4; ++m) { const float bs = kvb[a * 128 + wr * 64 + m * 16 + fr];
#pragma unroll
                    for (int b = 0; b < 2; ++b)
#pragma unroll
                        for (int n = 0; n < 2; ++n) acc[a][b][m][n] = (f32x4){bs, bs, bs, bs}; }
            return;
        }
        const float* bp = (u.type == 0 ? bq + u.c0 : kvb) + wc * 32 + 8 * fq;
        acc_colbias(acc, *(const f32x4*)bp, *(const f32x4*)(bp + 4), *(const f32x4*)(bp + 128), *(const f32x4*)(bp + 132));
    }
    DI void epi(const AccT& acc, const pg8::Unit& u, int wr, int wc, int fr, int fq) const {
        const int tid = (wr * 4 + wc) * 64 + fq * 16 + fr, rowl = wr * 16 + fr;
        if (u.type == 2) {
            st_realign(wr);
#pragma unroll
            for (int m = 0; m < 4; ++m) {
#pragma unroll
                for (int bj = 0; bj < 2; ++bj) st_put(lds, rowl, (bj * 128 + wc * 32 + 8 * fq) * 2, acc[1][bj][m][0], acc[1][bj][m][1]);
                st_flush<512>(lds, tid, VT1 + (size_t)(m * 16) * T + u.c0, T, 256); }
            st_restagger(wr);
            return;
        }
        const bool isq = (u.type == 0); const bool rl = ((wc & 1) == 0) && fq < 2; const float sc = isq ? QSCALE : 1.f;
        st_realign(wr);
#pragma unroll
        for (int ai = 0; ai < 2; ++ai)
#pragma unroll
            for (int m = 0; m < 4; ++m) { const int row = u.r0 + ai * 128 + wr * 64 + m * 16 + fr;
#pragma unroll
                for (int bj = 0; bj < 2; ++bj) {
                    if (!isq && bj == 1) continue;
                    f32x4 v0 = acc[ai][bj][m][0], v1 = acc[ai][bj][m][1];
                    if ((wc & 1) == 0) { f32x4 r0 = v0, r1 = v1; rope8(r0, r1, ROPE + (size_t)row * 16, fq); if (rl) { v0 = r0; v1 = r1; } }
                    v0 = v0 * sc; v1 = v1 * sc;
                    st_put(lds, rowl, (bj * 128 + wc * 32 + 8 * fq) * 2, v0, v1); }
                if (isq) st_flush<512>(lds, tid, Q + (size_t)(u.r0 + ai * 128 + m * 16) * D + u.c0, D, 256);
                else st_flush<256>(lds, tid, K1 + (size_t)(u.r0 + ai * 128 + m * 16) * 128, 128, 256); }
        st_restagger(wr);
    }
};
DI float gelu_tanh(float z) {
    const float u = 0.7978845608028654f * (z + 0.044715f * z * z * z);
    const float e = ex2(2.f * LOG2E * u);
    const float th = 1.f - 2.f * rcpf(e + 1.f);
    return 0.5f * z * (1.f + th);
}
DI void compress_phase(Frame& F) {
    const int lane = F.lane, r = lane & 31, h = lane >> 5, quad = F.wave >> 2, q = F.wave & 3;
    const int rb = F.bx * 2 + quad, kv = rb >> 8, rem = rb & 255, b = rem >> 4, g = (rem >> 2) & 3, nb = rem & 3;
    const int n = nb * 32 + r, nn = n < 126 ? n : 126;
    LAS unsigned char* hid = F.lds + quad * (32 * 272);
    const bf16_t* w1p = F.CW1T() + ((size_t)kv * 128 + 32 * q + r) * 2048 + 8 * h;
    const bf16_t* xp = F.KV() + ((size_t)(b * SEQ + 16 * nn)) * D + kv * 256 + g * 64 + 8 * h;
    f32x16 acc;
#pragma unroll
    for (int i = 0; i < 16; ++i) acc[i] = 0.f;
#pragma unroll 4
    for (int ks = 0; ks < 128; ++ks) {
        const bf16x8 a = *(const bf16x8*)(w1p + 16 * ks);
        const bf16x8 bb = *(const bf16x8*)(xp + (size_t)(ks >> 2) * D + (ks & 3) * 16);
        acc = MFMA32(a, bb, acc);
    }
    {
        const float* cb = F.CMPB() + kv * 128 + 32 * q;
#pragma unroll
        for (int q4 = 0; q4 < 4; ++q4) {
            float v[4];
#pragma unroll
            for (int i = 0; i < 4; ++i) v[i] = gelu_tanh(acc[4 * q4 + i] + cb[8 * q4 + 4 * h + i]);
            u32x2 o; o.x = pk2(v[0], v[1]); o.y = pk2(v[2], v[3]);
            *(LAS u32x2*)(hid + r * 272 + (32 * q + 8 * q4 + 4 * h) * 2) = o;
        }
    }
    __syncthreads();
    if (q < 2) {
        const int db = q;
        f32x16 o2;
#pragma unroll
        for (int i = 0; i < 16; ++i) o2[i] = 0.f;
        const bf16_t* w2p = F.CW2T() + ((size_t)kv * 64 + 32 * db + r) * 128 + 8 * h;
#pragma unroll
        for (int s = 0; s < 8; ++s) {
            const bf16x8 a = *(const bf16x8*)(w2p + 16 * s);
            const bf16x8 bb = *(const LAS bf16x8*)(hid + r * 272 + (16 * s + 8 * h) * 2);
            o2 = MFMA32(a, bb, o2);
        }
        const bool valid = n < 127;
        if (kv == 0) {
            if (db == 0) {
                const float* rp = F.ROPE() + (size_t)(b * SEQ + 16 * nn + 31) * 16 + 4 * h;
                const f32x4 c = *(const f32x4*)rp, sn = *(const f32x4*)(rp + 8);
#pragma unroll
                for (int i = 0; i < 4; ++i) { const float x1 = o2[i], x2 = o2[4 + i]; o2[i] = x1 * c[i] - x2 * sn[i]; o2[4 + i] = x2 * c[i] + x1 * sn[i]; }
            }
            bf16_t* kp = F.KC() + ((size_t)((b * 4 + g) * 128 + n)) * 64 + 32 * db + 4 * h;
#pragma unroll
            for (int q4 = 0; q4 < 4; ++q4) { u32x2 o; o.x = valid ? pk2(o2[4 * q4], o2[4 * q4 + 1]) : 0u; o.y = valid ? pk2(o2[4 * q4 + 2], o2[4 * q4 + 3]) : 0u; *(u32x2*)(kp + 8 * q4) = o; }
        } else {
#pragma unroll
            for (int i = 0; i < 16; ++i) { const int d = 32 * db + crow(i, h);
                F.VCT()[((size_t)((b * 4 + g) * 64 + d)) * 128 + n] = valid ? (bf16_t)(pk2(o2[i], 0.f) & 0xffffu) : (bf16_t)0; }
        }
    }
    __syncthreads();
}

constexpr int AT_KT = 0, AT_VT = 18432  , AT_KC = 46080, AT_VC = 64512, AT_IMPP = 81408, AT_IMPS = 114176, AT_SELM = 122368;
#define NEG_INF (-INFINITY)

constexpr float AT_THR = 24.0f;
DI float max3f(float a, float b, float c) { float r; asm("v_max3_f32 %0, %1, %2, %3" : "=v"(r) : "v"(a), "v"(b), "v"(c)); return r; }
DI void qk_tile(const LAS unsigned char* kt, const bf16x8 (&qf)[4], f32x16& s0, f32x16& s1, int r, int h) {
    const LAS unsigned char* kp = kt + r * 144 + h * 16;
    f32x16 z;
#pragma unroll
    for (int i = 0; i < 16; ++i) z[i] = 0.f;
    { const bf16x8 a0 = *(const LAS bf16x8*)(kp), a1 = *(const LAS bf16x8*)(kp + 32 * 144); s0 = MFMA32(a0, qf[0], z); s1 = MFMA32(a1, qf[0], z); }
#pragma unroll
    for (int s = 1; s < 4; ++s) {
        const bf16x8 a0 = *(const LAS bf16x8*)(kp + s * 32), a1 = *(const LAS bf16x8*)(kp + 32 * 144 + s * 32);
        s0 = MFMA32(a0, qf[s], s0); s1 = MFMA32(a1, qf[s], s1);
    }
}
DI void v_frags(const LAS unsigned char* vt, bf16x8 (&vf)[2][2][2], int r, int h) {
    const LAS unsigned char* vp = vt + r * 144 + h * 16;
#pragma unroll
    for (int db = 0; db < 2; ++db)
#pragma unroll
        for (int kb = 0; kb < 2; ++kb)
#pragma unroll
            for (int s2 = 0; s2 < 2; ++s2) vf[db][kb][s2] = *(const LAS bf16x8*)(vp + db * 32 * 144 + kb * 64 + s2 * 32);
}
DI void pv_mma(const bf16x8 (&vf)[2][2][2], const u32x4 (&pb)[2][2], f32x16 (&O)[2]) {
#pragma unroll
    for (int db = 0; db < 2; ++db)
#pragma unroll
        for (int kb = 0; kb < 2; ++kb)
#pragma unroll
            for (int s2 = 0; s2 < 2; ++s2) O[db] = MFMA32(vf[db][kb][s2], __builtin_bit_cast(bf16x8, pb[kb][s2]), O[db]);
}
DI void pv_tile(const LAS unsigned char* vt, const u32x4 (&pb)[2][2], f32x16 (&O)[2], int r, int h) {
    bf16x8 vf[2][2][2]; v_frags(vt, vf, r, h); pv_mma(vf, pb, O);
}
DI void make_mask(int lo, int hi, int h, unsigned& w0, unsigned& w1) {
    const int a = lo + 1 < 0 ? 0 : lo + 1, b = hi > 63 ? 63 : hi;
    unsigned long long mk = (a <= b) ? ((~0ull >> (63 - b)) & (~0ull << a)) : 0ull;
    mk >>= 4 * h;
    w0 = (unsigned)mk; w1 = (unsigned)(mk >> 32);
}
DI unsigned bitm(unsigned w, int q) { unsigned r_; asm("v_bfe_i32 %0, %1, %2, 1" : "=v"(r_) : "v"(w), "n"((q & 3) + 8 * (q >> 2))); return r_; }
DI float msel(float s, unsigned mk) { return __uint_as_float((__float_as_uint(s) & mk) | (0xff800000u & ~mk)); }
template <bool MASKED> DI float tile_max(const f32x16& S0, const f32x16& S1, unsigned w0, unsigned w1) {
    float mx = NEG_INF;
    if (!MASKED) {
#pragma unroll
        for (int q = 0; q < 16; q += 2) mx = max3f(mx, max3f(S0[q], S0[q + 1], S1[q]), S1[q + 1]);
    } else {
#pragma unroll
        for (int q = 0; q < 16; ++q) mx = max3f(mx, msel(S0[q], bitm(w0, q)), msel(S1[q], bitm(w1, q)));
    }
    return mx;
}
template <bool MASKED, bool SUB> DI float tile_exp(const f32x16& S0, const f32x16& S1, unsigned w0, unsigned w1, float m, u32x4 (&pb)[2][2]) {
    float ls = 0.f;
#pragma unroll
    for (int s2 = 0; s2 < 2; ++s2)
#pragma unroll
        for (int w = 0; w < 4; ++w) {
            const int q = 8 * s2 + 2 * w;
            float a0 = SUB ? ex2(S0[q] - m) : ex2(S0[q]), a1 = SUB ? ex2(S0[q + 1] - m) : ex2(S0[q + 1]), b0 = SUB ? ex2(S1[q] - m) : ex2(S1[q]), b1 = SUB ? ex2(S1[q + 1] - m) : ex2(S1[q + 1]);
            if (MASKED) { a0 = __uint_as_float(__float_as_uint(a0) & bitm(w0, q)); a1 = __uint_as_float(__float_as_uint(a1) & bitm(w0, q + 1));
                          b0 = __uint_as_float(__float_as_uint(b0) & bitm(w1, q)); b1 = __uint_as_float(__float_as_uint(b1) & bitm(w1, q + 1)); }
            ls += (a0 + a1) + (b0 + b1);
            pb[0][s2][w] = pk2(a0, a1); pb[1][s2][w] = pk2(b0, b1);
        }
    return ls;
}
#define AT_WRITE_K(buf, kreg) do { *(LAS u32x4*)(lds + AT_KT + (buf) * 9216 + (tid >> 3) * 144 + (tid & 7) * 16) = (kreg); } while (0)
#define AT_WRITE_V(buf, vreg) do {   \
        LAS unsigned char* _vp = lds + AT_VT + (buf) * 9216 + (tid >> 3) * 144 + ((tid & 7) >> 1) * 32 + (tid & 1) * 8; *(LAS u32x2*)_vp = (u32x2){(vreg).x, (vreg).y}; *(LAS u32x2*)(_vp + 16) = (u32x2){(vreg).z, (vreg).w}; } while (0)

template <class Seq, int DBG = 0>
DI void attn_stream(LAS unsigned char* lds, int tid, int r, int h, const Seq& seq, const bf16_t* kbase, size_t ktile, const bf16_t* vbase,
                    const bf16x8 (&qf)[4], f32x16 (&O)[2], float& m, float& l) {
    int j = seq.first(), j1 = seq.next(j), j2 = (j1 >= 0) ? seq.next(j1) : -1;
    u32x4 krA, krB, vrA, vrB;
    krA = *(const u32x4*)(kbase + (size_t)j * ktile); vrA = *(const u32x4*)(vbase + 64 * j);
    krB = krA; vrB = vrA;
    if (j1 >= 0) { krB = *(const u32x4*)(kbase + (size_t)j1 * ktile); vrB = *(const u32x4*)(vbase + 64 * j1); }
    AT_WRITE_K(0, krA); AT_WRITE_V(0, vrA);
    if (j2 >= 0) { krA = *(const u32x4*)(kbase + (size_t)j2 * ktile); vrA = *(const u32x4*)(vbase + 64 * j2); }
    __syncthreads();
    f32x16 sa0, sa1, sb0, sb1;
    qk_tile(lds + AT_KT, qf, sa0, sa1, r, h);
    sb0 = sa0; sb1 = sa1;
    if (j1 >= 0) { AT_WRITE_K(1, krB); AT_WRITE_V(1, vrB); }
    __syncthreads();
    int vcur = 0;
#define AT_STEP(SA0, SA1, SB0, SB1, PAR, KR, VR, KS, VS) { \
        const int j3 = (j2 >= 0) ? seq.next(j2) : -1; \
        if (j3 >= 0 && !(DBG & 4)) { KS = *(const u32x4*)(kbase + (size_t)j3 * ktile); VS = *(const u32x4*)(vbase + 64 * j3); } \
        if (j1 >= 0 && !(DBG & 2)) qk_tile(lds + AT_KT + ((PAR) ^ 1) * 9216, qf, SB0, SB1, r, h); \
        __builtin_amdgcn_sched_barrier(0); \
        bf16x8 vf[2][2][2]; if (!(DBG & 2)) v_frags(lds + AT_VT + vcur * 9216, vf, r, h); \
        const bool allow = seq.allow(j); \
        float mx = (DBG & 1) ? 0.f : tile_max<false>(SA0, SA1, 0u, 0u); \
        if (!(DBG & 1)) mx = fmaxf(mx, __shfl_xor(mx, 32)); if (Seq::HAS_ALLOW) mx = allow ? mx : NEG_INF; \
        if (__any(mx - m > AT_THR)) { \
            const float mn = fmaxf(m, mx), alpha = ex2(m - mn); \
            m = mn; l *= alpha; O[0] = O[0] * alpha; O[1] = O[1] * alpha; \
        } \
        u32x4 pb[2][2]; float ls; \
        if (DBG & 1) { ls = 1.f; _Pragma("unroll") for (int a_ = 0; a_ < 2; ++a_) _Pragma("unroll") for (int b_ = 0; b_ < 2; ++b_) pb[a_][b_] = (u32x4){__float_as_uint(SA0[a_]), __float_as_uint(SA0[2 + b_]), __float_as_uint(SA1[a_]), __float_as_uint(SA1[3])}; } \
        else if (__any(m != 0.f)) ls = tile_exp<false, true>(SA0, SA1, 0u, 0u, m, pb); \
        else ls = tile_exp<false, false>(SA0, SA1, 0u, 0u, m, pb); \
        if (Seq::HAS_ALLOW) { const unsigned km = allow ? 0xffffffffu : 0u; ls = allow ? ls : 0.f; \
            _Pragma("unroll") for (int a_ = 0; a_ < 2; ++a_) _Pragma("unroll") for (int b_ = 0; b_ < 2; ++b_) { pb[a_][b_].x &= km; pb[a_][b_].y &= km; pb[a_][b_].z &= km; pb[a_][b_].w &= km; } } \
        l += ls; \
        if (!(DBG & 2)) pv_mma(vf, pb, O); else { O[0][0] += __uint_as_float(pb[0][0].x); O[1][0] += __uint_as_float(pb[1][1].w); } \
        { const int vw = vcur >= 1 ? vcur - 1 : 2;        \
          if (j2 >= 0 && !(DBG & 4)) { AT_WRITE_K((PAR), KR); AT_WRITE_V(vw, VR); } }     \
        vcur = vcur == 2 ? 0 : vcur + 1; \
        if (!(DBG & 8)) __syncthreads(); \
        if (j1 < 0) break; \
        j = j1; j1 = j2; j2 = j3; }
    for (;;) {
        AT_STEP(sa0, sa1, sb0, sb1, 0, krA, vrA, krB, vrB)
        AT_STEP(sb0, sb1, sa0, sa1, 1, krB, vrB, krA, vrA)
    }
#undef AT_STEP
}
DI void attn_tile_masked(LAS unsigned char* lds, int tid, int r, int h, const bf16_t* kptr, const bf16_t* vptr, const bf16x8 (&qf)[4], f32x16 (&O)[2], float& m, float& l, int lo, int hi) {
    const u32x4 kr = *(const u32x4*)kptr, vr = *(const u32x4*)vptr;
    AT_WRITE_K(0, kr); AT_WRITE_V(0, vr);
    __syncthreads();
    f32x16 s0, s1;
    qk_tile(lds + AT_KT, qf, s0, s1, r, h);
    unsigned w0, w1; make_mask(lo, hi, h, w0, w1);
    float mx = tile_max<true>(s0, s1, w0, w1);
    mx = fmaxf(mx, __shfl_xor(mx, 32));
    if (__any(mx - m > AT_THR)) {
        const float mn = fmaxf(m, mx), alpha = ex2(m - mn);
        m = mn; l *= alpha; O[0] = O[0] * alpha; O[1] = O[1] * alpha;
    }
    u32x4 pb[2][2];
    l += tile_exp<true, true>(s0, s1, w0, w1, m, pb);
    pv_tile(lds + AT_VT, pb, O, r, h);
    __syncthreads();
}
struct SeqSel { static constexpr bool HAS_ALLOW = true; unsigned need, myselm;
    DI int first() const { return __builtin_ctz(need); }
    DI int next(int j) const { const unsigned rest = need & ~((2u << j) - 1u); return rest ? __builtin_ctz(rest) : -1; }
    DI bool allow(int j) const { return (myselm >> j) & 1u; }
};
struct SeqRange { static constexpr bool HAS_ALLOW = false; int j0, j1;
    DI int first() const { return j0; }
    DI int next(int j) const { return j < j1 ? j + 1 : -1; }
    DI bool allow(int) const { return true; }
};

DI void nsa_attn_phase(Frame& F) {
    LAS unsigned char* lds = F.lds;
    const int tid0 = F.tid, wave = F.wave, hh = wave & 3, th = wave >> 2;
    const int bg = F.bx & 63, b = bg >> 2, g = bg & 3, s4 = F.bx >> 6;
    LAS float* impP = (LAS float*)(lds + AT_IMPP);
    LAS float* impS = (LAS float*)(lds + AT_IMPS);
    LAS unsigned* selm = (LAS unsigned*)(lds + AT_SELM);
    const int head = g * 4 + hh;
    for (int ui = 0; ui < 8; ++ui) {
        int tid = tid0; asm volatile("" : "+v"(tid));
        const int lane = tid & 63, r = lane & 31, h = lane >> 5, tl = th * 32 + r;
        const int pp = s4 + 4 * (ui >> 1), qt = (ui & 1) ? 31 - pp : pp;
        const int t = qt * 64 + tl; const size_t tokrow = (size_t)b * SEQ + t;
        bf16x8 qf[4];
#pragma unroll
        for (int s = 0; s < 4; ++s) qf[s] = *(const bf16x8*)(F.Q() + tokrow * D + head * 64 + 16 * s + 8 * h);
        const int tids = tid;
#pragma unroll
        for (int i = 0; i < 2; ++i) { const int idx = tids + 512 * i, row = idx >> 3, ch = idx & 7;
            *(LAS u32x4*)(lds + AT_KC + row * 144 + ch * 16) = *(const u32x4*)(F.KC() + ((size_t)((b * 4 + g) * 128 + row)) * 64 + ch * 8); }
#pragma unroll
        for (int i = 0; i < 2; ++i) { const int idx = tids + 512 * i, d = idx >> 4, ch = idx & 15;
            const u32x4 v = *(const u32x4*)(F.VCT() + ((size_t)((b * 4 + g) * 64 + d)) * 128 + ch * 8);
            LAS u32x2* vp = (LAS u32x2*)(lds + AT_VC + d * 264 + ch * 16); vp[0] = (u32x2){v.x, v.y}; vp[1] = (u32x2){v.z, v.w}; }
        if (tid < 64) selm[tid] = 0u;
        __syncthreads();
        f32x16 Ot[2];
#pragma unroll
        for (int i = 0; i < 16; ++i) { Ot[0][i] = 0.f; Ot[1][i] = 0.f; }
#ifndef NO_CMP
        {
            const int nmax = (t - 31) >> 4;
            float mrun = NEG_INF, lrun = 0.f;
#pragma unroll 1
            for (int kb = 0; kb < 4; ++kb) {
                f32x16 sc;
#pragma unroll
                for (int i = 0; i < 16; ++i) sc[i] = 0.f;
#pragma unroll
                for (int s = 0; s < 4; ++s) { const bf16x8 a = *(const LAS bf16x8*)(lds + AT_KC + (kb * 32 + r) * 144 + s * 32 + h * 16); sc = MFMA32(a, qf[s], sc); }
                float bm = NEG_INF;
#pragma unroll
                for (int i = 0; i < 16; ++i) { const int nn = kb * 32 + crow(i, h); sc[i] = (nn <= nmax) ? sc[i] : NEG_INF; bm = fmaxf(bm, sc[i]); }
                const float mn = fmaxf(mrun, bm), mu = (mn == NEG_INF) ? 0.f : mn;
                float ls = 0.f;
#pragma unroll
                for (int i = 0; i < 16; ++i) ls += ex2(sc[i] - mu);
                lrun = lrun * ex2(mrun - mu) + ls; mrun = mn;
            }
            float mu, inv;
            { const float mo = __shfl_xor(mrun, 32), lo_ = __shfl_xor(lrun, 32); const float mt = fmaxf(mrun, mo); mu = (mt == NEG_INF) ? 0.f : mt;
              const float lt = lrun * ex2(mrun - mu) + lo_ * ex2(mo - mu); inv = lt > 0.f ? 1.f / lt : 0.f; }
            f32x16 Oc[2];
#pragma unroll
            for (int i = 0; i < 16; ++i) { Oc[0][i] = 0.f; Oc[1][i] = 0.f; }
            LAS float* ip = impP + ((hh * 64 + tl) * 32);
            float carry = 0.f;
#pragma unroll 1
            for (int kb = 0; kb < 4; ++kb) {
                f32x16 sc;
#pragma unroll
                for (int i = 0; i < 16; ++i) sc[i] = 0.f;
#pragma unroll
                for (int s = 0; s < 4; ++s) { const bf16x8 a = *(const LAS bf16x8*)(lds + AT_KC + (kb * 32 + r) * 144 + s * 32 + h * 16); sc = MFMA32(a, qf[s], sc); }
#pragma unroll
                for (int i = 0; i < 16; ++i) { const int nn = kb * 32 + crow(i, h); sc[i] = (nn <= nmax) ? ex2(sc[i] - mu) * inv : 0.f; }
                float Lo[4];
#pragma unroll
                for (int q4 = 0; q4 < 4; ++q4) Lo[q4] = __shfl_xor(sc[4 * q4 + 3], 32);
#pragma unroll
                for (int q4 = 0; q4 < 4; ++q4) {
                    const float G = (sc[4 * q4] + sc[4 * q4 + 1]) + (sc[4 * q4 + 2] + sc[4 * q4 + 3]);
                    const float prev0 = (q4 > 0) ? Lo[q4 > 0 ? q4 - 1 : 0] : carry;
                    const float Lp = (h == 1) ? Lo[q4] : prev0;
                    ip[8 * kb + 2 * q4 + h] = G + Lp;
                }
                carry = Lo[3];
#pragma unroll
                for (int s2 = 0; s2 < 2; ++s2) {
                    u32x4 p;
                    p.x = pk2(sc[8 * s2 + 0], sc[8 * s2 + 1]); p.y = pk2(sc[8 * s2 + 2], sc[8 * s2 + 3]); p.z = pk2(sc[8 * s2 + 4], sc[8 * s2 + 5]); p.w = pk2(sc[8 * s2 + 6], sc[8 * s2 + 7]);
                    const bf16x8 pb = __builtin_bit_cast(bf16x8, p);
#pragma unroll
                    for (int db = 0; db < 2; ++db) {
                        const LAS unsigned char* a = lds + AT_VC + (db * 32 + r) * 264 + (kb * 32 + 16 * s2 + 4 * h) * 2;
                        const s16x4 lo4 = *(const LAS s16x4*)a, hi4 = *(const LAS s16x4*)(a + 16);
                        const bf16x8 va = __builtin_shufflevector(lo4, hi4, 0, 1, 2, 3, 4, 5, 6, 7);
                        Oc[db] = MFMA32(va, pb, Oc[db]);
                    }
                }
            }
            const float gc = F.GATES()[tokrow * 64 + head * 3 + 0];
#pragma unroll
            for (int i = 0; i < 16; ++i) { Ot[0][i] = gc * Oc[0][i]; Ot[1][i] = gc * Oc[1][i]; }
        }
#endif
        __syncthreads();
        {
            const int tok = tid >> 3, sub = tid & 7;
#pragma unroll
            for (int jj = 0; jj < 4; ++jj) { const int j = sub * 4 + jj;
                impS[tok * 32 + j] = ((impP[(0 * 64 + tok) * 32 + j] + impP[(1 * 64 + tok) * 32 + j]) + impP[(2 * 64 + tok) * 32 + j]) + impP[(3 * 64 + tok) * 32 + j]; }
        }
        __syncthreads();
#ifndef NO_TOPK
        {
            const int tok = tid >> 3, sub = tid & 7;
            if (qt < 16) { if (sub == 0) selm[tok] = (2u << qt) - 1u; }
            else {
                float vj[4]; int rank[4];
#pragma unroll
                for (int jj = 0; jj < 4; ++jj) { vj[jj] = impS[tok * 32 + sub * 4 + jj]; rank[jj] = 0; }
#pragma unroll 1
                for (int i = 1; i <= qt - 2; ++i) { const float vi = impS[tok * 32 + i];
#pragma unroll
                    for (int jj = 0; jj < 4; ++jj) { const int j = sub * 4 + jj; rank[jj] += ((vi > vj[jj]) || (vi == vj[jj] && i < j)) ? 1 : 0; } }
                unsigned bits = 0u;
#pragma unroll
                for (int jj = 0; jj < 4; ++jj) { const int j = sub * 4 + jj;
                    const bool forced = (j == 0 || j == qt || j == qt - 1);
                    const bool sel = forced || (j <= qt - 2 && rank[jj] < 13);
                    bits |= sel ? (1u << j) : 0u; }
                if (bits) __hip_atomic_fetch_or(selm + tok, bits, __ATOMIC_RELAXED, __HIP_MEMORY_SCOPE_WORKGROUP);
            }
        }
#endif
        __syncthreads();
        LAS float* park = (LAS float*)(lds + AT_KC) + wave * 2048 + lane;
#pragma unroll
        for (int i = 0; i < 16; ++i) { park[i * 64] = Ot[0][i]; park[(16 + i) * 64] = Ot[1][i]; }
        const unsigned myselm = selm[tl];
        unsigned need;
        { unsigned w = selm[lane];
#pragma unroll
            for (int o = 1; o < 64; o <<= 1) w |= (unsigned)__shfl_xor((int)w, o);
            need = (unsigned)__builtin_amdgcn_readfirstlane((int)w) & ((2u << qt) - 1u); }
#ifdef REPEAT_SEL
        { f32x16 O2[2]; float m2 = 0.f, l2 = 0.f;
#pragma unroll
          for (int i = 0; i < 16; ++i) { O2[0][i] = 0.f; O2[1][i] = 0.f; }
          const bf16_t* kbase = F.KV() + ((size_t)b * SEQ + (tid >> 3)) * D + 512 + g * 64 + (tid & 7) * 8;
          const bf16_t* vbase = F.VT() + ((size_t)(g * 64 + (tid >> 3))) * T + (size_t)b * SEQ + (tid & 7) * 8;
          const unsigned inner = need & ~(1u << qt);
          if (inner) { const SeqSel seq{inner, myselm}; attn_stream<SeqSel, REPEAT_SEL>(lds, tid, r, h, seq, kbase, (size_t)64 * D, vbase, qf, O2, m2, l2); }
          attn_tile_masked(lds, tid, r, h, kbase + (size_t)qt * 64 * D, vbase + 64 * qt, qf, O2, m2, l2, -1, tl);
          asm volatile("" :: "v"(O2[0]), "v"(O2[1]), "v"(l2)); }
#endif
#ifndef NO_SEL
        {
            f32x16 O[2];
#pragma unroll
            for (int i = 0; i < 16; ++i) { O[0][i] = 0.f; O[1][i] = 0.f; }
            float m = 0.f, l = 0.f;
            const bf16_t* kbase = F.KV() + ((size_t)b * SEQ + (tid >> 3)) * D + 512 + g * 64 + (tid & 7) * 8;
            const bf16_t* vbase = F.VT() + ((size_t)(g * 64 + (tid >> 3))) * T + (size_t)b * SEQ + (tid & 7) * 8;
            const unsigned inner = need & ~(1u << qt);
            if (inner) { const SeqSel seq{inner, myselm}; attn_stream(lds, tid, r, h, seq, kbase, (size_t)64 * D, vbase, qf, O, m, l); }
            attn_tile_masked(lds, tid, r, h, kbase + (size_t)qt * 64 * D, vbase + 64 * qt, qf, O, m, l, -1, tl);
            l += __shfl_xor(l, 32);
            const float gs = F.GATES()[tokrow * 64 + head * 3 + 1];
            const float sc = l > 0.f ? gs / l : 0.f;
#pragma unroll
            for (int i = 0; i < 16; ++i) { park[i * 64] += sc * O[0][i]; park[(16 + i) * 64] += sc * O[1][i]; }
        }
#endif
#ifdef REPEAT_SWA
        { f32x16 O2[2]; float m2 = 0.f, l2 = 0.f;
#pragma unroll
          for (int i = 0; i < 16; ++i) { O2[0][i] = 0.f; O2[1][i] = 0.f; }
          const bf16_t* kbase = F.KV() + ((size_t)b * SEQ + (tid >> 3)) * D + 768 + g * 64 + (tid & 7) * 8;
          const bf16_t* vbase = F.VT() + ((size_t)(256 + g * 64 + (tid >> 3))) * T + (size_t)b * SEQ + (tid & 7) * 8;
          if (qt >= 8) attn_tile_masked(lds, tid, r, h, kbase + (size_t)(qt - 8) * 64 * D, vbase + 64 * (qt - 8), qf, O2, m2, l2, tl, 64);
          const int i0 = qt > 7 ? qt - 7 : 0;
          if (i0 <= qt - 1) { const SeqRange seq{i0, qt - 1}; attn_stream(lds, tid, r, h, seq, kbase, (size_t)64 * D, vbase, qf, O2, m2, l2); }
          attn_tile_masked(lds, tid, r, h, kbase + (size_t)qt * 64 * D, vbase + 64 * qt, qf, O2, m2, l2, -1, tl);
          asm volatile("" :: "v"(O2[0]), "v"(O2[1]), "v"(l2)); }
#endif
#ifndef NO_SWA
        {
            f32x16 O[2];
#pragma unroll
            for (int i = 0; i < 16; ++i) { O[0][i] = 0.f; O[1][i] = 0.f; }
            float m = 0.f, l = 0.f;
            const bf16_t* kbase = F.KV() + ((size_t)b * SEQ + (tid >> 3)) * D + 768 + g * 64 + (tid & 7) * 8;
            const bf16_t* vbase = F.VT() + ((size_t)(256 + g * 64 + (tid >> 3))) * T + (size_t)b * SEQ + (tid & 7) * 8;
            if (qt >= 8) attn_tile_masked(lds, tid, r, h, kbase + (size_t)(qt - 8) * 64 * D, vbase + 64 * (qt - 8), qf, O, m, l, tl, 64);
            const int i0 = qt > 7 ? qt - 7 : 0;
            if (i0 <= qt - 1) { const SeqRange seq{i0, qt - 1}; attn_stream(lds, tid, r, h, seq, kbase, (size_t)64 * D, vbase, qf, O, m, l); }
            attn_tile_masked(lds, tid, r, h, kbase + (size_t)qt * 64 * D, vbase + 64 * qt, qf, O, m, l, -1, tl);
            l += __shfl_xor(l, 32);
            const float gw = F.GATES()[tokrow * 64 + head * 3 + 2];
            const float sc = l > 0.f ? gw / l : 0.f;
#pragma unroll
            for (int i = 0; i < 16; ++i) { Ot[0][i] = park[i * 64] + sc * O[0][i]; Ot[1][i] = park[(16 + i) * 64] + sc * O[1][i]; }
        }
#endif
        {
            bf16_t* op = F.O() + tokrow * D + head * 64 + 4 * h;
#pragma unroll
            for (int db = 0; db < 2; ++db)
#pragma unroll
                for (int q4 = 0; q4 < 4; ++q4) { u32x2 o; o.x = pk2(Ot[db][4 * q4], Ot[db][4 * q4 + 1]); o.y = pk2(Ot[db][4 * q4 + 2], Ot[db][4 * q4 + 3]); *(u32x2*)(op + db * 32 + 8 * q4) = o; }
        }
        __syncthreads();
    }
}

DI void swa_sink_phase(Frame& F) {
    LAS unsigned char* lds = F.lds;
    const int tid = F.tid, lane = F.lane, wave = F.wave, r = lane & 31, h = lane >> 5;
    for (int ui = 0; ui < 8; ++ui) {
        const int u = ui * GRID + F.vcu, q32 = u & 63, kvh = (u >> 6) & 1, b = u >> 7;
        const int head = kvh * 8 + wave, t = q32 * 32 + r; const size_t tokrow = (size_t)b * SEQ + t;
        bf16x8 qf[4];
#pragma unroll
        for (int s = 0; s < 4; ++s) qf[s] = *(const bf16x8*)(F.Q() + tokrow * D + head * 64 + 16 * s + 8 * h);
        f32x16 O[2];
#pragma unroll
        for (int i = 0; i < 16; ++i) { O[0][i] = 0.f; O[1][i] = 0.f; }
        float m = F.b_sinks()[head] * LOG2E, l = (h == 0) ? 1.f : 0.f;
        const bf16_t* kbase = F.KV() + ((size_t)b * SEQ + (tid >> 3)) * 128 + kvh * 64 + (tid & 7) * 8;
        const bf16_t* vbase = F.VT() + ((size_t)(kvh * 64 + (tid >> 3))) * T + (size_t)b * SEQ + (tid & 7) * 8;
        const int klo = 32 * q32 - 127, j0 = (klo > 0 ? klo : 0) >> 6, j1 = (32 * q32 + 31) >> 6;
        for (int j = j0; j <= j1; ++j) { const int hi = t - 64 * j; attn_tile_masked(lds, tid, r, h, kbase + (size_t)j * 64 * 128, vbase + 64 * j, qf, O, m, l, hi - 128, hi); }
        l += __shfl_xor(l, 32);
        const float sc = 1.f / l;
        bf16_t* op = F.O() + tokrow * D + head * 64 + 4 * h;
#pragma unroll
        for (int db = 0; db < 2; ++db)
#pragma unroll
            for (int q4 = 0; q4 < 4; ++q4) { u32x2 o; o.x = pk2(O[db][4 * q4] * sc, O[db][4 * q4 + 1] * sc); o.y = pk2(O[db][4 * q4 + 2] * sc, O[db][4 * q4 + 3] * sc); *(u32x2*)(op + db * 32 + 8 * q4) = o; }
    }
}
#ifndef N_LAUNCHES
#define N_LAUNCHES 1
#endif
constexpr int N_PHASES = 17;
__global__ void __launch_bounds__(NTHR, 2) fwd_kernel(Args args) {
    extern __shared__ __attribute__((aligned(16))) unsigned char lds_raw[];
    LAS unsigned char* const lds = (LAS unsigned char*)lds_raw;
    const int wave0 = __builtin_amdgcn_readfirstlane((int)(threadIdx.x >> 6));
    for (int u = threadIdx.x; u < 256; u += NTHR) ((LAS unsigned*)(lds + MISC_OFF))[u] = 0u;
    __syncthreads();
#if N_LAUNCHES == 1
    { Frame F = make_frame(lds, wave0); (void)xcd_barrier_post(F.ctl() + CW_BAR, (volatile LAS unsigned*)(lds + MISC_OFF)); }
#define IN(k) true
#define SEAM(k) do { Frame Fb = make_frame(lds, wave0); XcdBarrier _b; _b.bar = Fb.ctl() + CW_BAR; _b.x = xb_xcc_id(); _b.st = (volatile LAS unsigned*)(lds + MISC_OFF); xcd_barrier(_b); } while (0)
#else
#ifdef ONLY_PHASE
#define IN(k) ((k) == ONLY_PHASE && args.ph_lo <= (k) && (k) < args.ph_hi)
#else
#define IN(k) (args.ph_lo <= (k) && (k) < args.ph_hi)
#endif
#define SEAM(k) do { } while (0)
#endif
    const LAS unsigned* ext = (const LAS unsigned*)(lds + EXT_OFF);
#ifndef REPEAT_MASK
#define REPEAT_MASK 0
#endif
#define PH(k, ...) do { if (IN(k)) { __VA_ARGS__ } if ((((REPEAT_MASK) >> (k)) & 1) && IN(k)) { __VA_ARGS__ } } while (0)

    PH(0, Frame F = make_frame(lds, wave0); p0_prologue(F);); SEAM(0);
    PH(1, Frame F = make_frame(lds, wave0); norm_plain_phase(F);); SEAM(1);
    PH(2, Frame F = make_frame(lds, wave0); PolProj0 P{F.HN(), F.WINT(), F.Q(), F.KV(), F.VT(), F.GATES(), F.ROPE(), F.vcu, lds}; pg8::gemm_phase(lds, P, F.wave, F.lane);); SEAM(2);
    PH(3, Frame F = make_frame(lds, wave0); compress_phase(F);); SEAM(3);
    PH(4, Frame F = make_frame(lds, wave0); nsa_attn_phase(F);); SEAM(4);
    PH(5, Frame F = make_frame(lds, wave0); PolOut P{F.O(), F.WAOT(), F.x(), F.MODV() + (size_t)0 * 16 * 3072, nullptr, F.H(), F.vcu}; pg8::gemm_phase(lds, P, F.wave, F.lane);); SEAM(5);
    PH(6, Frame F = make_frame(lds, wave0); norm_router_phase(F, 0);); SEAM(6);
#ifdef PROBE_GU_NOEPI
    { Frame F = make_frame(lds, wave0); load_expert_tables(F, 0, 8); PolGateUpT<true> P{F.HN(), F.WGUT(), F.b_gate_up(), F.LIST(), F.ACT(), ext, F.vcu, lds}; pg8::gemm_phase(lds, P, F.wave, F.lane); }
#endif
    PH(7, Frame F = make_frame(lds, wave0); load_expert_tables(F, 0, 8); PolGateUp P{F.HN(), F.WGUT(), F.b_gate_up(), F.LIST(), F.ACT(), ext, F.vcu, lds}; pg8::gemm_phase(lds, P, F.wave, F.lane);); SEAM(7);
#ifdef PROBE_DN
    { Frame F = make_frame(lds, wave0); load_expert_tables(F, 0, 4); PolDownT<(PROBE_DN == 1)> P{F.ACT(), F.WDNT(), F.b_down(), F.LISTW(), F.OUTB(), ext, F.vcu, lds}; pg8::gemm_phase(lds, P, F.wave, F.lane); }
#endif
    PH(8, Frame F = make_frame(lds, wave0); load_expert_tables(F, 0, 4); PolDown P{F.ACT(), F.WDNT(), F.b_down(), F.LISTW(), F.OUTB(), ext, F.vcu, lds}; pg8::gemm_phase(lds, P, F.wave, F.lane);); SEAM(8);
    PH(9, Frame F = make_frame(lds, wave0); combine_phase<false>(F, 0);); SEAM(9);
    PH(10, Frame F = make_frame(lds, wave0); PolProj1 P{F.HN(), F.HN2(), F.WBQT(), F.WKVT(), F.b_b_q(), F.kv_b(), F.ROPE(), F.Q(), F.KV(), F.VT(), F.vcu, lds}; pg8::gemm_phase(lds, P, F.wave, F.lane);); SEAM(10);
    PH(11, Frame F = make_frame(lds, wave0); swa_sink_phase(F);); SEAM(11);
    PH(12, Frame F = make_frame(lds, wave0); PolOut P{F.O(), F.WBOT(), F.H(), F.MODV() + (size_t)2 * 16 * 3072, F.b_b_out(), F.H(), F.vcu}; pg8::gemm_phase(lds, P, F.wave, F.lane);); SEAM(12);
    PH(13, Frame F = make_frame(lds, wave0); norm_router_phase(F, 1);); SEAM(13);
    PH(14, Frame F = make_frame(lds, wave0); load_expert_tables(F, 1, 8); PolGateUp P{F.HN(), F.WGUT() + (size_t)32 * 2048 * D, F.b_gate_up() + 32 * 2048, F.LIST(), F.ACT(), ext, F.vcu, lds}; pg8::gemm_phase(lds, P, F.wave, F.lane);); SEAM(14);
    PH(15, Frame F = make_frame(lds, wave0); load_expert_tables(F, 1, 4); PolDown P{F.ACT(), F.WDNT() + (size_t)32 * D * D, F.b_down() + 32 * 1024, F.LISTW(), F.OUTB(), ext, F.vcu, lds}; pg8::gemm_phase(lds, P, F.wave, F.lane);); SEAM(15);
    PH(16, Frame F = make_frame(lds, wave0); combine_phase<true>(F, 1););
#undef IN
#undef SEAM
}

extern "C" void kernel_launch(void* const* d_in, const int* in_sizes, int n_in, void* d_out, int out_size, void* d_ws, size_t ws_size, hipStream_t stream) {
    static int ready = 0;
    if (ready == 0) {
        if (n_in != 28 || out_size != T * D || ws_size < WS_END) { fprintf(stderr, "kernel_launch: unexpected shapes (n_in %d out %d ws %zu)\n", n_in, out_size, ws_size); ready = -1; return; }
        int dev = 0, cus = 0, per_cu = 0;
        if (hipGetDevice(&dev) != hipSuccess || hipDeviceGetAttribute(&cus, hipDeviceAttributeMultiprocessorCount, dev) != hipSuccess) { ready = -1; return; }
        if (hipFuncSetAttribute((const void*)fwd_kernel, hipFuncAttributeMaxDynamicSharedMemorySize, LDS_BYTES) != hipSuccess) { fprintf(stderr, "kernel_launch: hipFuncSetAttribute failed\n"); ready = -1; return; }
        if (hipOccupancyMaxActiveBlocksPerMultiprocessor(&per_cu, (const void*)fwd_kernel, NTHR, LDS_BYTES) != hipSuccess || per_cu < 1) fprintf(stderr, "kernel_launch: occupancy query reports %d\n", per_cu);
        (void)hipGetLastError();
        if (cus < GRID) { fprintf(stderr, "kernel_launch: needs %d CUs, device has %d\n", GRID, cus); ready = -1; return; }
        ready = 1;
    }
    if (ready < 0) return;
    (void)hipMemsetAsync((char*)d_ws + WS_CTL, 0, CTL_ZERO_BYTES, stream);
    Args a{};
    for (int i = 0; i < 28; ++i) a.in[i] = d_in[i];
    a.out = (float*)d_out; a.ws = (unsigned char*)d_ws;
    if (N_LAUNCHES == 1) {
        a.ph_lo = 0; a.ph_hi = N_PHASES;
        hipLaunchKernelGGL(fwd_kernel, dim3(GRID), dim3(NTHR), LDS_BYTES, stream, a);
    } else {
        for (int p = 0; p < N_PHASES; ++p) { a.ph_lo = p; a.ph_hi = p + 1; hipLaunchKernelGGL(fwd_kernel, dim3(GRID), dim3(NTHR), LDS_BYTES, stream, a); }
    }
}
```

```cpp
#include <hip/hip_runtime.h>
#include <cstdio>
#include <cstdint>

#define DI __device__ __forceinline__
#define LAS __attribute__((address_space(3)))
#define GAS __attribute__((address_space(1)))
typedef unsigned short bf16_t;
typedef short bf16x8 __attribute__((ext_vector_type(8)));
typedef short s16x4 __attribute__((ext_vector_type(4)));
typedef float f32x2 __attribute__((ext_vector_type(2)));
typedef float f32x4 __attribute__((ext_vector_type(4)));
typedef float f32x16 __attribute__((ext_vector_type(16)));
typedef unsigned u32x4 __attribute__((ext_vector_type(4)));
typedef unsigned u32x2 __attribute__((ext_vector_type(2)));

constexpr int NB = 16, SEQ = 2048, T = NB * SEQ, D = 1024, HD = 64;
constexpr int NEXP = 32, TOPK = 4;
constexpr int A_PROJ = 2608;
constexpr float NORM_EPS = 1e-5f;
constexpr float QSCALE = 0.125f * 1.4426950408889634f;
constexpr float LOG2E = 1.4426950408889634f;
constexpr int NWAVES = 8, NTHR = 512, GRID = 256;

constexpr size_t MiB = (size_t)1 << 20;
constexpr size_t WS_CTL = 0, CTL_ZERO_BYTES = 1 * MiB;
constexpr size_t WS_MODV = 1 * MiB;
constexpr size_t WS_ROPE = 2 * MiB;
constexpr size_t WS_CMPB = 4 * MiB;
constexpr size_t WS_CW1T = 5 * MiB;
constexpr size_t WS_CW2T = 6 * MiB;
constexpr size_t WS_WINT = 7 * MiB;
constexpr size_t WS_WAOT = 13 * MiB;
constexpr size_t WS_WBQT = 15 * MiB;
constexpr size_t WS_WBOT = 17 * MiB;
constexpr size_t WS_WKVT = 19 * MiB;
constexpr size_t WS_KC = 20 * MiB;
constexpr size_t WS_VCT = 21 * MiB;
constexpr size_t WS_TOKSLOT = 22 * MiB;
constexpr size_t WS_GATES = 24 * MiB;
constexpr size_t WS_LIST = 32 * MiB;
constexpr size_t WS_LISTW = 36 * MiB;
constexpr size_t WS_VT = 40 * MiB;
constexpr size_t WS_WGUT = 72 * MiB;
constexpr size_t WS_WDNT = 328 * MiB;
constexpr size_t WS_H = 456 * MiB;
constexpr size_t WS_HN = 584 * MiB;
constexpr size_t WS_HN2 = 648 * MiB;
constexpr size_t WS_Q = 712 * MiB;
constexpr size_t WS_KV = 776 * MiB;
constexpr size_t WS_O = 840 * MiB;
constexpr size_t WS_ACT = 904 * MiB;
constexpr size_t WS_OUTB = 1161 * MiB;
constexpr size_t WS_END = 1417 * MiB;
constexpr int CW_BAR = 1024;
constexpr int CW_CNT = 8192;

constexpr int LDS_BYTES = 163840;
constexpr int MISC_OFF = LDS_BYTES - 1024;
constexpr int EXT_OFF = MISC_OFF + 64;

DI unsigned pk2(float lo, float hi) {
    typedef __bf16 bf2 __attribute__((ext_vector_type(2)));
    f32x2 v = {lo, hi}; bf2 b = __builtin_convertvector(v, bf2); return __builtin_bit_cast(unsigned, b);
}
DI float bf_lo(unsigned u) { return __uint_as_float(u << 16); }
DI float bf_hi(unsigned u) { return __uint_as_float(u & 0xffff0000u); }
DI float ex2(float x) { return __builtin_amdgcn_exp2f(x); }
DI float rcpf(float x) { return __builtin_amdgcn_rcpf(x); }
DI float wave_sum(float v) {
#pragma unroll
    for (int o = 1; o < 64; o <<= 1) v += __shfl_xor(v, o);
    return v;
}
DI int crow(int reg, int h) { return (reg & 3) + 8 * (reg >> 2) + 4 * h; }
#define MFMA32(a, b, c) __builtin_amdgcn_mfma_f32_32x32x16_bf16((a), (b), (c), 0, 0, 0)
#define LDS_WAIT() asm volatile("s_waitcnt lgkmcnt(0)" ::: "memory")
#define VM_WAIT() asm volatile("s_waitcnt vmcnt(0)" ::: "memory")

#define XB_TMO      128
#define XB_XCNT(j)  (256  + 64 * (j))
#define XB_XSUB(j)  (1280 + 64 * (j))
#define XB_XGEN(j)  (2304 + 64 * (j))
#define XB_TOP      3328
#define XB_TOPGEN   3392
#define XCD_BAR_WORDS 3456
#define XB_SPIN_CAP (1u << 21)

DI unsigned xb_ld(unsigned* p)              { return __hip_atomic_load(p, __ATOMIC_RELAXED, __HIP_MEMORY_SCOPE_AGENT); }
DI unsigned xb_add(unsigned* p, unsigned v) { return __hip_atomic_fetch_add(p, v, __ATOMIC_RELAXED, __HIP_MEMORY_SCOPE_AGENT); }
DI unsigned xb_xcc_id() { return (unsigned)__builtin_amdgcn_s_getreg((3 << 11) | 20) & 0xFu; }
#define XB_SPIN(cond, bar) do { unsigned _sp = 0; while (cond) { __builtin_amdgcn_s_sleep(1); \
    if ((++_sp & 255u) == 0u) { if (xb_ld(&(bar)[XB_TMO])) break; if (_sp > XB_SPIN_CAP) { atomicAdd(&(bar)[XB_TMO], 1u); break; } } } } while (0)

struct XcdBarrier { unsigned* bar; unsigned x; volatile LAS unsigned* st; };

DI XcdBarrier xcd_barrier_post(unsigned* bar, volatile LAS unsigned* st) {
    XcdBarrier b; b.bar = bar; b.x = xb_xcc_id(); b.st = st;
    if (threadIdx.x == 0) (void)xb_add(&bar[XB_XCNT(b.x)], 1u);
    return b;
}
DI void xcd_barrier_complete(unsigned* bar, unsigned x, unsigned& nloc, unsigned& nx) {
    const unsigned G = gridDim.x * gridDim.y * gridDim.z;
    unsigned sum, cnt, mine, sp = 0u;
    for (;;) {
        sum = 0u; cnt = 0u; mine = 0u;
#pragma unroll
        for (unsigned j = 0; j < 16; ++j) { const unsigned c = xb_ld(&bar[XB_XCNT(j)]); sum += c; cnt += (c > 0u) ? 1u : 0u; mine = (j == x) ? c : mine; }
        if (sum == G) break;
        __builtin_amdgcn_s_sleep(1);
        if ((++sp & 255u) == 0u) { if (xb_ld(&bar[XB_TMO])) break; if (sp > XB_SPIN_CAP) { atomicAdd(&bar[XB_TMO], 1u); break; } }
    }
    nloc = mine > 0u ? mine : 1u; nx = cnt > 0u ? cnt : 1u;
}
DI void xcd_barrier(const XcdBarrier& b) {
    asm volatile("s_waitcnt vmcnt(0)" ::: "memory");
    __syncthreads();
    if (threadIdx.x == 0) {
        unsigned* bar = b.bar;
        __builtin_amdgcn_s_waitcnt(0);
        unsigned nloc = b.st[0], nx = b.st[1];
        if (nloc == 0u) { xcd_barrier_complete(bar, b.x, nloc, nx); b.st[0] = nloc; b.st[1] = nx; }
        const unsigned old = xb_add(&bar[XB_XSUB(b.x)], 1u);
        const unsigned gen = old / nloc;
        if (old + 1u == (gen + 1u) * nloc) {
            __builtin_amdgcn_fence(__ATOMIC_RELEASE, "agent");
            asm volatile("s_waitcnt vmcnt(0)" ::: "memory");
            const unsigned og = xb_add(&bar[XB_TOP], 1u);
            const unsigned tg = og / nx;
            if (og + 1u == (tg + 1u) * nx) xb_add(&bar[XB_TOPGEN], 1u);
            else XB_SPIN(xb_ld(&bar[XB_TOPGEN]) == tg, bar);
            __builtin_amdgcn_fence(__ATOMIC_ACQUIRE, "agent");
            xb_add(&bar[XB_XGEN(b.x)], 1u);
            asm volatile("s_waitcnt vmcnt(0)" ::: "memory");
        } else {
            XB_SPIN(xb_ld(&bar[XB_XGEN(b.x)]) == gen, bar);
            __builtin_amdgcn_fence(__ATOMIC_ACQUIRE, "agent");
            asm volatile("s_waitcnt vmcnt(0)" ::: "memory");
        }
    }
    __syncthreads();
}

struct Args { const void* in[28]; float* out; unsigned char* ws; int ph_lo, ph_hi; };

typedef const __attribute__((address_space(4))) unsigned char* KPtr;
struct Frame {
    LAS unsigned char* lds; KPtr kp; int tid, lane, wave, vcu, bx;
    DI void* arg(int i) const { return *(void* const __attribute__((address_space(4)))*)(kp + 8 * i); }
    DI unsigned char* wsp() const { return (unsigned char*)arg(29); }
    DI unsigned* ctl() const { return (unsigned*)(wsp() + WS_CTL); }
    DI float* out() const { return (float*)arg(28); }
    DI const float* x() const { return (const float*)arg(0); }
    DI const float* c() const { return (const float*)arg(1); }
    DI const int* positions() const { return (const int*)arg(2); }
    DI const float* mod_w() const { return (const float*)arg(3); }
    DI const float* mod_b() const { return (const float*)arg(4); }
    DI const float* norm_g() const { return (const float*)arg(5); }
    DI const float* final_g() const { return (const float*)arg(6); }
    DI const float* a_w_in() const { return (const float*)arg(7); }
    DI const float* cmp_pe() const { return (const float*)arg(8); }
    DI const float* cmp_w1() const { return (const float*)arg(9); }
    DI const float* cmp_w2() const { return (const float*)arg(10); }
    DI const float* a_w_out() const { return (const float*)arg(11); }
    DI const float* kv_norm_g() const { return (const float*)arg(12); }
    DI const float* kv_mod_w() const { return (const float*)arg(13); }
    DI const float* kv_mod_b() const { return (const float*)arg(14); }
    DI const float* kv_w() const { return (const float*)arg(15); }
    DI const float* kv_b() const { return (const float*)arg(16); }
    DI const float* b_w_q() const { return (const float*)arg(17); }
    DI const float* b_b_q() const { return (const float*)arg(18); }
    DI const float* b_sinks() const { return (const float*)arg(19); }
    DI const float* b_w_out() const { return (const float*)arg(20); }
    DI const float* b_b_out() const { return (const float*)arg(21); }
    DI const float* router_w() const { return (const float*)arg(22); }
    DI const float* router_b() const { return (const float*)arg(23); }
    DI const float* w_gate_up() const { return (const float*)arg(24); }
    DI const float* b_gate_up() const { return (const float*)arg(25); }
    DI const float* w_down() const { return (const float*)arg(26); }
    DI const float* b_down() const { return (const float*)arg(27); }
    DI float* MODV() const { return (float*)(wsp() + WS_MODV); }
    DI float* ROPE() const { return (float*)(wsp() + WS_ROPE); }
    DI float* CMPB() const { return (float*)(wsp() + WS_CMPB); }
    DI float* GATES() const { return (float*)(wsp() + WS_GATES); }
    DI float* LISTW() const { return (float*)(wsp() + WS_LISTW); }
    DI float* H() const { return (float*)(wsp() + WS_H); }
    DI bf16_t* CW1T() const { return (bf16_t*)(wsp() + WS_CW1T); }
    DI bf16_t* CW2T() const { return (bf16_t*)(wsp() + WS_CW2T); }
    DI bf16_t* WINT() const { return (bf16_t*)(wsp() + WS_WINT); }
    DI bf16_t* WAOT() const { return (bf16_t*)(wsp() + WS_WAOT); }
    DI bf16_t* WBQT() const { return (bf16_t*)(wsp() + WS_WBQT); }
    DI bf16_t* WBOT() const { return (bf16_t*)(wsp() + WS_WBOT); }
    DI bf16_t* WKVT() const { return (bf16_t*)(wsp() + WS_WKVT); }
    DI bf16_t* KC() const { return (bf16_t*)(wsp() + WS_KC); }
    DI bf16_t* VCT() const { return (bf16_t*)(wsp() + WS_VCT); }
    DI bf16_t* VT() const { return (bf16_t*)(wsp() + WS_VT); }
    DI bf16_t* WGUT() const { return (bf16_t*)(wsp() + WS_WGUT); }
    DI bf16_t* WDNT() const { return (bf16_t*)(wsp() + WS_WDNT); }
    DI bf16_t* HN() const { return (bf16_t*)(wsp() + WS_HN); }
    DI bf16_t* HN2() const { return (bf16_t*)(wsp() + WS_HN2); }
    DI bf16_t* Q() const { return (bf16_t*)(wsp() + WS_Q); }
    DI bf16_t* KV() const { return (bf16_t*)(wsp() + WS_KV); }
    DI bf16_t* O() const { return (bf16_t*)(wsp() + WS_O); }
    DI bf16_t* ACT() const { return (bf16_t*)(wsp() + WS_ACT); }
    DI bf16_t* OUTB() const { return (bf16_t*)(wsp() + WS_OUTB); }
    DI unsigned* TOKSLOT() const { return (unsigned*)(wsp() + WS_TOKSLOT); }
    DI unsigned* LIST() const { return (unsigned*)(wsp() + WS_LIST); }
};
DI int vcu_of(int bx) { return (bx & 7) * (GRID / 8) + (bx >> 3); }
DI int fresh_lane() { int l; asm volatile("v_mbcnt_lo_u32_b32 %0, -1, 0\n\tv_mbcnt_hi_u32_b32 %0, -1, %0" : "=&v"(l)); return l; }
DI Frame make_frame(LAS unsigned char* lds, int wave_sgpr) {
    Frame F; F.lds = lds;
    KPtr kp = (KPtr)__builtin_amdgcn_kernarg_segment_ptr(); asm volatile("" : "+s"(kp)); F.kp = kp;
    int wv = wave_sgpr; asm volatile("" : "+s"(wv)); F.wave = wv; F.lane = fresh_lane(); F.tid = wv * 64 + F.lane;
    int bx = (int)blockIdx.x; asm volatile("" : "+s"(bx)); F.bx = bx; F.vcu = vcu_of(bx);
    return F;
}
DI void transpose_item(const float* W, int ld, int K, bf16_t* WT, int drow0, int k0, int n0, LAS float* scr, int lane) {
    f32x4 v[16];
    const float* src = W + (size_t)(k0 + (lane >> 4)) * ld + n0 + 4 * (lane & 15);
#pragma unroll
    for (int i = 0; i < 16; ++i) v[i] = __builtin_nontemporal_load((const f32x4*)(src + (size_t)(4 * i) * ld));
    LAS float* wp = scr + (lane >> 4) * 65 + 4 * (lane & 15);
#pragma unroll
    for (int i = 0; i < 16; ++i) { LAS float* q = wp + (4 * i) * 65; q[0] = v[i].x; q[1] = v[i].y; q[2] = v[i].z; q[3] = v[i].w; }
    LDS_WAIT(); asm volatile("" ::: "memory");
    const int c = lane & 7;
#pragma unroll
    for (int j = 0; j < 8; ++j) { const int n = (lane >> 3) + 8 * j; const LAS float* s = scr + (8 * c) * 65 + n;
        u32x4 o; o.x = pk2(s[0 * 65], s[1 * 65]); o.y = pk2(s[2 * 65], s[3 * 65]); o.z = pk2(s[4 * 65], s[5 * 65]); o.w = pk2(s[6 * 65], s[7 * 65]);
        __builtin_nontemporal_store(o, (u32x4*)(WT + (size_t)(drow0 + n) * K + k0 + 8 * c)); }
    LDS_WAIT(); asm volatile("" ::: "memory");
}

DI void p0_prologue(Frame& F) {
    const int gw = F.bx * NWAVES + F.wave, NGW = GRID * NWAVES, lane = F.lane;
    const int gtid = F.bx * NTHR + F.tid, NGT = GRID * NTHR;
    LAS float* cact = (LAS float*)(F.lds + 73728);
    const bool modblk = (F.bx >= 32 && F.bx < 60);
    if (modblk) {
        for (int idx = F.tid; idx < NB * D; idx += NTHR) { const int b = idx / D, k = idx % D; const float v = F.c()[idx]; cact[k * 16 + b] = v / (1.f + __expf(-v)); }
    }
    __syncthreads();
    if (gw >= 256 && gw < 480) {
        const int it = gw - 256; const float* W; const float* bias; float* outp; int ld;
        int chunk;
        if (it < 192) { const int set = it / 48; chunk = it % 48; W = F.mod_w() + (size_t)set * D * 3072; ld = 3072; bias = F.mod_b() + set * 3072; outp = F.MODV() + (size_t)set * 16 * 3072; }
        else { chunk = it - 192; W = F.kv_mod_w(); ld = 2048; bias = F.kv_mod_b(); outp = F.MODV() + (size_t)4 * 16 * 3072; }
        const int col = chunk * 64 + lane;
        float acc[16];
#pragma unroll
        for (int b = 0; b < 16; ++b) acc[b] = 0.f;
#pragma unroll 4
        for (int k = 0; k < D; ++k) {
            const float w = W[(size_t)k * ld + col];
            const LAS f32x4* cp = (const LAS f32x4*)(cact + k * 16);
            const f32x4 c0 = cp[0], c1 = cp[1], c2 = cp[2], c3 = cp[3];
            acc[0] += c0.x * w; acc[1] += c0.y * w; acc[2] += c0.z * w; acc[3] += c0.w * w;
            acc[4] += c1.x * w; acc[5] += c1.y * w; acc[6] += c1.z * w; acc[7] += c1.w * w;
            acc[8] += c2.x * w; acc[9] += c2.y * w; acc[10] += c2.z * w; acc[11] += c2.w * w;
            acc[12] += c3.x * w; acc[13] += c3.y * w; acc[14] += c3.z * w; acc[15] += c3.w * w;
        }
        const float bv = bias[col];
#pragma unroll
        for (int b = 0; b < 16; ++b) outp[(size_t)b * ld + col] = acc[b] + bv;
    }
    if (gw < 256) {
        const int kv = gw / 128, e = gw % 128; float s = 0.f;
        for (int j = 0; j < 32; ++j) { const int k = lane + 64 * j; s += F.cmp_pe()[kv * 2048 + k] * F.cmp_w1()[((size_t)kv * 2048 + k) * 128 + e]; }
        s = wave_sum(s);
        if (lane == 0) F.CMPB()[gw] = s;
    }
    for (int idx = gtid; idx < T * 8; idx += NGT) {
        const int tok = idx >> 3, i = idx & 7;
        const float inv = (float)pow(500000.0, -(double)(2 * i) / 16.0);
        const float ang = (float)F.positions()[tok] * inv;
        double a = (double)ang; const double twopi = 6.283185307179586476925286766559;
        a -= twopi * rint(a / twopi);
        const float ar = (float)a;
        F.ROPE()[(size_t)tok * 16 + i] = cosf(ar); F.ROPE()[(size_t)tok * 16 + 8 + i] = sinf(ar);
    }
    for (int idx = gtid; idx < 256 * D; idx += NGT) {
        const int row = idx / D, k = idx % D;
        const float v = row < 48 ? F.a_w_in()[(size_t)k * A_PROJ + 2560 + row] : 0.f;
        F.WINT()[(size_t)(2048 + row) * D + k] = (bf16_t)(pk2(v, 0.f) & 0xffffu);
    }
#ifdef PROBE_COPY
    {
        const f32x4* src = (const f32x4*)F.w_gate_up(); u32x4* dst = (u32x4*)F.ACT();
        const size_t n8 = (size_t)2 * 32 * D * 2048 / 8 + (size_t)2 * 32 * D * D / 8;
        const size_t n8a = (size_t)2 * 32 * D * 2048 / 8;
        const f32x4* src2 = (const f32x4*)F.w_down();
        for (size_t i = (size_t)gtid; i < n8; i += (size_t)NGT * 4) {
#pragma unroll
            for (int u = 0; u < 4; ++u) { const size_t k = i + (size_t)u * NGT; if (k < n8) {
                const f32x4* s = k < n8a ? src + 2 * k : src2 + 2 * (k - n8a);
                const f32x4 a = __builtin_nontemporal_load(s), b = __builtin_nontemporal_load(s + 1);
                u32x4 o; o.x = pk2(a.x, a.y); o.y = pk2(a.z, a.w); o.z = pk2(b.x, b.y); o.w = pk2(b.z, b.w);
                __builtin_nontemporal_store(o, dst + k); } }
        }
    }
#endif
    __syncthreads();
    LAS float* scr = (LAS float*)(F.lds + F.wave * 16640);
    constexpr int J0 = 32768, J1 = 16384, J2 = 640, J3 = 256, J6 = 64, J7 = 128, J8 = 4;
    constexpr int NITEMS = J0 + J1 + J2 + 3 * J3 + J6 + J7 + J8;
    for (int it = gw; it < NITEMS; it += NGW) {
        int r = it;
        if (r < J0) { const int mat = r >> 9, q = r & 511, kb = q >> 5, nb = q & 31;
            transpose_item(F.w_gate_up() + (size_t)mat * D * 2048, 2048, D, F.WGUT() + (size_t)mat * 2048 * D, 64 * nb, 64 * kb, 64 * nb, scr, lane); continue; }
        r -= J0;
        if (r < J1) { const int mat = r >> 8, q = r & 255, kb = q >> 4, nb = q & 15;
            transpose_item(F.w_down() + (size_t)mat * D * D, D, D, F.WDNT() + (size_t)mat * D * D, 64 * nb, 64 * kb, 64 * nb, scr, lane); continue; }
        r -= J1;
        if (r < J2) { const int kb = r / 40, nb = r % 40, n0 = 64 * nb;
            const int dr = n0 < 1792 ? n0 : (n0 < 2048 ? 2304 + (n0 - 1792) : (n0 < 2304 ? 1792 + (n0 - 2048) : 2560 + (n0 - 2304)));
            transpose_item(F.a_w_in(), A_PROJ, D, F.WINT(), dr, 64 * kb, n0, scr, lane); continue; }
        r -= J2;
        if (r < J3) { const int kb = r >> 4, nb = r & 15; transpose_item(F.a_w_out(), D, D, F.WAOT(), 64 * nb, 64 * kb, 64 * nb, scr, lane); continue; }
        r -= J3;
        if (r < J3) { const int kb = r >> 4, nb = r & 15; transpose_item(F.b_w_q(), D, D, F.WBQT(), 64 * nb, 64 * kb, 64 * nb, scr, lane); continue; }
        r -= J3;
        if (r < J3) { const int kb = r >> 4, nb = r & 15; transpose_item(F.b_w_out(), D, D, F.WBOT(), 64 * nb, 64 * kb, 64 * nb, scr, lane); continue; }
        r -= J3;
        if (r < J6) { const int kb = r >> 2, nb = r & 3; transpose_item(F.kv_w(), 256, D, F.WKVT(), 64 * nb, 64 * kb, 64 * nb, scr, lane); continue; }
        r -= J6;
        if (r < J7) { const int kv = r >> 6, q = r & 63, kb = q >> 1, nb = q & 1;
            transpose_item(F.cmp_w1() + (size_t)kv * 2048 * 128, 128, 2048, F.CW1T() + (size_t)kv * 128 * 2048, 64 * nb, 64 * kb, 64 * nb, scr, lane); continue; }
        r -= J7;
        { const int kv = r >> 1, kb = r & 1;
            transpose_item(F.cmp_w2() + (size_t)kv * 128 * 64, 64, 128, F.CW2T() + (size_t)kv * 64 * 128, 0, 64 * kb, 0, scr, lane); }
    }
}

DI void load_mod(const float* g, const float* scale, const float* shift, int lane, f32x4 (&A)[4], f32x4 (&Bv)[4]) {
#pragma unroll
    for (int j = 0; j < 4; ++j) { const int c = 4 * lane + 256 * j;
        const f32x4 gg = *(const f32x4*)(g + c), sc = *(const f32x4*)(scale + c), sh = *(const f32x4*)(shift + c);
        A[j] = gg * (sc + 1.f); Bv[j] = sh; }
}
DI float row_ss(const f32x4 (&v)[4]) {
    float s = 0.f;
#pragma unroll
    for (int j = 0; j < 4; ++j) s += (v[j].x * v[j].x + v[j].y * v[j].y) + (v[j].z * v[j].z + v[j].w * v[j].w);
    return wave_sum(s);
}
DI void store_bf16_row(bf16_t* dst, int lane, const f32x4 (&y)[4]) {
#pragma unroll
    for (int j = 0; j < 4; ++j) { u32x2 o; o.x = pk2(y[j].x, y[j].y); o.y = pk2(y[j].z, y[j].w); *(u32x2*)(dst + 4 * lane + 256 * j) = o; }
}

DI void norm_plain_phase(Frame& F) {
    const int gw = F.bx * NWAVES + F.wave, lane = F.lane, b = gw >> 7;
    const float* mv = F.MODV() + ((size_t)0 * 16 + b) * 3072;
    f32x4 A[4], Bv[4]; load_mod(F.norm_g(), mv + 1024, mv, lane, A, Bv);
    for (int rr = 0; rr < 16; ++rr) {
        const size_t row = (size_t)gw * 16 + rr;
        f32x4 v[4];
#pragma unroll
        for (int j = 0; j < 4; ++j) v[j] = *(const f32x4*)(F.x() + row * D + 4 * lane + 256 * j);
        const float rstd = 1.0f / sqrtf(row_ss(v) * (1.f / D) + NORM_EPS);
        f32x4 y[4];
#pragma unroll
        for (int j = 0; j < 4; ++j) y[j] = v[j] * rstd * A[j] + Bv[j];
        store_bf16_row(F.HN() + row * D, lane, y);
    }
}

constexpr int RT_IMG = 0, RT_LGS = 147456, RT_PE = 149504, RT_PW = 151552, RT_LCNT = 153600, RT_LBASE = 153728;

DI void norm_router_phase(Frame& F, int layer) {
    const int gw = F.bx * NWAVES + F.wave, lane = F.lane, tid = F.tid, b = gw >> 7;
    LAS float* img = (LAS float*)(F.lds + RT_IMG);
    LAS float* lgs = (LAS float*)(F.lds + RT_LGS) + F.wave * 64;
    LAS unsigned* pend_e = (LAS unsigned*)(F.lds + RT_PE);
    LAS float* pend_w = (LAS float*)(F.lds + RT_PW);
    LAS unsigned* lcnt = (LAS unsigned*)(F.lds + RT_LCNT);
    LAS unsigned* lbase = (LAS unsigned*)(F.lds + RT_LBASE);
    const float* rw = F.router_w() + (size_t)layer * D * NEXP;
    for (int idx = tid; idx < D * NEXP; idx += NTHR) { const int col = idx >> 5, e = idx & 31;
        const int rho = (col & 3) * 64 + ((col >> 2) & 63) + 256 * (col >> 8); img[rho * 36 + e] = rw[idx]; }
    if (tid < 32) lcnt[tid] = 0u;
    __syncthreads();
    const int set = layer * 2 + 1;
    const float* mv = F.MODV() + ((size_t)set * 16 + b) * 3072;
    f32x4 A[4], Bv[4]; load_mod(F.norm_g() + (layer * 2 + 1) * D, mv + 1024, mv, lane, A, Bv);
    const float* rb = F.router_b() + layer * NEXP;
    for (int rp = 0; rp < 8; ++rp) {
        const size_t row0 = (size_t)gw * 16 + rp * 2;
        f32x4 y0[4], y1[4];
        {
            f32x4 v0[4], v1[4];
#pragma unroll
            for (int j = 0; j < 4; ++j) { v0[j] = *(const f32x4*)(F.H() + row0 * D + 4 * lane + 256 * j); v1[j] = *(const f32x4*)(F.H() + (row0 + 1) * D + 4 * lane + 256 * j); }
            const float r0 = 1.0f / sqrtf(row_ss(v0) * (1.f / D) + NORM_EPS), r1 = 1.0f / sqrtf(row_ss(v1) * (1.f / D) + NORM_EPS);
#pragma unroll
            for (int j = 0; j < 4; ++j) { y0[j] = v0[j] * r0 * A[j] + Bv[j]; y1[j] = v1[j] * r1 * A[j] + Bv[j]; }
        }
        store_bf16_row(F.HN() + row0 * D, lane, y0); store_bf16_row(F.HN() + (row0 + 1) * D, lane, y1);
        float l0[32], l1[32];
#pragma unroll
        for (int e = 0; e < 32; ++e) { l0[e] = 0.f; l1[e] = 0.f; }
#pragma unroll
        for (int j = 0; j < 4; ++j)
#pragma unroll
            for (int i = 0; i < 4; ++i) {
                const float a0 = y0[j][i], a1 = y1[j][i];
                const LAS f32x4* wp = (const LAS f32x4*)(img + (i * 64 + lane + 256 * j) * 36);
#pragma unroll
                for (int e4 = 0; e4 < 8; ++e4) { const f32x4 w = wp[e4];
                    l0[4 * e4 + 0] += a0 * w.x; l0[4 * e4 + 1] += a0 * w.y; l0[4 * e4 + 2] += a0 * w.z; l0[4 * e4 + 3] += a0 * w.w;
                    l1[4 * e4 + 0] += a1 * w.x; l1[4 * e4 + 1] += a1 * w.y; l1[4 * e4 + 2] += a1 * w.z; l1[4 * e4 + 3] += a1 * w.w; }
            }
#define RS_STEP(N, OFF) { const bool up = (lane & (OFF)) != 0; _Pragma("unroll") for (int k = 0; k < (N); ++k) { \
            const float s0 = up ? l0[k] : l0[k + (N)], k0 = up ? l0[k + (N)] : l0[k]; l0[k] = k0 + __shfl_xor(s0, (OFF)); \
            const float s1 = up ? l1[k] : l1[k + (N)], k1 = up ? l1[k + (N)] : l1[k]; l1[k] = k1 + __shfl_xor(s1, (OFF)); } }
        RS_STEP(16, 32) RS_STEP(8, 16) RS_STEP(4, 8) RS_STEP(2, 4) RS_STEP(1, 2)
#undef RS_STEP
        float g0 = l0[0] + __shfl_xor(l0[0], 1), g1 = l1[0] + __shfl_xor(l1[0], 1);
        const int e_own = lane >> 1; const float rbv = rb[e_own];
        if ((lane & 1) == 0) { lgs[e_own] = g0 + rbv; lgs[32 + e_own] = g1 + rbv; }
        LDS_WAIT(); asm volatile("" ::: "memory");
        if (lane < 2) {
            float v[32];
#pragma unroll
            for (int e = 0; e < 32; ++e) v[e] = lgs[lane * 32 + e];
            float tv[4]; int ti[4];
#pragma unroll
            for (int k = 0; k < 4; ++k) {
                float best = -INFINITY; int bi = 0;
#pragma unroll
                for (int e = 0; e < 32; ++e) { const bool gt = v[e] > best; best = gt ? v[e] : best; bi = gt ? e : bi; }
                tv[k] = best; ti[k] = bi;
#pragma unroll
                for (int e = 0; e < 32; ++e) v[e] = (e == bi) ? -INFINITY : v[e];
            }
            const float e1 = __expf(tv[1] - tv[0]), e2 = __expf(tv[2] - tv[0]), e3 = __expf(tv[3] - tv[0]);
            const float inv = 1.f / (1.f + e1 + e2 + e3);
            const float w[4] = {inv, e1 * inv, e2 * inv, e3 * inv};
            const int tl = F.wave * 16 + rp * 2 + lane;
#pragma unroll
            for (int k = 0; k < 4; ++k) {
                const unsigned pl = __hip_atomic_fetch_add(lcnt + ti[k], 1u, __ATOMIC_RELAXED, __HIP_MEMORY_SCOPE_WORKGROUP);
                pend_e[tl * 4 + k] = ((unsigned)ti[k] << 16) | pl; pend_w[tl * 4 + k] = w[k];
            }
        }
        LDS_WAIT(); asm volatile("" ::: "memory");
    }
    __syncthreads();
    unsigned* gcnt = F.ctl() + CW_CNT + 64 * layer;
    if (tid < 32) lbase[tid] = __hip_atomic_fetch_add(gcnt + tid, lcnt[tid], __ATOMIC_RELAXED, __HIP_MEMORY_SCOPE_AGENT);
    __syncthreads();
    {
        const int tl = tid >> 2, k = tid & 3; const unsigned pe = pend_e[tid]; const unsigned e = pe >> 16, pos = lbase[e] + (pe & 0xffffu);
        const unsigned token = (unsigned)(F.bx * 128 + tl);
        F.LIST()[(size_t)e * T + pos] = token; F.LISTW()[(size_t)e * T + pos] = pend_w[tid]; F.TOKSLOT()[(size_t)token * 4 + k] = (e << 16) | pos;
    }
    __syncthreads();
}

DI void load_expert_tables(Frame& F, int layer, int npn) {
    LAS unsigned* ext = (LAS unsigned*)(F.lds + EXT_OFF);
    if (F.tid < 32) ext[F.tid] = __hip_atomic_load(F.ctl() + CW_CNT + 64 * layer + F.tid, __ATOMIC_RELAXED, __HIP_MEMORY_SCOPE_AGENT);
    __syncthreads();
    if (F.tid == 0) { unsigned o = 0, u = 0; for (int e = 0; e < 32; ++e) { const unsigned c = ext[e]; ext[32 + e] = o; ext[64 + e] = u; o += c; u += ((c + 255u) >> 8) * (unsigned)npn; } ext[96] = u; }
    __syncthreads();
}

template <bool FINAL> DI void combine_phase(Frame& F, int layer) {
    load_expert_tables(F, layer, 1);
    const LAS unsigned* offs = (const LAS unsigned*)(F.lds + EXT_OFF) + 32;
    const int gw = F.bx * NWAVES + F.wave, lane = F.lane, b = gw >> 7;
    const float* gate = F.MODV() + ((size_t)(layer * 2 + 1) * 16 + b) * 3072 + 2048;
    f32x4 G[4];
#pragma unroll
    for (int j = 0; j < 4; ++j) G[j] = *(const f32x4*)(gate + 4 * lane + 256 * j);
    f32x4 A1[4], B1[4], A2[4], B2[4];
    if (FINAL) {
#pragma unroll
        for (int j = 0; j < 4; ++j) A1[j] = *(const f32x4*)(F.final_g() + 4 * lane + 256 * j);
    } else {
        const float* m2 = F.MODV() + ((size_t)2 * 16 + b) * 3072; load_mod(F.norm_g() + 2 * D, m2 + 1024, m2, lane, A1, B1);
        const float* m4 = F.MODV() + (size_t)4 * 16 * 3072 + (size_t)b * 2048; load_mod(F.kv_norm_g(), m4 + 1024, m4, lane, A2, B2);
    }
    for (int rr = 0; rr < 16; ++rr) {
        const size_t row = (size_t)gw * 16 + rr;
        const u32x4 ts = *(const u32x4*)(F.TOKSLOT() + row * 4);
        const unsigned sl[4] = {offs[ts.x >> 16] + (ts.x & 0xffffu), offs[ts.y >> 16] + (ts.y & 0xffffu), offs[ts.z >> 16] + (ts.z & 0xffffu), offs[ts.w >> 16] + (ts.w & 0xffffu)};
        f32x4 y[4];
#pragma unroll
        for (int j = 0; j < 4; ++j) y[j] = (f32x4){0.f, 0.f, 0.f, 0.f};
#pragma unroll
        for (int k = 0; k < 4; ++k)
#pragma unroll
            for (int j = 0; j < 4; ++j) { const u32x2 o = *(const u32x2*)(F.OUTB() + (size_t)sl[k] * D + 4 * lane + 256 * j);
                y[j].x += bf_lo(o.x); y[j].y += bf_hi(o.x); y[j].z += bf_lo(o.y); y[j].w += bf_hi(o.y); }
        f32x4 h[4];
#pragma unroll
        for (int j = 0; j < 4; ++j) h[j] = *(const f32x4*)(F.H() + row * D + 4 * lane + 256 * j) + G[j] * y[j];
        const float rstd = 1.0f / sqrtf(row_ss(h) * (1.f / D) + NORM_EPS);
        if (FINAL) {
#pragma unroll
            for (int j = 0; j < 4; ++j) *(f32x4*)(F.out() + row * D + 4 * lane + 256 * j) = h[j] * rstd * A1[j];
        } else {
#pragma unroll
            for (int j = 0; j < 4; ++j) *(f32x4*)(F.H() + row * D + 4 * lane + 256 * j) = h[j];
            f32x4 ya[4], yb[4];
#pragma unroll
            for (int j = 0; j < 4; ++j) { const f32x4 n = h[j] * rstd; ya[j] = n * A1[j] + B1[j]; yb[j] = n * A2[j] + B2[j]; }
            store_bf16_row(F.HN() + row * D, lane, ya); store_bf16_row(F.HN2() + row * D, lane, yb);
        }
    }
}
namespace pg8 {
constexpr int BM = 256, BK = 64, HALF = 128, HTB = HALF * BK * 2, STAGE_BYTES = 8 * HTB, KD = 1024;
DI int lds_byte(int r, int c) { const int st = (r >> 4) * 2 + (c >> 5), rr = r & 15, cc = c & 31, ob = rr * 64 + cc * 2; return st * 1024 + (ob ^ (((ob >> 9) & 1) << 5)); }
DI void stage_rc(int b, int& R, int& C) { const int st = b / 1024, sb = b % 1024, swz = sb ^ (((sb >> 9) & 1) << 5); R = (st >> 1) * 16 + swz / 64; C = (st & 1) * 32 + (swz % 64) / 2; }
DI int perm32(int rho) { const int n = rho >> 4, i = rho & 15; return 8 * (i >> 2) + 4 * n + (i & 3); }

struct Unit {
    const char* A;
    const char* B0;
    unsigned bh;
    int type, r0, c0, nvalid, aux;
};

template <class Pol>
DI void gemm_phase(LAS unsigned char* lds, const Pol& P, int wave_id, int lane_id) {
    const int wid = wave_id, lane = lane_id, tid = wid * 64 + lane, wr = wid >> 2, wc = wid & 3, fr = lane & 15, fq = lane >> 4;
    constexpr int K = KD, nt = K / BK;
    unsigned voffB[2];
#pragma unroll
    for (int i = 0; i < 2; ++i) { int R, C; stage_rc(tid * 16 + i * 8192, R, C); const int Rb = Pol::PERM ? ((R & ~31) + perm32(R & 31)) : R; voffB[i] = (unsigned)(Rb * K + C) * 2u; }
    const size_t kstep = (size_t)(BK * 2);
    const unsigned ldsw = (unsigned)wid * 1024u;
    const int aoff = lds_byte(wr * 64 + fr, fq * 8), boff = lds_byte(wc * 32 + fr, fq * 8);
#define PG8_SA(b, h) (((b) * 2 + (h)) * HTB)
#define PG8_SB(b, h) ((4 + (b) * 2 + (h)) * HTB)
#define PG8_STAGE_A(bufoff, gbase, va, h) do { _Pragma("unroll") for (int _i = 0; _i < 2; ++_i) \
        __builtin_amdgcn_global_load_lds((const unsigned*)((const char*)(gbase) + (va)[h][_i]), (LAS unsigned*)(lds + (bufoff) + ldsw + _i * 8192), 16, 0, 0); } while (0)
#define PG8_STAGE_B(bufoff, gbase) do { _Pragma("unroll") for (int _i = 0; _i < 2; ++_i) \
        __builtin_amdgcn_global_load_lds((const unsigned*)((const char*)(gbase) + voffB[_i]), (LAS unsigned*)(lds + (bufoff) + ldsw + _i * 8192), 16, 0, 0); } while (0)
#define PG8_LDA(dst, b, h) do { _Pragma("unroll") for (int m = 0; m < 4; ++m) _Pragma("unroll") for (int k = 0; k < 2; ++k) dst[m][k] = *(const LAS bf16x8*)(lds + PG8_SA(b, h) + aoff + m * 2048 + k * 1024); } while (0)
#define PG8_LDB(dst, b, h) do { _Pragma("unroll") for (int n = 0; n < 2; ++n) _Pragma("unroll") for (int k = 0; k < 2; ++k) dst[n][k] = *(const LAS bf16x8*)(lds + PG8_SB(b, h) + boff + n * 2048 + k * 1024); } while (0)
#define PG8_MMA(ai, bj, At, Bt) do { __builtin_amdgcn_s_setprio(1); _Pragma("unroll") for (int m = 0; m < 4; ++m) _Pragma("unroll") for (int n = 0; n < 2; ++n) _Pragma("unroll") for (int k = 0; k < 2; ++k) \
        acc[ai][bj][m][n] = __builtin_amdgcn_mfma_f32_16x16x32_bf16(Bt[n][k], At[m][k], acc[ai][bj][m][n], 0, 0, 0); __builtin_amdgcn_s_setprio(0); } while (0)
#define PG8_WAIT_V(n) asm volatile("s_waitcnt vmcnt(" #n ")" ::: "memory")
#define PG8_WAIT_L(n) asm volatile("s_waitcnt lgkmcnt(" #n ")" ::: "memory")
#define PG8_BAR __builtin_amdgcn_s_barrier()
#define PG8_SCHED __builtin_amdgcn_sched_barrier(0)
    Unit cur, nxt; int ui = 0;
    if (!P.next(0, cur)) return;
    unsigned vaC[2][2], vaN[2][2];
    P.aoff(cur, wid * 64, tid, vaC);
    bool has_next = P.next(1, nxt);
    if (has_next) P.aoff(nxt, wid * 64, tid, vaN);
    else { vaN[0][0] = vaC[0][0]; vaN[0][1] = vaC[0][1]; vaN[1][0] = vaC[1][0]; vaN[1][1] = vaC[1][1]; }
    if (Pol::GATHER) asm volatile("" : "+v"(vaC[0][0]), "+v"(vaC[0][1]), "+v"(vaC[1][0]), "+v"(vaC[1][1]), "+v"(vaN[0][0]), "+v"(vaN[0][1]), "+v"(vaN[1][0]), "+v"(vaN[1][1]));
    f32x4 acc[2][2][4][2];
    { const int l2 = fresh_lane(); P.init(acc, cur, wr, wc, l2 & 15, l2 >> 4); }
    bf16x8 At[4][2], B0[2][2], B1[2][2];
    const char* cA = cur.A; const char* cB = cur.B0; unsigned cbh = cur.bh;
    PG8_STAGE_B(PG8_SB(0, 0), cB); PG8_STAGE_A(PG8_SA(0, 0), cA, vaC, 0); PG8_STAGE_B(PG8_SB(0, 1), cB + cbh); PG8_STAGE_A(PG8_SA(0, 1), cA, vaC, 1);
    if (wr == 1) PG8_BAR;
    PG8_WAIT_V(4); PG8_BAR;
    PG8_STAGE_B(PG8_SB(1, 0), cB + kstep); PG8_STAGE_A(PG8_SA(1, 0), cA + kstep, vaC, 0); PG8_STAGE_B(PG8_SB(1, 1), cB + cbh + kstep);
    PG8_WAIT_V(6); PG8_BAR;
    for (;;) {
        const char* nA = has_next ? nxt.A : cA; const char* nB = has_next ? nxt.B0 : cB; const unsigned nbh = has_next ? nxt.bh : cbh;
        for (int t = 0; t < nt; t += 2) {
            const bool last = (t == nt - 2);
            const char* a1 = cA + (size_t)(t + 1) * kstep;
            const char* a2 = last ? nA : cA + (size_t)(t + 2) * kstep; const char* b2 = last ? nB : cB + (size_t)(t + 2) * kstep;
            const char* a3 = a2 + kstep; const char* b3 = b2 + kstep;
            const unsigned bh2 = last ? nbh : cbh;
            unsigned va2[2][2];
            if (Pol::GATHER) { va2[0][0] = last ? vaN[0][0] : vaC[0][0]; va2[0][1] = last ? vaN[0][1] : vaC[0][1]; va2[1][0] = last ? vaN[1][0] : vaC[1][0]; va2[1][1] = last ? vaN[1][1] : vaC[1][1]; }
            else { va2[0][0] = vaC[0][0]; va2[0][1] = vaC[0][1]; va2[1][0] = vaC[1][0]; va2[1][1] = vaC[1][1]; }
            PG8_LDB(B0, 0, 0); PG8_SCHED; PG8_LDA(At, 0, 0); PG8_STAGE_A(PG8_SA(1, 1), a1, vaC, 1);
            PG8_WAIT_L(8); PG8_BAR; PG8_WAIT_L(0); PG8_MMA(0, 0, At, B0); PG8_BAR; PG8_SCHED;
            PG8_LDB(B1, 0, 1); PG8_STAGE_B(PG8_SB(0, 0), b2);
            PG8_BAR; PG8_WAIT_L(0); PG8_MMA(0, 1, At, B1); PG8_BAR;
            PG8_LDA(At, 0, 1); PG8_STAGE_A(PG8_SA(0, 0), a2, va2, 0);
            PG8_BAR; PG8_WAIT_L(0); PG8_MMA(1, 0, At, B0); PG8_BAR; PG8_SCHED;
            PG8_STAGE_B(PG8_SB(0, 1), b2 + bh2);
            PG8_WAIT_V(6); PG8_BAR; PG8_MMA(1, 1, At, B1); PG8_BAR;
            PG8_LDB(B0, 1, 0); PG8_SCHED; PG8_LDA(At, 1, 0); PG8_STAGE_A(PG8_SA(0, 1), a2, va2, 1);
            PG8_WAIT_L(8); PG8_BAR; PG8_WAIT_L(0); PG8_MMA(0, 0, At, B0); PG8_BAR; PG8_SCHED;
            PG8_LDB(B1, 1, 1); PG8_STAGE_B(PG8_SB(1, 0), b3);
            PG8_BAR; PG8_WAIT_L(0); PG8_MMA(0, 1, At, B1); PG8_BAR;
            PG8_LDA(At, 1, 1); PG8_STAGE_A(PG8_SA(1, 0), a3, va2, 0);
            PG8_BAR; PG8_WAIT_L(0); PG8_MMA(1, 0, At, B0); PG8_BAR; PG8_SCHED;
            PG8_STAGE_B(PG8_SB(1, 1), b3 + bh2);
            PG8_WAIT_V(6); PG8_BAR; PG8_MMA(1, 1, At, B1); PG8_BAR;
        }
        { const int l2 = fresh_lane(); P.epi(acc, cur, wr, wc, l2 & 15, l2 >> 4); }
        if (!has_next) break;
        { const int l2 = fresh_lane(); P.init(acc, nxt, wr, wc, l2 & 15, l2 >> 4); }
        cur = nxt; cA = nA; cB = nB; cbh = nbh; ++ui;
        vaC[0][0] = vaN[0][0]; vaC[0][1] = vaN[0][1]; vaC[1][0] = vaN[1][0]; vaC[1][1] = vaN[1][1];
        has_next = P.next(ui + 1, nxt);
        if (has_next) { P.aoff(nxt, wid * 64, tid, vaN);
            if (Pol::GATHER) asm volatile("" : "+v"(vaN[0][0]), "+v"(vaN[0][1]), "+v"(vaN[1][0]), "+v"(vaN[1][1])); }
    }
    PG8_WAIT_V(0);
    if (wr == 0) PG8_BAR;
    PG8_BAR;
#undef PG8_SA
#undef PG8_SB
#undef PG8_STAGE_A
#undef PG8_STAGE_B
#undef PG8_LDA
#undef PG8_LDB
#undef PG8_MMA
#undef PG8_WAIT_V
#undef PG8_WAIT_L
#undef PG8_BAR
#undef PG8_SCHED
}
DI void aoff_std(int tid, unsigned (&va)[2][2]) {
#pragma unroll
    for (int i = 0; i < 2; ++i) { int R, C; stage_rc(tid * 16 + i * 8192, R, C);
#pragma unroll
        for (int h = 0; h < 2; ++h) va[h][i] = (unsigned)((h * HALF + R) * KD + C) * 2u; }
}
}

typedef f32x4 AccT[2][2][4][2];
DI void acc_zero(AccT& acc) {
#pragma unroll
    for (int a = 0; a < 2; ++a)
#pragma unroll
        for (int b = 0; b < 2; ++b)
#pragma unroll
            for (int m = 0; m < 4; ++m)
#pragma unroll
                for (int n = 0; n < 2; ++n) acc[a][b][m][n] = (f32x4){0.f, 0.f, 0.f, 0.f};
}
DI void acc_colbias(AccT& acc, const f32x4& b00, const f32x4& b01, const f32x4& b10, const f32x4& b11) {
#pragma unroll
    for (int a = 0; a < 2; ++a)
#pragma unroll
        for (int m = 0; m < 4; ++m) { acc[a][0][m][0] = b00; acc[a][0][m][1] = b01; acc[a][1][m][0] = b10; acc[a][1][m][1] = b11; }
}

DI void rope8(f32x4& v0, f32x4& v1, const float* rope_row, int fq) {
    const f32x4 c0 = *(const f32x4*)(rope_row), c1 = *(const f32x4*)(rope_row + 4), s0 = *(const f32x4*)(rope_row + 8), s1 = *(const f32x4*)(rope_row + 12);
    f32x4 p0, p1;
#pragma unroll
    for (int i = 0; i < 4; ++i) { p0[i] = __shfl_xor(v0[i], 16); p1[i] = __shfl_xor(v1[i], 16); }
    const float sg = (fq == 0) ? -1.f : 1.f;
    v0 = v0 * c0 + p0 * (s0 * sg); v1 = v1 * c1 + p1 * (s1 * sg);
}
DI void store8_bf16(bf16_t* p, const f32x4& v0, const f32x4& v1) {
    u32x4 w; w.x = pk2(v0[0], v0[1]); w.y = pk2(v0[2], v0[3]); w.z = pk2(v1[0], v1[1]); w.w = pk2(v1[2], v1[3]); *(u32x4*)p = w;
}
constexpr int ST_OFF = 131072, ST_STRIDE = 528;
DI void st_realign(int wr) { if (wr == 0) __builtin_amdgcn_s_barrier(); }
DI void st_restagger(int wr) { if (wr == 1) __builtin_amdgcn_s_barrier(); }
DI void st_put(LAS unsigned char* lds, int rowl, int colb, const f32x4& v0, const f32x4& v1) {
    u32x4 w; w.x = pk2(v0[0], v0[1]); w.y = pk2(v0[2], v0[3]); w.z = pk2(v1[0], v1[1]); w.w = pk2(v1[2], v1[3]);
    *(LAS u32x4*)(lds + ST_OFF + rowl * ST_STRIDE + colb) = w;
}
template <int ROWB> DI void st_flush(LAS unsigned char* lds, int tid, bf16_t* out_pass, size_t ld, int nvalid_rel) {
    asm volatile("s_waitcnt lgkmcnt(0)" ::: "memory"); __builtin_amdgcn_s_barrier(); asm volatile("" ::: "memory");
    if (ROWB == 512) {
#pragma unroll
        for (int k = 0; k < 2; ++k) { const int rowl = (tid >> 5) + 16 * k, c = tid & 31, rel = 64 * (rowl >> 4) + (rowl & 15);
            const u32x4 v = *(const LAS u32x4*)(lds + ST_OFF + rowl * ST_STRIDE + c * 16);
            if (rel < nvalid_rel) *(u32x4*)(out_pass + (size_t)rel * ld + c * 8) = v; }
    } else {
        const int rowl = tid >> 4, c = tid & 15, rel = 64 * (rowl >> 4) + (rowl & 15);
        const u32x4 v = *(const LAS u32x4*)(lds + ST_OFF + rowl * ST_STRIDE + c * 16);
        if (rel < nvalid_rel) *(u32x4*)(out_pass + (size_t)rel * ld + c * 8) = v;
    }
    asm volatile("s_waitcnt lgkmcnt(0)" ::: "memory"); __builtin_amdgcn_s_barrier(); asm volatile("" ::: "memory");
}

struct PolProj0 {
    static constexpr bool PERM = true, GATHER = false;
    const bf16_t *HN, *WINT; bf16_t *Q, *KV, *VT; float* GATES; const float* ROPE; int vcu; LAS unsigned char* lds;
    DI bool next(int i, pg8::Unit& u) const {
        const int L = i * GRID + vcu; if (L >= 1408) return false;
        if (L < 1152) { const int pm = L / 9, pn = L % 9; u.type = 0; u.A = (const char*)(HN + (size_t)pm * 256 * D); u.B0 = (const char*)(WINT + (size_t)pn * 256 * D); u.bh = 128 * D * 2; u.r0 = pm * 256; u.c0 = pn * 256; u.aux = pn; u.nvalid = 256; }
        else { const int l2 = L - 1152, pm = l2 >> 7, pn = l2 & 127; u.type = 1; u.A = (const char*)(WINT + (size_t)(2304 + pm * 256) * D); u.B0 = (const char*)(HN + (size_t)pn * 256 * D); u.bh = 128 * D * 2; u.r0 = pm * 256; u.c0 = pn * 256; u.aux = 0; u.nvalid = 256; }
        return true;
    }
    DI void aoff(const pg8::Unit&, int, int tid, unsigned (&va)[2][2]) const { pg8::aoff_std(tid, va); }
    DI void init(AccT& acc, const pg8::Unit&, int, int, int, int) const { acc_zero(acc); }
    DI void epi(const AccT& acc, const pg8::Unit& u, int wr, int wc, int fr, int fq) const {
        const int pn = u.aux;
        const int tid = (wr * 4 + wc) * 64 + fq * 16 + fr, rowl = wr * 16 + fr;
        if (u.type == 1) {
            st_realign(wr);
#pragma unroll
            for (int ai = 0; ai < 2; ++ai)
#pragma unroll
                for (int m = 0; m < 4; ++m) {
#pragma unroll
                    for (int bj = 0; bj < 2; ++bj) st_put(lds, rowl, (bj * 128 + wc * 32 + 8 * fq) * 2, acc[ai][bj][m][0], acc[ai][bj][m][1]);
                    st_flush<512>(lds, tid, VT + (size_t)(u.r0 + ai * 128 + m * 16) * T + u.c0, T, 256); }
            st_restagger(wr);
            return;
        }
        if (pn == 8) {
            if (wc < 2) {
#pragma unroll
                for (int ai = 0; ai < 2; ++ai)
#pragma unroll
                    for (int m = 0; m < 4; ++m) { const int row = u.r0 + ai * 128 + wr * 64 + m * 16 + fr; float* gp = GATES + (size_t)row * 64 + wc * 32 + 8 * fq;
                        f32x4 a = acc[ai][0][m][0], b = acc[ai][0][m][1];
#pragma unroll
                        for (int i = 0; i < 4; ++i) { a[i] = rcpf(1.f + ex2(-a[i] * LOG2E)); b[i] = rcpf(1.f + ex2(-b[i] * LOG2E)); }
                        *(f32x4*)gp = a; *(f32x4*)(gp + 4) = b; }
            }
            return;
        }
        const bool is_q = pn < 4, do_rope = (pn != 4 && pn != 5);
        bf16_t* dst = is_q ? Q + pn * 256 : KV + (pn - 4) * 256;
        const float sc = is_q ? QSCALE : 1.f;
        const bool rl = do_rope && ((wc & 1) == 0) && fq < 2;
        st_realign(wr);
#pragma unroll
        for (int ai = 0; ai < 2; ++ai)
#pragma unroll
            for (int m = 0; m < 4; ++m) { const int row = u.r0 + ai * 128 + wr * 64 + m * 16 + fr;
#pragma unroll
                for (int bj = 0; bj < 2; ++bj) { f32x4 v0 = acc[ai][bj][m][0], v1 = acc[ai][bj][m][1];
                    if (do_rope && (wc & 1) == 0) { f32x4 r0 = v0, r1 = v1; rope8(r0, r1, ROPE + (size_t)row * 16, fq); if (rl) { v0 = r0; v1 = r1; } }
                    v0 = v0 * sc; v1 = v1 * sc;
                    st_put(lds, rowl, (bj * 128 + wc * 32 + 8 * fq) * 2, v0, v1); }
                st_flush<512>(lds, tid, dst + (size_t)(u.r0 + ai * 128 + m * 16) * D, D, 256); }
        st_restagger(wr);
    }
};

struct PolOut {
    static constexpr bool PERM = false, GATHER = false;
    const bf16_t *O, *WT; const float *base, *gate_mv, *bias; float* H; int vcu;
    DI bool next(int i, pg8::Unit& u) const {
        const int L = i * GRID + vcu; if (L >= 512) return false;
        const int pm = L >> 2, pn = L & 3; u.type = 0; u.A = (const char*)(O + (size_t)pm * 256 * D); u.B0 = (const char*)(WT + (size_t)pn * 256 * D); u.bh = 128 * D * 2; u.r0 = pm * 256; u.c0 = pn * 256; u.aux = 0; u.nvalid = 256;
        return true;
    }
    DI void aoff(const pg8::Unit&, int, int tid, unsigned (&va)[2][2]) const { pg8::aoff_std(tid, va); }
    DI void init(AccT& acc, const pg8::Unit& u, int, int wc, int, int fq) const {
        if (!bias) { acc_zero(acc); return; }
        const float* bp = bias + u.c0 + wc * 32 + 4 * fq;
        acc_colbias(acc, *(const f32x4*)bp, *(const f32x4*)(bp + 16), *(const f32x4*)(bp + 128), *(const f32x4*)(bp + 144));
    }
    DI void epi(const AccT& acc, const pg8::Unit& u, int wr, int wc, int fr, int fq) const {
        const int b = u.r0 >> 11; const float* gv = gate_mv + (size_t)b * 3072 + 2048;
#pragma unroll
        for (int bj = 0; bj < 2; ++bj)
#pragma unroll
            for (int n = 0; n < 2; ++n) { const int col = u.c0 + bj * 128 + wc * 32 + n * 16 + 4 * fq;
                const f32x4 g = *(const f32x4*)(gv + col);
#pragma unroll
                for (int ai = 0; ai < 2; ++ai)
#pragma unroll
                    for (int m = 0; m < 4; ++m) { const size_t off = (size_t)(u.r0 + ai * 128 + wr * 64 + m * 16 + fr) * D + col;
                        *(f32x4*)(H + off) = *(const f32x4*)(base + off) + g * acc[ai][bj][m][n]; } }
    }
};

DI bool moe_unit(const LAS unsigned* ext, int L, int npn, int& e, int& mt, int& pn, int& nvalid, unsigned& slot0) {
    if ((unsigned)L >= ext[96]) return false;
    int ee = 0;
    for (int k = 1; k < 32; ++k) ee = ((unsigned)L >= ext[64 + k]) ? k : ee;
    const int local = L - (int)ext[64 + ee]; mt = local / npn; pn = local % npn; e = ee;
    const int cnt = (int)ext[ee]; nvalid = cnt - mt * 256; nvalid = nvalid > 256 ? 256 : nvalid; slot0 = ext[32 + ee] + (unsigned)mt * 256u;
    return true;
}
template <bool NOEPI = false> struct PolGateUpT {
    static constexpr bool PERM = true, GATHER = true;
    const bf16_t *HN, *WGUT; const float* bgu; const unsigned* LIST; bf16_t* ACT; const LAS unsigned* ext; int vcu; LAS unsigned char* lds;
    DI bool next(int i, pg8::Unit& u) const {
        int e, mt, pn, nv; unsigned s0;
        if (!moe_unit(ext, i * GRID + vcu, 8, e, mt, pn, nv, s0)) return false;
        u.type = mt; u.A = (const char*)HN; u.B0 = (const char*)(WGUT + ((size_t)e * 2048 + pn * 128) * D); u.bh = 1024u * D * 2u; u.r0 = (int)s0; u.c0 = pn * 128; u.nvalid = nv; u.aux = e;
        return true;
    }
    DI void aoff(const pg8::Unit& u, int wbase, int, unsigned (&va)[2][2]) const {
        const unsigned* lp = LIST + (size_t)u.aux * T + (size_t)u.type * 256;
        const int t = wbase | fresh_lane();
#pragma unroll
        for (int i = 0; i < 2; ++i) { int R, C; pg8::stage_rc(t * 16 + i * 8192, R, C);
#pragma unroll
            for (int h = 0; h < 2; ++h) { int r = h * 128 + R; r = r < u.nvalid ? r : u.nvalid - 1; const unsigned tok = lp[r]; va[h][i] = tok * (unsigned)(D * 2) + (unsigned)C * 2u; } }
    }
    DI void init(AccT& acc, const pg8::Unit& u, int, int wc, int, int fq) const {
        const float* bp = bgu + (size_t)u.aux * 2048 + u.c0 + wc * 32 + 8 * fq;
        acc_colbias(acc, *(const f32x4*)bp, *(const f32x4*)(bp + 4), *(const f32x4*)(bp + 1024), *(const f32x4*)(bp + 1028));
    }
    DI void epi(const AccT& acc, const pg8::Unit& u, int wr, int wc, int fr, int fq) const {
        if (NOEPI) {
#pragma unroll
            for (int ai = 0; ai < 2; ++ai)
#pragma unroll
                for (int bj = 0; bj < 2; ++bj) asm volatile("" :: "v"(acc[ai][bj][0][0]), "v"(acc[ai][bj][0][1]), "v"(acc[ai][bj][1][0]), "v"(acc[ai][bj][1][1]), "v"(acc[ai][bj][2][0]), "v"(acc[ai][bj][2][1]), "v"(acc[ai][bj][3][0]), "v"(acc[ai][bj][3][1]));
            return;
        }
        st_realign(wr);
#pragma unroll
        for (int ai = 0; ai < 2; ++ai)
#pragma unroll
            for (int m = 0; m < 4; ++m) {
                const f32x4 g0 = acc[ai][0][m][0], g1 = acc[ai][0][m][1], l0 = acc[ai][1][m][0], l1 = acc[ai][1][m][1]; f32x4 a0, a1;
#pragma unroll
                for (int i = 0; i < 4; ++i) {
                    const float x0 = fminf(g0[i], 7.f), x1 = fminf(g1[i], 7.f), y0 = fminf(fmaxf(l0[i], -7.f), 7.f), y1 = fminf(fmaxf(l1[i], -7.f), 7.f);
                    a0[i] = x0 * rcpf(1.f + ex2(-1.702f * LOG2E * x0)) * (y0 + 1.f); a1[i] = x1 * rcpf(1.f + ex2(-1.702f * LOG2E * x1)) * (y1 + 1.f); }
                st_put(lds, wr * 16 + fr, (wc * 32 + 8 * fq) * 2, a0, a1);
                st_flush<256>(lds, (wr * 4 + wc) * 64 + fq * 16 + fr, ACT + (size_t)(u.r0 + ai * 128 + m * 16) * D + u.c0, D, u.nvalid - (ai * 128 + m * 16)); }
        st_restagger(wr);
    }
};
typedef PolGateUpT<false> PolGateUp;
template <bool NOEPI = false> struct PolDownT {
    static constexpr bool PERM = true, GATHER = false;
    const bf16_t *ACT, *WDNT; const float *bdn, *LISTW; bf16_t* OUTB; const LAS unsigned* ext; int vcu; LAS unsigned char* lds;
    DI bool next(int i, pg8::Unit& u) const {
        int e, mt, pn, nv; unsigned s0;
        if (!moe_unit(ext, i * GRID + vcu, 4, e, mt, pn, nv, s0)) return false;
        u.type = mt; u.A = (const char*)(ACT + (size_t)s0 * D); u.B0 = (const char*)(WDNT + ((size_t)e * 1024 + pn * 256) * D); u.bh = 128 * D * 2; u.r0 = (int)s0; u.c0 = pn * 256; u.nvalid = nv; u.aux = e;
        return true;
    }
    DI void aoff(const pg8::Unit&, int, int tid, unsigned (&va)[2][2]) const { pg8::aoff_std(tid, va); }
    DI void init(AccT& acc, const pg8::Unit& u, int, int wc, int, int fq) const {
        const float* bp = bdn + (size_t)u.aux * 1024 + u.c0 + wc * 32 + 8 * fq;
        acc_colbias(acc, *(const f32x4*)bp, *(const f32x4*)(bp + 4), *(const f32x4*)(bp + 128), *(const f32x4*)(bp + 132));
    }
    DI void epi(const AccT& acc, const pg8::Unit& u, int wr, int wc, int fr, int fq) const {
        if (NOEPI) {
#pragma unroll
            for (int ai = 0; ai < 2; ++ai)
#pragma unroll
                for (int bj = 0; bj < 2; ++bj) asm volatile("" :: "v"(acc[ai][bj][0][0]), "v"(acc[ai][bj][0][1]), "v"(acc[ai][bj][1][0]), "v"(acc[ai][bj][1][1]), "v"(acc[ai][bj][2][0]), "v"(acc[ai][bj][2][1]), "v"(acc[ai][bj][3][0]), "v"(acc[ai][bj][3][1]));
            return;
        }
        const float* wp = LISTW + (size_t)u.aux * T + (size_t)u.type * 256;
        st_realign(wr);
#pragma unroll
        for (int ai = 0; ai < 2; ++ai)
#pragma unroll
            for (int m = 0; m < 4; ++m) { const int rl = ai * 128 + wr * 64 + m * 16 + fr;
                const float w = wp[rl < u.nvalid ? rl : u.nvalid - 1];
#pragma unroll
                for (int bj = 0; bj < 2; ++bj) st_put(lds, wr * 16 + fr, (bj * 128 + wc * 32 + 8 * fq) * 2, acc[ai][bj][m][0] * w, acc[ai][bj][m][1] * w);
                st_flush<512>(lds, (wr * 4 + wc) * 64 + fq * 16 + fr, OUTB + (size_t)(u.r0 + ai * 128 + m * 16) * D + u.c0, D, u.nvalid - (ai * 128 + m * 16)); }
        st_restagger(wr);
    }
};

typedef PolDownT<false> PolDown;
struct PolProj1 {
    static constexpr bool PERM = true, GATHER = false;
    const bf16_t *HN, *HN2, *WBQT, *WKVT; const float *bq, *kvb, *ROPE; bf16_t *Q, *K1, *VT1; int vcu; LAS unsigned char* lds;
    DI bool next(int i, pg8::Unit& u) const {
        const int L = i * GRID + vcu; if (L >= 768) return false;
        u.bh = 128 * D * 2; u.nvalid = 256; u.aux = 0;
        if (L < 512) { const int pm = L >> 2, pn = L & 3; u.type = 0; u.A = (const char*)(HN + (size_t)pm * 256 * D); u.B0 = (const char*)(WBQT + (size_t)pn * 256 * D); u.r0 = pm * 256; u.c0 = pn * 256; }
        else if (L < 640) { const int pm = L - 512; u.type = 1; u.A = (const char*)(HN2 + (size_t)pm * 256 * D); u.B0 = (const char*)WKVT; u.r0 = pm * 256; u.c0 = 0; }
        else { const int pn = L - 640; u.type = 2; u.A = (const char*)WKVT; u.B0 = (const char*)(HN2 + (size_t)pn * 256 * D); u.r0 = 0; u.c0 = pn * 256; }
        return true;
    }
    DI void aoff(const pg8::Unit&, int, int tid, unsigned (&va)[2][2]) const { pg8::aoff_std(tid, va); }
    DI void init(AccT& acc, const pg8::Unit& u, int wr, int wc, int fr, int fq) const {
        if (u.type == 2) {
#pragma unroll
            for (int a = 0; a < 2; ++a)
#pragma unroll
                for (int m = 0; m < 4; ++m) { const float bs = kvb[a * 128 + wr * 64 + m * 16 + fr];
#pragma unroll
                    for (int b = 0; b < 2; ++b)
#pragma unroll
                        for (int n = 0; n < 2; ++n) acc[a][b][m][n] = (f32x4){bs, bs, bs, bs}; }
            return;
        }
        const float* bp = (u.type == 0 ? bq + u.c0 : kvb) + wc * 32 + 8 * fq;
        acc_colbias(acc, *(const f32x4*)bp, *(const f32x4*)(bp + 4), *(const f32x4*)(bp + 128), *(const f32x4*)(bp + 132));
    }
    DI void epi(const AccT& acc, const pg8::Unit& u, int wr, int wc, int fr, int fq) const {
        const int tid = (wr * 4 + wc) * 64 + fq * 16 + fr, rowl = wr * 16 + fr;
        if (u.type == 2) {
            st_realign(wr);
#pragma unroll
            for (int m = 0; m < 4; ++m) {
#pragma unroll
                for (int bj = 0; bj < 2; ++bj) st_put(lds, rowl, (bj * 128 + wc * 32 + 8 * fq) * 2, acc[1][bj][m][0], acc[1][bj][m][1]);
                st_flush<512>(lds, tid, VT1 + (size_t)(m * 16) * T + u.c0, T, 256); }
            st_restagger(wr);
            return;
        }
        const bool isq = (u.type == 0); const bool rl = ((wc & 1) == 0) && fq < 2; const float sc = isq ? QSCALE : 1.f;
        st_realign(wr);
#pragma unroll
        for (int ai = 0; ai < 2; ++ai)
#pragma unroll
            for (int m = 0; m < 4; ++m) { const int row = u.r0 + ai * 128 + wr * 64 + m * 16 + fr;
#pragma unroll
                for (int bj = 0; bj < 2; ++bj) {
                    if (!isq && bj == 1) continue;
                    f32x4 v0 = acc[ai][bj][m][0], v1 = acc[ai][bj][m][1];
                    if ((wc & 1) == 0) { f32x4 r0 = v0, r1 = v1; rope8(r0, r1, ROPE + (size_t)row * 16, fq); if (rl) { v0 = r0; v1 = r1; } }
                    v0 = v0 * sc; v1 = v1 * sc;
                    st_put(lds, rowl, (bj * 128 + wc * 32 + 8 * fq) * 2, v0, v1); }
                if (isq) st_flush<512>(lds, tid, Q + (size_t)(u.r0 + ai * 128 + m * 16) * D + u.c0, D, 256);
                else st_flush<256>(lds, tid, K1 + (size_t)(u.r0 + ai * 128 + m * 16) * 128, 128, 256); }
        st_restagger(wr);
    }
};

template <class Base> struct NoEpi : Base {
    DI void epi(const AccT& acc, const pg8::Unit&, int, int, int, int) const {
#pragma unroll
        for (int ai = 0; ai < 2; ++ai)
#pragma unroll
            for (int bj = 0; bj < 2; ++bj) asm volatile("" :: "v"(acc[ai][bj][0][0]), "v"(acc[ai][bj][0][1]), "v"(acc[ai][bj][1][0]), "v"(acc[ai][bj][1][1]), "v"(acc[ai][bj][2][0]), "v"(acc[ai][bj][2][1]), "v"(acc[ai][bj][3][0]), "v"(acc[ai][bj][3][1]));
    }
};
DI float gelu_tanh(float z) {
    const float u = 0.7978845608028654f * (z + 0.044715f * z * z * z);
    const float e = ex2(2.f * LOG2E * u);
    const float th = 1.f - 2.f * rcpf(e + 1.f);
    return 0.5f * z * (1.f + th);
}
DI void compress_phase(Frame& F) {
    const int lane = F.lane, r = lane & 31, h = lane >> 5, quad = F.wave >> 2, q = F.wave & 3;
    const int rb = F.bx * 2 + quad, kv = rb >> 8, rem = rb & 255, b = rem >> 4, g = (rem >> 2) & 3, nb = rem & 3;
    const int n = nb * 32 + r, nn = n < 126 ? n : 126;
    LAS unsigned char* hid = F.lds + quad * (32 * 272);
    const bf16_t* w1p = F.CW1T() + ((size_t)kv * 128 + 32 * q + r) * 2048 + 8 * h;
    const bf16_t* xp = F.KV() + ((size_t)(b * SEQ + 16 * nn)) * D + kv * 256 + g * 64 + 8 * h;
    f32x16 acc;
#pragma unroll
    for (int i = 0; i < 16; ++i) acc[i] = 0.f;
#pragma unroll 16
    for (int ks = 0; ks < 128; ++ks) {
        const bf16x8 a = *(const bf16x8*)(w1p + 16 * ks);
        const bf16x8 bb = *(const bf16x8*)(xp + (size_t)(ks >> 2) * D + (ks & 3) * 16);
        acc = MFMA32(a, bb, acc);
    }
    {
        const float* cb = F.CMPB() + kv * 128 + 32 * q;
#pragma unroll
        for (int q4 = 0; q4 < 4; ++q4) {
            float v[4];
#pragma unroll
            for (int i = 0; i < 4; ++i) v[i] = gelu_tanh(acc[4 * q4 + i] + cb[8 * q4 + 4 * h + i]);
            u32x2 o; o.x = pk2(v[0], v[1]); o.y = pk2(v[2], v[3]);
            *(LAS u32x2*)(hid + r * 272 + (32 * q + 8 * q4 + 4 * h) * 2) = o;
        }
    }
    __syncthreads();
    if (q < 2) {
        const int db = q;
        f32x16 o2;
#pragma unroll
        for (int i = 0; i < 16; ++i) o2[i] = 0.f;
        const bf16_t* w2p = F.CW2T() + ((size_t)kv * 64 + 32 * db + r) * 128 + 8 * h;
#pragma unroll
        for (int s = 0; s < 8; ++s) {
            const bf16x8 a = *(const bf16x8*)(w2p + 16 * s);
            const bf16x8 bb = *(const LAS bf16x8*)(hid + r * 272 + (16 * s + 8 * h) * 2);
            o2 = MFMA32(a, bb, o2);
        }
        const bool valid = n < 127;
        if (kv == 0) {
            if (db == 0) {
                const float* rp = F.ROPE() + (size_t)(b * SEQ + 16 * nn + 31) * 16 + 4 * h;
                const f32x4 c = *(const f32x4*)rp, sn = *(const f32x4*)(rp + 8);
#pragma unroll
                for (int i = 0; i < 4; ++i) { const float x1 = o2[i], x2 = o2[4 + i]; o2[i] = x1 * c[i] - x2 * sn[i]; o2[4 + i] = x2 * c[i] + x1 * sn[i]; }
            }
            bf16_t* kp = F.KC() + ((size_t)((b * 4 + g) * 128 + n)) * 64 + 32 * db + 4 * h;
#pragma unroll
            for (int q4 = 0; q4 < 4; ++q4) { u32x2 o; o.x = valid ? pk2(o2[4 * q4], o2[4 * q4 + 1]) : 0u; o.y = valid ? pk2(o2[4 * q4 + 2], o2[4 * q4 + 3]) : 0u; *(u32x2*)(kp + 8 * q4) = o; }
        } else {
#pragma unroll
            for (int i = 0; i < 16; ++i) { const int d = 32 * db + crow(i, h);
                F.VCT()[((size_t)((b * 4 + g) * 64 + d)) * 128 + n] = valid ? (bf16_t)(pk2(o2[i], 0.f) & 0xffffu) : (bf16_t)0; }
        }
    }
    __syncthreads();
}

constexpr int AT_KT = 0, AT_VT = 18432  , AT_KC = 46080, AT_VC = 64512, AT_IMPP = 81408, AT_IMPS = 114176, AT_SELM = 122368;
#define NEG_INF (-INFINITY)

constexpr float AT_THR = 24.0f;
DI float max3f(float a, float b, float c) { float r; asm("v_max3_f32 %0, %1, %2, %3" : "=v"(r) : "v"(a), "v"(b), "v"(c)); return r; }
DI void qk_tile(const LAS unsigned char* kt, const bf16x8 (&qf)[4], f32x16& s0, f32x16& s1, int r, int h) {
    const LAS unsigned char* kp = kt + r * 144 + h * 16;
    f32x16 z;
#pragma unroll
    for (int i = 0; i < 16; ++i) z[i] = 0.f;
    { const bf16x8 a0 = *(const LAS bf16x8*)(kp), a1 = *(const LAS bf16x8*)(kp + 32 * 144); s0 = MFMA32(a0, qf[0], z); s1 = MFMA32(a1, qf[0], z); }
#pragma unroll
    for (int s = 1; s < 4; ++s) {
        const bf16x8 a0 = *(const LAS bf16x8*)(kp + s * 32), a1 = *(const LAS bf16x8*)(kp + 32 * 144 + s * 32);
        s0 = MFMA32(a0, qf[s], s0); s1 = MFMA32(a1, qf[s], s1);
    }
}
DI void v_frags(const LAS unsigned char* vt, bf16x8 (&vf)[2][2][2], int r, int h) {
    const LAS unsigned char* vp = vt + r * 144 + h * 16;
#pragma unroll
    for (int db = 0; db < 2; ++db)
#pragma unroll
        for (int kb = 0; kb < 2; ++kb)
#pragma unroll
            for (int s2 = 0; s2 < 2; ++s2) vf[db][kb][s2] = *(const LAS bf16x8*)(vp + db * 32 * 144 + kb * 64 + s2 * 32);
}
DI void pv_mma(const bf16x8 (&vf)[2][2][2], const u32x4 (&pb)[2][2], f32x16 (&O)[2]) {
#pragma unroll
    for (int db = 0; db < 2; ++db)
#pragma unroll
        for (int kb = 0; kb < 2; ++kb)
#pragma unroll
            for (int s2 = 0; s2 < 2; ++s2) O[db] = MFMA32(vf[db][kb][s2], __builtin_bit_cast(bf16x8, pb[kb][s2]), O[db]);
}
DI void pv_tile(const LAS unsigned char* vt, const u32x4 (&pb)[2][2], f32x16 (&O)[2], int r, int h) {
    bf16x8 vf[2][2][2]; v_frags(vt, vf, r, h); pv_mma(vf, pb, O);
}
DI void make_mask(int lo, int hi, int h, unsigned& w0, unsigned& w1) {
    const int a = lo + 1 < 0 ? 0 : lo + 1, b = hi > 63 ? 63 : hi;
    unsigned long long mk = (a <= b) ? ((~0ull >> (63 - b)) & (~0ull << a)) : 0ull;
    mk >>= 4 * h;
    w0 = (unsigned)mk; w1 = (unsigned)(mk >> 32);
}
DI unsigned bitm(unsigned w, int q) { unsigned r_; asm("v_bfe_i32 %0, %1, %2, 1" : "=v"(r_) : "v"(w), "n"((q & 3) + 8 * (q >> 2))); return r_; }
DI float msel(float s, unsigned mk) { return __uint_as_float((__float_as_uint(s) & mk) | (0xff800000u & ~mk)); }
template <bool MASKED> DI float tile_max(const f32x16& S0, const f32x16& S1, unsigned w0, unsigned w1) {
    float mx = NEG_INF;
    if (!MASKED) {
#pragma unroll
        for (int q = 0; q < 16; q += 2) mx = max3f(mx, max3f(S0[q], S0[q + 1], S1[q]), S1[q + 1]);
    } else {
#pragma unroll
        for (int q = 0; q < 16; ++q) mx = max3f(mx, msel(S0[q], bitm(w0, q)), msel(S1[q], bitm(w1, q)));
    }
    return mx;
}
template <bool MASKED, bool SUB> DI float tile_exp(const f32x16& S0, const f32x16& S1, unsigned w0, unsigned w1, float m, u32x4 (&pb)[2][2]) {
    float ls = 0.f;
#pragma unroll
    for (int s2 = 0; s2 < 2; ++s2)
#pragma unroll
        for (int w = 0; w < 4; ++w) {
            const int q = 8 * s2 + 2 * w;
            float a0 = SUB ? ex2(S0[q] - m) : ex2(S0[q]), a1 = SUB ? ex2(S0[q + 1] - m) : ex2(S0[q + 1]), b0 = SUB ? ex2(S1[q] - m) : ex2(S1[q]), b1 = SUB ? ex2(S1[q + 1] - m) : ex2(S1[q + 1]);
            if (MASKED) { a0 = __uint_as_float(__float_as_uint(a0) & bitm(w0, q)); a1 = __uint_as_float(__float_as_uint(a1) & bitm(w0, q + 1));
                          b0 = __uint_as_float(__float_as_uint(b0) & bitm(w1, q)); b1 = __uint_as_float(__float_as_uint(b1) & bitm(w1, q + 1)); }
            ls += (a0 + a1) + (b0 + b1);
            pb[0][s2][w] = pk2(a0, a1); pb[1][s2][w] = pk2(b0, b1);
        }
    return ls;
}
#define AT_WRITE_K(buf, kreg) do { *(LAS u32x4*)(lds + AT_KT + (buf) * 9216 + (tid >> 3) * 144 + (tid & 7) * 16) = (kreg); } while (0)
#define AT_WRITE_V(buf, vreg) do {   \
        LAS unsigned char* _vp = lds + AT_VT + (buf) * 9216 + (tid >> 3) * 144 + ((tid & 7) >> 1) * 32 + (tid & 1) * 8; *(LAS u32x2*)_vp = (u32x2){(vreg).x, (vreg).y}; *(LAS u32x2*)(_vp + 16) = (u32x2){(vreg).z, (vreg).w}; } while (0)

template <class Seq, int DBG = 0>
DI void attn_stream(LAS unsigned char* lds, int tid, int r, int h, const Seq& seq, const bf16_t* kbase, size_t ktile, const bf16_t* vbase,
                    const bf16x8 (&qf)[4], f32x16 (&O)[2], float& m, float& l) {
    const bool late = __builtin_amdgcn_readfirstlane(tid >> 8) != 0;
    int j = seq.first(), j1 = seq.next(j), j2 = (j1 >= 0) ? seq.next(j1) : -1;
    u32x4 krA, krB, vrA, vrB;
    krA = *(const u32x4*)(kbase + (size_t)j * ktile); vrA = *(const u32x4*)(vbase + 64 * j);
    krB = krA; vrB = vrA;
    if (j1 >= 0) { krB = *(const u32x4*)(kbase + (size_t)j1 * ktile); vrB = *(const u32x4*)(vbase + 64 * j1); }
    AT_WRITE_K(0, krA); AT_WRITE_V(0, vrA);
    if (j2 >= 0) { krA = *(const u32x4*)(kbase + (size_t)j2 * ktile); vrA = *(const u32x4*)(vbase + 64 * j2); }
    __syncthreads();
    f32x16 sa0, sa1, sb0, sb1;
    qk_tile(lds + AT_KT, qf, sa0, sa1, r, h);
    sb0 = sa0; sb1 = sa1;
    if (j1 >= 0) { AT_WRITE_K(1, krB); AT_WRITE_V(1, vrB); }
    __syncthreads();
    int vcur = 0;
#define AT_STEP(SA0, SA1, SB0, SB1, PAR, KR, VR, KS, VS) { \
        const int j3 = (j2 >= 0) ? seq.next(j2) : -1; \
        if (j3 >= 0 && !(DBG & 4)) { KS = *(const u32x4*)(kbase + (size_t)j3 * ktile); VS = *(const u32x4*)(vbase + 64 * j3); } \
        if (!late && j1 >= 0 && !(DBG & 2)) qk_tile(lds + AT_KT + ((PAR) ^ 1) * 9216, qf, SB0, SB1, r, h);        \
        __builtin_amdgcn_sched_barrier(0); \
        bf16x8 vf[2][2][2]; if (!(DBG & 2)) v_frags(lds + AT_VT + vcur * 9216, vf, r, h); \
        const bool allow = seq.allow(j); \
        float mx = (DBG & 1) ? 0.f : tile_max<false>(SA0, SA1, 0u, 0u); \
        if (!(DBG & 1)) mx = fmaxf(mx, __shfl_xor(mx, 32)); if (Seq::HAS_ALLOW) mx = allow ? mx : NEG_INF; \
        if (__any(mx - m > AT_THR)) { \
            const float mn = fmaxf(m, mx), alpha = ex2(m - mn); \
            m = mn; l *= alpha; O[0] = O[0] * alpha; O[1] = O[1] * alpha; \
        } \
        u32x4 pb[2][2]; float ls; \
        if (DBG & 1) { ls = 1.f; _Pragma("unroll") for (int a_ = 0; a_ < 2; ++a_) _Pragma("unroll") for (int b_ = 0; b_ < 2; ++b_) pb[a_][b_] = (u32x4){__float_as_uint(SA0[a_]), __float_as_uint(SA0[2 + b_]), __float_as_uint(SA1[a_]), __float_as_uint(SA1[3])}; } \
        else if (__any(m != 0.f)) ls = tile_exp<false, true>(SA0, SA1, 0u, 0u, m, pb); \
        else ls = tile_exp<false, false>(SA0, SA1, 0u, 0u, m, pb); \
        if (Seq::HAS_ALLOW) { const unsigned km = allow ? 0xffffffffu : 0u; ls = allow ? ls : 0.f; \
            _Pragma("unroll") for (int a_ = 0; a_ < 2; ++a_) _Pragma("unroll") for (int b_ = 0; b_ < 2; ++b_) { pb[a_][b_].x &= km; pb[a_][b_].y &= km; pb[a_][b_].z &= km; pb[a_][b_].w &= km; } } \
        l += ls; \
        if (!(DBG & 2)) pv_mma(vf, pb, O); else { O[0][0] += __uint_as_float(pb[0][0].x); O[1][0] += __uint_as_float(pb[1][1].w); } \
        __builtin_amdgcn_sched_barrier(0); \
        if (late && j1 >= 0 && !(DBG & 2)) qk_tile(lds + AT_KT + ((PAR) ^ 1) * 9216, qf, SB0, SB1, r, h);         \
        { const int vw = vcur >= 1 ? vcur - 1 : 2;        \
          if (j2 >= 0 && !(DBG & 4)) { AT_WRITE_K((PAR), KR); AT_WRITE_V(vw, VR); } }     \
        vcur = vcur == 2 ? 0 : vcur + 1; \
        if (!(DBG & 8)) __syncthreads(); \
        if (j1 < 0) break; \
        j = j1; j1 = j2; j2 = j3; }
    for (;;) {
        AT_STEP(sa0, sa1, sb0, sb1, 0, krA, vrA, krB, vrB)
        AT_STEP(sb0, sb1, sa0, sa1, 1, krB, vrB, krA, vrA)
    }
#undef AT_STEP
}
DI void attn_tile_masked(LAS unsigned char* lds, int tid, int r, int h, const bf16_t* kptr, const bf16_t* vptr, const bf16x8 (&qf)[4], f32x16 (&O)[2], float& m, float& l, int lo, int hi) {
    const u32x4 kr = *(const u32x4*)kptr, vr = *(const u32x4*)vptr;
    AT_WRITE_K(0, kr); AT_WRITE_V(0, vr);
    __syncthreads();
    f32x16 s0, s1;
    qk_tile(lds + AT_KT, qf, s0, s1, r, h);
    unsigned w0, w1; make_mask(lo, hi, h, w0, w1);
    float mx = tile_max<true>(s0, s1, w0, w1);
    mx = fmaxf(mx, __shfl_xor(mx, 32));
    if (__any(mx - m > AT_THR)) {
        const float mn = fmaxf(m, mx), alpha = ex2(m - mn);
        m = mn; l *= alpha; O[0] = O[0] * alpha; O[1] = O[1] * alpha;
    }
    u32x4 pb[2][2];
    l += tile_exp<true, true>(s0, s1, w0, w1, m, pb);
    pv_tile(lds + AT_VT, pb, O, r, h);
    __syncthreads();
}
struct SeqSel { static constexpr bool HAS_ALLOW = true; unsigned need, myselm;
    DI int first() const { return __builtin_ctz(need); }
    DI int next(int j) const { const unsigned rest = need & ~((2u << j) - 1u); return rest ? __builtin_ctz(rest) : -1; }
    DI bool allow(int j) const { return (myselm >> j) & 1u; }
};
struct SeqRange { static constexpr bool HAS_ALLOW = false; int j0, j1;
    DI int first() const { return j0; }
    DI int next(int j) const { return j < j1 ? j + 1 : -1; }
    DI bool allow(int) const { return true; }
};

DI void nsa_attn_phase(Frame& F) {
    LAS unsigned char* lds = F.lds;
    const int tid0 = F.tid, wave = F.wave, hh = wave & 3, th = wave >> 2;
    const int bg = F.bx & 63, b = bg >> 2, g = bg & 3, s4 = F.bx >> 6;
    LAS float* impP = (LAS float*)(lds + AT_IMPP);
    LAS float* impS = (LAS float*)(lds + AT_IMPS);
    LAS unsigned* selm = (LAS unsigned*)(lds + AT_SELM);
    const int head = g * 4 + hh;
    {
#pragma unroll
        for (int i = 0; i < 2; ++i) { const int idx = tid0 + 512 * i, row = idx >> 3, ch = idx & 7;
            *(LAS u32x4*)(lds + AT_KC + row * 144 + ch * 16) = *(const u32x4*)(F.KC() + ((size_t)((b * 4 + g) * 128 + row)) * 64 + ch * 8); }
#pragma unroll
        for (int i = 0; i < 2; ++i) { const int idx = tid0 + 512 * i, d = idx >> 4, ch = idx & 15;
            const u32x4 v = *(const u32x4*)(F.VCT() + ((size_t)((b * 4 + g) * 64 + d)) * 128 + ch * 8);
            LAS u32x2* vp = (LAS u32x2*)(lds + AT_VC + d * 264 + ch * 16); vp[0] = (u32x2){v.x, v.y}; vp[1] = (u32x2){v.z, v.w}; }
        __syncthreads();
    }
    for (int ui = 0; ui < 8; ++ui) {
        int tid = tid0; asm volatile("" : "+v"(tid));
        const int lane = tid & 63, r = lane & 31, h = lane >> 5, tl = th * 32 + r;
        const int pp = s4 + 4 * (ui >> 1), qt = (ui & 1) ? 31 - pp : pp;
        const int t = qt * 64 + tl; const size_t tokrow = (size_t)b * SEQ + t;
        bf16x8 qf[4];
#pragma unroll
        for (int s = 0; s < 4; ++s) qf[s] = *(const bf16x8*)(F.Q() + tokrow * D + head * 64 + 16 * s + 8 * h);
        if (tid < 64) selm[tid] = 0u;
        f32x16 Ot[2];
#pragma unroll
        for (int i = 0; i < 16; ++i) { Ot[0][i] = 0.f; Ot[1][i] = 0.f; }
#ifndef NO_CMP
        {
            const int nmax = (t - 31) >> 4;
            float mrun = NEG_INF, lrun = 0.f;
#pragma unroll 1
            for (int kb = 0; kb < 4; ++kb) {
                f32x16 sc;
#pragma unroll
                for (int i = 0; i < 16; ++i) sc[i] = 0.f;
#pragma unroll
                for (int s = 0; s < 4; ++s) { const bf16x8 a = *(const LAS bf16x8*)(lds + AT_KC + (kb * 32 + r) * 144 + s * 32 + h * 16); sc = MFMA32(a, qf[s], sc); }
                float bm = NEG_INF;
#pragma unroll
                for (int i = 0; i < 16; ++i) { const int nn = kb * 32 + crow(i, h); sc[i] = (nn <= nmax) ? sc[i] : NEG_INF; bm = fmaxf(bm, sc[i]); }
                const float mn = fmaxf(mrun, bm), mu = (mn == NEG_INF) ? 0.f : mn;
                float ls = 0.f;
#pragma unroll
                for (int i = 0; i < 16; ++i) ls += ex2(sc[i] - mu);
                lrun = lrun * ex2(mrun - mu) + ls; mrun = mn;
            }
            float mu, inv;
            { const float mo = __shfl_xor(mrun, 32), lo_ = __shfl_xor(lrun, 32); const float mt = fmaxf(mrun, mo); mu = (mt == NEG_INF) ? 0.f : mt;
              const float lt = lrun * ex2(mrun - mu) + lo_ * ex2(mo - mu); inv = lt > 0.f ? 1.f / lt : 0.f; }
            f32x16 Oc[2];
#pragma unroll
            for (int i = 0; i < 16; ++i) { Oc[0][i] = 0.f; Oc[1][i] = 0.f; }
            LAS float* ip = impP + ((hh * 64 + tl) * 32);
            float carry = 0.f;
#pragma unroll 1
            for (int kb = 0; kb < 4; ++kb) {
                f32x16 sc;
#pragma unroll
                for (int i = 0; i < 16; ++i) sc[i] = 0.f;
#pragma unroll
                for (int s = 0; s < 4; ++s) { const bf16x8 a = *(const LAS bf16x8*)(lds + AT_KC + (kb * 32 + r) * 144 + s * 32 + h * 16); sc = MFMA32(a, qf[s], sc); }
#pragma unroll
                for (int i = 0; i < 16; ++i) { const int nn = kb * 32 + crow(i, h); sc[i] = (nn <= nmax) ? ex2(sc[i] - mu) * inv : 0.f; }
                float Lo[4];
#pragma unroll
                for (int q4 = 0; q4 < 4; ++q4) Lo[q4] = __shfl_xor(sc[4 * q4 + 3], 32);
#pragma unroll
                for (int q4 = 0; q4 < 4; ++q4) {
                    const float G = (sc[4 * q4] + sc[4 * q4 + 1]) + (sc[4 * q4 + 2] + sc[4 * q4 + 3]);
                    const float prev0 = (q4 > 0) ? Lo[q4 > 0 ? q4 - 1 : 0] : carry;
                    const float Lp = (h == 1) ? Lo[q4] : prev0;
                    ip[8 * kb + 2 * q4 + h] = G + Lp;
                }
                carry = Lo[3];
#pragma unroll
                for (int s2 = 0; s2 < 2; ++s2) {
                    u32x4 p;
                    p.x = pk2(sc[8 * s2 + 0], sc[8 * s2 + 1]); p.y = pk2(sc[8 * s2 + 2], sc[8 * s2 + 3]); p.z = pk2(sc[8 * s2 + 4], sc[8 * s2 + 5]); p.w = pk2(sc[8 * s2 + 6], sc[8 * s2 + 7]);
                    const bf16x8 pb = __builtin_bit_cast(bf16x8, p);
#pragma unroll
                    for (int db = 0; db < 2; ++db) {
                        const LAS unsigned char* a = lds + AT_VC + (db * 32 + r) * 264 + (kb * 32 + 16 * s2 + 4 * h) * 2;
                        const s16x4 lo4 = *(const LAS s16x4*)a, hi4 = *(const LAS s16x4*)(a + 16);
                        const bf16x8 va = __builtin_shufflevector(lo4, hi4, 0, 1, 2, 3, 4, 5, 6, 7);
                        Oc[db] = MFMA32(va, pb, Oc[db]);
                    }
                }
            }
            const float gc = F.GATES()[tokrow * 64 + head * 3 + 0];
#pragma unroll
            for (int i = 0; i < 16; ++i) { Ot[0][i] = gc * Oc[0][i]; Ot[1][i] = gc * Oc[1][i]; }
        }
#endif
        __syncthreads();
        {
            const int tok = tid >> 3, sub = tid & 7;
#pragma unroll
            for (int jj = 0; jj < 4; ++jj) { const int j = sub * 4 + jj;
                impS[tok * 32 + j] = ((impP[(0 * 64 + tok) * 32 + j] + impP[(1 * 64 + tok) * 32 + j]) + impP[(2 * 64 + tok) * 32 + j]) + impP[(3 * 64 + tok) * 32 + j]; }
        }
        __syncthreads();
#ifndef NO_TOPK
        {
            const int tok = tid >> 3, sub = tid & 7;
            if (qt < 16) { if (sub == 0) selm[tok] = (2u << qt) - 1u; }
            else {
                float vj[4]; int rank[4];
#pragma unroll
                for (int jj = 0; jj < 4; ++jj) { vj[jj] = impS[tok * 32 + sub * 4 + jj]; rank[jj] = 0; }
#pragma unroll 1
                for (int i = 1; i <= qt - 2; ++i) { const float vi = impS[tok * 32 + i];
#pragma unroll
                    for (int jj = 0; jj < 4; ++jj) { const int j = sub * 4 + jj; rank[jj] += ((vi > vj[jj]) || (vi == vj[jj] && i < j)) ? 1 : 0; } }
                unsigned bits = 0u;
#pragma unroll
                for (int jj = 0; jj < 4; ++jj) { const int j = sub * 4 + jj;
                    const bool forced = (j == 0 || j == qt || j == qt - 1);
                    const bool sel = forced || (j <= qt - 2 && rank[jj] < 13);
                    bits |= sel ? (1u << j) : 0u; }
                if (bits) __hip_atomic_fetch_or(selm + tok, bits, __ATOMIC_RELAXED, __HIP_MEMORY_SCOPE_WORKGROUP);
            }
        }
#endif
        __syncthreads();
        LAS unsigned* park = (LAS unsigned*)(lds + AT_IMPP) + wave * 1024 + lane;
#pragma unroll
        for (int i = 0; i < 8; ++i) { park[i * 64] = pk2(Ot[0][2 * i], Ot[0][2 * i + 1]); park[(8 + i) * 64] = pk2(Ot[1][2 * i], Ot[1][2 * i + 1]); }
        const unsigned myselm = selm[tl];
        unsigned need;
        { unsigned w = selm[lane];
#pragma unroll
            for (int o = 1; o < 64; o <<= 1) w |= (unsigned)__shfl_xor((int)w, o);
            need = (unsigned)__builtin_amdgcn_readfirstlane((int)w) & ((2u << qt) - 1u); }
#ifdef REPEAT_SEL
        { f32x16 O2[2]; float m2 = 0.f, l2 = 0.f;
#pragma unroll
          for (int i = 0; i < 16; ++i) { O2[0][i] = 0.f; O2[1][i] = 0.f; }
          const bf16_t* kbase = F.KV() + ((size_t)b * SEQ + (tid >> 3)) * D + 512 + g * 64 + (tid & 7) * 8;
          const bf16_t* vbase = F.VT() + ((size_t)(g * 64 + (tid >> 3))) * T + (size_t)b * SEQ + (tid & 7) * 8;
          const unsigned inner = need & ~(1u << qt);
          if (inner) { const SeqSel seq{inner, myselm}; attn_stream<SeqSel, REPEAT_SEL>(lds, tid, r, h, seq, kbase, (size_t)64 * D, vbase, qf, O2, m2, l2); }
          attn_tile_masked(lds, tid, r, h, kbase + (size_t)qt * 64 * D, vbase + 64 * qt, qf, O2, m2, l2, -1, tl);
          asm volatile("" :: "v"(O2[0]), "v"(O2[1]), "v"(l2)); }
#endif
#ifndef NO_SEL
        {
            f32x16 O[2];
#pragma unroll
            for (int i = 0; i < 16; ++i) { O[0][i] = 0.f; O[1][i] = 0.f; }
            float m = 0.f, l = 0.f;
            const bf16_t* kbase = F.KV() + ((size_t)b * SEQ + (tid >> 3)) * D + 512 + g * 64 + (tid & 7) * 8;
            const bf16_t* vbase = F.VT() + ((size_t)(g * 64 + (tid >> 3))) * T + (size_t)b * SEQ + (tid & 7) * 8;
            const unsigned inner = need & ~(1u << qt);
            if (inner) { const SeqSel seq{inner, myselm}; attn_stream(lds, tid, r, h, seq, kbase, (size_t)64 * D, vbase, qf, O, m, l); }
            attn_tile_masked(lds, tid, r, h, kbase + (size_t)qt * 64 * D, vbase + 64 * qt, qf, O, m, l, -1, tl);
            l += __shfl_xor(l, 32);
            const float gs = F.GATES()[tokrow * 64 + head * 3 + 1];
            const float sc = l > 0.f ? gs / l : 0.f;
#pragma unroll
            for (int i = 0; i < 8; ++i) { const unsigned a = park[i * 64], c = park[(8 + i) * 64];
                park[i * 64] = pk2(bf_lo(a) + sc * O[0][2 * i], bf_hi(a) + sc * O[0][2 * i + 1]); park[(8 + i) * 64] = pk2(bf_lo(c) + sc * O[1][2 * i], bf_hi(c) + sc * O[1][2 * i + 1]); }
        }
#endif
#ifdef REPEAT_SWA
        { f32x16 O2[2]; float m2 = 0.f, l2 = 0.f;
#pragma unroll
          for (int i = 0; i < 16; ++i) { O2[0][i] = 0.f; O2[1][i] = 0.f; }
          const bf16_t* kbase = F.KV() + ((size_t)b * SEQ + (tid >> 3)) * D + 768 + g * 64 + (tid & 7) * 8;
          const bf16_t* vbase = F.VT() + ((size_t)(256 + g * 64 + (tid >> 3))) * T + (size_t)b * SEQ + (tid & 7) * 8;
          if (qt >= 8) attn_tile_masked(lds, tid, r, h, kbase + (size_t)(qt - 8) * 64 * D, vbase + 64 * (qt - 8), qf, O2, m2, l2, tl, 64);
          const int i0 = qt > 7 ? qt - 7 : 0;
          if (i0 <= qt - 1) { const SeqRange seq{i0, qt - 1}; attn_stream(lds, tid, r, h, seq, kbase, (size_t)64 * D, vbase, qf, O2, m2, l2); }
          attn_tile_masked(lds, tid, r, h, kbase + (size_t)qt * 64 * D, vbase + 64 * qt, qf, O2, m2, l2, -1, tl);
          asm volatile("" :: "v"(O2[0]), "v"(O2[1]), "v"(l2)); }
#endif
#ifndef NO_SWA
        {
            f32x16 O[2];
#pragma unroll
            for (int i = 0; i < 16; ++i) { O[0][i] = 0.f; O[1][i] = 0.f; }
            float m = 0.f, l = 0.f;
            const bf16_t* kbase = F.KV() + ((size_t)b * SEQ + (tid >> 3)) * D + 768 + g * 64 + (tid & 7) * 8;
            const bf16_t* vbase = F.VT() + ((size_t)(256 + g * 64 + (tid >> 3))) * T + (size_t)b * SEQ + (tid & 7) * 8;
            if (qt >= 8) attn_tile_masked(lds, tid, r, h, kbase + (size_t)(qt - 8) * 64 * D, vbase + 64 * (qt - 8), qf, O, m, l, tl, 64);
            const int i0 = qt > 7 ? qt - 7 : 0;
            if (i0 <= qt - 1) { const SeqRange seq{i0, qt - 1}; attn_stream(lds, tid, r, h, seq, kbase, (size_t)64 * D, vbase, qf, O, m, l); }
            attn_tile_masked(lds, tid, r, h, kbase + (size_t)qt * 64 * D, vbase + 64 * qt, qf, O, m, l, -1, tl);
            l += __shfl_xor(l, 32);
            const float gw = F.GATES()[tokrow * 64 + head * 3 + 2];
            const float sc = l > 0.f ? gw / l : 0.f;
#pragma unroll
            for (int i = 0; i < 8; ++i) { const unsigned a = park[i * 64], c = park[(8 + i) * 64];
                Ot[0][2 * i] = bf_lo(a) + sc * O[0][2 * i]; Ot[0][2 * i + 1] = bf_hi(a) + sc * O[0][2 * i + 1]; Ot[1][2 * i] = bf_lo(c) + sc * O[1][2 * i]; Ot[1][2 * i + 1] = bf_hi(c) + sc * O[1][2 * i + 1]; }
        }
#endif
        {
            bf16_t* op = F.O() + tokrow * D + head * 64 + 4 * h;
#pragma unroll
            for (int db = 0; db < 2; ++db)
#pragma unroll
                for (int q4 = 0; q4 < 4; ++q4) { u32x2 o; o.x = pk2(Ot[db][4 * q4], Ot[db][4 * q4 + 1]); o.y = pk2(Ot[db][4 * q4 + 2], Ot[db][4 * q4 + 3]); *(u32x2*)(op + db * 32 + 8 * q4) = o; }
        }
        __syncthreads();
    }
}

DI void swa_sink_phase(Frame& F) {
    LAS unsigned char* lds = F.lds;
    const int tid = F.tid, lane = F.lane, wave = F.wave, r = lane & 31, h = lane >> 5;
    const bf16_t* Qp = F.Q(); const bf16_t* Kp = F.KV(); const bf16_t* Vp = F.VT(); bf16_t* Op = F.O(); const float* sk = F.b_sinks();
    int ui = 0, q32 = F.vcu & 63, kvh = (F.vcu >> 6) & 1, b = F.vcu >> 7;
    int j1 = (32 * q32 + 31) >> 6, j = ((32 * q32 - 127) > 0 ? (32 * q32 - 127) : 0) >> 6;
    bf16x8 qf[4];
#pragma unroll
    for (int s = 0; s < 4; ++s) qf[s] = *(const bf16x8*)(Qp + ((size_t)b * SEQ + q32 * 32 + r) * D + (kvh * 8 + wave) * 64 + 16 * s + 8 * h);
    u32x4 kr = *(const u32x4*)(Kp + ((size_t)b * SEQ + 64 * j + (tid >> 3)) * 128 + kvh * 64 + (tid & 7) * 8);
    u32x4 vr = *(const u32x4*)(Vp + ((size_t)(kvh * 64 + (tid >> 3))) * T + (size_t)b * SEQ + 64 * j + (tid & 7) * 8);
    AT_WRITE_K(0, kr); AT_WRITE_V(0, vr);
    __syncthreads();
    f32x16 O[2];
#pragma unroll
    for (int i = 0; i < 16; ++i) { O[0][i] = 0.f; O[1][i] = 0.f; }
    float m = sk[kvh * 8 + wave] * LOG2E, l = (h == 0) ? 1.f : 0.f;
    int buf = 0;
    for (;;) {
        const bool last_tile = (j == j1);
        int nq32 = q32, nkvh = kvh, nb = b, nj = j + 1; bool has = true;
        if (last_tile) { has = (ui + 1) < 8;
            if (has) { const int u = (ui + 1) * GRID + F.vcu; nq32 = u & 63; nkvh = (u >> 6) & 1; nb = u >> 7; nj = ((32 * nq32 - 127) > 0 ? (32 * nq32 - 127) : 0) >> 6; } }
        bf16x8 qn[4];
        if (has) {
            kr = *(const u32x4*)(Kp + ((size_t)nb * SEQ + 64 * nj + (tid >> 3)) * 128 + nkvh * 64 + (tid & 7) * 8);
            vr = *(const u32x4*)(Vp + ((size_t)(nkvh * 64 + (tid >> 3))) * T + (size_t)nb * SEQ + 64 * nj + (tid & 7) * 8);
            if (last_tile) {
#pragma unroll
                for (int s = 0; s < 4; ++s) qn[s] = *(const bf16x8*)(Qp + ((size_t)nb * SEQ + nq32 * 32 + r) * D + (nkvh * 8 + wave) * 64 + 16 * s + 8 * h);
            }
        }
        {
            const int hi = q32 * 32 + r - 64 * j;
            f32x16 s0, s1;
            qk_tile(lds + AT_KT + buf * 9216, qf, s0, s1, r, h);
            unsigned w0, w1; make_mask(hi - 128, hi, h, w0, w1);
            float mx = tile_max<true>(s0, s1, w0, w1);
            mx = fmaxf(mx, __shfl_xor(mx, 32));
            if (__any(mx - m > AT_THR)) { const float mn = fmaxf(m, mx), alpha = ex2(m - mn); m = mn; l *= alpha; O[0] = O[0] * alpha; O[1] = O[1] * alpha; }
            u32x4 pb[2][2];
            l += tile_exp<true, true>(s0, s1, w0, w1, m, pb);
            pv_tile(lds + AT_VT + buf * 9216, pb, O, r, h);
        }
        if (has) { AT_WRITE_K(buf ^ 1, kr); AT_WRITE_V(buf ^ 1, vr); }
        __syncthreads();
        buf ^= 1;
        if (last_tile) {
            l += __shfl_xor(l, 32);
            const float sc = 1.f / l;
            bf16_t* op = Op + ((size_t)b * SEQ + q32 * 32 + r) * D + (kvh * 8 + wave) * 64 + 4 * h;
#pragma unroll
            for (int db = 0; db < 2; ++db)
#pragma unroll
                for (int q4 = 0; q4 < 4; ++q4) { u32x2 o; o.x = pk2(O[db][4 * q4] * sc, O[db][4 * q4 + 1] * sc); o.y = pk2(O[db][4 * q4 + 2] * sc, O[db][4 * q4 + 3] * sc); *(u32x2*)(op + db * 32 + 8 * q4) = o; }
            if (!has) break;
#pragma unroll
            for (int i = 0; i < 16; ++i) { O[0][i] = 0.f; O[1][i] = 0.f; }
#pragma unroll
            for (int s = 0; s < 4; ++s) qf[s] = qn[s];
            ++ui; q32 = nq32; kvh = nkvh; b = nb; j1 = (32 * q32 + 31) >> 6;
            m = sk[kvh * 8 + wave] * LOG2E; l = (h == 0) ? 1.f : 0.f;
        }
        j = nj;
    }
}
#ifndef N_LAUNCHES
#define N_LAUNCHES 1
#endif
constexpr int N_PHASES = 17;
__global__ void __launch_bounds__(NTHR, 2) fwd_kernel(Args args) {
    extern __shared__ __attribute__((aligned(16))) unsigned char lds_raw[];
    LAS unsigned char* const lds = (LAS unsigned char*)lds_raw;
    const int wave0 = __builtin_amdgcn_readfirstlane((int)(threadIdx.x >> 6));
    for (int u = threadIdx.x; u < 256; u += NTHR) ((LAS unsigned*)(lds + MISC_OFF))[u] = 0u;
    __syncthreads();
#if N_LAUNCHES == 1
    { Frame F = make_frame(lds, wave0); (void)xcd_barrier_post(F.ctl() + CW_BAR, (volatile LAS unsigned*)(lds + MISC_OFF)); }
#define IN(k) true
#define SEAM(k) do { Frame Fb = make_frame(lds, wave0); XcdBarrier _b; _b.bar = Fb.ctl() + CW_BAR; _b.x = xb_xcc_id(); _b.st = (volatile LAS unsigned*)(lds + MISC_OFF); xcd_barrier(_b); } while (0)
#else
#ifdef ONLY_PHASE
#define IN(k) ((k) == ONLY_PHASE && args.ph_lo <= (k) && (k) < args.ph_hi)
#else
#define IN(k) (args.ph_lo <= (k) && (k) < args.ph_hi)
#endif
#define SEAM(k) do { } while (0)
#endif
    const LAS unsigned* ext = (const LAS unsigned*)(lds + EXT_OFF);
#ifndef REPEAT_MASK
#define REPEAT_MASK 0
#endif
#define PH(k, ...) do { if (IN(k)) { __VA_ARGS__ } if ((((REPEAT_MASK) >> (k)) & 1) && IN(k)) { __VA_ARGS__ } } while (0)

    PH(0, Frame F = make_frame(lds, wave0); p0_prologue(F);); SEAM(0);
    PH(1, Frame F = make_frame(lds, wave0); norm_plain_phase(F);); SEAM(1);
    PH(2, Frame F = make_frame(lds, wave0); PolProj0 P{F.HN(), F.WINT(), F.Q(), F.KV(), F.VT(), F.GATES(), F.ROPE(), F.vcu, lds}; pg8::gemm_phase(lds, P, F.wave, F.lane);); SEAM(2);
    PH(3, Frame F = make_frame(lds, wave0); compress_phase(F);); SEAM(3);
    PH(4, Frame F = make_frame(lds, wave0); nsa_attn_phase(F);); SEAM(4);
#ifdef PROBE_OUT
    { Frame F = make_frame(lds, wave0); NoEpi<PolOut> P{{F.O(), F.WAOT(), F.x(), F.MODV(), nullptr, F.H(), F.vcu}};
      for (int rep = 0; rep < PROBE_OUT; ++rep) pg8::gemm_phase(lds, P, F.wave, F.lane); }
#endif
    PH(5, Frame F = make_frame(lds, wave0); PolOut P{F.O(), F.WAOT(), F.x(), F.MODV() + (size_t)0 * 16 * 3072, nullptr, F.H(), F.vcu}; pg8::gemm_phase(lds, P, F.wave, F.lane);); SEAM(5);
    PH(6, Frame F = make_frame(lds, wave0); norm_router_phase(F, 0);); SEAM(6);
#ifdef PROBE_GU_NOEPI
    { Frame F = make_frame(lds, wave0); load_expert_tables(F, 0, 8); PolGateUpT<true> P{F.HN(), F.WGUT(), F.b_gate_up(), F.LIST(), F.ACT(), ext, F.vcu, lds}; pg8::gemm_phase(lds, P, F.wave, F.lane); }
#endif
    PH(7, Frame F = make_frame(lds, wave0); load_expert_tables(F, 0, 8); PolGateUp P{F.HN(), F.WGUT(), F.b_gate_up(), F.LIST(), F.ACT(), ext, F.vcu, lds}; pg8::gemm_phase(lds, P, F.wave, F.lane);); SEAM(7);
#ifdef PROBE_DN
    { Frame F = make_frame(lds, wave0); load_expert_tables(F, 0, 4); PolDownT<(PROBE_DN == 1)> P{F.ACT(), F.WDNT(), F.b_down(), F.LISTW(), F.OUTB(), ext, F.vcu, lds}; pg8::gemm_phase(lds, P, F.wave, F.lane); }
#endif
    PH(8, Frame F = make_frame(lds, wave0); load_expert_tables(F, 0, 4); PolDown P{F.ACT(), F.WDNT(), F.b_down(), F.LISTW(), F.OUTB(), ext, F.vcu, lds}; pg8::gemm_phase(lds, P, F.wave, F.lane);); SEAM(8);
    PH(9, Frame F = make_frame(lds, wave0); combine_phase<false>(F, 0);); SEAM(9);
    PH(10, Frame F = make_frame(lds, wave0); PolProj1 P{F.HN(), F.HN2(), F.WBQT(), F.WKVT(), F.b_b_q(), F.kv_b(), F.ROPE(), F.Q(), F.KV(), F.VT(), F.vcu, lds}; pg8::gemm_phase(lds, P, F.wave, F.lane);); SEAM(10);
    PH(11, Frame F = make_frame(lds, wave0); swa_sink_phase(F);); SEAM(11);
    PH(12, Frame F = make_frame(lds, wave0); PolOut P{F.O(), F.WBOT(), F.H(), F.MODV() + (size_t)2 * 16 * 3072, F.b_b_out(), F.H(), F.vcu}; pg8::gemm_phase(lds, P, F.wave, F.lane);); SEAM(12);
    PH(13, Frame F = make_frame(lds, wave0); norm_router_phase(F, 1);); SEAM(13);
    PH(14, Frame F = make_frame(lds, wave0); load_expert_tables(F, 1, 8); PolGateUp P{F.HN(), F.WGUT() + (size_t)32 * 2048 * D, F.b_gate_up() + 32 * 2048, F.LIST(), F.ACT(), ext, F.vcu, lds}; pg8::gemm_phase(lds, P, F.wave, F.lane);); SEAM(14);
    PH(15, Frame F = make_frame(lds, wave0); load_expert_tables(F, 1, 4); PolDown P{F.ACT(), F.WDNT() + (size_t)32 * D * D, F.b_down() + 32 * 1024, F.LISTW(), F.OUTB(), ext, F.vcu, lds}; pg8::gemm_phase(lds, P, F.wave, F.lane);); SEAM(15);
    PH(16, Frame F = make_frame(lds, wave0); combine_phase<true>(F, 1););
#undef IN
#undef SEAM
}

extern "C" void kernel_launch(void* const* d_in, const int* in_sizes, int n_in, void* d_out, int out_size, void* d_ws, size_t ws_size, hipStream_t stream) {
    static int ready = 0;
    if (ready == 0) {
        if (n_in != 28 || out_size != T * D || ws_size < WS_END) { fprintf(stderr, "kernel_launch: unexpected shapes (n_in %d out %d ws %zu)\n", n_in, out_size, ws_size); ready = -1; return; }
        int dev = 0, cus = 0, per_cu = 0;
        if (hipGetDevice(&dev) != hipSuccess || hipDeviceGetAttribute(&cus, hipDeviceAttributeMultiprocessorCount, dev) != hipSuccess) { ready = -1; return; }
        if (hipFuncSetAttribute((const void*)fwd_kernel, hipFuncAttributeMaxDynamicSharedMemorySize, LDS_BYTES) != hipSuccess) { fprintf(stderr, "kernel_launch: hipFuncSetAttribute failed\n"); ready = -1; return; }
        if (hipOccupancyMaxActiveBlocksPerMultiprocessor(&per_cu, (const void*)fwd_kernel, NTHR, LDS_BYTES) != hipSuccess || per_cu < 1) fprintf(stderr, "kernel_launch: occupancy query reports %d\n", per_cu);
        (void)hipGetLastError();
        if (cus < GRID) { fprintf(stderr, "kernel_launch: needs %d CUs, device has %d\n", GRID, cus); ready = -1; return; }
        ready = 1;
    }
    if (ready < 0) return;
    (void)hipMemsetAsync((char*)d_ws + WS_CTL, 0, CTL_ZERO_BYTES, stream);
    Args a{};
    for (int i = 0; i < 28; ++i) a.in[i] = d_in[i];
    a.out = (float*)d_out; a.ws = (unsigned char*)d_ws;
    if (N_LAUNCHES == 1) {
        a.ph_lo = 0; a.ph_hi = N_PHASES;
        hipLaunchKernelGGL(fwd_kernel, dim3(GRID), dim3(NTHR), LDS_BYTES, stream, a);
    } else {
        for (int p = 0; p < N_PHASES; ++p) { a.ph_lo = p; a.ph_hi = p + 1; hipLaunchKernelGGL(fwd_kernel, dim3(GRID), dim3(NTHR), LDS_BYTES, stream, a); }
    }
}
```

```cpp
#include <hip/hip_runtime.h>
#include <cstdio>
#include <cstdint>

#define DI __device__ __forceinline__
#define LAS __attribute__((address_space(3)))
#define GAS __attribute__((address_space(1)))
typedef unsigned short bf16_t;
typedef short bf16x8 __attribute__((ext_vector_type(8)));
typedef short s16x4 __attribute__((ext_vector_type(4)));
typedef float f32x2 __attribute__((ext_vector_type(2)));
typedef float f32x4 __attribute__((ext_vector_type(4)));
typedef float f32x16 __attribute__((ext_vector_type(16)));
typedef unsigned u32x4 __attribute__((ext_vector_type(4)));
typedef unsigned u32x2 __attribute__((ext_vector_type(2)));

constexpr int NB = 16, SEQ = 2048, T = NB * SEQ, D = 1024, HD = 64;
constexpr int NEXP = 32, TOPK = 4;
constexpr int A_PROJ = 2608;
constexpr float NORM_EPS = 1e-5f;
constexpr float QSCALE = 0.125f * 1.4426950408889634f;
constexpr float LOG2E = 1.4426950408889634f;
constexpr int NWAVES = 8, NTHR = 512, GRID = 256;
constexpr int MODN = 4 * 16 * 3072 + 16 * 2048;

constexpr size_t MiB = (size_t)1 << 20;
constexpr size_t WS_CTL = 0, CTL_ZERO_BYTES = 1 * MiB;
constexpr size_t WS_MODV = 1 * MiB;
constexpr size_t WS_ROPE = 2 * MiB;
constexpr size_t WS_CMPB = 4 * MiB;
constexpr size_t WS_CW1T = 5 * MiB;
constexpr size_t WS_CW2T = 6 * MiB;
constexpr size_t WS_WINT = 7 * MiB;
constexpr size_t WS_WAOT = 13 * MiB;
constexpr size_t WS_WBQT = 15 * MiB;
constexpr size_t WS_WBOT = 17 * MiB;
constexpr size_t WS_WKVT = 19 * MiB;
constexpr size_t WS_KC = 20 * MiB;
constexpr size_t WS_VCT = 21 * MiB;
constexpr size_t WS_TOKSLOT = 22 * MiB;
constexpr size_t WS_GATES = 24 * MiB;
constexpr size_t WS_LIST = 32 * MiB;
constexpr size_t WS_LISTW = 36 * MiB;
constexpr size_t WS_VT = 40 * MiB;
constexpr size_t WS_WGUT = 72 * MiB;
constexpr size_t WS_WDNT = 328 * MiB;
constexpr size_t WS_H = 456 * MiB;
constexpr size_t WS_HN = 584 * MiB;
constexpr size_t WS_HN2 = 648 * MiB;
constexpr size_t WS_Q = 712 * MiB;
constexpr size_t WS_KV = 776 * MiB;
constexpr size_t WS_O = 840 * MiB;
constexpr size_t WS_ACT = 904 * MiB;
constexpr size_t WS_OUTB = 1161 * MiB;
constexpr size_t WS_MODP = 1417 * MiB;
constexpr size_t WS_DUMMY = 1425 * MiB;
constexpr size_t WS_END = 1428 * MiB;
constexpr int CW_BAR = 1024;
constexpr int CW_CNT = 8192;
constexpr int CW_PANEL = 16384;

constexpr int LDS_BYTES = 163840;
constexpr int MISC_OFF = LDS_BYTES - 1024;
constexpr int EXT_OFF = MISC_OFF + 64;

DI unsigned pk2(float lo, float hi) {
    typedef __bf16 bf2 __attribute__((ext_vector_type(2)));
    f32x2 v = {lo, hi}; bf2 b = __builtin_convertvector(v, bf2); return __builtin_bit_cast(unsigned, b);
}
DI float bf_lo(unsigned u) { return __uint_as_float(u << 16); }
DI float bf_hi(unsigned u) { return __uint_as_float(u & 0xffff0000u); }
DI float ex2(float x) { return __builtin_amdgcn_exp2f(x); }
DI float rcpf(float x) { return __builtin_amdgcn_rcpf(x); }
DI void halves32(unsigned x, unsigned& lo, unsigned& hi) { const auto r = __builtin_amdgcn_permlane32_swap(x, x, false, false); lo = r[0]; hi = r[1]; }
DI void halves32(float x, float& lo, float& hi) { unsigned a, b; halves32(__float_as_uint(x), a, b); lo = __uint_as_float(a); hi = __uint_as_float(b); }
DI float max_xor32(float x) { float a, b; halves32(x, a, b); return fmaxf(a, b); }
DI float sum_xor32(float x) { float a, b; halves32(x, a, b); return a + b; }
template <int O> DI unsigned shx_u(unsigned x, int lane) {
    if constexpr (O == 32) { unsigned a, b; halves32(x, a, b); return (lane & 32) ? a : b; }
    else return (unsigned)__builtin_amdgcn_ds_swizzle((int)x, (O << 10) | 0x1f);
}
template <int O> DI float shx(float x, int lane) { return __uint_as_float(shx_u<O>(__float_as_uint(x), lane)); }
DI float wave_sum(float v) {
    v += shx<1>(v, 0); v += shx<2>(v, 0); v += shx<4>(v, 0); v += shx<8>(v, 0); v += shx<16>(v, 0);
    return sum_xor32(v);
}
DI int crow(int reg, int h) { return (reg & 3) + 8 * (reg >> 2) + 4 * h; }
#define MFMA32(a, b, c) __builtin_amdgcn_mfma_f32_32x32x16_bf16((a), (b), (c), 0, 0, 0)
#define LDS_WAIT() asm volatile("s_waitcnt lgkmcnt(0)" ::: "memory")
#define VM_WAIT() asm volatile("s_waitcnt vmcnt(0)" ::: "memory")

#define XB_TMO      128
#define XB_XCNT(j)  (256  + 64 * (j))
#define XB_XSUB(j)  (1280 + 64 * (j))
#define XB_XGEN(j)  (2304 + 64 * (j))
#define XB_TOP      3328
#define XB_TOPGEN   3392
#define XCD_BAR_WORDS 3456
#define XB_SPIN_CAP (1u << 21)

DI unsigned xb_ld(unsigned* p)              { return __hip_atomic_load(p, __ATOMIC_RELAXED, __HIP_MEMORY_SCOPE_AGENT); }
DI unsigned xb_add(unsigned* p, unsigned v) { return __hip_atomic_fetch_add(p, v, __ATOMIC_RELAXED, __HIP_MEMORY_SCOPE_AGENT); }
DI unsigned xb_xcc_id() { return (unsigned)__builtin_amdgcn_s_getreg((3 << 11) | 20) & 0xFu; }
#define XB_SPIN(cond, bar) do { unsigned _sp = 0; while (cond) { __builtin_amdgcn_s_sleep(1); \
    if ((++_sp & 255u) == 0u) { if (xb_ld(&(bar)[XB_TMO])) break; if (_sp > XB_SPIN_CAP) { atomicAdd(&(bar)[XB_TMO], 1u); break; } } } } while (0)

struct XcdBarrier { unsigned* bar; unsigned x; volatile LAS unsigned* st; };

DI XcdBarrier xcd_barrier_post(unsigned* bar, volatile LAS unsigned* st) {
    XcdBarrier b; b.bar = bar; b.x = xb_xcc_id(); b.st = st;
    if (threadIdx.x == 0) (void)xb_add(&bar[XB_XCNT(b.x)], 1u);
    return b;
}
DI void xcd_barrier_complete(unsigned* bar, unsigned x, unsigned& nloc, unsigned& nx) {
    const unsigned G = gridDim.x * gridDim.y * gridDim.z;
    unsigned sum, cnt, mine, sp = 0u;
    for (;;) {
        sum = 0u; cnt = 0u; mine = 0u;
#pragma unroll
        for (unsigned j = 0; j < 16; ++j) { const unsigned c = xb_ld(&bar[XB_XCNT(j)]); sum += c; cnt += (c > 0u) ? 1u : 0u; mine = (j == x) ? c : mine; }
        if (sum == G) break;
        __builtin_amdgcn_s_sleep(1);
        if ((++sp & 255u) == 0u) { if (xb_ld(&bar[XB_TMO])) break; if (sp > XB_SPIN_CAP) { atomicAdd(&bar[XB_TMO], 1u); break; } }
    }
    nloc = mine > 0u ? mine : 1u; nx = cnt > 0u ? cnt : 1u;
}
DI void xcd_barrier(const XcdBarrier& b) {
    asm volatile("s_waitcnt vmcnt(0)" ::: "memory");
    __syncthreads();
    if (threadIdx.x == 0) {
        unsigned* bar = b.bar;
        __builtin_amdgcn_s_waitcnt(0);
        unsigned nloc = b.st[0], nx = b.st[1];
        if (nloc == 0u) { xcd_barrier_complete(bar, b.x, nloc, nx); b.st[0] = nloc; b.st[1] = nx; }
        const unsigned old = xb_add(&bar[XB_XSUB(b.x)], 1u);
        const unsigned gen = old / nloc;
        if (old + 1u == (gen + 1u) * nloc) {
            __builtin_amdgcn_fence(__ATOMIC_RELEASE, "agent");
            asm volatile("s_waitcnt vmcnt(0)" ::: "memory");
            const unsigned og = xb_add(&bar[XB_TOP], 1u);
            const unsigned tg = og / nx;
            if (og + 1u == (tg + 1u) * nx) xb_add(&bar[XB_TOPGEN], 1u);
            else XB_SPIN(xb_ld(&bar[XB_TOPGEN]) == tg, bar);
            __builtin_amdgcn_fence(__ATOMIC_ACQUIRE, "agent");
            xb_add(&bar[XB_XGEN(b.x)], 1u);
            asm volatile("s_waitcnt vmcnt(0)" ::: "memory");
        } else {
            XB_SPIN(xb_ld(&bar[XB_XGEN(b.x)]) == gen, bar);
            __builtin_amdgcn_fence(__ATOMIC_ACQUIRE, "agent");
            asm volatile("s_waitcnt vmcnt(0)" ::: "memory");
        }
    }
    __syncthreads();
}

struct Args { const void* in[28]; float* out; unsigned char* ws; int ph_lo, ph_hi; };

typedef const __attribute__((address_space(4))) unsigned char* KPtr;
struct Frame {
    LAS unsigned char* lds; KPtr kp; int tid, lane, wave, vcu, bx;
    DI void* arg(int i) const { return *(void* const __attribute__((address_space(4)))*)(kp + 8 * i); }
    DI unsigned char* wsp() const { return (unsigned char*)arg(29); }
    DI unsigned* ctl() const { return (unsigned*)(wsp() + WS_CTL); }
    DI float* out() const { return (float*)arg(28); }
    DI const float* x() const { return (const float*)arg(0); }
    DI const float* c() const { return (const float*)arg(1); }
    DI const int* positions() const { return (const int*)arg(2); }
    DI const float* mod_w() const { return (const float*)arg(3); }
    DI const float* mod_b() const { return (const float*)arg(4); }
    DI const float* norm_g() const { return (const float*)arg(5); }
    DI const float* final_g() const { return (const float*)arg(6); }
    DI const float* a_w_in() const { return (const float*)arg(7); }
    DI const float* cmp_pe() const { return (const float*)arg(8); }
    DI const float* cmp_w1() const { return (const float*)arg(9); }
    DI const float* cmp_w2() const { return (const float*)arg(10); }
    DI const float* a_w_out() const { return (const float*)arg(11); }
    DI const float* kv_norm_g() const { return (const float*)arg(12); }
    DI const float* kv_mod_w() const { return (const float*)arg(13); }
    DI const float* kv_mod_b() const { return (const float*)arg(14); }
    DI const float* kv_w() const { return (const float*)arg(15); }
    DI const float* kv_b() const { return (const float*)arg(16); }
    DI const float* b_w_q() const { return (const float*)arg(17); }
    DI const float* b_b_q() const { return (const float*)arg(18); }
    DI const float* b_sinks() const { return (const float*)arg(19); }
    DI const float* b_w_out() const { return (const float*)arg(20); }
    DI const float* b_b_out() const { return (const float*)arg(21); }
    DI const float* router_w() const { return (const float*)arg(22); }
    DI const float* router_b() const { return (const float*)arg(23); }
    DI const float* w_gate_up() const { return (const float*)arg(24); }
    DI const float* b_gate_up() const { return (const float*)arg(25); }
    DI const float* w_down() const { return (const float*)arg(26); }
    DI const float* b_down() const { return (const float*)arg(27); }
    DI float* MODV() const { return (float*)(wsp() + WS_MODV); }
    DI float* MODP() const { return (float*)(wsp() + WS_MODP); }
    DI float* ROPE() const { return (float*)(wsp() + WS_ROPE); }
    DI float* CMPB() const { return (float*)(wsp() + WS_CMPB); }
    DI float* GATES() const { return (float*)(wsp() + WS_GATES); }
    DI float* LISTW() const { return (float*)(wsp() + WS_LISTW); }
    DI float* H() const { return (float*)(wsp() + WS_H); }
    DI bf16_t* CW1T() const { return (bf16_t*)(wsp() + WS_CW1T); }
    DI bf16_t* CW2T() const { return (bf16_t*)(wsp() + WS_CW2T); }
    DI bf16_t* WINT() const { return (bf16_t*)(wsp() + WS_WINT); }
    DI bf16_t* WAOT() const { return (bf16_t*)(wsp() + WS_WAOT); }
    DI bf16_t* WBQT() const { return (bf16_t*)(wsp() + WS_WBQT); }
    DI bf16_t* WBOT() const { return (bf16_t*)(wsp() + WS_WBOT); }
    DI bf16_t* WKVT() const { return (bf16_t*)(wsp() + WS_WKVT); }
    DI bf16_t* KC() const { return (bf16_t*)(wsp() + WS_KC); }
    DI bf16_t* VCT() const { return (bf16_t*)(wsp() + WS_VCT); }
    DI bf16_t* VT() const { return (bf16_t*)(wsp() + WS_VT); }
    DI bf16_t* WGUT() const { return (bf16_t*)(wsp() + WS_WGUT); }
    DI bf16_t* WDNT() const { return (bf16_t*)(wsp() + WS_WDNT); }
    DI bf16_t* HN() const { return (bf16_t*)(wsp() + WS_HN); }
    DI bf16_t* HN2() const { return (bf16_t*)(wsp() + WS_HN2); }
    DI bf16_t* Q() const { return (bf16_t*)(wsp() + WS_Q); }
    DI bf16_t* KV() const { return (bf16_t*)(wsp() + WS_KV); }
    DI bf16_t* O() const { return (bf16_t*)(wsp() + WS_O); }
    DI bf16_t* ACT() const { return (bf16_t*)(wsp() + WS_ACT); }
    DI bf16_t* OUTB() const { return (bf16_t*)(wsp() + WS_OUTB); }
    DI unsigned* TOKSLOT() const { return (unsigned*)(wsp() + WS_TOKSLOT); }
    DI unsigned* LIST() const { return (unsigned*)(wsp() + WS_LIST); }
};
DI int vcu_of(int bx) { return (bx & 7) * (GRID / 8) + (bx >> 3); }
DI int fresh_lane() { int l; asm volatile("v_mbcnt_lo_u32_b32 %0, -1, 0\n\tv_mbcnt_hi_u32_b32 %0, -1, %0" : "=&v"(l)); return l; }
DI Frame make_frame(LAS unsigned char* lds, int wave_sgpr) {
    Frame F; F.lds = lds;
    KPtr kp = (KPtr)__builtin_amdgcn_kernarg_segment_ptr(); asm volatile("" : "+s"(kp)); F.kp = kp;
    int wv = wave_sgpr; asm volatile("" : "+s"(wv)); F.wave = wv; F.lane = fresh_lane(); F.tid = wv * 64 + F.lane;
    int bx = (int)blockIdx.x; asm volatile("" : "+s"(bx)); F.bx = bx; F.vcu = vcu_of(bx);
    return F;
}
DI void transpose_item(const float* W, int ld, int K, bf16_t* WT, int drow0, int k0, int n0, LAS float* scr, int lane) {
    f32x4 v[16];
    const float* src = W + (size_t)(k0 + (lane >> 4)) * ld + n0 + 4 * (lane & 15);
#pragma unroll
    for (int i = 0; i < 16; ++i) v[i] = __builtin_nontemporal_load((const f32x4*)(src + (size_t)(4 * i) * ld));
    LAS float* wp = scr + (lane >> 4) * 65 + 4 * (lane & 15);
#pragma unroll
    for (int i = 0; i < 16; ++i) { LAS float* q = wp + (4 * i) * 65; q[0] = v[i].x; q[1] = v[i].y; q[2] = v[i].z; q[3] = v[i].w; }
    LDS_WAIT(); asm volatile("" ::: "memory");
    const int c = lane & 7;
#pragma unroll
    for (int j = 0; j < 8; ++j) { const int n = (lane >> 3) + 8 * j; const LAS float* s = scr + (8 * c) * 65 + n;
        u32x4 o; o.x = pk2(s[0 * 65], s[1 * 65]); o.y = pk2(s[2 * 65], s[3 * 65]); o.z = pk2(s[4 * 65], s[5 * 65]); o.w = pk2(s[6 * 65], s[7 * 65]);
        __builtin_nontemporal_store(o, (u32x4*)(WT + (size_t)(drow0 + n) * K + k0 + 8 * c)); }
    LDS_WAIT(); asm volatile("" ::: "memory");
}

DI void p0_prologue(Frame& F) {
    const int gw = F.bx * NWAVES + F.wave, NGW = GRID * NWAVES, lane = F.lane;
    const int gtid = F.bx * NTHR + F.tid, NGT = GRID * NTHR;
    LAS float* cact = (LAS float*)(F.lds + 73728);
#pragma unroll 1
    for (int i0 = 0; i0 < (NB * D) / NTHR; i0 += 16) {
        float cv[16];
#pragma unroll
        for (int i = 0; i < 16; ++i) cv[i] = F.c()[F.tid + (i0 + i) * NTHR];
#pragma unroll
        for (int i = 0; i < 16; ++i) { const int idx = F.tid + (i0 + i) * NTHR, b = idx / D, k = idx % D; const float v = cv[i]; cact[k * 16 + b] = v / (1.f + __expf(-v)); }
    }
    __syncthreads();
    if (gw < 1792) {
        const int seg = gw / 224, it = gw % 224; const float* W; float* outp; int ld; int chunk;
        if (it < 192) { const int set = it / 48; chunk = it % 48; W = F.mod_w() + (size_t)set * D * 3072; ld = 3072; outp = F.MODP() + (size_t)seg * MODN + (size_t)set * 16 * 3072; }
        else { chunk = it - 192; W = F.kv_mod_w(); ld = 2048; outp = F.MODP() + (size_t)seg * MODN + (size_t)4 * 16 * 3072; }
        const int col = chunk * 64 + lane;
        float acc[16];
#pragma unroll
        for (int b = 0; b < 16; ++b) acc[b] = 0.f;
#pragma unroll 8
        for (int kk = 0; kk < 128; ++kk) {
            const int k = seg * 128 + kk;
            const float w = W[(size_t)k * ld + col];
            const LAS f32x4* cp = (const LAS f32x4*)(cact + k * 16);
            const f32x4 c0 = cp[0], c1 = cp[1], c2 = cp[2], c3 = cp[3];
            acc[0] += c0.x * w; acc[1] += c0.y * w; acc[2] += c0.z * w; acc[3] += c0.w * w;
            acc[4] += c1.x * w; acc[5] += c1.y * w; acc[6] += c1.z * w; acc[7] += c1.w * w;
            acc[8] += c2.x * w; acc[9] += c2.y * w; acc[10] += c2.z * w; acc[11] += c2.w * w;
            acc[12] += c3.x * w; acc[13] += c3.y * w; acc[14] += c3.z * w; acc[15] += c3.w * w;
        }
#pragma unroll
        for (int b = 0; b < 16; ++b) outp[(size_t)b * ld + col] = acc[b];
    }
    if (gw < 256) {
        const int kv = gw / 128, e = gw % 128; float s = 0.f;
        for (int j = 0; j < 32; ++j) { const int k = lane + 64 * j; s += F.cmp_pe()[kv * 2048 + k] * F.cmp_w1()[((size_t)kv * 2048 + k) * 128 + e]; }
        s = wave_sum(s);
        if (lane == 0) F.CMPB()[gw] = s;
    }
    for (int idx = gtid; idx < T * 8; idx += NGT) {
        const int tok = idx >> 3, i = idx & 7;
        const float inv = (float)pow(500000.0, -(double)(2 * i) / 16.0);
        const float ang = (float)F.positions()[tok] * inv;
        double a = (double)ang; const double twopi = 6.283185307179586476925286766559;
        a -= twopi * rint(a / twopi);
        const float ar = (float)a;
        F.ROPE()[(size_t)tok * 16 + i] = cosf(ar); F.ROPE()[(size_t)tok * 16 + 8 + i] = sinf(ar);
    }
    for (int idx = gtid; idx < 256 * D; idx += NGT) {
        const int row = idx / D, k = idx % D;
        const float v = row < 48 ? F.a_w_in()[(size_t)k * A_PROJ + 2560 + row] : 0.f;
        F.WINT()[(size_t)(2048 + row) * D + k] = (bf16_t)(pk2(v, 0.f) & 0xffffu);
    }
#ifdef PROBE_COPY
    {
        const f32x4* src = (const f32x4*)F.w_gate_up(); u32x4* dst = (u32x4*)F.ACT();
        const size_t n8 = (size_t)2 * 32 * D * 2048 / 8 + (size_t)2 * 32 * D * D / 8;
        const size_t n8a = (size_t)2 * 32 * D * 2048 / 8;
        const f32x4* src2 = (const f32x4*)F.w_down();
        for (size_t i = (size_t)gtid; i < n8; i += (size_t)NGT * 4) {
#pragma unroll
            for (int u = 0; u < 4; ++u) { const size_t k = i + (size_t)u * NGT; if (k < n8) {
                const f32x4* s = k < n8a ? src + 2 * k : src2 + 2 * (k - n8a);
                const f32x4 a = __builtin_nontemporal_load(s), b = __builtin_nontemporal_load(s + 1);
                u32x4 o; o.x = pk2(a.x, a.y); o.y = pk2(a.z, a.w); o.z = pk2(b.x, b.y); o.w = pk2(b.z, b.w);
                __builtin_nontemporal_store(o, dst + k); } }
        }
    }
#endif
    __syncthreads();
    LAS float* scr = (LAS float*)(F.lds + F.wave * 16640);
#ifdef CONV_IN_P0
    constexpr int J0 = 32768, J1 = 16384;
#else
    constexpr int J0 = 0, J1 = 0;
#endif
    constexpr int J2 = 640, J3 = 256, J6 = 64, J7 = 128, J8 = 4;
    constexpr int NITEMS = J0 + J1 + J2 + 3 * J3 + J6 + J7 + J8;
    for (int it = gw; it < NITEMS; it += NGW) {
        int r = it;
#ifdef CONV_IN_P0
        if (r < J0) { const int mat = r >> 9, q = r & 511, kb = q >> 5, nb = q & 31;
            transpose_item(F.w_gate_up() + (size_t)mat * D * 2048, 2048, D, F.WGUT() + (size_t)mat * 2048 * D, 64 * nb, 64 * kb, 64 * nb, scr, lane); continue; }
        r -= J0;
        if (r < J1) { const int mat = r >> 8, q = r & 255, kb = q >> 4, nb = q & 15;
            transpose_item(F.w_down() + (size_t)mat * D * D, D, D, F.WDNT() + (size_t)mat * D * D, 64 * nb, 64 * kb, 64 * nb, scr, lane); continue; }
        r -= J1;
#endif
        if (r < J2) { const int kb = r / 40, nb = r % 40, n0 = 64 * nb;
            const int dr = n0 < 1792 ? n0 : (n0 < 2048 ? 2304 + (n0 - 1792) : (n0 < 2304 ? 1792 + (n0 - 2048) : 2560 + (n0 - 2304)));
            transpose_item(F.a_w_in(), A_PROJ, D, F.WINT(), dr, 64 * kb, n0, scr, lane); continue; }
        r -= J2;
        if (r < J3) { const int kb = r >> 4, nb = r & 15; transpose_item(F.a_w_out(), D, D, F.WAOT(), 64 * nb, 64 * kb, 64 * nb, scr, lane); continue; }
        r -= J3;
        if (r < J3) { const int kb = r >> 4, nb = r & 15; transpose_item(F.b_w_q(), D, D, F.WBQT(), 64 * nb, 64 * kb, 64 * nb, scr, lane); continue; }
        r -= J3;
        if (r < J3) { const int kb = r >> 4, nb = r & 15; transpose_item(F.b_w_out(), D, D, F.WBOT(), 64 * nb, 64 * kb, 64 * nb, scr, lane); continue; }
        r -= J3;
        if (r < J6) { const int kb = r >> 2, nb = r & 3; transpose_item(F.kv_w(), 256, D, F.WKVT(), 64 * nb, 64 * kb, 64 * nb, scr, lane); continue; }
        r -= J6;
        if (r < J7) { const int kv = r >> 6, q = r & 63, kb = q >> 1, nb = q & 1;
            transpose_item(F.cmp_w1() + (size_t)kv * 2048 * 128, 128, 2048, F.CW1T() + (size_t)kv * 128 * 2048, 64 * nb, 64 * kb, 64 * nb, scr, lane); continue; }
        r -= J7;
        { const int kv = r >> 1, kb = r & 1;
            transpose_item(F.cmp_w2() + (size_t)kv * 128 * 64, 64, 128, F.CW2T() + (size_t)kv * 64 * 128, 0, 64 * kb, 0, scr, lane); }
    }
}

DI void load_mod(const float* g, const float* scale, const float* shift, int lane, f32x4 (&A)[4], f32x4 (&Bv)[4]) {
#pragma unroll
    for (int j = 0; j < 4; ++j) { const int c = 4 * lane + 256 * j;
        const f32x4 gg = *(const f32x4*)(g + c), sc = *(const f32x4*)(scale + c), sh = *(const f32x4*)(shift + c);
        A[j] = gg * (sc + 1.f); Bv[j] = sh; }
}
DI float row_ss(const f32x4 (&v)[4]) {
    float s = 0.f;
#pragma unroll
    for (int j = 0; j < 4; ++j) s += (v[j].x * v[j].x + v[j].y * v[j].y) + (v[j].z * v[j].z + v[j].w * v[j].w);
    return wave_sum(s);
}
DI void store_bf16_row(bf16_t* dst, int lane, const f32x4 (&y)[4]) {
#pragma unroll
    for (int j = 0; j < 4; ++j) { u32x2 o; o.x = pk2(y[j].x, y[j].y); o.y = pk2(y[j].z, y[j].w); *(u32x2*)(dst + 4 * lane + 256 * j) = o; }
}

DI f32x4 modsum(const float* modp, size_t flat, const float* bias4) {
    f32x4 s = *(const f32x4*)bias4, p[8];
#pragma unroll
    for (int seg = 0; seg < 8; ++seg) p[seg] = *(const f32x4*)(modp + (size_t)seg * MODN + flat);
    __builtin_amdgcn_sched_barrier(0);
#pragma unroll
    for (int seg = 0; seg < 8; ++seg) s = s + p[seg];
    return s;
}
DI void modsum2(const float* modp, size_t flatA, const float* biasA, size_t flatB, const float* biasB, f32x4& ra, f32x4& rb) {
    f32x4 sa = *(const f32x4*)biasA, sb = *(const f32x4*)biasB, pa[8], pb[8];
#pragma unroll
    for (int seg = 0; seg < 8; ++seg) { pa[seg] = *(const f32x4*)(modp + (size_t)seg * MODN + flatA); pb[seg] = *(const f32x4*)(modp + (size_t)seg * MODN + flatB); }
    __builtin_amdgcn_sched_barrier(0);
#pragma unroll
    for (int seg = 0; seg < 8; ++seg) { sa = sa + pa[seg]; sb = sb + pb[seg]; }
    asm volatile("" : "+v"(sa), "+v"(sb) :: "memory");
    ra = sa; rb = sb;
}
constexpr int NP_GSTRIDE = 2064;
DI void norm_plain_phase(Frame& F) {
    const int gw = F.bx * NWAVES + F.wave, lane = F.lane, b = gw >> 7;
    {
        u32x4 gv[12];
#pragma unroll
        for (int it = 0; it < 12; ++it) { const int idx = F.tid + it * NTHR, row = idx >> 7, ch = idx & 127; gv[it] = *(const u32x4*)(F.WINT() + (size_t)(2048 + row) * D + ch * 8); }
#pragma unroll
        for (int it = 0; it < 12; ++it) { const int idx = F.tid + it * NTHR, row = idx >> 7, ch = idx & 127; *(LAS u32x4*)(F.lds + row * NP_GSTRIDE + ch * 16) = gv[it]; }
    }
    __syncthreads();
    f32x4 A[4], Bv[4];
#pragma unroll
    for (int j = 0; j < 4; ++j) { const int c = 4 * lane + 256 * j;
        const f32x4 gg = *(const f32x4*)(F.norm_g() + c); f32x4 sc, sh;
        modsum2(F.MODP(), (size_t)b * 3072 + 1024 + c, F.mod_b() + 1024 + c, (size_t)b * 3072 + c, F.mod_b() + c, sc, sh);
        A[j] = gg * (sc + 1.f); Bv[j] = sh; }
    if (F.tid < 224) { const size_t flat = ((size_t)F.bx * 224 + F.tid) * 4;
        const float* bias4 = flat < (size_t)4 * 16 * 3072 ? F.mod_b() + (flat / (16 * 3072)) * 3072 + (flat % 3072) : F.kv_mod_b() + ((flat - (size_t)4 * 16 * 3072) % 2048);
        *(f32x4*)(F.MODV() + flat) = modsum(F.MODP(), flat, bias4); }
    for (int rr = 0; rr < 16; ++rr) {
        const size_t row = (size_t)gw * 16 + rr;
        f32x4 v[4];
#pragma unroll
        for (int j = 0; j < 4; ++j) v[j] = *(const f32x4*)(F.x() + row * D + 4 * lane + 256 * j);
        const float rstd = 1.0f / sqrtf(row_ss(v) * (1.f / D) + NORM_EPS);
        f32x4 y[4];
#pragma unroll
        for (int j = 0; j < 4; ++j) y[j] = v[j] * rstd * A[j] + Bv[j];
        store_bf16_row(F.HN() + row * D, lane, y);
    }
    asm volatile("s_waitcnt vmcnt(0)" ::: "memory");
    {
        const int l2 = fresh_lane(), fr = l2 & 15, fq = l2 >> 4;
        const bf16_t* arow = F.HN() + ((size_t)gw * 16 + fr) * D + 8 * fq;
        const LAS unsigned char* bimg = F.lds + fr * NP_GSTRIDE + fq * 16;
        f32x4 g0 = {0.f, 0.f, 0.f, 0.f}, g1 = g0, g2 = g0;
#pragma unroll 8
        for (int kk = 0; kk < 32; ++kk) {
            const bf16x8 a = *(const bf16x8*)(arow + 32 * kk);
            const bf16x8 b0 = *(const LAS bf16x8*)(bimg + kk * 64), b1 = *(const LAS bf16x8*)(bimg + 16 * NP_GSTRIDE + kk * 64), b2 = *(const LAS bf16x8*)(bimg + 32 * NP_GSTRIDE + kk * 64);
            g0 = __builtin_amdgcn_mfma_f32_16x16x32_bf16(a, b0, g0, 0, 0, 0); g1 = __builtin_amdgcn_mfma_f32_16x16x32_bf16(a, b1, g1, 0, 0, 0); g2 = __builtin_amdgcn_mfma_f32_16x16x32_bf16(a, b2, g2, 0, 0, 0);
        }
        float* gp = F.GATES() + ((size_t)gw * 16 + 4 * fq) * 64 + fr;
#pragma unroll
        for (int i = 0; i < 4; ++i) { gp[i * 64] = rcpf(1.f + ex2(-g0[i] * LOG2E)); gp[i * 64 + 16] = rcpf(1.f + ex2(-g1[i] * LOG2E)); gp[i * 64 + 32] = rcpf(1.f + ex2(-g2[i] * LOG2E)); }
    }
}

constexpr int RT_IMG = 0, RT_LGS = 147456, RT_PE = 151552, RT_PW = 153600, RT_LCNT = 155648, RT_LBASE = 155776;

DI void norm_router_phase(Frame& F, int layer) {
    const int gw = F.bx * NWAVES + F.wave, lane = F.lane, tid = F.tid, b = gw >> 7;
    LAS float* img = (LAS float*)(F.lds + RT_IMG);
    LAS float* lgs = (LAS float*)(F.lds + RT_LGS) + F.wave * 128;
    LAS unsigned* pend_e = (LAS unsigned*)(F.lds + RT_PE);
    LAS float* pend_w = (LAS float*)(F.lds + RT_PW);
    LAS unsigned* lcnt = (LAS unsigned*)(F.lds + RT_LCNT);
    LAS unsigned* lbase = (LAS unsigned*)(F.lds + RT_LBASE);
    const float* rw = F.router_w() + (size_t)layer * D * NEXP;
#pragma unroll
    for (int it = 0; it < (D * NEXP / 4) / NTHR; ++it) { const int idx = tid + it * NTHR, col = idx >> 3, e4 = idx & 7;
        const int rho = (col & 3) * 64 + ((col >> 2) & 63) + 256 * (col >> 8); *(LAS f32x4*)(img + rho * 36 + 4 * e4) = *(const f32x4*)(rw + 4 * idx); }
    if (tid < 32) lcnt[tid] = 0u;
    __syncthreads();
    const int set = layer * 2 + 1;
    const float* mv = F.MODV() + ((size_t)set * 16 + b) * 3072;
    f32x4 A[4], Bv[4]; load_mod(F.norm_g() + (layer * 2 + 1) * D, mv + 1024, mv, lane, A, Bv);
    const float* rb = F.router_b() + layer * NEXP;
    for (int rp = 0; rp < 4; ++rp) {
        const size_t row0 = (size_t)gw * 16 + rp * 4;
        f32x4 y[4][4];
        {
            f32x4 v[4][4];
#pragma unroll
            for (int rr = 0; rr < 4; ++rr)
#pragma unroll
                for (int j = 0; j < 4; ++j) v[rr][j] = *(const f32x4*)(F.H() + (row0 + rr) * D + 4 * lane + 256 * j);
#pragma unroll
            for (int rr = 0; rr < 4; ++rr) { const float rs = 1.0f / sqrtf(row_ss(v[rr]) * (1.f / D) + NORM_EPS);
#pragma unroll
                for (int j = 0; j < 4; ++j) y[rr][j] = v[rr][j] * rs * A[j] + Bv[j]; }
        }
#pragma unroll
        for (int rr = 0; rr < 4; ++rr) store_bf16_row(F.HN() + (row0 + rr) * D, lane, y[rr]);
#pragma unroll 1
        for (int half = 0; half < 2; ++half) {
            float l0[32], l1[32];
            {
                typedef float f32x2 __attribute__((ext_vector_type(2)));
                f32x2 L[4][8];
#pragma unroll
                for (int rr = 0; rr < 4; ++rr)
#pragma unroll
                    for (int e = 0; e < 8; ++e) L[rr][e] = (f32x2){0.f, 0.f};
#pragma unroll
                for (int j = 0; j < 4; ++j)
#pragma unroll
                    for (int i = 0; i < 4; ++i) {
                        const f32x2 A0 = {y[0][j][i], y[0][j][i]}, A1 = {y[1][j][i], y[1][j][i]}, A2 = {y[2][j][i], y[2][j][i]}, A3 = {y[3][j][i], y[3][j][i]};
                        const LAS f32x4* wp = (const LAS f32x4*)(img + (i * 64 + lane + 256 * j) * 36 + 16 * half);
#pragma unroll
                        for (int e4 = 0; e4 < 4; ++e4) { const f32x4 w = wp[e4]; const f32x2 wl = {w.x, w.y}, wh = {w.z, w.w};
                            L[0][2 * e4] = __builtin_elementwise_fma(A0, wl, L[0][2 * e4]); L[0][2 * e4 + 1] = __builtin_elementwise_fma(A0, wh, L[0][2 * e4 + 1]);
                            L[1][2 * e4] = __builtin_elementwise_fma(A1, wl, L[1][2 * e4]); L[1][2 * e4 + 1] = __builtin_elementwise_fma(A1, wh, L[1][2 * e4 + 1]);
                            L[2][2 * e4] = __builtin_elementwise_fma(A2, wl, L[2][2 * e4]); L[2][2 * e4 + 1] = __builtin_elementwise_fma(A2, wh, L[2][2 * e4 + 1]);
                            L[3][2 * e4] = __builtin_elementwise_fma(A3, wl, L[3][2 * e4]); L[3][2 * e4 + 1] = __builtin_elementwise_fma(A3, wh, L[3][2 * e4 + 1]); }
                    }
#pragma unroll
                for (int rr = 0; rr < 2; ++rr)
#pragma unroll
                    for (int e = 0; e < 8; ++e) { l0[16 * rr + 2 * e] = L[rr][e].x; l0[16 * rr + 2 * e + 1] = L[rr][e].y; l1[16 * rr + 2 * e] = L[2 + rr][e].x; l1[16 * rr + 2 * e + 1] = L[2 + rr][e].y; }
            }
#define RS_STEP(N, OFF) { const bool up = (lane & (OFF)) != 0; _Pragma("unroll") for (int k = 0; k < (N); ++k) { \
                const float s0 = up ? l0[k] : l0[k + (N)], k0 = up ? l0[k + (N)] : l0[k]; l0[k] = k0 + shx<(OFF)>(s0, lane); \
                const float s1 = up ? l1[k] : l1[k + (N)], k1 = up ? l1[k + (N)] : l1[k]; l1[k] = k1 + shx<(OFF)>(s1, lane); } }
            RS_STEP(16, 32) RS_STEP(8, 16) RS_STEP(4, 8) RS_STEP(2, 4) RS_STEP(1, 2)
#undef RS_STEP
            const float g0 = l0[0] + shx<1>(l0[0], lane), g1 = l1[0] + shx<1>(l1[0], lane);
            const int idx = lane >> 1, rr = idx >> 4, e_own = (idx & 15) + 16 * half; const float rbv = rb[e_own];
            if ((lane & 1) == 0) { lgs[rr * 32 + e_own] = g0 + rbv; lgs[(2 + rr) * 32 + e_own] = g1 + rbv; }
        }
        LDS_WAIT(); asm volatile("" ::: "memory");
        if (lane < 4) {
            float v[32];
#pragma unroll
            for (int e = 0; e < 32; ++e) v[e] = lgs[lane * 32 + e];
            float tv[4]; int ti[4];
#pragma unroll
            for (int k = 0; k < 4; ++k) {
                float best = -INFINITY; int bi = 0;
#pragma unroll
                for (int e = 0; e < 32; ++e) { const bool gt = v[e] > best; best = gt ? v[e] : best; bi = gt ? e : bi; }
                tv[k] = best; ti[k] = bi;
#pragma unroll
                for (int e = 0; e < 32; ++e) v[e] = (e == bi) ? -INFINITY : v[e];
            }
            const float e1 = __expf(tv[1] - tv[0]), e2 = __expf(tv[2] - tv[0]), e3 = __expf(tv[3] - tv[0]);
            const float inv = 1.f / (1.f + e1 + e2 + e3);
            const float w[4] = {inv, e1 * inv, e2 * inv, e3 * inv};
            const int tl = F.wave * 16 + rp * 4 + lane;
#pragma unroll
            for (int k = 0; k < 4; ++k) {
                const unsigned pl = __hip_atomic_fetch_add(lcnt + ti[k], 1u, __ATOMIC_RELAXED, __HIP_MEMORY_SCOPE_WORKGROUP);
                pend_e[tl * 4 + k] = ((unsigned)ti[k] << 16) | pl; pend_w[tl * 4 + k] = w[k];
            }
        }
        LDS_WAIT(); asm volatile("" ::: "memory");
    }
    __syncthreads();
    unsigned* gcnt = F.ctl() + CW_CNT + 64 * layer;
    if (tid < 32) lbase[tid] = __hip_atomic_fetch_add(gcnt + tid, lcnt[tid], __ATOMIC_RELAXED, __HIP_MEMORY_SCOPE_AGENT);
    __syncthreads();
    {
        const int tl = tid >> 2, k = tid & 3; const unsigned pe = pend_e[tid]; const unsigned e = pe >> 16, pos = lbase[e] + (pe & 0xffffu);
        const unsigned token = (unsigned)(F.bx * 128 + tl);
        F.LIST()[(size_t)e * T + pos] = token; F.LISTW()[(size_t)e * T + pos] = pend_w[tid]; F.TOKSLOT()[(size_t)token * 4 + k] = (e << 16) | pos;
    }
    __syncthreads();
}

DI void load_expert_tables(Frame& F, int layer, int npn) {
    LAS unsigned* ext = (LAS unsigned*)(F.lds + EXT_OFF);
    if (F.tid < 32) ext[F.tid] = __hip_atomic_load(F.ctl() + CW_CNT + 64 * layer + F.tid, __ATOMIC_RELAXED, __HIP_MEMORY_SCOPE_AGENT);
    __syncthreads();
    if (F.tid == 0) { unsigned o = 0, u = 0; for (int e = 0; e < 32; ++e) { const unsigned c = ext[e]; ext[32 + e] = o; ext[64 + e] = u; o += c; u += ((c + 255u) >> 8) * (unsigned)npn; } ext[96] = u; }
    __syncthreads();
}

template <bool FINAL> DI void combine_phase(Frame& F, int layer) {
    load_expert_tables(F, layer, 1);
    const LAS unsigned* offs = (const LAS unsigned*)(F.lds + EXT_OFF) + 32;
    const int gw = F.bx * NWAVES + F.wave, lane = F.lane, b = gw >> 7;
    const float* gate = F.MODV() + ((size_t)(layer * 2 + 1) * 16 + b) * 3072 + 2048;
    f32x4 G[4];
#pragma unroll
    for (int j = 0; j < 4; ++j) G[j] = *(const f32x4*)(gate + 4 * lane + 256 * j);
    f32x4 A1[4], B1[4], A2[4], B2[4];
    if (FINAL) {
#pragma unroll
        for (int j = 0; j < 4; ++j) A1[j] = *(const f32x4*)(F.final_g() + 4 * lane + 256 * j);
    } else {
        const float* m2 = F.MODV() + ((size_t)2 * 16 + b) * 3072; load_mod(F.norm_g() + 2 * D, m2 + 1024, m2, lane, A1, B1);
        const float* m4 = F.MODV() + (size_t)4 * 16 * 3072 + (size_t)b * 2048; load_mod(F.kv_norm_g(), m4 + 1024, m4, lane, A2, B2);
    }
    for (int rr = 0; rr < 16; ++rr) {
        const size_t row = (size_t)gw * 16 + rr;
        const u32x4 ts = *(const u32x4*)(F.TOKSLOT() + row * 4);
        const unsigned sl[4] = {offs[ts.x >> 16] + (ts.x & 0xffffu), offs[ts.y >> 16] + (ts.y & 0xffffu), offs[ts.z >> 16] + (ts.z & 0xffffu), offs[ts.w >> 16] + (ts.w & 0xffffu)};
        f32x4 y[4];
#pragma unroll
        for (int j = 0; j < 4; ++j) y[j] = (f32x4){0.f, 0.f, 0.f, 0.f};
#pragma unroll
        for (int k = 0; k < 4; ++k)
#pragma unroll
            for (int j = 0; j < 4; ++j) { const u32x2 o = *(const u32x2*)(F.OUTB() + (size_t)sl[k] * D + 4 * lane + 256 * j);
                y[j].x += bf_lo(o.x); y[j].y += bf_hi(o.x); y[j].z += bf_lo(o.y); y[j].w += bf_hi(o.y); }
        f32x4 h[4];
#pragma unroll
        for (int j = 0; j < 4; ++j) h[j] = *(const f32x4*)(F.H() + row * D + 4 * lane + 256 * j) + G[j] * y[j];
        const float rstd = 1.0f / sqrtf(row_ss(h) * (1.f / D) + NORM_EPS);
        if (FINAL) {
#pragma unroll
            for (int j = 0; j < 4; ++j) *(f32x4*)(F.out() + row * D + 4 * lane + 256 * j) = h[j] * rstd * A1[j];
        } else {
#pragma unroll
            for (int j = 0; j < 4; ++j) *(f32x4*)(F.H() + row * D + 4 * lane + 256 * j) = h[j];
            f32x4 ya[4], yb[4];
#pragma unroll
            for (int j = 0; j < 4; ++j) { const f32x4 n = h[j] * rstd; ya[j] = n * A1[j] + B1[j]; yb[j] = n * A2[j] + B2[j]; }
            store_bf16_row(F.HN() + row * D, lane, ya); store_bf16_row(F.HN2() + row * D, lane, yb);
        }
    }
}
namespace pg8 {
constexpr int BM = 256, BK = 64, HALF = 128, HTB = HALF * BK * 2, STAGE_BYTES = 8 * HTB, KD = 1024;
DI int lds_byte(int r, int c) { const int st = (r >> 4) * 2 + (c >> 5), rr = r & 15, cc = c & 31, ob = rr * 64 + cc * 2; return st * 1024 + (ob ^ (((ob >> 9) & 1) << 5)); }
DI void stage_rc(int b, int& R, int& C) { const int st = b / 1024, sb = b % 1024, swz = sb ^ (((sb >> 9) & 1) << 5); R = (st >> 1) * 16 + swz / 64; C = (st & 1) * 32 + (swz % 64) / 2; }
DI int perm32(int rho) { const int n = rho >> 4, i = rho & 15; return 8 * (i >> 2) + 4 * n + (i & 3); }

struct Unit {
    const char* A;
    const char* B0;
    unsigned bh;
    int type, r0, c0, nvalid, aux;
};

template <class Pol>
DI void gemm_phase(LAS unsigned char* lds, const Pol& P, int wave_id, int lane_id) {
    const int wid = wave_id, lane = lane_id, tid = wid * 64 + lane, wr = wid >> 2, wc = wid & 3, fr = lane & 15, fq = lane >> 4;
    constexpr int K = KD, nt = K / BK;
    unsigned voffB[2];
#pragma unroll
    for (int i = 0; i < 2; ++i) { int R, C; stage_rc(tid * 16 + i * 8192, R, C); const int Rb = Pol::PERM ? ((R & ~31) + perm32(R & 31)) : R; voffB[i] = (unsigned)(Rb * K + C) * 2u; }
    const size_t kstep = (size_t)(BK * 2);
    const unsigned ldsw = (unsigned)wid * 1024u;
    const int aoff = lds_byte(wr * 64 + fr, fq * 8), boff = lds_byte(wc * 32 + fr, fq * 8);
#define PG8_SA(b, h) (((b) * 2 + (h)) * HTB)
#define PG8_SB(b, h) ((4 + (b) * 2 + (h)) * HTB)
#define PG8_STAGE_A(bufoff, gbase, va, h) do { _Pragma("unroll") for (int _i = 0; _i < 2; ++_i) \
        __builtin_amdgcn_global_load_lds((const unsigned*)((const char*)(gbase) + (va)[h][_i]), (LAS unsigned*)(lds + (bufoff) + ldsw + _i * 8192), 16, 0, 0); } while (0)
#define PG8_STAGE_B(bufoff, gbase) do { _Pragma("unroll") for (int _i = 0; _i < 2; ++_i) \
        __builtin_amdgcn_global_load_lds((const unsigned*)((const char*)(gbase) + voffB[_i]), (LAS unsigned*)(lds + (bufoff) + ldsw + _i * 8192), 16, 0, 0); } while (0)
#define PG8_LDA(dst, b, h) do { _Pragma("unroll") for (int m = 0; m < 4; ++m) _Pragma("unroll") for (int k = 0; k < 2; ++k) dst[m][k] = *(const LAS bf16x8*)(lds + PG8_SA(b, h) + aoff + m * 2048 + k * 1024); } while (0)
#define PG8_LDB(dst, b, h) do { _Pragma("unroll") for (int n = 0; n < 2; ++n) _Pragma("unroll") for (int k = 0; k < 2; ++k) dst[n][k] = *(const LAS bf16x8*)(lds + PG8_SB(b, h) + boff + n * 2048 + k * 1024); } while (0)
#define PG8_MMA(ai, bj, At, Bt) do { __builtin_amdgcn_s_setprio(1); _Pragma("unroll") for (int m = 0; m < 4; ++m) _Pragma("unroll") for (int n = 0; n < 2; ++n) _Pragma("unroll") for (int k = 0; k < 2; ++k) \
        acc[ai][bj][m][n] = __builtin_amdgcn_mfma_f32_16x16x32_bf16(Bt[n][k], At[m][k], acc[ai][bj][m][n], 0, 0, 0); __builtin_amdgcn_s_setprio(0); } while (0)
#define PG8_WAIT_V(n) asm volatile("s_waitcnt vmcnt(" #n ")" ::: "memory")
#define PG8_WAIT_L(n) asm volatile("s_waitcnt lgkmcnt(" #n ")" ::: "memory")
#define PG8_BAR __builtin_amdgcn_s_barrier()
#define PG8_SCHED __builtin_amdgcn_sched_barrier(0)
    Unit cur, nxt; int ui = 0; int pub_e = -1, pub_mt = 0;
    if (!P.next(0, cur)) return;
    unsigned vaC[2][2], vaN[2][2];
    P.aoff(cur, wid * 64, tid, vaC);
    bool has_next = P.next(1, nxt);
    if (has_next) P.aoff(nxt, wid * 64, tid, vaN);
    else { vaN[0][0] = vaC[0][0]; vaN[0][1] = vaC[0][1]; vaN[1][0] = vaC[1][0]; vaN[1][1] = vaC[1][1]; }
    if constexpr (Pol::COUNTED) __syncthreads();
    if (Pol::GATHER) asm volatile("" : "+v"(vaC[0][0]), "+v"(vaC[0][1]), "+v"(vaC[1][0]), "+v"(vaC[1][1]), "+v"(vaN[0][0]), "+v"(vaN[0][1]), "+v"(vaN[1][0]), "+v"(vaN[1][1]));
    f32x4 acc[2][2][4][2];
    { const int l2 = fresh_lane(); P.init(acc, cur, wr, wc, l2 & 15, l2 >> 4); }
    bf16x8 At[4][2], B0[2][2], B1[2][2];
    const char* cA = cur.A; const char* cB = cur.B0; unsigned cbh = cur.bh;
    PG8_STAGE_B(PG8_SB(0, 0), cB); PG8_STAGE_A(PG8_SA(0, 0), cA, vaC, 0); PG8_STAGE_B(PG8_SB(0, 1), cB + cbh); PG8_STAGE_A(PG8_SA(0, 1), cA, vaC, 1);
    if (wr == 1) PG8_BAR;
    PG8_WAIT_V(4); PG8_BAR;
    PG8_STAGE_B(PG8_SB(1, 0), cB + kstep); PG8_STAGE_A(PG8_SA(1, 0), cA + kstep, vaC, 0); PG8_STAGE_B(PG8_SB(1, 1), cB + cbh + kstep);
    PG8_WAIT_V(6); PG8_BAR;
    for (;;) {
        const char* nA = has_next ? nxt.A : cA; const char* nB = has_next ? nxt.B0 : cB; const unsigned nbh = has_next ? nxt.bh : cbh;
        for (int t = 0; t < nt; t += 2) {
            const bool last = (t == nt - 2);
            const char* a1 = cA + (size_t)(t + 1) * kstep;
            const char* a2 = last ? nA : cA + (size_t)(t + 2) * kstep; const char* b2 = last ? nB : cB + (size_t)(t + 2) * kstep;
            const char* a3 = a2 + kstep; const char* b3 = b2 + kstep;
            const unsigned bh2 = last ? nbh : cbh;
            unsigned va2[2][2];
            if (Pol::GATHER) { va2[0][0] = last ? vaN[0][0] : vaC[0][0]; va2[0][1] = last ? vaN[0][1] : vaC[0][1]; va2[1][0] = last ? vaN[1][0] : vaC[1][0]; va2[1][1] = last ? vaN[1][1] : vaC[1][1]; }
            else { va2[0][0] = vaC[0][0]; va2[0][1] = vaC[0][1]; va2[1][0] = vaC[1][0]; va2[1][1] = vaC[1][1]; }
            PG8_LDB(B0, 0, 0); PG8_SCHED; PG8_LDA(At, 0, 0); PG8_STAGE_A(PG8_SA(1, 1), a1, vaC, 1);
            PG8_WAIT_L(8); PG8_BAR; PG8_WAIT_L(0); PG8_MMA(0, 0, At, B0); PG8_BAR; PG8_SCHED;
            PG8_LDB(B1, 0, 1); PG8_STAGE_B(PG8_SB(0, 0), b2);
            PG8_BAR; PG8_WAIT_L(0); PG8_MMA(0, 1, At, B1); PG8_BAR;
            PG8_LDA(At, 0, 1); PG8_STAGE_A(PG8_SA(0, 0), a2, va2, 0);
            PG8_BAR; PG8_WAIT_L(0); PG8_MMA(1, 0, At, B0); PG8_BAR; PG8_SCHED;
            PG8_STAGE_B(PG8_SB(0, 1), b2 + bh2);
            PG8_WAIT_V(6); PG8_BAR; PG8_MMA(1, 1, At, B1); PG8_BAR;
            PG8_LDB(B0, 1, 0); PG8_SCHED; PG8_LDA(At, 1, 0); PG8_STAGE_A(PG8_SA(0, 1), a2, va2, 1);
            PG8_WAIT_L(8); PG8_BAR; PG8_WAIT_L(0); PG8_MMA(0, 0, At, B0); PG8_BAR; PG8_SCHED;
            PG8_LDB(B1, 1, 1); PG8_STAGE_B(PG8_SB(1, 0), b3);
            PG8_BAR; PG8_WAIT_L(0); PG8_MMA(0, 1, At, B1); PG8_BAR;
            PG8_LDA(At, 1, 1); PG8_STAGE_A(PG8_SA(1, 0), a3, va2, 0);
            PG8_BAR; PG8_WAIT_L(0); PG8_MMA(1, 0, At, B0); PG8_BAR; PG8_SCHED;
            PG8_STAGE_B(PG8_SB(1, 1), b3 + bh2);
            PG8_WAIT_V(6); PG8_BAR; PG8_MMA(1, 1, At, B1); PG8_BAR;
        }
        if constexpr (Pol::GATHER) {
            Unit nn; bool has_nn = false; unsigned tokNN[2][2] = {{0u, 0u}, {0u, 0u}};
            if (has_next) { has_nn = P.next(ui + 2, nn); if (has_nn) P.aoff_load(nn, wid * 64, tokNN); }
            f32x4 bvN[4] = {};
            if (has_next) P.bias_load(nxt, wc, fresh_lane() >> 4, bvN);
            if constexpr (Pol::PUBLISH) { if (pub_e >= 0) P.publish(pub_e, pub_mt); pub_e = cur.aux; pub_mt = cur.type; }
            { const int l2 = fresh_lane(); P.epi(acc, cur, wr, wc, l2 & 15, l2 >> 4); }
            if (!has_next) break;
            { _Pragma("unroll") for (int a_ = 0; a_ < 2; ++a_) _Pragma("unroll") for (int m_ = 0; m_ < 4; ++m_) { acc[a_][0][m_][0] = bvN[0]; acc[a_][0][m_][1] = bvN[1]; acc[a_][1][m_][0] = bvN[2]; acc[a_][1][m_][1] = bvN[3]; } }
            cur = nxt; cA = nA; cB = nB; cbh = nbh; ++ui;
            vaC[0][0] = vaN[0][0]; vaC[0][1] = vaN[0][1]; vaC[1][0] = vaN[1][0]; vaC[1][1] = vaN[1][1];
            has_next = has_nn; nxt = nn;
            asm volatile("" : "+v"(tokNN[0][0]), "+v"(tokNN[0][1]), "+v"(tokNN[1][0]), "+v"(tokNN[1][1]));
            if (has_next) { P.aoff_calc(wid * 64, tokNN, vaN); asm volatile("" : "+v"(vaN[0][0]), "+v"(vaN[0][1]), "+v"(vaN[1][0]), "+v"(vaN[1][1])); }
        } else {
            f32x4 bvN[4] = {};
            if constexpr (Pol::PREBIAS) { if (has_next) P.bias_load(nxt, wc, fresh_lane() >> 4, bvN); }
            { const int l2 = fresh_lane(); P.epi(acc, cur, wr, wc, l2 & 15, l2 >> 4); }
            if (!has_next) break;
            if constexpr (Pol::PREBIAS) { _Pragma("unroll") for (int a_ = 0; a_ < 2; ++a_) _Pragma("unroll") for (int m_ = 0; m_ < 4; ++m_) { acc[a_][0][m_][0] = bvN[0]; acc[a_][0][m_][1] = bvN[1]; acc[a_][1][m_][0] = bvN[2]; acc[a_][1][m_][1] = bvN[3]; } }
            else { const int l2 = fresh_lane(); P.init(acc, nxt, wr, wc, l2 & 15, l2 >> 4); }
            cur = nxt; cA = nA; cB = nB; cbh = nbh; ++ui;
            vaC[0][0] = vaN[0][0]; vaC[0][1] = vaN[0][1]; vaC[1][0] = vaN[1][0]; vaC[1][1] = vaN[1][1];
            has_next = P.next(ui + 1, nxt);
            if (has_next) P.aoff(nxt, wid * 64, tid, vaN);
        }
    }
    PG8_WAIT_V(0);
    if constexpr (Pol::PUBLISH) { if (pub_e >= 0) P.publish(pub_e, pub_mt); }
    if (wr == 0) PG8_BAR;
    PG8_BAR;
#undef PG8_SA
#undef PG8_SB
#undef PG8_STAGE_A
#undef PG8_STAGE_B
#undef PG8_LDA
#undef PG8_LDB
#undef PG8_MMA
#undef PG8_WAIT_V
#undef PG8_WAIT_L
#undef PG8_BAR
#undef PG8_SCHED
}
DI void aoff_std(int tid, unsigned (&va)[2][2]) {
#pragma unroll
    for (int i = 0; i < 2; ++i) { int R, C; stage_rc(tid * 16 + i * 8192, R, C);
#pragma unroll
        for (int h = 0; h < 2; ++h) va[h][i] = (unsigned)((h * HALF + R) * KD + C) * 2u; }
}
}

DI float vmin_raw(float x, float hi) { float r; asm("v_min_f32 %0, %1, %2" : "=v"(r) : "v"(x), "v"(hi)); return r; }
DI float vmed3_raw(float x, float lo, float hi) { float r; asm("v_med3_f32 %0, %1, %2, %3" : "=v"(r) : "v"(x), "v"(lo), "v"(hi)); return r; }
typedef f32x4 AccT[2][2][4][2];
DI void acc_zero(AccT& acc) {
#pragma unroll
    for (int a = 0; a < 2; ++a)
#pragma unroll
        for (int b = 0; b < 2; ++b)
#pragma unroll
            for (int m = 0; m < 4; ++m)
#pragma unroll
                for (int n = 0; n < 2; ++n) acc[a][b][m][n] = (f32x4){0.f, 0.f, 0.f, 0.f};
}
DI void acc_colbias(AccT& acc, const f32x4& b00, const f32x4& b01, const f32x4& b10, const f32x4& b11) {
#pragma unroll
    for (int a = 0; a < 2; ++a)
#pragma unroll
        for (int m = 0; m < 4; ++m) { acc[a][0][m][0] = b00; acc[a][0][m][1] = b01; acc[a][1][m][0] = b10; acc[a][1][m][1] = b11; }
}

struct RopeRow { f32x4 c0, c1, s0, s1; };
DI RopeRow rope_load(const float* rope_row) { RopeRow q; q.c0 = *(const f32x4*)(rope_row); q.c1 = *(const f32x4*)(rope_row + 4); q.s0 = *(const f32x4*)(rope_row + 8); q.s1 = *(const f32x4*)(rope_row + 12); return q; }
DI void rope8(f32x4& v0, f32x4& v1, const RopeRow& q, int fq) {
    const f32x4 c0 = q.c0, c1 = q.c1, s0 = q.s0, s1 = q.s1;
    f32x4 p0, p1;
#pragma unroll
    for (int i = 0; i < 4; ++i) { p0[i] = shx<16>(v0[i], 0); p1[i] = shx<16>(v1[i], 0); }
    const float sg = (fq == 0) ? -1.f : 1.f;
    v0 = v0 * c0 + p0 * (s0 * sg); v1 = v1 * c1 + p1 * (s1 * sg);
}
DI void store8_bf16(bf16_t* p, const f32x4& v0, const f32x4& v1) {
    u32x4 w; w.x = pk2(v0[0], v0[1]); w.y = pk2(v0[2], v0[3]); w.z = pk2(v1[0], v1[1]); w.w = pk2(v1[2], v1[3]); *(u32x4*)p = w;
}
constexpr int ST_OFF = 131072, ST_STRIDE = 528;
DI void st_realign(int wr) { if (wr == 0) __builtin_amdgcn_s_barrier(); }
DI void st_restagger(int wr) { if (wr == 1) __builtin_amdgcn_s_barrier(); }
DI void st_put(LAS unsigned char* lds, int rowl, int colb, const f32x4& v0, const f32x4& v1) {
    u32x4 w; w.x = pk2(v0[0], v0[1]); w.y = pk2(v0[2], v0[3]); w.z = pk2(v1[0], v1[1]); w.w = pk2(v1[2], v1[3]);
    *(LAS u32x4*)(lds + ST_OFF + rowl * ST_STRIDE + colb) = w;
}
template <int ROWB, bool CHECK = true> DI void st_flush(LAS unsigned char* lds, int tid, bf16_t* out_pass, size_t ld, int nvalid_rel) {
    asm volatile("s_waitcnt lgkmcnt(0)" ::: "memory"); __builtin_amdgcn_s_barrier(); asm volatile("" ::: "memory");
    if (ROWB == 512) {
#pragma unroll
        for (int k = 0; k < 2; ++k) { const int rowl = (tid >> 5) + 16 * k, c = tid & 31, rel = 64 * (rowl >> 4) + (rowl & 15);
            const u32x4 v = *(const LAS u32x4*)(lds + ST_OFF + rowl * ST_STRIDE + c * 16);
            if (!CHECK || rel < nvalid_rel) *(u32x4*)(out_pass + (size_t)rel * ld + c * 8) = v; }
    } else {
        const int rowl = tid >> 4, c = tid & 15, rel = 64 * (rowl >> 4) + (rowl & 15);
        const u32x4 v = *(const LAS u32x4*)(lds + ST_OFF + rowl * ST_STRIDE + c * 16);
        if (!CHECK || rel < nvalid_rel) *(u32x4*)(out_pass + (size_t)rel * ld + c * 8) = v;
    }
    asm volatile("s_waitcnt lgkmcnt(0)" ::: "memory"); __builtin_amdgcn_s_barrier(); asm volatile("" ::: "memory");
}

constexpr int ST_STRIDE_GU = 272;
DI void st_put_gu(LAS unsigned char* lds, int rowl, int colb, const f32x4& v0, const f32x4& v1) {
    u32x4 w; w.x = pk2(v0[0], v0[1]); w.y = pk2(v0[2], v0[3]); w.z = pk2(v1[0], v1[1]); w.w = pk2(v1[2], v1[3]);
    *(LAS u32x4*)(lds + ST_OFF + rowl * ST_STRIDE_GU + colb) = w;
}
DI void st_flush_gu(LAS unsigned char* lds, int tid, bf16_t* out_pass, size_t ld, int nvalid_rel) {
    asm volatile("s_waitcnt lgkmcnt(0)" ::: "memory"); __builtin_amdgcn_s_barrier(); asm volatile("" ::: "memory");
#pragma unroll
    for (int k = 0; k < 2; ++k) { const int rowl = (tid >> 4) + 32 * k, c = tid & 15, rel = 64 * ((rowl >> 4) & 1) + 16 * (rowl >> 5) + (rowl & 15);
        const u32x4 v = *(const LAS u32x4*)(lds + ST_OFF + rowl * ST_STRIDE_GU + c * 16);
        if (rel < nvalid_rel) { u32x4* gp_ = (u32x4*)(out_pass + (size_t)rel * ld + c * 8); asm volatile("global_store_dwordx4 %0, %1, off sc1" :: "v"(gp_), "v"(v) : "memory"); } }
    asm volatile("s_waitcnt lgkmcnt(0)" ::: "memory"); __builtin_amdgcn_s_barrier(); asm volatile("" ::: "memory");
}

struct PolProj0 {
    static constexpr bool PERM = true, GATHER = false, PREBIAS = false, COUNTED = false, PUBLISH = false;
    const bf16_t *HN, *WINT; bf16_t *Q, *KV, *VT; float* GATES; const float* ROPE; int vcu; LAS unsigned char* lds;
    DI bool next(int i, pg8::Unit& u) const {
        const int L = i * GRID + vcu; if (L >= 1280) return false;
        if (L < 1024) { const int pm = L >> 3, pn = L & 7; u.type = 0; u.A = (const char*)(HN + (size_t)pm * 256 * D); u.B0 = (const char*)(WINT + (size_t)pn * 256 * D); u.bh = 128 * D * 2; u.r0 = pm * 256; u.c0 = pn * 256; u.aux = pn; u.nvalid = 256; }
        else { const int l2 = L - 1024, pm = l2 >> 7, pn = l2 & 127; u.type = 1; u.A = (const char*)(WINT + (size_t)(2304 + pm * 256) * D); u.B0 = (const char*)(HN + (size_t)pn * 256 * D); u.bh = 128 * D * 2; u.r0 = pm * 256; u.c0 = pn * 256; u.aux = 0; u.nvalid = 256; }
        return true;
    }
    DI void aoff(const pg8::Unit&, int, int tid, unsigned (&va)[2][2]) const { pg8::aoff_std(tid, va); }
    DI void init(AccT& acc, const pg8::Unit&, int, int, int, int) const { acc_zero(acc); }
    DI void epi(const AccT& acc, const pg8::Unit& u, int wr, int wc, int fr, int fq) const {
        const int pn = u.aux;
        const int tid = (wr * 4 + wc) * 64 + fq * 16 + fr, rowl = wr * 16 + fr;
        if (u.type == 1) {
            st_realign(wr);
#pragma unroll
            for (int ai = 0; ai < 2; ++ai)
#pragma unroll
                for (int m = 0; m < 4; ++m) {
#pragma unroll
                    for (int bj = 0; bj < 2; ++bj) st_put(lds, rowl, (bj * 128 + wc * 32 + 8 * fq) * 2, acc[ai][bj][m][0], acc[ai][bj][m][1]);
                    st_flush<512, false>(lds, tid, VT + (size_t)(u.r0 + ai * 128 + m * 16) * T + u.c0, T, 256); }
            st_restagger(wr);
            return;
        }
        const bool is_q = pn < 4, do_rope = (pn != 4 && pn != 5);
        bf16_t* dst = is_q ? Q + pn * 256 : KV + (pn - 4) * 256;
        const float sc = is_q ? QSCALE : 1.f;
        const bool rl = do_rope && ((wc & 1) == 0) && fq < 2;
        const bool rw = do_rope && (wc & 1) == 0;
        RopeRow rr = rope_load(ROPE + (size_t)(u.r0 + wr * 64 + fr) * 16);
        st_realign(wr);
#pragma unroll
        for (int ai = 0; ai < 2; ++ai)
#pragma unroll
            for (int m = 0; m < 4; ++m) {
                const int nx = (ai * 4 + m + 1) & 7;
                const RopeRow rn = rope_load(ROPE + (size_t)(u.r0 + (nx >> 2) * 128 + wr * 64 + (nx & 3) * 16 + fr) * 16);
#pragma unroll
                for (int bj = 0; bj < 2; ++bj) { f32x4 v0 = acc[ai][bj][m][0], v1 = acc[ai][bj][m][1];
                    if (rw) { f32x4 r0 = v0, r1 = v1; rope8(r0, r1, rr, fq); if (rl) { v0 = r0; v1 = r1; } }
                    v0 = v0 * sc; v1 = v1 * sc;
                    st_put(lds, rowl, (bj * 128 + wc * 32 + 8 * fq) * 2, v0, v1); }
                st_flush<512, false>(lds, tid, dst + (size_t)(u.r0 + ai * 128 + m * 16) * D, D, 256);
                rr = rn; }
        st_restagger(wr);
    }
};

struct PolOut {
    static constexpr bool PERM = false, GATHER = false, PREBIAS = false, COUNTED = false, PUBLISH = false;
    const bf16_t *O, *WT; const float *base, *gate_mv, *bias; float* H; int vcu;
    DI bool next(int i, pg8::Unit& u) const {
        const int L = i * GRID + vcu; if (L >= 512) return false;
        const int pm = L >> 2, pn = L & 3; u.type = 0; u.A = (const char*)(O + (size_t)pm * 256 * D); u.B0 = (const char*)(WT + (size_t)pn * 256 * D); u.bh = 128 * D * 2; u.r0 = pm * 256; u.c0 = pn * 256; u.aux = 0; u.nvalid = 256;
        return true;
    }
    DI void aoff(const pg8::Unit&, int, int tid, unsigned (&va)[2][2]) const { pg8::aoff_std(tid, va); }
    DI void init(AccT& acc, const pg8::Unit& u, int, int wc, int, int fq) const {
        if (!bias) { acc_zero(acc); return; }
        const float* bp = bias + u.c0 + wc * 32 + 4 * fq;
        acc_colbias(acc, *(const f32x4*)bp, *(const f32x4*)(bp + 16), *(const f32x4*)(bp + 128), *(const f32x4*)(bp + 144));
    }
    DI void epi(const AccT& acc, const pg8::Unit& u, int wr, int wc, int fr, int fq) const {
        const int b = u.r0 >> 11; const float* gv = gate_mv + (size_t)b * 3072 + 2048;
        const size_t row0 = (size_t)(u.r0 + wr * 64 + fr) * D + u.c0 + wc * 32 + 4 * fq;
        f32x4 xa[8], xb[8], ga, gb;
#define PO_LOAD(q, X, G) { const int co = ((q) >> 1) * 128 + ((q) & 1) * 16; G = *(const f32x4*)(gv + u.c0 + wc * 32 + 4 * fq + co); \
            _Pragma("unroll") for (int ai = 0; ai < 2; ++ai) _Pragma("unroll") for (int m = 0; m < 4; ++m) X[ai * 4 + m] = *(const f32x4*)(base + row0 + (size_t)(ai * 128 + m * 16) * D + co); }
#define PO_STORE(q, X, G) { const int co = ((q) >> 1) * 128 + ((q) & 1) * 16; \
            _Pragma("unroll") for (int ai = 0; ai < 2; ++ai) _Pragma("unroll") for (int m = 0; m < 4; ++m) *(f32x4*)(H + row0 + (size_t)(ai * 128 + m * 16) * D + co) = X[ai * 4 + m] + G * acc[ai][(q) >> 1][m][(q) & 1]; }
        PO_LOAD(0, xa, ga) PO_LOAD(1, xb, gb) PO_STORE(0, xa, ga) PO_LOAD(2, xa, ga) PO_STORE(1, xb, gb) PO_LOAD(3, xb, gb) PO_STORE(2, xa, ga) PO_STORE(3, xb, gb)
#undef PO_LOAD
#undef PO_STORE
    }
};

DI bool moe_unit(const LAS unsigned* ext, int L, int npn, int& e, int& mt, int& pn, int& nvalid, unsigned& slot0) {
    if ((unsigned)L >= (unsigned)__builtin_amdgcn_readfirstlane((int)ext[96])) return false;
    int ee = 0;
    for (int k = 1; k < 32; ++k) ee = ((unsigned)L >= ext[64 + k]) ? k : ee;
    ee = __builtin_amdgcn_readfirstlane(ee);
    const int local = L - __builtin_amdgcn_readfirstlane((int)ext[64 + ee]); mt = local / npn; pn = local % npn; e = ee;
    const int cnt = __builtin_amdgcn_readfirstlane((int)ext[ee]); nvalid = cnt - mt * 256; nvalid = nvalid > 256 ? 256 : nvalid;
    slot0 = (unsigned)__builtin_amdgcn_readfirstlane((int)ext[32 + ee]) + (unsigned)mt * 256u;
    return true;
}
template <bool NOEPI = false> struct PolGateUpT {
    static constexpr bool PERM = true, GATHER = true, PREBIAS = true, COUNTED = false, PUBLISH = true;
    const bf16_t *HN, *WGUT; const float* bgu; const unsigned* LIST; bf16_t* ACT; const LAS unsigned* ext; int vcu; LAS unsigned char* lds; unsigned* panel;
    DI bool next(int i, pg8::Unit& u) const {
        int e, mt, pn, nv; unsigned s0;
        if (!moe_unit(ext, i * GRID + vcu, 8, e, mt, pn, nv, s0)) return false;
        u.type = mt; u.A = (const char*)HN; u.B0 = (const char*)(WGUT + ((size_t)e * 2048 + pn * 128) * D); u.bh = 1024u * D * 2u; u.r0 = (int)s0; u.c0 = pn * 128; u.nvalid = nv; u.aux = e;
        return true;
    }
    DI void aoff(const pg8::Unit& u, int wbase, int, unsigned (&va)[2][2]) const { unsigned tok[2][2]; aoff_load(u, wbase, tok); aoff_calc(wbase, tok, va); }
    DI void aoff_load(const pg8::Unit& u, int wbase, unsigned (&tok)[2][2]) const {
        const unsigned* lp = LIST + (size_t)u.aux * T + (size_t)u.type * 256;
        const int t = wbase | fresh_lane();
#pragma unroll
        for (int i = 0; i < 2; ++i) { int R, C; pg8::stage_rc(t * 16 + i * 8192, R, C);
#pragma unroll
            for (int h = 0; h < 2; ++h) { int r = h * 128 + R; r = r < u.nvalid ? r : u.nvalid - 1; tok[h][i] = lp[r]; } }
    }
    DI void aoff_calc(int wbase, const unsigned (&tok)[2][2], unsigned (&va)[2][2]) const {
        const int t = wbase | fresh_lane();
#pragma unroll
        for (int i = 0; i < 2; ++i) { int R, C; pg8::stage_rc(t * 16 + i * 8192, R, C);
#pragma unroll
            for (int h = 0; h < 2; ++h) va[h][i] = tok[h][i] * (unsigned)(D * 2) + (unsigned)C * 2u; }
    }
    DI void init(AccT& acc, const pg8::Unit& u, int, int wc, int, int fq) const {
        const float* bp = bgu + (size_t)u.aux * 2048 + u.c0 + wc * 32 + 8 * fq;
        acc_colbias(acc, *(const f32x4*)bp, *(const f32x4*)(bp + 4), *(const f32x4*)(bp + 1024), *(const f32x4*)(bp + 1028));
    }
    DI void bias_load(const pg8::Unit& u, int wc, int fq, f32x4 (&bv)[4]) const {
        const float* bp = bgu + (size_t)u.aux * 2048 + u.c0 + wc * 32 + 8 * fq;
        bv[0] = *(const f32x4*)bp; bv[1] = *(const f32x4*)(bp + 4); bv[2] = *(const f32x4*)(bp + 1024); bv[3] = *(const f32x4*)(bp + 1028);
    }
    DI void epi(const AccT& acc, const pg8::Unit& u, int wr, int wc, int fr, int fq) const {
        if (NOEPI) {
#pragma unroll
            for (int ai = 0; ai < 2; ++ai)
#pragma unroll
                for (int bj = 0; bj < 2; ++bj) asm volatile("" :: "v"(acc[ai][bj][0][0]), "v"(acc[ai][bj][0][1]), "v"(acc[ai][bj][1][0]), "v"(acc[ai][bj][1][1]), "v"(acc[ai][bj][2][0]), "v"(acc[ai][bj][2][1]), "v"(acc[ai][bj][3][0]), "v"(acc[ai][bj][3][1]));
            return;
        }
        st_realign(wr);
#pragma unroll
        for (int ai = 0; ai < 2; ++ai)
#pragma unroll
            for (int m = 0; m < 4; ++m) {
                const f32x4 g0 = acc[ai][0][m][0], g1 = acc[ai][0][m][1], l0 = acc[ai][1][m][0], l1 = acc[ai][1][m][1]; f32x4 a0, a1;
#pragma unroll
                for (int i = 0; i < 4; ++i) {
                    typedef float f32x2 __attribute__((ext_vector_type(2)));
                    const f32x2 x = {vmin_raw(g0[i], 7.f), vmin_raw(g1[i], 7.f)}, y = {vmed3_raw(l0[i], -7.f, 7.f), vmed3_raw(l1[i], -7.f, 7.f)};
                    const f32x2 t = x * (f32x2){-1.702f * LOG2E, -1.702f * LOG2E};
                    const f32x2 d = (f32x2){ex2(t.x), ex2(t.y)} + (f32x2){1.f, 1.f};
                    const float rr = rcpf(d.x * d.y);
                    const f32x2 o = x * ((f32x2){d.y, d.x} * (f32x2){rr, rr}) * (y + (f32x2){1.f, 1.f});
                    a0[i] = o.x; a1[i] = o.y; }
                st_put_gu(lds, (m & 1) * 32 + wr * 16 + fr, (wc * 32 + 8 * fq) * 2, a0, a1);
                if (m & 1) st_flush_gu(lds, (wr * 4 + wc) * 64 + fq * 16 + fr, ACT + (size_t)(u.r0 + ai * 128 + (m - 1) * 16) * D + u.c0, D, u.nvalid - (ai * 128 + (m - 1) * 16)); }
        st_restagger(wr);
    }
    DI void publish(int e, int mt) const {
        if (fresh_lane() == 0) __hip_atomic_fetch_add(panel + (ext[64 + e] >> 3) + (unsigned)mt, 1u, __ATOMIC_RELAXED, __HIP_MEMORY_SCOPE_AGENT);
    }
};
typedef PolGateUpT<false> PolGateUp;
template <bool NOEPI = false> struct PolDownT {
    static constexpr bool PERM = true, GATHER = false, PREBIAS = true, COUNTED = true, PUBLISH = false;
    const bf16_t *ACT, *WDNT; const float *bdn, *LISTW; bf16_t* OUTB; const LAS unsigned* ext; int vcu; LAS unsigned char* lds; const unsigned* panel; int wave;
    DI bool next(int i, pg8::Unit& u) const {
        int e, mt, pn, nv; unsigned s0;
        if (!moe_unit(ext, i * GRID + vcu, 4, e, mt, pn, nv, s0)) return false;
        if (wave == 0) {
            const unsigned* cp = panel + (__builtin_amdgcn_readfirstlane((int)ext[64 + e]) >> 2) + mt;
            for (unsigned spins = 0; spins < (1u << 22); ++spins) { if (__hip_atomic_load(cp, __ATOMIC_RELAXED, __HIP_MEMORY_SCOPE_AGENT) >= 64u) break; __builtin_amdgcn_s_sleep(2); }
            __builtin_amdgcn_fence(__ATOMIC_ACQUIRE, "agent");
        }
        u.type = mt; u.A = (const char*)(ACT + (size_t)s0 * D); u.B0 = (const char*)(WDNT + ((size_t)e * 1024 + pn * 256) * D); u.bh = 128 * D * 2; u.r0 = (int)s0; u.c0 = pn * 256; u.nvalid = nv; u.aux = e;
        return true;
    }
    DI void aoff(const pg8::Unit&, int, int tid, unsigned (&va)[2][2]) const { pg8::aoff_std(tid, va); }
    DI void init(AccT& acc, const pg8::Unit& u, int, int wc, int, int fq) const {
        const float* bp = bdn + (size_t)u.aux * 1024 + u.c0 + wc * 32 + 8 * fq;
        acc_colbias(acc, *(const f32x4*)bp, *(const f32x4*)(bp + 4), *(const f32x4*)(bp + 128), *(const f32x4*)(bp + 132));
    }
    DI void bias_load(const pg8::Unit& u, int wc, int fq, f32x4 (&bv)[4]) const {
        const float* bp = bdn + (size_t)u.aux * 1024 + u.c0 + wc * 32 + 8 * fq;
        bv[0] = *(const f32x4*)bp; bv[1] = *(const f32x4*)(bp + 4); bv[2] = *(const f32x4*)(bp + 128); bv[3] = *(const f32x4*)(bp + 132);
    }
    DI void epi(const AccT& acc, const pg8::Unit& u, int wr, int wc, int fr, int fq) const {
        if (NOEPI) {
#pragma unroll
            for (int ai = 0; ai < 2; ++ai)
#pragma unroll
                for (int bj = 0; bj < 2; ++bj) asm volatile("" :: "v"(acc[ai][bj][0][0]), "v"(acc[ai][bj][0][1]), "v"(acc[ai][bj][1][0]), "v"(acc[ai][bj][1][1]), "v"(acc[ai][bj][2][0]), "v"(acc[ai][bj][2][1]), "v"(acc[ai][bj][3][0]), "v"(acc[ai][bj][3][1]));
            return;
        }
        const float* wp = LISTW + (size_t)u.aux * T + (size_t)u.type * 256;
        float wv[2][4];
#pragma unroll
        for (int ai = 0; ai < 2; ++ai)
#pragma unroll
            for (int m = 0; m < 4; ++m) { const int rl = ai * 128 + wr * 64 + m * 16 + fr; wv[ai][m] = wp[rl < u.nvalid ? rl : u.nvalid - 1]; }
        st_realign(wr);
#pragma unroll
        for (int ai = 0; ai < 2; ++ai)
#pragma unroll
            for (int m = 0; m < 4; ++m) {
                const float w = wv[ai][m];
#pragma unroll
                for (int bj = 0; bj < 2; ++bj) st_put(lds, wr * 16 + fr, (bj * 128 + wc * 32 + 8 * fq) * 2, acc[ai][bj][m][0] * w, acc[ai][bj][m][1] * w);
                st_flush<512>(lds, (wr * 4 + wc) * 64 + fq * 16 + fr, OUTB + (size_t)(u.r0 + ai * 128 + m * 16) * D + u.c0, D, u.nvalid - (ai * 128 + m * 16)); }
        st_restagger(wr);
    }
};

typedef PolDownT<false> PolDown;
template <int MODE> struct PolProj1T {
    static constexpr bool PERM = true, GATHER = false, PREBIAS = false, COUNTED = false, PUBLISH = false;
    unsigned char* ws; const float *bq, *kvb; int vcu; LAS unsigned char* lds;
#define PJ1(name, type, off) DI type* name() const { return (type*)(ws + (off)); }
    PJ1(HN, const bf16_t, WS_HN) PJ1(HN2, const bf16_t, WS_HN2) PJ1(WBQT, const bf16_t, WS_WBQT) PJ1(WKVT, const bf16_t, WS_WKVT) PJ1(ROPE, const float, WS_ROPE)
    PJ1(Q, bf16_t, WS_Q) PJ1(K1, bf16_t, WS_KV) PJ1(VT1, bf16_t, WS_VT)
#undef PJ1
    DI bool next(int i, pg8::Unit& u) const {
        const int L = (MODE == 0 ? 0 : 512) + i * GRID + vcu; if (L >= (MODE == 0 ? 512 : 768)) return false;
        u.bh = 128 * D * 2; u.nvalid = 256; u.aux = 0;
        if (MODE == 0) { const int pm = L >> 2, pn = L & 3; u.type = 0; u.A = (const char*)(HN() + (size_t)pm * 256 * D); u.B0 = (const char*)(WBQT() + (size_t)pn * 256 * D); u.r0 = pm * 256; u.c0 = pn * 256; }
        else if (L < 640) { const int pm = L - 512; u.type = 1; u.A = (const char*)(HN2() + (size_t)pm * 256 * D); u.B0 = (const char*)WKVT(); u.r0 = pm * 256; u.c0 = 0; }
        else { const int pn = L - 640; u.type = 2; u.A = (const char*)WKVT(); u.B0 = (const char*)(HN2() + (size_t)pn * 256 * D); u.r0 = 0; u.c0 = pn * 256; }
        return true;
    }
    DI void aoff(const pg8::Unit&, int, int tid, unsigned (&va)[2][2]) const { pg8::aoff_std(tid, va); }
    DI void init(AccT& acc, const pg8::Unit& u, int wr, int wc, int fr, int fq) const {
        if (MODE == 1 && u.type == 2) {
#pragma unroll
            for (int a = 0; a < 2; ++a)
#pragma unroll
                for (int m = 0; m < 4; ++m) { const float bs = kvb[a * 128 + wr * 64 + m * 16 + fr];
#pragma unroll
                    for (int b = 0; b < 2; ++b)
#pragma unroll
                        for (int n = 0; n < 2; ++n) acc[a][b][m][n] = (f32x4){bs, bs, bs, bs}; }
            return;
        }
        const float* bp = (MODE == 0 ? bq + u.c0 : kvb) + wc * 32 + 8 * fq;
        acc_colbias(acc, *(const f32x4*)bp, *(const f32x4*)(bp + 4), *(const f32x4*)(bp + 128), *(const f32x4*)(bp + 132));
    }
    DI void epi(const AccT& acc, const pg8::Unit& u, int wr, int wc, int fr, int fq) const {
        const int tid = (wr * 4 + wc) * 64 + fq * 16 + fr, rowl = wr * 16 + fr;
        if (MODE == 1 && u.type == 2) {
            st_realign(wr);
#pragma unroll
            for (int m = 0; m < 4; ++m) {
#pragma unroll
                for (int bj = 0; bj < 2; ++bj) st_put(lds, rowl, (bj * 128 + wc * 32 + 8 * fq) * 2, acc[1][bj][m][0], acc[1][bj][m][1]);
                st_flush<512, false>(lds, tid, VT1() + (size_t)(m * 16) * T + u.c0, T, 256); }
            st_restagger(wr);
            return;
        }
        constexpr bool isq = (MODE == 0); const bool rl = ((wc & 1) == 0) && fq < 2; const float sc = isq ? QSCALE : 1.f;
        RopeRow rr = rope_load(ROPE() + (size_t)(u.r0 + wr * 64 + fr) * 16);
        st_realign(wr);
#pragma unroll
        for (int ai = 0; ai < 2; ++ai)
#pragma unroll
            for (int m = 0; m < 4; ++m) {
                const int nx = (ai * 4 + m + 1) & 7;
                const RopeRow rn = rope_load(ROPE() + (size_t)(u.r0 + (nx >> 2) * 128 + wr * 64 + (nx & 3) * 16 + fr) * 16);
#pragma unroll
                for (int bj = 0; bj < 2; ++bj) {
                    if (!isq && bj == 1) continue;
                    f32x4 v0 = acc[ai][bj][m][0], v1 = acc[ai][bj][m][1];
                    if ((wc & 1) == 0) { f32x4 r0 = v0, r1 = v1; rope8(r0, r1, rr, fq); if (rl) { v0 = r0; v1 = r1; } }
                    v0 = v0 * sc; v1 = v1 * sc;
                    st_put(lds, rowl, (bj * 128 + wc * 32 + 8 * fq) * 2, v0, v1); }
                if (isq) st_flush<512, false>(lds, tid, Q() + (size_t)(u.r0 + ai * 128 + m * 16) * D + u.c0, D, 256);
                else st_flush<256, false>(lds, tid, K1() + (size_t)(u.r0 + ai * 128 + m * 16) * 128, 128, 256);
                rr = rn; }
        st_restagger(wr);
    }
};

template <class Base> struct NoEpi : Base {
    DI void epi(const AccT& acc, const pg8::Unit&, int, int, int, int) const {
#pragma unroll
        for (int ai = 0; ai < 2; ++ai)
#pragma unroll
            for (int bj = 0; bj < 2; ++bj) asm volatile("" :: "v"(acc[ai][bj][0][0]), "v"(acc[ai][bj][0][1]), "v"(acc[ai][bj][1][0]), "v"(acc[ai][bj][1][1]), "v"(acc[ai][bj][2][0]), "v"(acc[ai][bj][2][1]), "v"(acc[ai][bj][3][0]), "v"(acc[ai][bj][3][1]));
    }
};
DI float gelu_tanh(float z) {
    const float u = 0.7978845608028654f * (z + 0.044715f * z * z * z);
    const float e = ex2(2.f * LOG2E * u);
    const float th = 1.f - 2.f * rcpf(e + 1.f);
    return 0.5f * z * (1.f + th);
}
DI void compress_phase(Frame& F) {
    const int tid = F.tid, lane = F.lane, r = lane & 31, h = lane >> 5, quad = F.wave >> 2, q = F.wave & 3;
    const int rb = F.bx * 2 + quad, kv = rb >> 8, rem = rb & 255, b = rem >> 4, g = (rem >> 2) & 3, nb = rem & 3;
    const int n = nb * 32 + r, nn = n < 126 ? n : 126;
    constexpr int CW = 0, CX = 36864, CH = 55296;
    LAS unsigned char* lds = F.lds;
    LAS unsigned char* hid = lds + CH + quad * (32 * 272);
    const int wrow = tid >> 3, wch = tid & 7;
    const bf16_t* wsrc = F.CW1T() + ((size_t)kv * 128 + wrow) * 2048 + wch * 8;
    const int xq = tid >> 8, xr = (tid >> 3) & 31, xch = tid & 7;
    const bf16_t* xsrc;
    { const int rbq = F.bx * 2 + xq, remq = rbq & 255, bq = remq >> 4, gq = (remq >> 2) & 3, nbq = remq & 3; const int nq = nbq * 32 + xr, nnq = nq < 126 ? nq : 126;
      xsrc = F.KV() + ((size_t)(bq * SEQ + 16 * nnq)) * D + kv * 256 + gq * 64 + xch * 8; }
    f32x16 acc;
#pragma unroll
    for (int i = 0; i < 16; ++i) acc[i] = 0.f;
    u32x4 w0 = *(const u32x4*)wsrc, w1 = *(const u32x4*)(wsrc + (size_t)64 * 2048), xv = *(const u32x4*)xsrc;
#define CP_WRITE(buf) do { *(LAS u32x4*)(lds + CW + (buf) * 18432 + wrow * 144 + wch * 16) = w0; *(LAS u32x4*)(lds + CW + (buf) * 18432 + (wrow + 64) * 144 + wch * 16) = w1; \
        *(LAS u32x4*)(lds + CX + ((buf) * 2 + xq) * 4608 + xr * 144 + xch * 16) = xv; } while (0)
    CP_WRITE(0);
    __syncthreads();
#pragma unroll 2
    for (int c = 0; c < 32; ++c) {
        const int buf = c & 1;
        if (c + 1 < 32) { w0 = *(const u32x4*)(wsrc + 64 * (c + 1)); w1 = *(const u32x4*)(wsrc + (size_t)64 * 2048 + 64 * (c + 1)); xv = *(const u32x4*)(xsrc + (size_t)(c + 1) * D); }
        const LAS unsigned char* ap = lds + CW + buf * 18432 + (32 * q + r) * 144 + 16 * h;
        const LAS unsigned char* bp = lds + CX + (buf * 2 + quad) * 4608 + r * 144 + 16 * h;
#pragma unroll
        for (int s = 0; s < 4; ++s) { const bf16x8 a = *(const LAS bf16x8*)(ap + 32 * s); const bf16x8 bb = *(const LAS bf16x8*)(bp + 32 * s); acc = MFMA32(a, bb, acc); }
        if (c + 1 < 32) CP_WRITE(buf ^ 1);
        __syncthreads();
    }
#undef CP_WRITE
    {
        const float* cb = F.CMPB() + kv * 128 + 32 * q;
#pragma unroll
        for (int q4 = 0; q4 < 4; ++q4) {
            float v[4];
#pragma unroll
            for (int i = 0; i < 4; ++i) v[i] = gelu_tanh(acc[4 * q4 + i] + cb[8 * q4 + 4 * h + i]);
            u32x2 o; o.x = pk2(v[0], v[1]); o.y = pk2(v[2], v[3]);
            *(LAS u32x2*)(hid + r * 272 + (32 * q + 8 * q4 + 4 * h) * 2) = o;
        }
    }
    __syncthreads();
    if (q < 2) {
        const int db = q;
        f32x16 o2;
#pragma unroll
        for (int i = 0; i < 16; ++i) o2[i] = 0.f;
        const bf16_t* w2p = F.CW2T() + ((size_t)kv * 64 + 32 * db + r) * 128 + 8 * h;
#pragma unroll
        for (int s = 0; s < 8; ++s) {
            const bf16x8 a = *(const bf16x8*)(w2p + 16 * s);
            const bf16x8 bb = *(const LAS bf16x8*)(hid + r * 272 + (16 * s + 8 * h) * 2);
            o2 = MFMA32(a, bb, o2);
        }
        const bool valid = n < 127;
        if (kv == 0) {
            if (db == 0) {
                const float* rp = F.ROPE() + (size_t)(b * SEQ + 16 * nn + 31) * 16 + 4 * h;
                const f32x4 c = *(const f32x4*)rp, sn = *(const f32x4*)(rp + 8);
#pragma unroll
                for (int i = 0; i < 4; ++i) { const float x1 = o2[i], x2 = o2[4 + i]; o2[i] = x1 * c[i] - x2 * sn[i]; o2[4 + i] = x2 * c[i] + x1 * sn[i]; }
            }
            bf16_t* kp = F.KC() + ((size_t)((b * 4 + g) * 128 + n)) * 64 + 32 * db + 4 * h;
#pragma unroll
            for (int q4 = 0; q4 < 4; ++q4) { u32x2 o; o.x = valid ? pk2(o2[4 * q4], o2[4 * q4 + 1]) : 0u; o.y = valid ? pk2(o2[4 * q4 + 2], o2[4 * q4 + 3]) : 0u; *(u32x2*)(kp + 8 * q4) = o; }
        } else {
#pragma unroll
            for (int i = 0; i < 16; ++i) { const int d = 32 * db + crow(i, h);
                F.VCT()[((size_t)((b * 4 + g) * 64 + d)) * 128 + n] = valid ? (bf16_t)(pk2(o2[i], 0.f) & 0xffffu) : (bf16_t)0; }
        }
    }
    __syncthreads();
}

constexpr int AT_KT = 0, AT_VT = 18432  , AT_KC = 46080, AT_VC = 64512, AT_IMPP = 81408, AT_IMPS = 114176, AT_SELM = 122368;
#define NEG_INF (-INFINITY)

constexpr int AT_BG = 122880, BG_PER_WAVE = 96;
struct BgCvt { KPtr kp; LAS float* tile; int gw, cnt, st; f32x4 r[4]; };
DI void bg_decode(const BgCvt& g, const float*& src, bf16_t*& dst, int& ld) {
    const int it = g.gw + g.cnt * (GRID * NWAVES);
    unsigned char* ws = *(unsigned char* const __attribute__((address_space(4)))*)(g.kp + 8 * 29);
    if (it < 131072) { const int mat = it >> 11, q = it & 2047, kb = q >> 6, nb = q & 63;
        src = *(const float* const __attribute__((address_space(4)))*)(g.kp + 8 * 24) + (size_t)mat * (D * 2048) + (size_t)(32 * kb) * 2048 + 32 * nb; ld = 2048;
        dst = (bf16_t*)(ws + WS_WGUT) + (size_t)mat * (2048 * D) + (size_t)(32 * nb) * D + 32 * kb; }
    else { const int i2 = it - 131072, mat = i2 >> 10, q = i2 & 1023, kb = q >> 5, nb = q & 31;
        src = *(const float* const __attribute__((address_space(4)))*)(g.kp + 8 * 26) + (size_t)mat * (D * D) + (size_t)(32 * kb) * D + 32 * nb; ld = D;
        dst = (bf16_t*)(ws + WS_WDNT) + (size_t)mat * (D * D) + (size_t)(32 * nb) * D + 32 * kb; }
}
DI void bg_issue(BgCvt& g, int lane) {
    const float* src; bf16_t* dst; int ld; bg_decode(g, src, dst, ld);
    const float* p = src + (size_t)(lane >> 3) * ld + 4 * (lane & 7);
#pragma unroll
    for (int i = 0; i < 4; ++i) g.r[i] = __builtin_nontemporal_load((const f32x4*)(p + (size_t)(8 * i) * ld));
}
DI void bg_finish(BgCvt& g, int lane) {
    const float* src; bf16_t* dst; int ld; bg_decode(g, src, dst, ld);
    LAS float* w = g.tile + (lane >> 3) * 33 + 4 * (lane & 7);
#pragma unroll
    for (int i = 0; i < 4; ++i) { LAS float* q = w + (8 * i) * 33; q[0] = g.r[i].x; q[1] = g.r[i].y; q[2] = g.r[i].z; q[3] = g.r[i].w; }
    LDS_WAIT(); asm volatile("" ::: "memory");
    const int n = lane >> 1, kh = lane & 1; const LAS float* s = g.tile + (16 * kh) * 33 + n;
    u32x4 o0, o1;
    o0.x = pk2(s[0 * 33], s[1 * 33]); o0.y = pk2(s[2 * 33], s[3 * 33]); o0.z = pk2(s[4 * 33], s[5 * 33]); o0.w = pk2(s[6 * 33], s[7 * 33]);
    o1.x = pk2(s[8 * 33], s[9 * 33]); o1.y = pk2(s[10 * 33], s[11 * 33]); o1.z = pk2(s[12 * 33], s[13 * 33]); o1.w = pk2(s[14 * 33], s[15 * 33]);
    bf16_t* d = dst + (size_t)n * D + 16 * kh;
    __builtin_nontemporal_store(o0, (u32x4*)d); __builtin_nontemporal_store(o1, (u32x4*)(d + 8));
    LDS_WAIT(); asm volatile("" ::: "memory");
    ++g.cnt;
}

DI void bg_start(BgCvt& g, int lane) { if (g.st == 0 && g.cnt < BG_PER_WAVE) { bg_issue(g, lane); g.st = 1; } }
DI void bg_end(BgCvt& g, int lane) { if (g.st == 2) { bg_finish(g, lane); g.st = 0; } else if (g.st == 1) g.st = 2; else if (g.st == 3) g.st = 0; }
DI void bg_flush(BgCvt& g, int lane) { if (g.st == 1 || g.st == 2) bg_finish(g, lane); g.st = 0; }

constexpr float AT_THR = 24.0f;
DI float max3f(float a, float b, float c) { float r; asm("v_max3_f32 %0, %1, %2, %3" : "=v"(r) : "v"(a), "v"(b), "v"(c)); return r; }
DI void qk_tile(const LAS unsigned char* kt, const bf16x8 (&qf)[4], f32x16& s0, f32x16& s1, int r, int h) {
    const LAS unsigned char* kp = kt + r * 144 + h * 16;
    f32x16 z;
#pragma unroll
    for (int i = 0; i < 16; ++i) z[i] = 0.f;
    { const bf16x8 a0 = *(const LAS bf16x8*)(kp), a1 = *(const LAS bf16x8*)(kp + 32 * 144); s0 = MFMA32(a0, qf[0], z); s1 = MFMA32(a1, qf[0], z); }
#pragma unroll
    for (int s = 1; s < 4; ++s) {
        const bf16x8 a0 = *(const LAS bf16x8*)(kp + s * 32), a1 = *(const LAS bf16x8*)(kp + 32 * 144 + s * 32);
        s0 = MFMA32(a0, qf[s], s0); s1 = MFMA32(a1, qf[s], s1);
    }
}
DI void v_frags(const LAS unsigned char* vt, bf16x8 (&vf)[2][2][2], int r, int h) {
    const LAS unsigned char* vp = vt + r * 144 + h * 16;
#pragma unroll
    for (int db = 0; db < 2; ++db)
#pragma unroll
        for (int kb = 0; kb < 2; ++kb)
#pragma unroll
            for (int s2 = 0; s2 < 2; ++s2) vf[db][kb][s2] = *(const LAS bf16x8*)(vp + db * 32 * 144 + kb * 64 + s2 * 32);
}
DI void pv_mma(const bf16x8 (&vf)[2][2][2], const u32x4 (&pb)[2][2], f32x16 (&O)[2]) {
#pragma unroll
    for (int db = 0; db < 2; ++db)
#pragma unroll
        for (int kb = 0; kb < 2; ++kb)
#pragma unroll
            for (int s2 = 0; s2 < 2; ++s2) O[db] = MFMA32(vf[db][kb][s2], __builtin_bit_cast(bf16x8, pb[kb][s2]), O[db]);
}
DI void pv_tile(const LAS unsigned char* vt, const u32x4 (&pb)[2][2], f32x16 (&O)[2], int r, int h) {
    bf16x8 vf[2][2][2]; v_frags(vt, vf, r, h); pv_mma(vf, pb, O);
}
DI void make_mask(int lo, int hi, int h, unsigned& w0, unsigned& w1) {
    const int a = lo + 1 < 0 ? 0 : lo + 1, b = hi > 63 ? 63 : hi;
    unsigned long long mk = (a <= b) ? ((~0ull >> (63 - b)) & (~0ull << a)) : 0ull;
    mk >>= 4 * h;
    w0 = (unsigned)mk; w1 = (unsigned)(mk >> 32);
}
DI unsigned bitm(unsigned w, int q) { unsigned r_; asm("v_bfe_i32 %0, %1, %2, 1" : "=v"(r_) : "v"(w), "n"((q & 3) + 8 * (q >> 2))); return r_; }
DI float msel(float s, unsigned mk) { return __uint_as_float((__float_as_uint(s) & mk) | (0xff800000u & ~mk)); }
template <bool MASKED> DI float tile_max(const f32x16& S0, const f32x16& S1, unsigned w0, unsigned w1) {
    float mx = NEG_INF;
    if (!MASKED) {
#pragma unroll
        for (int q = 0; q < 16; q += 2) mx = max3f(mx, max3f(S0[q], S0[q + 1], S1[q]), S1[q + 1]);
    } else {
#pragma unroll
        for (int q = 0; q < 16; ++q) mx = max3f(mx, msel(S0[q], bitm(w0, q)), msel(S1[q], bitm(w1, q)));
    }
    return mx;
}
template <bool MASKED, bool SUB> DI float tile_exp(const f32x16& S0, const f32x16& S1, unsigned w0, unsigned w1, float m, u32x4 (&pb)[2][2]) {
    float ls = 0.f;
#pragma unroll
    for (int s2 = 0; s2 < 2; ++s2)
#pragma unroll
        for (int w = 0; w < 4; ++w) {
            const int q = 8 * s2 + 2 * w;
            float a0 = SUB ? ex2(S0[q] - m) : ex2(S0[q]), a1 = SUB ? ex2(S0[q + 1] - m) : ex2(S0[q + 1]), b0 = SUB ? ex2(S1[q] - m) : ex2(S1[q]), b1 = SUB ? ex2(S1[q + 1] - m) : ex2(S1[q + 1]);
            if (MASKED) { a0 = __uint_as_float(__float_as_uint(a0) & bitm(w0, q)); a1 = __uint_as_float(__float_as_uint(a1) & bitm(w0, q + 1));
                          b0 = __uint_as_float(__float_as_uint(b0) & bitm(w1, q)); b1 = __uint_as_float(__float_as_uint(b1) & bitm(w1, q + 1)); }
            ls += (a0 + a1) + (b0 + b1);
            pb[0][s2][w] = pk2(a0, a1); pb[1][s2][w] = pk2(b0, b1);
        }
    return ls;
}
#define AT_WRITE_K(buf, kreg) do { *(LAS u32x4*)(lds + AT_KT + (buf) * 9216 + (tid >> 3) * 144 + (tid & 7) * 16) = (kreg); } while (0)
#define AT_WRITE_V(buf, vreg) do {   \
        LAS unsigned char* _vp = lds + AT_VT + (buf) * 9216 + (tid >> 3) * 144 + ((tid & 7) >> 1) * 32 + (tid & 1) * 8; *(LAS u32x2*)_vp = (u32x2){(vreg).x, (vreg).y}; *(LAS u32x2*)(_vp + 16) = (u32x2){(vreg).z, (vreg).w}; } while (0)

template <class Seq, int DBG = 0>
DI void attn_stream(LAS unsigned char* lds, int tid, int r, int h, const Seq& seq, const bf16_t* kbase, size_t ktile, const bf16_t* vbase,
                    const bf16x8 (&qf)[4], f32x16 (&O)[2], float& m, float& l, BgCvt& bg) {
    const bool late = __builtin_amdgcn_readfirstlane(tid >> 8) != 0;
    int j = seq.first(), j1 = seq.next(j), j2 = (j1 >= 0) ? seq.next(j1) : -1;
    u32x4 krA, krB, vrA, vrB;
    krA = *(const u32x4*)(kbase + (size_t)j * ktile); vrA = *(const u32x4*)(vbase + 64 * j);
    krB = krA; vrB = vrA;
    if (j1 >= 0) { krB = *(const u32x4*)(kbase + (size_t)j1 * ktile); vrB = *(const u32x4*)(vbase + 64 * j1); }
    AT_WRITE_K(0, krA); AT_WRITE_V(0, vrA);
    if (j2 >= 0) { krA = *(const u32x4*)(kbase + (size_t)j2 * ktile); vrA = *(const u32x4*)(vbase + 64 * j2); }
    __syncthreads();
    f32x16 sa0, sa1, sb0, sb1;
    qk_tile(lds + AT_KT, qf, sa0, sa1, r, h);
    sb0 = sa0; sb1 = sa1;
    if (j1 >= 0) { AT_WRITE_K(1, krB); AT_WRITE_V(1, vrB); }
    __syncthreads();
    int vcur = 0;
#define AT_STEP(SA0, SA1, SB0, SB1, PAR, KR, VR, KS, VS) { \
        const int j3 = (j2 >= 0) ? seq.next(j2) : -1; \
        if (j3 >= 0 && !(DBG & 4)) { KS = *(const u32x4*)(kbase + (size_t)j3 * ktile); VS = *(const u32x4*)(vbase + 64 * j3); } \
        bg_start(bg, tid & 63); \
        if (!late && j1 >= 0 && !(DBG & 2)) qk_tile(lds + AT_KT + ((PAR) ^ 1) * 9216, qf, SB0, SB1, r, h);        \
        __builtin_amdgcn_sched_barrier(0); \
        bf16x8 vf[2][2][2]; if (!(DBG & 2)) v_frags(lds + AT_VT + vcur * 9216, vf, r, h); \
        const bool allow = seq.allow(j); \
        float mx = (DBG & 1) ? 0.f : tile_max<false>(SA0, SA1, 0u, 0u); \
        if (!(DBG & 1)) mx = fmaxf(mx, __shfl_xor(mx, 32)); if (Seq::HAS_ALLOW) mx = allow ? mx : NEG_INF; \
        if (__any(mx - m > AT_THR)) { \
            const float mn = fmaxf(m, mx), alpha = ex2(m - mn); \
            m = mn; l *= alpha; O[0] = O[0] * alpha; O[1] = O[1] * alpha; \
        } \
        u32x4 pb[2][2]; float ls; \
        if (DBG & 1) { ls = 1.f; _Pragma("unroll") for (int a_ = 0; a_ < 2; ++a_) _Pragma("unroll") for (int b_ = 0; b_ < 2; ++b_) pb[a_][b_] = (u32x4){__float_as_uint(SA0[a_]), __float_as_uint(SA0[2 + b_]), __float_as_uint(SA1[a_]), __float_as_uint(SA1[3])}; } \
        else if (__any(m != 0.f)) ls = tile_exp<false, true>(SA0, SA1, 0u, 0u, m, pb); \
        else ls = tile_exp<false, false>(SA0, SA1, 0u, 0u, m, pb); \
        if (Seq::HAS_ALLOW) { const unsigned km = allow ? 0xffffffffu : 0u; ls = allow ? ls : 0.f; \
            _Pragma("unroll") for (int a_ = 0; a_ < 2; ++a_) _Pragma("unroll") for (int b_ = 0; b_ < 2; ++b_) { pb[a_][b_].x &= km; pb[a_][b_].y &= km; pb[a_][b_].z &= km; pb[a_][b_].w &= km; } } \
        l += ls; \
        if (!(DBG & 2)) pv_mma(vf, pb, O); else { O[0][0] += __uint_as_float(pb[0][0].x); O[1][0] += __uint_as_float(pb[1][1].w); } \
        __builtin_amdgcn_sched_barrier(0); \
        if (late && j1 >= 0 && !(DBG & 2)) qk_tile(lds + AT_KT + ((PAR) ^ 1) * 9216, qf, SB0, SB1, r, h);         \
        { const int vw = vcur >= 1 ? vcur - 1 : 2;        \
          if (j2 >= 0 && !(DBG & 4)) { AT_WRITE_K((PAR), KR); AT_WRITE_V(vw, VR); } }     \
        vcur = vcur == 2 ? 0 : vcur + 1; \
        bg_end(bg, tid & 63); \
        if (!(DBG & 8)) __syncthreads(); \
        if (j1 < 0) break; \
        j = j1; j1 = j2; j2 = j3; }
    for (;;) {
        AT_STEP(sa0, sa1, sb0, sb1, 0, krA, vrA, krB, vrB)
        AT_STEP(sb0, sb1, sa0, sa1, 1, krB, vrB, krA, vrA)
    }
#undef AT_STEP
}
DI void attn_tile_masked(LAS unsigned char* lds, int tid, int r, int h, const bf16_t* kptr, const bf16_t* vptr, const bf16x8 (&qf)[4], f32x16 (&O)[2], float& m, float& l, int lo, int hi, BgCvt& bg) {
    const u32x4 kr = *(const u32x4*)kptr, vr = *(const u32x4*)vptr;
    bg_start(bg, tid & 63);
    AT_WRITE_K(0, kr); AT_WRITE_V(0, vr);
    __syncthreads();
    f32x16 s0, s1;
    qk_tile(lds + AT_KT, qf, s0, s1, r, h);
    unsigned w0, w1; make_mask(lo, hi, h, w0, w1);
    float mx = tile_max<true>(s0, s1, w0, w1);
    mx = fmaxf(mx, __shfl_xor(mx, 32));
    if (__any(mx - m > AT_THR)) {
        const float mn = fmaxf(m, mx), alpha = ex2(m - mn);
        m = mn; l *= alpha; O[0] = O[0] * alpha; O[1] = O[1] * alpha;
    }
    u32x4 pb[2][2];
    l += tile_exp<true, true>(s0, s1, w0, w1, m, pb);
    pv_tile(lds + AT_VT, pb, O, r, h);
    bg_end(bg, tid & 63);
    __syncthreads();
}
struct SeqSel { static constexpr bool HAS_ALLOW = true; unsigned need, myselm;
    DI int first() const { return __builtin_ctz(need); }
    DI int next(int j) const { const unsigned rest = need & ~((2u << j) - 1u); return rest ? __builtin_ctz(rest) : -1; }
    DI bool allow(int j) const { return (myselm >> j) & 1u; }
};
struct SeqRange { static constexpr bool HAS_ALLOW = false; int j0, j1;
    DI int first() const { return j0; }
    DI int next(int j) const { return j < j1 ? j + 1 : -1; }
    DI bool allow(int) const { return true; }
};

DI void nsa_attn_phase(Frame& F) {
    LAS unsigned char* lds = F.lds;
    const int tid0 = F.tid, wave = F.wave, hh = wave & 3, th = wave >> 2;
    const int bg = F.bx & 63, b = bg >> 2, g = bg & 3, s4 = F.bx >> 6;
    LAS float* impP = (LAS float*)(lds + AT_IMPP);
    LAS float* impS = (LAS float*)(lds + AT_IMPS);
    LAS unsigned* selm = (LAS unsigned*)(lds + AT_SELM);
    const int head = g * 4 + hh;
    BgCvt bgc; bgc.kp = F.kp; bgc.tile = (LAS float*)(lds + AT_BG) + wave * 1056; bgc.gw = F.bx * NWAVES + wave; bgc.cnt = 0; bgc.st = 0;
    {
#pragma unroll
        for (int i = 0; i < 2; ++i) { const int idx = tid0 + 512 * i, row = idx >> 3, ch = idx & 7;
            *(LAS u32x4*)(lds + AT_KC + row * 144 + ch * 16) = *(const u32x4*)(F.KC() + ((size_t)((b * 4 + g) * 128 + row)) * 64 + ch * 8); }
#pragma unroll
        for (int i = 0; i < 2; ++i) { const int idx = tid0 + 512 * i, d = idx >> 4, ch = idx & 15;
            const u32x4 v = *(const u32x4*)(F.VCT() + ((size_t)((b * 4 + g) * 64 + d)) * 128 + ch * 8);
            LAS u32x2* vp = (LAS u32x2*)(lds + AT_VC + d * 264 + ch * 16); vp[0] = (u32x2){v.x, v.y}; vp[1] = (u32x2){v.z, v.w}; }
        __syncthreads();
    }
    for (int ui = 0; ui < 8; ++ui) {
        int tid = tid0; asm volatile("" : "+v"(tid));
        const int lane = tid & 63, r = lane & 31, h = lane >> 5, tl = th * 32 + r;
        const int pp = s4 + 4 * (ui >> 1), qt = (ui & 1) ? 31 - pp : pp;
        const int t = qt * 64 + tl; const size_t tokrow = (size_t)b * SEQ + t;
        bf16x8 qf[4];
#pragma unroll
        for (int s = 0; s < 4; ++s) qf[s] = *(const bf16x8*)(F.Q() + tokrow * D + head * 64 + 16 * s + 8 * h);
        const float* gatep = F.GATES() + tokrow * 64 + head * 3;
        const float gc = gatep[0], gs = gatep[1], gw = gatep[2];
        if (tid < 64) selm[tid] = 0u;
        f32x16 Ot[2];
#pragma unroll
        for (int i = 0; i < 16; ++i) { Ot[0][i] = 0.f; Ot[1][i] = 0.f; }
#ifndef NO_CMP
        {
            const int nmax = (t - 31) >> 4;
            float mrun = NEG_INF, lrun = 0.f;
#pragma unroll 1
            for (int kb = 0; kb < 4; ++kb) {
                f32x16 sc;
#pragma unroll
                for (int i = 0; i < 16; ++i) sc[i] = 0.f;
#pragma unroll
                for (int s = 0; s < 4; ++s) { const bf16x8 a = *(const LAS bf16x8*)(lds + AT_KC + (kb * 32 + r) * 144 + s * 32 + h * 16); sc = MFMA32(a, qf[s], sc); }
                float bm = NEG_INF;
#pragma unroll
                for (int i = 0; i < 16; ++i) { const int nn = kb * 32 + crow(i, h); sc[i] = (nn <= nmax) ? sc[i] : NEG_INF; bm = fmaxf(bm, sc[i]); }
                const float mn = fmaxf(mrun, bm), mu = (mn == NEG_INF) ? 0.f : mn;
                float ls = 0.f;
#pragma unroll
                for (int i = 0; i < 16; ++i) ls += ex2(sc[i] - mu);
                lrun = lrun * ex2(mrun - mu) + ls; mrun = mn;
            }
            float mu, inv;
            { const float mo = __shfl_xor(mrun, 32), lo_ = __shfl_xor(lrun, 32); const float mt = fmaxf(mrun, mo); mu = (mt == NEG_INF) ? 0.f : mt;
              const float lt = lrun * ex2(mrun - mu) + lo_ * ex2(mo - mu); inv = lt > 0.f ? 1.f / lt : 0.f; }
            f32x16 Oc[2];
#pragma unroll
            for (int i = 0; i < 16; ++i) { Oc[0][i] = 0.f; Oc[1][i] = 0.f; }
            LAS float* ip = impP + ((hh * 64 + tl) * 32);
            float carry = 0.f;
#pragma unroll 1
            for (int kb = 0; kb < 4; ++kb) {
                f32x16 sc;
#pragma unroll
                for (int i = 0; i < 16; ++i) sc[i] = 0.f;
#pragma unroll
                for (int s = 0; s < 4; ++s) { const bf16x8 a = *(const LAS bf16x8*)(lds + AT_KC + (kb * 32 + r) * 144 + s * 32 + h * 16); sc = MFMA32(a, qf[s], sc); }
#pragma unroll
                for (int i = 0; i < 16; ++i) { const int nn = kb * 32 + crow(i, h); sc[i] = (nn <= nmax) ? ex2(sc[i] - mu) * inv : 0.f; }
                float Lo[4];
#pragma unroll
                for (int q4 = 0; q4 < 4; ++q4) Lo[q4] = __shfl_xor(sc[4 * q4 + 3], 32);
#pragma unroll
                for (int q4 = 0; q4 < 4; ++q4) {
                    const float G = (sc[4 * q4] + sc[4 * q4 + 1]) + (sc[4 * q4 + 2] + sc[4 * q4 + 3]);
                    const float prev0 = (q4 > 0) ? Lo[q4 > 0 ? q4 - 1 : 0] : carry;
                    const float Lp = (h == 1) ? Lo[q4] : prev0;
                    ip[8 * kb + 2 * q4 + h] = G + Lp;
                }
                carry = Lo[3];
#pragma unroll
                for (int s2 = 0; s2 < 2; ++s2) {
                    u32x4 p;
                    p.x = pk2(sc[8 * s2 + 0], sc[8 * s2 + 1]); p.y = pk2(sc[8 * s2 + 2], sc[8 * s2 + 3]); p.z = pk2(sc[8 * s2 + 4], sc[8 * s2 + 5]); p.w = pk2(sc[8 * s2 + 6], sc[8 * s2 + 7]);
                    const bf16x8 pb = __builtin_bit_cast(bf16x8, p);
#pragma unroll
                    for (int db = 0; db < 2; ++db) {
                        const LAS unsigned char* a = lds + AT_VC + (db * 32 + r) * 264 + (kb * 32 + 16 * s2 + 4 * h) * 2;
                        const s16x4 lo4 = *(const LAS s16x4*)a, hi4 = *(const LAS s16x4*)(a + 16);
                        const bf16x8 va = __builtin_shufflevector(lo4, hi4, 0, 1, 2, 3, 4, 5, 6, 7);
                        Oc[db] = MFMA32(va, pb, Oc[db]);
                    }
                }
            }
#pragma unroll
            for (int i = 0; i < 16; ++i) { Ot[0][i] = gc * Oc[0][i]; Ot[1][i] = gc * Oc[1][i]; }
        }
#endif
        __syncthreads();
        {
            const int tok = tid >> 3, sub = tid & 7;
#pragma unroll
            for (int jj = 0; jj < 4; ++jj) { const int j = sub * 4 + jj;
                impS[tok * 32 + j] = ((impP[(0 * 64 + tok) * 32 + j] + impP[(1 * 64 + tok) * 32 + j]) + impP[(2 * 64 + tok) * 32 + j]) + impP[(3 * 64 + tok) * 32 + j]; }
        }
        __syncthreads();
#ifndef NO_TOPK
        {
            const int tok = tid >> 3, sub = tid & 7;
            if (qt < 16) { if (sub == 0) selm[tok] = (2u << qt) - 1u; }
            else {
                float vj[4]; int rank[4];
#pragma unroll
                for (int jj = 0; jj < 4; ++jj) { vj[jj] = impS[tok * 32 + sub * 4 + jj]; rank[jj] = 0; }
#pragma unroll 1
                for (int i = 1; i <= qt - 2; ++i) { const float vi = impS[tok * 32 + i];
#pragma unroll
                    for (int jj = 0; jj < 4; ++jj) { const int j = sub * 4 + jj; rank[jj] += ((vi > vj[jj]) || (vi == vj[jj] && i < j)) ? 1 : 0; } }
                unsigned bits = 0u;
#pragma unroll
                for (int jj = 0; jj < 4; ++jj) { const int j = sub * 4 + jj;
                    const bool forced = (j == 0 || j == qt || j == qt - 1);
                    const bool sel = forced || (j <= qt - 2 && rank[jj] < 13);
                    bits |= sel ? (1u << j) : 0u; }
                if (bits) __hip_atomic_fetch_or(selm + tok, bits, __ATOMIC_RELAXED, __HIP_MEMORY_SCOPE_WORKGROUP);
            }
        }
#endif
        __syncthreads();
        LAS unsigned* park = (LAS unsigned*)(lds + AT_IMPP) + wave * 1024 + lane;
#pragma unroll
        for (int i = 0; i < 8; ++i) { park[i * 64] = pk2(Ot[0][2 * i], Ot[0][2 * i + 1]); park[(8 + i) * 64] = pk2(Ot[1][2 * i], Ot[1][2 * i + 1]); }
        const unsigned myselm = selm[tl];
        unsigned need;
        { unsigned w = selm[lane];
#pragma unroll
            for (int o = 1; o < 64; o <<= 1) w |= (unsigned)__shfl_xor((int)w, o);
            need = (unsigned)__builtin_amdgcn_readfirstlane((int)w) & ((2u << qt) - 1u); }
#ifdef REPEAT_SEL
        { f32x16 O2[2]; float m2 = 0.f, l2 = 0.f;
#pragma unroll
          for (int i = 0; i < 16; ++i) { O2[0][i] = 0.f; O2[1][i] = 0.f; }
          const bf16_t* kbase = F.KV() + ((size_t)b * SEQ + (tid >> 3)) * D + 512 + g * 64 + (tid & 7) * 8;
          const bf16_t* vbase = F.VT() + ((size_t)(g * 64 + (tid >> 3))) * T + (size_t)b * SEQ + (tid & 7) * 8;
          const unsigned inner = need & ~(1u << qt);
          if (inner) { const SeqSel seq{inner, myselm}; attn_stream<SeqSel, REPEAT_SEL>(lds, tid, r, h, seq, kbase, (size_t)64 * D, vbase, qf, O2, m2, l2, bgc); }
          attn_tile_masked(lds, tid, r, h, kbase + (size_t)qt * 64 * D, vbase + 64 * qt, qf, O2, m2, l2, -1, tl, bgc);
          asm volatile("" :: "v"(O2[0]), "v"(O2[1]), "v"(l2)); }
#endif
#ifndef NO_SEL
        {
            f32x16 O[2];
#pragma unroll
            for (int i = 0; i < 16; ++i) { O[0][i] = 0.f; O[1][i] = 0.f; }
            float m = 0.f, l = 0.f;
            const bf16_t* kbase = F.KV() + ((size_t)b * SEQ + (tid >> 3)) * D + 512 + g * 64 + (tid & 7) * 8;
            const bf16_t* vbase = F.VT() + ((size_t)(g * 64 + (tid >> 3))) * T + (size_t)b * SEQ + (tid & 7) * 8;
            const unsigned inner = need & ~(1u << qt);
            if (inner) { const SeqSel seq{inner, myselm}; attn_stream(lds, tid, r, h, seq, kbase, (size_t)64 * D, vbase, qf, O, m, l, bgc); }
            attn_tile_masked(lds, tid, r, h, kbase + (size_t)qt * 64 * D, vbase + 64 * qt, qf, O, m, l, -1, tl, bgc);
            l += __shfl_xor(l, 32);
            const float sc = l > 0.f ? gs / l : 0.f;
#pragma unroll
            for (int i = 0; i < 8; ++i) { const unsigned a = park[i * 64], c = park[(8 + i) * 64];
                park[i * 64] = pk2(bf_lo(a) + sc * O[0][2 * i], bf_hi(a) + sc * O[0][2 * i + 1]); park[(8 + i) * 64] = pk2(bf_lo(c) + sc * O[1][2 * i], bf_hi(c) + sc * O[1][2 * i + 1]); }
        }
#endif
#ifdef REPEAT_SWA
        { f32x16 O2[2]; float m2 = 0.f, l2 = 0.f;
#pragma unroll
          for (int i = 0; i < 16; ++i) { O2[0][i] = 0.f; O2[1][i] = 0.f; }
          const bf16_t* kbase = F.KV() + ((size_t)b * SEQ + (tid >> 3)) * D + 768 + g * 64 + (tid & 7) * 8;
          const bf16_t* vbase = F.VT() + ((size_t)(256 + g * 64 + (tid >> 3))) * T + (size_t)b * SEQ + (tid & 7) * 8;
          if (qt >= 8) attn_tile_masked(lds, tid, r, h, kbase + (size_t)(qt - 8) * 64 * D, vbase + 64 * (qt - 8), qf, O2, m2, l2, tl, 64, bgc);
          const int i0 = qt > 7 ? qt - 7 : 0;
          if (i0 <= qt - 1) { const SeqRange seq{i0, qt - 1}; attn_stream(lds, tid, r, h, seq, kbase, (size_t)64 * D, vbase, qf, O2, m2, l2, bgc); }
          attn_tile_masked(lds, tid, r, h, kbase + (size_t)qt * 64 * D, vbase + 64 * qt, qf, O2, m2, l2, -1, tl, bgc);
          asm volatile("" :: "v"(O2[0]), "v"(O2[1]), "v"(l2)); }
#endif
#ifndef NO_SWA
        {
            f32x16 O[2];
#pragma unroll
            for (int i = 0; i < 16; ++i) { O[0][i] = 0.f; O[1][i] = 0.f; }
            float m = 0.f, l = 0.f;
            const bf16_t* kbase = F.KV() + ((size_t)b * SEQ + (tid >> 3)) * D + 768 + g * 64 + (tid & 7) * 8;
            const bf16_t* vbase = F.VT() + ((size_t)(256 + g * 64 + (tid >> 3))) * T + (size_t)b * SEQ + (tid & 7) * 8;
            if (qt >= 8) attn_tile_masked(lds, tid, r, h, kbase + (size_t)(qt - 8) * 64 * D, vbase + 64 * (qt - 8), qf, O, m, l, tl, 64, bgc);
            const int i0 = qt > 7 ? qt - 7 : 0;
            if (i0 <= qt - 1) { const SeqRange seq{i0, qt - 1}; attn_stream(lds, tid, r, h, seq, kbase, (size_t)64 * D, vbase, qf, O, m, l, bgc); }
            attn_tile_masked(lds, tid, r, h, kbase + (size_t)qt * 64 * D, vbase + 64 * qt, qf, O, m, l, -1, tl, bgc);
            l += __shfl_xor(l, 32);
            const float sc = l > 0.f ? gw / l : 0.f;
#pragma unroll
            for (int i = 0; i < 8; ++i) { const unsigned a = park[i * 64], c = park[(8 + i) * 64];
                Ot[0][2 * i] = bf_lo(a) + sc * O[0][2 * i]; Ot[0][2 * i + 1] = bf_hi(a) + sc * O[0][2 * i + 1]; Ot[1][2 * i] = bf_lo(c) + sc * O[1][2 * i]; Ot[1][2 * i + 1] = bf_hi(c) + sc * O[1][2 * i + 1]; }
        }
#endif
        {
            bf16_t* op = F.O() + tokrow * D + head * 64 + 4 * h;
#pragma unroll
            for (int db = 0; db < 2; ++db)
#pragma unroll
                for (int q4 = 0; q4 < 4; ++q4) { u32x2 o; o.x = pk2(Ot[db][4 * q4], Ot[db][4 * q4 + 1]); o.y = pk2(Ot[db][4 * q4 + 2], Ot[db][4 * q4 + 3]); *(u32x2*)(op + db * 32 + 8 * q4) = o; }
        }
        __syncthreads();
    }
#ifdef PROBE_TAIL
    const int pt_rem = BG_PER_WAVE - bgc.cnt; const unsigned long long pt_t0 = __builtin_amdgcn_s_memrealtime();
#endif
    bg_flush(bgc, tid0 & 63);
    while (bgc.cnt < BG_PER_WAVE) { bg_issue(bgc, tid0 & 63); bg_finish(bgc, tid0 & 63); }
#ifdef PROBE_TAIL
    if (F.bx == PROBE_BLK && wave == 0) { const unsigned long long t1 = __builtin_amdgcn_s_memrealtime();
        const unsigned long long until = t1 + (PROBE_TAIL == 1 ? (unsigned long long)pt_rem * 10000ull : (t1 - pt_t0) * 100ull);
        while (__builtin_amdgcn_s_memrealtime() < until) __builtin_amdgcn_s_sleep(8); }
#endif
}

DI void swa_sink_phase(Frame& F) {
    LAS unsigned char* lds = F.lds;
    const int tid = F.tid, lane = F.lane, wave = F.wave, r = lane & 31, h = lane >> 5;
    const bf16_t* Qp = F.Q(); const bf16_t* Kp = F.KV(); const bf16_t* Vp = F.VT(); bf16_t* Op = F.O(); const float* sk = F.b_sinks();
    int ui = 0, q32 = F.vcu & 63, kvh = (F.vcu >> 6) & 1, b = F.vcu >> 7;
    int j1 = (32 * q32 + 31) >> 6, j = ((32 * q32 - 127) > 0 ? (32 * q32 - 127) : 0) >> 6;
    bf16x8 qf[4];
#pragma unroll
    for (int s = 0; s < 4; ++s) qf[s] = *(const bf16x8*)(Qp + ((size_t)b * SEQ + q32 * 32 + r) * D + (kvh * 8 + wave) * 64 + 16 * s + 8 * h);
    u32x4 kr = *(const u32x4*)(Kp + ((size_t)b * SEQ + 64 * j + (tid >> 3)) * 128 + kvh * 64 + (tid & 7) * 8);
    u32x4 vr = *(const u32x4*)(Vp + ((size_t)(kvh * 64 + (tid >> 3))) * T + (size_t)b * SEQ + 64 * j + (tid & 7) * 8);
    AT_WRITE_K(0, kr); AT_WRITE_V(0, vr);
    __syncthreads();
    f32x16 O[2];
#pragma unroll
    for (int i = 0; i < 16; ++i) { O[0][i] = 0.f; O[1][i] = 0.f; }
    const float skm0 = sk[wave] * LOG2E, skm1 = sk[8 + wave] * LOG2E;
    float m = kvh ? skm1 : skm0, l = (h == 0) ? 1.f : 0.f;
    int buf = 0;
    for (;;) {
        const bool last_tile = (j == j1);
        int nq32 = q32, nkvh = kvh, nb = b, nj = j + 1; bool has = true;
        if (last_tile) { has = (ui + 1) < 8;
            if (has) { const int u = (ui + 1) * GRID + F.vcu; nq32 = u & 63; nkvh = (u >> 6) & 1; nb = u >> 7; nj = ((32 * nq32 - 127) > 0 ? (32 * nq32 - 127) : 0) >> 6; } }
        bf16x8 qn[4];
        if (has) {
            kr = *(const u32x4*)(Kp + ((size_t)nb * SEQ + 64 * nj + (tid >> 3)) * 128 + nkvh * 64 + (tid & 7) * 8);
            vr = *(const u32x4*)(Vp + ((size_t)(nkvh * 64 + (tid >> 3))) * T + (size_t)nb * SEQ + 64 * nj + (tid & 7) * 8);
            if (last_tile) {
#pragma unroll
                for (int s = 0; s < 4; ++s) qn[s] = *(const bf16x8*)(Qp + ((size_t)nb * SEQ + nq32 * 32 + r) * D + (nkvh * 8 + wave) * 64 + 16 * s + 8 * h);
            }
        }
        {
            const int hi = q32 * 32 + r - 64 * j;
            f32x16 s0, s1;
            qk_tile(lds + AT_KT + buf * 9216, qf, s0, s1, r, h);
            unsigned w0, w1; make_mask(hi - 128, hi, h, w0, w1);
            float mx = tile_max<true>(s0, s1, w0, w1);
            mx = fmaxf(mx, __shfl_xor(mx, 32));
            if (__any(mx - m > AT_THR)) { const float mn = fmaxf(m, mx), alpha = ex2(m - mn); m = mn; l *= alpha; O[0] = O[0] * alpha; O[1] = O[1] * alpha; }
            u32x4 pb[2][2];
            l += tile_exp<true, true>(s0, s1, w0, w1, m, pb);
            pv_tile(lds + AT_VT + buf * 9216, pb, O, r, h);
        }
        if (has) { AT_WRITE_K(buf ^ 1, kr); AT_WRITE_V(buf ^ 1, vr); }
        __syncthreads();
        buf ^= 1;
        if (last_tile) {
            l += __shfl_xor(l, 32);
            const float sc = 1.f / l;
            bf16_t* op = Op + ((size_t)b * SEQ + q32 * 32 + r) * D + (kvh * 8 + wave) * 64 + 4 * h;
#pragma unroll
            for (int db = 0; db < 2; ++db)
#pragma unroll
                for (int q4 = 0; q4 < 4; ++q4) { u32x2 o; o.x = pk2(O[db][4 * q4] * sc, O[db][4 * q4 + 1] * sc); o.y = pk2(O[db][4 * q4 + 2] * sc, O[db][4 * q4 + 3] * sc); *(u32x2*)(op + db * 32 + 8 * q4) = o; }
            if (!has) break;
#pragma unroll
            for (int i = 0; i < 16; ++i) { O[0][i] = 0.f; O[1][i] = 0.f; }
#pragma unroll
            for (int s = 0; s < 4; ++s) qf[s] = qn[s];
            ++ui; q32 = nq32; kvh = nkvh; b = nb; j1 = (32 * q32 + 31) >> 6;
            m = kvh ? skm1 : skm0; l = (h == 0) ? 1.f : 0.f;
        }
        j = nj;
    }
}
#ifndef N_LAUNCHES
#define N_LAUNCHES 1
#endif
DI int down_deal(const LAS unsigned* ext, int vcu) { const int n_gu_extra = (int)((2u * (unsigned)__builtin_amdgcn_readfirstlane((int)ext[96])) & (GRID - 1)); return (vcu - n_gu_extra) & (GRID - 1); }
constexpr int N_PHASES = 17;
__global__ void __launch_bounds__(NTHR, 2) fwd_kernel(Args args) {
    extern __shared__ __attribute__((aligned(16))) unsigned char lds_raw[];
    LAS unsigned char* const lds = (LAS unsigned char*)lds_raw;
    const int wave0 = __builtin_amdgcn_readfirstlane((int)(threadIdx.x >> 6));
    for (int u = threadIdx.x; u < 256; u += NTHR) ((LAS unsigned*)(lds + MISC_OFF))[u] = 0u;
    __syncthreads();
#if N_LAUNCHES == 1
    { Frame F = make_frame(lds, wave0); (void)xcd_barrier_post(F.ctl() + CW_BAR, (volatile LAS unsigned*)(lds + MISC_OFF)); }
#define IN(k) true
#define SEAM(k) do { Frame Fb = make_frame(lds, wave0); XcdBarrier _b; _b.bar = Fb.ctl() + CW_BAR; _b.x = xb_xcc_id(); _b.st = (volatile LAS unsigned*)(lds + MISC_OFF); xcd_barrier(_b); } while (0)
#else
#ifdef ONLY_PHASE
#define IN(k) ((k) == ONLY_PHASE && args.ph_lo <= (k) && (k) < args.ph_hi)
#else
#define IN(k) (args.ph_lo <= (k) && (k) < args.ph_hi)
#endif
#define SEAM(k) do { } while (0)
#endif
    const LAS unsigned* ext = (const LAS unsigned*)(lds + EXT_OFF);
#ifndef REPEAT_MASK
#define REPEAT_MASK 0
#endif
#define PH(k, ...) do { if (IN(k)) { __VA_ARGS__ } if ((((REPEAT_MASK) >> (k)) & 1) && IN(k)) { __VA_ARGS__ } } while (0)

    PH(0, Frame F = make_frame(lds, wave0); p0_prologue(F);); SEAM(0);
    PH(1, Frame F = make_frame(lds, wave0); norm_plain_phase(F);); SEAM(1);
#ifdef PROBE_SEAMS
    for (int q_ = 0; q_ < PROBE_SEAMS; ++q_) { SEAM(1); }
#endif
    PH(2, Frame F = make_frame(lds, wave0); PolProj0 P{F.HN(), F.WINT(), F.Q(), F.KV(), F.VT(), F.GATES(), F.ROPE(), F.vcu, lds}; pg8::gemm_phase(lds, P, F.wave, F.lane);); SEAM(2);
    PH(3, Frame F = make_frame(lds, wave0); compress_phase(F);); SEAM(3);
    PH(4, Frame F = make_frame(lds, wave0); nsa_attn_phase(F);); SEAM(4);
#ifdef PROBE_OUT
    { Frame F = make_frame(lds, wave0); NoEpi<PolOut> P{{F.O(), F.WAOT(), F.x(), F.MODV(), nullptr, F.H(), F.vcu}};
      for (int rep = 0; rep < PROBE_OUT; ++rep) pg8::gemm_phase(lds, P, F.wave, F.lane); }
#endif
    PH(5, Frame F = make_frame(lds, wave0); PolOut P{F.O(), F.WAOT(), F.x(), F.MODV() + (size_t)0 * 16 * 3072, nullptr, F.H(), F.vcu}; pg8::gemm_phase(lds, P, F.wave, F.lane);); SEAM(5);
    PH(6, Frame F = make_frame(lds, wave0); norm_router_phase(F, 0);); SEAM(6);
#ifdef PROBE_GU_NOEPI
    { Frame F = make_frame(lds, wave0); load_expert_tables(F, 0, 8); PolGateUpT<true> P{F.HN(), F.WGUT(), F.b_gate_up(), F.LIST(), F.ACT(), ext, F.vcu, lds, F.ctl() + CW_PANEL}; pg8::gemm_phase(lds, P, F.wave, F.lane); }
#endif
#ifdef PROBE_CLOCK
    unsigned long long pc_t0 = __builtin_amdgcn_s_memtime(), pc_r0 = __builtin_amdgcn_s_memrealtime();
#endif
    PH(7, Frame F = make_frame(lds, wave0); load_expert_tables(F, 0, 8); PolGateUp P{F.HN(), F.WGUT(), F.b_gate_up(), F.LIST(), F.ACT(), ext, F.vcu, lds, F.ctl() + CW_PANEL}; pg8::gemm_phase(lds, P, F.wave, F.lane););
#ifdef PROBE_CLOCK
    {
        const unsigned long long t1 = __builtin_amdgcn_s_memtime(), r1 = __builtin_amdgcn_s_memrealtime();
        if (blockIdx.x == 0) { const unsigned long long f = (t1 - pc_t0) / (r1 - pc_r0);
            const unsigned long long until = r1 + f * 1000ull;
            while (__builtin_amdgcn_s_memrealtime() < until) __builtin_amdgcn_s_sleep(8); }
    }
#endif
#ifdef PROBE_DN
    { Frame F = make_frame(lds, wave0); load_expert_tables(F, 0, 4); PolDownT<(PROBE_DN == 1)> P{F.ACT(), F.WDNT(), F.b_down(), F.LISTW(), F.OUTB(), ext, F.vcu, lds, F.ctl() + CW_PANEL, F.wave}; pg8::gemm_phase(lds, P, F.wave, F.lane); }
#endif
    PH(8, Frame F = make_frame(lds, wave0); load_expert_tables(F, 0, 4); PolDown P{F.ACT(), F.WDNT(), F.b_down(), F.LISTW(), F.OUTB(), ext, down_deal(ext, F.vcu), lds, F.ctl() + CW_PANEL, F.wave}; pg8::gemm_phase(lds, P, F.wave, F.lane);); SEAM(8);
    PH(9, Frame F = make_frame(lds, wave0); combine_phase<false>(F, 0);); SEAM(9);
    PH(10, Frame F = make_frame(lds, wave0); { PolProj1T<0> P{F.wsp(), F.b_b_q(), F.kv_b(), F.vcu, lds}; pg8::gemm_phase(lds, P, F.wave, F.lane); } { Frame G = make_frame(lds, wave0); PolProj1T<1> P{G.wsp(), G.b_b_q(), G.kv_b(), G.vcu, lds}; pg8::gemm_phase(lds, P, G.wave, G.lane); }); SEAM(10);
    PH(11, Frame F = make_frame(lds, wave0); swa_sink_phase(F);); SEAM(11);
    PH(12, Frame F = make_frame(lds, wave0); PolOut P{F.O(), F.WBOT(), F.H(), F.MODV() + (size_t)2 * 16 * 3072, F.b_b_out(), F.H(), F.vcu}; pg8::gemm_phase(lds, P, F.wave, F.lane);); SEAM(12);
    PH(13, Frame F = make_frame(lds, wave0); norm_router_phase(F, 1);); SEAM(13);
    PH(14, Frame F = make_frame(lds, wave0); load_expert_tables(F, 1, 8); PolGateUp P{F.HN(), F.WGUT() + (size_t)32 * 2048 * D, F.b_gate_up() + 32 * 2048, F.LIST(), F.ACT(), ext, F.vcu, lds, F.ctl() + CW_PANEL + 1024}; pg8::gemm_phase(lds, P, F.wave, F.lane););
    PH(15, Frame F = make_frame(lds, wave0); load_expert_tables(F, 1, 4); PolDown P{F.ACT(), F.WDNT() + (size_t)32 * D * D, F.b_down() + 32 * 1024, F.LISTW(), F.OUTB(), ext, down_deal(ext, F.vcu), lds, F.ctl() + CW_PANEL + 1024, F.wave}; pg8::gemm_phase(lds, P, F.wave, F.lane);); SEAM(15);
    PH(16, Frame F = make_frame(lds, wave0); combine_phase<true>(F, 1););
#undef IN
#undef SEAM
}

extern "C" void kernel_launch(void* const* d_in, const int* in_sizes, int n_in, void* d_out, int out_size, void* d_ws, size_t ws_size, hipStream_t stream) {
    static int ready = 0;
    if (ready == 0) {
        if (n_in != 28 || out_size != T * D || ws_size < WS_END) { fprintf(stderr, "kernel_launch: unexpected shapes (n_in %d out %d ws %zu)\n", n_in, out_size, ws_size); ready = -1; return; }
        int dev = 0, cus = 0, per_cu = 0;
        if (hipGetDevice(&dev) != hipSuccess || hipDeviceGetAttribute(&cus, hipDeviceAttributeMultiprocessorCount, dev) != hipSuccess) { ready = -1; return; }
        if (hipFuncSetAttribute((const void*)fwd_kernel, hipFuncAttributeMaxDynamicSharedMemorySize, LDS_BYTES) != hipSuccess) { fprintf(stderr, "kernel_launch: hipFuncSetAttribute failed\n"); ready = -1; return; }
        if (hipOccupancyMaxActiveBlocksPerMultiprocessor(&per_cu, (const void*)fwd_kernel, NTHR, LDS_BYTES) != hipSuccess || per_cu < 1) fprintf(stderr, "kernel_launch: occupancy query reports %d\n", per_cu);
        (void)hipGetLastError();
        if (cus < GRID) { fprintf(stderr, "kernel_launch: needs %d CUs, device has %d\n", GRID, cus); ready = -1; return; }
        ready = 1;
    }
    if (ready < 0) return;
    (void)hipMemsetAsync((char*)d_ws + WS_CTL, 0, CTL_ZERO_BYTES, stream);
    Args a{};
    for (int i = 0; i < 28; ++i) a.in[i] = d_in[i];
    a.out = (float*)d_out; a.ws = (unsigned char*)d_ws;
    if (N_LAUNCHES == 1) {
        a.ph_lo = 0; a.ph_hi = N_PHASES;
        hipLaunchKernelGGL(fwd_kernel, dim3(GRID), dim3(NTHR), LDS_BYTES, stream, a);
    } else {
        for (int p = 0; p < N_PHASES; ++p) { a.ph_lo = p; a.ph_hi = p + 1; hipLaunchKernelGGL(fwd_kernel, dim3(GRID), dim3(NTHR), LDS_BYTES, stream, a); }
    }
}
```

```cpp
#include <hip/hip_runtime.h>
#include <cstdio>
#include <cstdint>

#define DI __device__ __forceinline__
#define LAS __attribute__((address_space(3)))
#define GAS __attribute__((address_space(1)))
typedef unsigned short bf16_t;
typedef short bf16x8 __attribute__((ext_vector_type(8)));
typedef short s16x4 __attribute__((ext_vector_type(4)));
typedef float f32x2 __attribute__((ext_vector_type(2)));
typedef float f32x4 __attribute__((ext_vector_type(4)));
typedef float f32x16 __attribute__((ext_vector_type(16)));
typedef unsigned u32x4 __attribute__((ext_vector_type(4)));
typedef unsigned u32x2 __attribute__((ext_vector_type(2)));

constexpr int NB = 16, SEQ = 2048, T = NB * SEQ, D = 1024, HD = 64;
constexpr int NEXP = 32, TOPK = 4;
constexpr int A_PROJ = 2608;
constexpr float NORM_EPS = 1e-5f;
constexpr float QSCALE = 0.125f * 1.4426950408889634f;
constexpr float LOG2E = 1.4426950408889634f;
constexpr int NWAVES = 8, NTHR = 512, GRID = 256;
constexpr int MODN = 4 * 16 * 3072 + 16 * 2048;

constexpr size_t MiB = (size_t)1 << 20;
constexpr size_t WS_CTL = 0, CTL_ZERO_BYTES = 1 * MiB;
constexpr size_t WS_MODV = 1 * MiB;
constexpr size_t WS_ROPE = 2 * MiB;
constexpr size_t WS_CMPB = 4 * MiB;
constexpr size_t WS_CW1T = 5 * MiB;
constexpr size_t WS_CW2T = 6 * MiB;
constexpr size_t WS_WINT = 7 * MiB;
constexpr size_t WS_WAOT = 13 * MiB;
constexpr size_t WS_WBQT = 15 * MiB;
constexpr size_t WS_WBOT = 17 * MiB;
constexpr size_t WS_WKVT = 19 * MiB;
constexpr size_t WS_KC = 20 * MiB;
constexpr size_t WS_VCT = 21 * MiB;
constexpr size_t WS_TOKSLOT = 22 * MiB;
constexpr size_t WS_GATES = 24 * MiB;
constexpr size_t WS_LIST = 32 * MiB;
constexpr size_t WS_LISTW = 36 * MiB;
constexpr size_t WS_VT = 40 * MiB;
constexpr size_t WS_WGUT = 72 * MiB;
constexpr size_t WS_WDNT = 328 * MiB;
constexpr size_t WS_H = 456 * MiB;
constexpr size_t WS_HN = 584 * MiB;
constexpr size_t WS_HN2 = 648 * MiB;
constexpr size_t WS_Q = 712 * MiB;
constexpr size_t WS_KV = 776 * MiB;
constexpr size_t WS_O = 840 * MiB;
constexpr size_t WS_ACT = 904 * MiB;
constexpr size_t WS_OUTB = 1161 * MiB;
constexpr size_t WS_MODP = 1417 * MiB;
constexpr size_t WS_DUMMY = 1425 * MiB;
constexpr size_t WS_END = 1428 * MiB;
constexpr int CW_BAR = 1024;
constexpr int CW_CNT = 8192;
constexpr int CW_XRANK = 12288;
constexpr int CW_PANEL = 16384;

constexpr int LDS_BYTES = 163840;
constexpr int MISC_OFF = LDS_BYTES - 1024;
constexpr int EXT_OFF = MISC_OFF + 64;
constexpr int XAFF_OFF = MISC_OFF + 512;

DI unsigned pk2(float lo, float hi) {
    typedef __bf16 bf2 __attribute__((ext_vector_type(2)));
    f32x2 v = {lo, hi}; bf2 b = __builtin_convertvector(v, bf2); return __builtin_bit_cast(unsigned, b);
}
DI float bf_lo(unsigned u) { return __uint_as_float(u << 16); }
DI float bf_hi(unsigned u) { return __uint_as_float(u & 0xffff0000u); }
DI float ex2(float x) { return __builtin_amdgcn_exp2f(x); }
DI float rcpf(float x) { return __builtin_amdgcn_rcpf(x); }
DI void halves32(unsigned x, unsigned& lo, unsigned& hi) { const auto r = __builtin_amdgcn_permlane32_swap(x, x, false, false); lo = r[0]; hi = r[1]; }
DI void halves32(float x, float& lo, float& hi) { unsigned a, b; halves32(__float_as_uint(x), a, b); lo = __uint_as_float(a); hi = __uint_as_float(b); }
DI float max_xor32(float x) { float a, b; halves32(x, a, b); return fmaxf(a, b); }
DI float sum_xor32(float x) { float a, b; halves32(x, a, b); return a + b; }
template <int O> DI unsigned shx_u(unsigned x, int lane) {
    if constexpr (O == 32) { unsigned a, b; halves32(x, a, b); return (lane & 32) ? a : b; }
    else return (unsigned)__builtin_amdgcn_ds_swizzle((int)x, (O << 10) | 0x1f);
}
template <int O> DI float shx(float x, int lane) { return __uint_as_float(shx_u<O>(__float_as_uint(x), lane)); }
DI float wave_sum(float v) {
    v += shx<1>(v, 0); v += shx<2>(v, 0); v += shx<4>(v, 0); v += shx<8>(v, 0); v += shx<16>(v, 0);
    return sum_xor32(v);
}
DI int crow(int reg, int h) { return (reg & 3) + 8 * (reg >> 2) + 4 * h; }
#define MFMA32(a, b, c) __builtin_amdgcn_mfma_f32_32x32x16_bf16((a), (b), (c), 0, 0, 0)
#define LDS_WAIT() asm volatile("s_waitcnt lgkmcnt(0)" ::: "memory")
#define VM_WAIT() asm volatile("s_waitcnt vmcnt(0)" ::: "memory")

#define XB_TMO      128
#define XB_XCNT(j)  (256  + 64 * (j))
#define XB_XSUB(j)  (1280 + 64 * (j))
#define XB_XGEN(j)  (2304 + 64 * (j))
#define XB_TOP      3328
#define XB_TOPGEN   3392
#define XCD_BAR_WORDS 3456
#define XB_SPIN_CAP (1u << 21)

DI unsigned xb_ld(unsigned* p)              { return __hip_atomic_load(p, __ATOMIC_RELAXED, __HIP_MEMORY_SCOPE_AGENT); }
DI unsigned xb_add(unsigned* p, unsigned v) { return __hip_atomic_fetch_add(p, v, __ATOMIC_RELAXED, __HIP_MEMORY_SCOPE_AGENT); }
DI unsigned xb_xcc_id() { return (unsigned)__builtin_amdgcn_s_getreg((3 << 11) | 20) & 0xFu; }
#define XB_SPIN(cond, bar) do { unsigned _sp = 0; while (cond) { __builtin_amdgcn_s_sleep(1); \
    if ((++_sp & 255u) == 0u) { if (xb_ld(&(bar)[XB_TMO])) break; if (_sp > XB_SPIN_CAP) { atomicAdd(&(bar)[XB_TMO], 1u); break; } } } } while (0)

struct XcdBarrier { unsigned* bar; unsigned x; volatile LAS unsigned* st; };

DI XcdBarrier xcd_barrier_post(unsigned* bar, volatile LAS unsigned* st) {
    XcdBarrier b; b.bar = bar; b.x = xb_xcc_id(); b.st = st;
    if (threadIdx.x == 0) (void)xb_add(&bar[XB_XCNT(b.x)], 1u);
    return b;
}
DI void xcd_barrier_complete(unsigned* bar, unsigned x, unsigned& nloc, unsigned& nx) {
    const unsigned G = gridDim.x * gridDim.y * gridDim.z;
    unsigned sum, cnt, mine, sp = 0u;
    for (;;) {
        sum = 0u; cnt = 0u; mine = 0u;
#pragma unroll
        for (unsigned j = 0; j < 16; ++j) { const unsigned c = xb_ld(&bar[XB_XCNT(j)]); sum += c; cnt += (c > 0u) ? 1u : 0u; mine = (j == x) ? c : mine; }
        if (sum == G) break;
        __builtin_amdgcn_s_sleep(1);
        if ((++sp & 255u) == 0u) { if (xb_ld(&bar[XB_TMO])) break; if (sp > XB_SPIN_CAP) { atomicAdd(&bar[XB_TMO], 1u); break; } }
    }
    nloc = mine > 0u ? mine : 1u; nx = cnt > 0u ? cnt : 1u;
}
DI void xcd_barrier(const XcdBarrier& b) {
    asm volatile("s_waitcnt vmcnt(0)" ::: "memory");
    __syncthreads();
    if (threadIdx.x == 0) {
        unsigned* bar = b.bar;
        __builtin_amdgcn_s_waitcnt(0);
        unsigned nloc = b.st[0], nx = b.st[1];
        if (nloc == 0u) { xcd_barrier_complete(bar, b.x, nloc, nx); b.st[0] = nloc; b.st[1] = nx; }
        const unsigned old = xb_add(&bar[XB_XSUB(b.x)], 1u);
        const unsigned gen = old / nloc;
        if (old + 1u == (gen + 1u) * nloc) {
            __builtin_amdgcn_fence(__ATOMIC_RELEASE, "agent");
            asm volatile("s_waitcnt vmcnt(0)" ::: "memory");
            const unsigned og = xb_add(&bar[XB_TOP], 1u);
            const unsigned tg = og / nx;
            if (og + 1u == (tg + 1u) * nx) xb_add(&bar[XB_TOPGEN], 1u);
            else XB_SPIN(xb_ld(&bar[XB_TOPGEN]) == tg, bar);
            __builtin_amdgcn_fence(__ATOMIC_ACQUIRE, "agent");
            xb_add(&bar[XB_XGEN(b.x)], 1u);
            asm volatile("s_waitcnt vmcnt(0)" ::: "memory");
        } else {
            XB_SPIN(xb_ld(&bar[XB_XGEN(b.x)]) == gen, bar);
            __builtin_amdgcn_fence(__ATOMIC_ACQUIRE, "agent");
            asm volatile("s_waitcnt vmcnt(0)" ::: "memory");
        }
    }
    __syncthreads();
}

struct Args { const void* in[28]; float* out; unsigned char* ws; int ph_lo, ph_hi; };

typedef const __attribute__((address_space(4))) unsigned char* KPtr;
struct Frame {
    LAS unsigned char* lds; KPtr kp; int tid, lane, wave, vcu, bx;
    DI void* arg(int i) const { return *(void* const __attribute__((address_space(4)))*)(kp + 8 * i); }
    DI unsigned char* wsp() const { return (unsigned char*)arg(29); }
    DI unsigned* ctl() const { return (unsigned*)(wsp() + WS_CTL); }
    DI float* out() const { return (float*)arg(28); }
    DI const float* x() const { return (const float*)arg(0); }
    DI const float* c() const { return (const float*)arg(1); }
    DI const int* positions() const { return (const int*)arg(2); }
    DI const float* mod_w() const { return (const float*)arg(3); }
    DI const float* mod_b() const { return (const float*)arg(4); }
    DI const float* norm_g() const { return (const float*)arg(5); }
    DI const float* final_g() const { return (const float*)arg(6); }
    DI const float* a_w_in() const { return (const float*)arg(7); }
    DI const float* cmp_pe() const { return (const float*)arg(8); }
    DI const float* cmp_w1() const { return (const float*)arg(9); }
    DI const float* cmp_w2() const { return (const float*)arg(10); }
    DI const float* a_w_out() const { return (const float*)arg(11); }
    DI const float* kv_norm_g() const { return (const float*)arg(12); }
    DI const float* kv_mod_w() const { return (const float*)arg(13); }
    DI const float* kv_mod_b() const { return (const float*)arg(14); }
    DI const float* kv_w() const { return (const float*)arg(15); }
    DI const float* kv_b() const { return (const float*)arg(16); }
    DI const float* b_w_q() const { return (const float*)arg(17); }
    DI const float* b_b_q() const { return (const float*)arg(18); }
    DI const float* b_sinks() const { return (const float*)arg(19); }
    DI const float* b_w_out() const { return (const float*)arg(20); }
    DI const float* b_b_out() const { return (const float*)arg(21); }
    DI const float* router_w() const { return (const float*)arg(22); }
    DI const float* router_b() const { return (const float*)arg(23); }
    DI const float* w_gate_up() const { return (const float*)arg(24); }
    DI const float* b_gate_up() const { return (const float*)arg(25); }
    DI const float* w_down() const { return (const float*)arg(26); }
    DI const float* b_down() const { return (const float*)arg(27); }
    DI float* MODV() const { return (float*)(wsp() + WS_MODV); }
    DI float* MODP() const { return (float*)(wsp() + WS_MODP); }
    DI float* ROPE() const { return (float*)(wsp() + WS_ROPE); }
    DI float* CMPB() const { return (float*)(wsp() + WS_CMPB); }
    DI float* GATES() const { return (float*)(wsp() + WS_GATES); }
    DI float* LISTW() const { return (float*)(wsp() + WS_LISTW); }
    DI float* H() const { return (float*)(wsp() + WS_H); }
    DI bf16_t* CW1T() const { return (bf16_t*)(wsp() + WS_CW1T); }
    DI bf16_t* CW2T() const { return (bf16_t*)(wsp() + WS_CW2T); }
    DI bf16_t* WINT() const { return (bf16_t*)(wsp() + WS_WINT); }
    DI bf16_t* WAOT() const { return (bf16_t*)(wsp() + WS_WAOT); }
    DI bf16_t* WBQT() const { return (bf16_t*)(wsp() + WS_WBQT); }
    DI bf16_t* WBOT() const { return (bf16_t*)(wsp() + WS_WBOT); }
    DI bf16_t* WKVT() const { return (bf16_t*)(wsp() + WS_WKVT); }
    DI bf16_t* KC() const { return (bf16_t*)(wsp() + WS_KC); }
    DI bf16_t* VCT() const { return (bf16_t*)(wsp() + WS_VCT); }
    DI bf16_t* VT() const { return (bf16_t*)(wsp() + WS_VT); }
    DI bf16_t* WGUT() const { return (bf16_t*)(wsp() + WS_WGUT); }
    DI bf16_t* WDNT() const { return (bf16_t*)(wsp() + WS_WDNT); }
    DI bf16_t* HN() const { return (bf16_t*)(wsp() + WS_HN); }
    DI bf16_t* HN2() const { return (bf16_t*)(wsp() + WS_HN2); }
    DI bf16_t* Q() const { return (bf16_t*)(wsp() + WS_Q); }
    DI bf16_t* KV() const { return (bf16_t*)(wsp() + WS_KV); }
    DI bf16_t* O() const { return (bf16_t*)(wsp() + WS_O); }
    DI bf16_t* ACT() const { return (bf16_t*)(wsp() + WS_ACT); }
    DI bf16_t* OUTB() const { return (bf16_t*)(wsp() + WS_OUTB); }
    DI unsigned* TOKSLOT() const { return (unsigned*)(wsp() + WS_TOKSLOT); }
    DI unsigned* LIST() const { return (unsigned*)(wsp() + WS_LIST); }
};
DI int vcu_of(int bx) { return (bx & 7) * (GRID / 8) + (bx >> 3); }
DI int fresh_lane() { int l; asm volatile("v_mbcnt_lo_u32_b32 %0, -1, 0\n\tv_mbcnt_hi_u32_b32 %0, -1, %0" : "=&v"(l)); return l; }
DI Frame make_frame(LAS unsigned char* lds, int wave_sgpr) {
    Frame F; F.lds = lds;
    KPtr kp = (KPtr)__builtin_amdgcn_kernarg_segment_ptr(); asm volatile("" : "+s"(kp)); F.kp = kp;
    int wv = wave_sgpr; asm volatile("" : "+s"(wv)); F.wave = wv; F.lane = fresh_lane(); F.tid = wv * 64 + F.lane;
    int bx = (int)blockIdx.x; asm volatile("" : "+s"(bx)); F.bx = bx; F.vcu = vcu_of(bx);
    return F;
}
DI void transpose_item(const float* W, int ld, int K, bf16_t* WT, int drow0, int k0, int n0, LAS float* scr, int lane) {
    f32x4 v[16];
    const float* src = W + (size_t)(k0 + (lane >> 4)) * ld + n0 + 4 * (lane & 15);
#pragma unroll
    for (int i = 0; i < 16; ++i) v[i] = __builtin_nontemporal_load((const f32x4*)(src + (size_t)(4 * i) * ld));
    LAS float* wp = scr + (lane >> 4) * 65 + 4 * (lane & 15);
#pragma unroll
    for (int i = 0; i < 16; ++i) { LAS float* q = wp + (4 * i) * 65; q[0] = v[i].x; q[1] = v[i].y; q[2] = v[i].z; q[3] = v[i].w; }
    LDS_WAIT(); asm volatile("" ::: "memory");
    const int c = lane & 7;
#pragma unroll
    for (int j = 0; j < 8; ++j) { const int n = (lane >> 3) + 8 * j; const LAS float* s = scr + (8 * c) * 65 + n;
        u32x4 o; o.x = pk2(s[0 * 65], s[1 * 65]); o.y = pk2(s[2 * 65], s[3 * 65]); o.z = pk2(s[4 * 65], s[5 * 65]); o.w = pk2(s[6 * 65], s[7 * 65]);
        __builtin_nontemporal_store(o, (u32x4*)(WT + (size_t)(drow0 + n) * K + k0 + 8 * c)); }
    LDS_WAIT(); asm volatile("" ::: "memory");
}

DI void p0_prologue(Frame& F) {
    const int gw = F.bx * NWAVES + F.wave, NGW = GRID * NWAVES, lane = F.lane;
    const int gtid = F.bx * NTHR + F.tid, NGT = GRID * NTHR;
    LAS float* cact = (LAS float*)(F.lds + 73728);
#pragma unroll 1
    for (int i0 = 0; i0 < (NB * D) / NTHR; i0 += 16) {
        float cv[16];
#pragma unroll
        for (int i = 0; i < 16; ++i) cv[i] = F.c()[F.tid + (i0 + i) * NTHR];
#pragma unroll
        for (int i = 0; i < 16; ++i) { const int idx = F.tid + (i0 + i) * NTHR, b = idx / D, k = idx % D; const float v = cv[i]; cact[k * 16 + b] = v / (1.f + __expf(-v)); }
    }
    __syncthreads();
    if (gw < 1792) {
        const int seg = gw / 224, it = gw % 224; const float* W; float* outp; int ld; int chunk;
        if (it < 192) { const int set = it / 48; chunk = it % 48; W = F.mod_w() + (size_t)set * D * 3072; ld = 3072; outp = F.MODP() + (size_t)seg * MODN + (size_t)set * 16 * 3072; }
        else { chunk = it - 192; W = F.kv_mod_w(); ld = 2048; outp = F.MODP() + (size_t)seg * MODN + (size_t)4 * 16 * 3072; }
        const int col = chunk * 64 + lane;
        float acc[16];
#pragma unroll
        for (int b = 0; b < 16; ++b) acc[b] = 0.f;
#pragma unroll 8
        for (int kk = 0; kk < 128; ++kk) {
            const int k = seg * 128 + kk;
            const float w = W[(size_t)k * ld + col];
            const LAS f32x4* cp = (const LAS f32x4*)(cact + k * 16);
            const f32x4 c0 = cp[0], c1 = cp[1], c2 = cp[2], c3 = cp[3];
            acc[0] += c0.x * w; acc[1] += c0.y * w; acc[2] += c0.z * w; acc[3] += c0.w * w;
            acc[4] += c1.x * w; acc[5] += c1.y * w; acc[6] += c1.z * w; acc[7] += c1.w * w;
            acc[8] += c2.x * w; acc[9] += c2.y * w; acc[10] += c2.z * w; acc[11] += c2.w * w;
            acc[12] += c3.x * w; acc[13] += c3.y * w; acc[14] += c3.z * w; acc[15] += c3.w * w;
        }
#pragma unroll
        for (int b = 0; b < 16; ++b) outp[(size_t)b * ld + col] = acc[b];
    }
    if (gw < 256) {
        const int kv = gw / 128, e = gw % 128; float s = 0.f;
        for (int j = 0; j < 32; ++j) { const int k = lane + 64 * j; s += F.cmp_pe()[kv * 2048 + k] * F.cmp_w1()[((size_t)kv * 2048 + k) * 128 + e]; }
        s = wave_sum(s);
        if (lane == 0) F.CMPB()[gw] = s;
    }
    for (int idx = gtid; idx < T * 8; idx += NGT) {
        const int tok = idx >> 3, i = idx & 7;
        const float inv = (float)pow(500000.0, -(double)(2 * i) / 16.0);
        const float ang = (float)F.positions()[tok] * inv;
        double a = (double)ang; const double twopi = 6.283185307179586476925286766559;
        a -= twopi * rint(a / twopi);
        const float ar = (float)a;
        F.ROPE()[(size_t)tok * 16 + i] = cosf(ar); F.ROPE()[(size_t)tok * 16 + 8 + i] = sinf(ar);
    }
    for (int idx = gtid; idx < 256 * D; idx += NGT) {
        const int row = idx / D, k = idx % D;
        const float v = row < 48 ? F.a_w_in()[(size_t)k * A_PROJ + 2560 + row] : 0.f;
        F.WINT()[(size_t)(2048 + row) * D + k] = (bf16_t)(pk2(v, 0.f) & 0xffffu);
    }
#ifdef PROBE_COPY
    {
        const f32x4* src = (const f32x4*)F.w_gate_up(); u32x4* dst = (u32x4*)F.ACT();
        const size_t n8 = (size_t)2 * 32 * D * 2048 / 8 + (size_t)2 * 32 * D * D / 8;
        const size_t n8a = (size_t)2 * 32 * D * 2048 / 8;
        const f32x4* src2 = (const f32x4*)F.w_down();
        for (size_t i = (size_t)gtid; i < n8; i += (size_t)NGT * 4) {
#pragma unroll
            for (int u = 0; u < 4; ++u) { const size_t k = i + (size_t)u * NGT; if (k < n8) {
                const f32x4* s = k < n8a ? src + 2 * k : src2 + 2 * (k - n8a);
                const f32x4 a = __builtin_nontemporal_load(s), b = __builtin_nontemporal_load(s + 1);
                u32x4 o; o.x = pk2(a.x, a.y); o.y = pk2(a.z, a.w); o.z = pk2(b.x, b.y); o.w = pk2(b.z, b.w);
                __builtin_nontemporal_store(o, dst + k); } }
        }
    }
#endif
    __syncthreads();
    LAS float* scr = (LAS float*)(F.lds + F.wave * 16640);
#ifdef CONV_IN_P0
    constexpr int J0 = 32768, J1 = 16384;
#else
    constexpr int J0 = 0, J1 = 0;
#endif
    constexpr int J2 = 640, J3 = 256, J6 = 64, J7 = 128, J8 = 4;
    constexpr int NITEMS = J0 + J1 + J2 + 3 * J3 + J6 + J7 + J8;
    for (int it = gw; it < NITEMS; it += NGW) {
        int r = it;
#ifdef CONV_IN_P0
        if (r < J0) { const int mat = r >> 9, q = r & 511, kb = q >> 5, nb = q & 31;
            transpose_item(F.w_gate_up() + (size_t)mat * D * 2048, 2048, D, F.WGUT() + (size_t)mat * 2048 * D, 64 * nb, 64 * kb, 64 * nb, scr, lane); continue; }
        r -= J0;
        if (r < J1) { const int mat = r >> 8, q = r & 255, kb = q >> 4, nb = q & 15;
            transpose_item(F.w_down() + (size_t)mat * D * D, D, D, F.WDNT() + (size_t)mat * D * D, 64 * nb, 64 * kb, 64 * nb, scr, lane); continue; }
        r -= J1;
#endif
        if (r < J2) { const int kb = r / 40, nb = r % 40, n0 = 64 * nb;
            const int dr = n0 < 1792 ? n0 : (n0 < 2048 ? 2304 + (n0 - 1792) : (n0 < 2304 ? 1792 + (n0 - 2048) : 2560 + (n0 - 2304)));
            transpose_item(F.a_w_in(), A_PROJ, D, F.WINT(), dr, 64 * kb, n0, scr, lane); continue; }
        r -= J2;
        if (r < J3) { const int kb = r >> 4, nb = r & 15; transpose_item(F.a_w_out(), D, D, F.WAOT(), 64 * nb, 64 * kb, 64 * nb, scr, lane); continue; }
        r -= J3;
        if (r < J3) { const int kb = r >> 4, nb = r & 15; transpose_item(F.b_w_q(), D, D, F.WBQT(), 64 * nb, 64 * kb, 64 * nb, scr, lane); continue; }
        r -= J3;
        if (r < J3) { const int kb = r >> 4, nb = r & 15; transpose_item(F.b_w_out(), D, D, F.WBOT(), 64 * nb, 64 * kb, 64 * nb, scr, lane); continue; }
        r -= J3;
        if (r < J6) { const int kb = r >> 2, nb = r & 3; transpose_item(F.kv_w(), 256, D, F.WKVT(), 64 * nb, 64 * kb, 64 * nb, scr, lane); continue; }
        r -= J6;
        if (r < J7) { const int kv = r >> 6, q = r & 63, kb = q >> 1, nb = q & 1;
            transpose_item(F.cmp_w1() + (size_t)kv * 2048 * 128, 128, 2048, F.CW1T() + (size_t)kv * 128 * 2048, 64 * nb, 64 * kb, 64 * nb, scr, lane); continue; }
        r -= J7;
        { const int kv = r >> 1, kb = r & 1;
            transpose_item(F.cmp_w2() + (size_t)kv * 128 * 64, 64, 128, F.CW2T() + (size_t)kv * 64 * 128, 0, 64 * kb, 0, scr, lane); }
    }
}

DI void load_mod(const float* g, const float* scale, const float* shift, int lane, f32x4 (&A)[4], f32x4 (&Bv)[4]) {
#pragma unroll
    for (int j = 0; j < 4; ++j) { const int c = 4 * lane + 256 * j;
        const f32x4 gg = *(const f32x4*)(g + c), sc = *(const f32x4*)(scale + c), sh = *(const f32x4*)(shift + c);
        A[j] = gg * (sc + 1.f); Bv[j] = sh; }
}
DI float row_ss(const f32x4 (&v)[4]) {
    float s = 0.f;
#pragma unroll
    for (int j = 0; j < 4; ++j) s += (v[j].x * v[j].x + v[j].y * v[j].y) + (v[j].z * v[j].z + v[j].w * v[j].w);
    return wave_sum(s);
}
DI void store_bf16_row(bf16_t* dst, int lane, const f32x4 (&y)[4]) {
#pragma unroll
    for (int j = 0; j < 4; ++j) { u32x2 o; o.x = pk2(y[j].x, y[j].y); o.y = pk2(y[j].z, y[j].w); *(u32x2*)(dst + 4 * lane + 256 * j) = o; }
}

DI f32x4 modsum(const float* modp, size_t flat, const float* bias4) {
    f32x4 s = *(const f32x4*)bias4, p[8];
#pragma unroll
    for (int seg = 0; seg < 8; ++seg) p[seg] = *(const f32x4*)(modp + (size_t)seg * MODN + flat);
    __builtin_amdgcn_sched_barrier(0);
#pragma unroll
    for (int seg = 0; seg < 8; ++seg) s = s + p[seg];
    return s;
}
DI void modsum2(const float* modp, size_t flatA, const float* biasA, size_t flatB, const float* biasB, f32x4& ra, f32x4& rb) {
    f32x4 sa = *(const f32x4*)biasA, sb = *(const f32x4*)biasB, pa[8], pb[8];
#pragma unroll
    for (int seg = 0; seg < 8; ++seg) { pa[seg] = *(const f32x4*)(modp + (size_t)seg * MODN + flatA); pb[seg] = *(const f32x4*)(modp + (size_t)seg * MODN + flatB); }
    __builtin_amdgcn_sched_barrier(0);
#pragma unroll
    for (int seg = 0; seg < 8; ++seg) { sa = sa + pa[seg]; sb = sb + pb[seg]; }
    asm volatile("" : "+v"(sa), "+v"(sb) :: "memory");
    ra = sa; rb = sb;
}
constexpr int NP_GSTRIDE = 2064;
DI void norm_plain_phase(Frame& F) {
    const int gw = F.bx * NWAVES + F.wave, lane = F.lane, b = gw >> 7;
    {
        u32x4 gv[12];
#pragma unroll
        for (int it = 0; it < 12; ++it) { const int idx = F.tid + it * NTHR, row = idx >> 7, ch = idx & 127; gv[it] = *(const u32x4*)(F.WINT() + (size_t)(2048 + row) * D + ch * 8); }
#pragma unroll
        for (int it = 0; it < 12; ++it) { const int idx = F.tid + it * NTHR, row = idx >> 7, ch = idx & 127; *(LAS u32x4*)(F.lds + row * NP_GSTRIDE + ch * 16) = gv[it]; }
    }
    __syncthreads();
    f32x4 A[4], Bv[4];
#pragma unroll
    for (int j = 0; j < 4; ++j) { const int c = 4 * lane + 256 * j;
        const f32x4 gg = *(const f32x4*)(F.norm_g() + c); f32x4 sc, sh;
        modsum2(F.MODP(), (size_t)b * 3072 + 1024 + c, F.mod_b() + 1024 + c, (size_t)b * 3072 + c, F.mod_b() + c, sc, sh);
        A[j] = gg * (sc + 1.f); Bv[j] = sh; }
    if (F.tid < 224) { const size_t flat = ((size_t)F.bx * 224 + F.tid) * 4;
        const float* bias4 = flat < (size_t)4 * 16 * 3072 ? F.mod_b() + (flat / (16 * 3072)) * 3072 + (flat % 3072) : F.kv_mod_b() + ((flat - (size_t)4 * 16 * 3072) % 2048);
        *(f32x4*)(F.MODV() + flat) = modsum(F.MODP(), flat, bias4); }
    for (int rr = 0; rr < 16; ++rr) {
        const size_t row = (size_t)gw * 16 + rr;
        f32x4 v[4];
#pragma unroll
        for (int j = 0; j < 4; ++j) v[j] = *(const f32x4*)(F.x() + row * D + 4 * lane + 256 * j);
        const float rstd = 1.0f / sqrtf(row_ss(v) * (1.f / D) + NORM_EPS);
        f32x4 y[4];
#pragma unroll
        for (int j = 0; j < 4; ++j) y[j] = v[j] * rstd * A[j] + Bv[j];
        store_bf16_row(F.HN() + row * D, lane, y);
    }
    asm volatile("s_waitcnt vmcnt(0)" ::: "memory");
    {
        const int l2 = fresh_lane(), fr = l2 & 15, fq = l2 >> 4;
        const bf16_t* arow = F.HN() + ((size_t)gw * 16 + fr) * D + 8 * fq;
        const LAS unsigned char* bimg = F.lds + fr * NP_GSTRIDE + fq * 16;
        f32x4 g0 = {0.f, 0.f, 0.f, 0.f}, g1 = g0, g2 = g0;
#pragma unroll 8
        for (int kk = 0; kk < 32; ++kk) {
            const bf16x8 a = *(const bf16x8*)(arow + 32 * kk);
            const bf16x8 b0 = *(const LAS bf16x8*)(bimg + kk * 64), b1 = *(const LAS bf16x8*)(bimg + 16 * NP_GSTRIDE + kk * 64), b2 = *(const LAS bf16x8*)(bimg + 32 * NP_GSTRIDE + kk * 64);
            g0 = __builtin_amdgcn_mfma_f32_16x16x32_bf16(a, b0, g0, 0, 0, 0); g1 = __builtin_amdgcn_mfma_f32_16x16x32_bf16(a, b1, g1, 0, 0, 0); g2 = __builtin_amdgcn_mfma_f32_16x16x32_bf16(a, b2, g2, 0, 0, 0);
        }
        float* gp = F.GATES() + ((size_t)gw * 16 + 4 * fq) * 64 + fr;
#pragma unroll
        for (int i = 0; i < 4; ++i) { gp[i * 64] = rcpf(1.f + ex2(-g0[i] * LOG2E)); gp[i * 64 + 16] = rcpf(1.f + ex2(-g1[i] * LOG2E)); gp[i * 64 + 32] = rcpf(1.f + ex2(-g2[i] * LOG2E)); }
    }
}

constexpr int RT_IMG = 0, RT_LGS = 147456, RT_PE = 151552, RT_PW = 153600, RT_LCNT = 155648, RT_LBASE = 155776;

DI void norm_router_phase(Frame& F, int layer) {
    const int gw = F.bx * NWAVES + F.wave, lane = F.lane, tid = F.tid, b = gw >> 7;
    LAS float* img = (LAS float*)(F.lds + RT_IMG);
    LAS float* lgs = (LAS float*)(F.lds + RT_LGS) + F.wave * 128;
    LAS unsigned* pend_e = (LAS unsigned*)(F.lds + RT_PE);
    LAS float* pend_w = (LAS float*)(F.lds + RT_PW);
    LAS unsigned* lcnt = (LAS unsigned*)(F.lds + RT_LCNT);
    LAS unsigned* lbase = (LAS unsigned*)(F.lds + RT_LBASE);
    const float* rw = F.router_w() + (size_t)layer * D * NEXP;
#pragma unroll
    for (int it = 0; it < (D * NEXP / 4) / NTHR; ++it) { const int idx = tid + it * NTHR, col = idx >> 3, e4 = idx & 7;
        const int rho = (col & 3) * 64 + ((col >> 2) & 63) + 256 * (col >> 8); *(LAS f32x4*)(img + rho * 36 + 4 * e4) = *(const f32x4*)(rw + 4 * idx); }
    if (tid < 32) lcnt[tid] = 0u;
    __syncthreads();
    const int set = layer * 2 + 1;
    const float* mv = F.MODV() + ((size_t)set * 16 + b) * 3072;
    f32x4 A[4], Bv[4]; load_mod(F.norm_g() + (layer * 2 + 1) * D, mv + 1024, mv, lane, A, Bv);
    const float* rb = F.router_b() + layer * NEXP;
    for (int rp = 0; rp < 4; ++rp) {
        const size_t row0 = (size_t)gw * 16 + rp * 4;
        f32x4 y[4][4];
        {
            f32x4 v[4][4];
#pragma unroll
            for (int rr = 0; rr < 4; ++rr)
#pragma unroll
                for (int j = 0; j < 4; ++j) v[rr][j] = *(const f32x4*)(F.H() + (row0 + rr) * D + 4 * lane + 256 * j);
#pragma unroll
            for (int rr = 0; rr < 4; ++rr) { const float rs = 1.0f / sqrtf(row_ss(v[rr]) * (1.f / D) + NORM_EPS);
#pragma unroll
                for (int j = 0; j < 4; ++j) y[rr][j] = v[rr][j] * rs * A[j] + Bv[j]; }
        }
#pragma unroll
        for (int rr = 0; rr < 4; ++rr) store_bf16_row(F.HN() + (row0 + rr) * D, lane, y[rr]);
#pragma unroll 1
        for (int half = 0; half < 2; ++half) {
            float l0[32], l1[32];
            {
                typedef float f32x2 __attribute__((ext_vector_type(2)));
                f32x2 L[4][8];
#pragma unroll
                for (int rr = 0; rr < 4; ++rr)
#pragma unroll
                    for (int e = 0; e < 8; ++e) L[rr][e] = (f32x2){0.f, 0.f};
#pragma unroll
                for (int j = 0; j < 4; ++j)
#pragma unroll
                    for (int i = 0; i < 4; ++i) {
                        const f32x2 A0 = {y[0][j][i], y[0][j][i]}, A1 = {y[1][j][i], y[1][j][i]}, A2 = {y[2][j][i], y[2][j][i]}, A3 = {y[3][j][i], y[3][j][i]};
                        const LAS f32x4* wp = (const LAS f32x4*)(img + (i * 64 + lane + 256 * j) * 36 + 16 * half);
#pragma unroll
                        for (int e4 = 0; e4 < 4; ++e4) { const f32x4 w = wp[e4]; const f32x2 wl = {w.x, w.y}, wh = {w.z, w.w};
                            L[0][2 * e4] = __builtin_elementwise_fma(A0, wl, L[0][2 * e4]); L[0][2 * e4 + 1] = __builtin_elementwise_fma(A0, wh, L[0][2 * e4 + 1]);
                            L[1][2 * e4] = __builtin_elementwise_fma(A1, wl, L[1][2 * e4]); L[1][2 * e4 + 1] = __builtin_elementwise_fma(A1, wh, L[1][2 * e4 + 1]);
                            L[2][2 * e4] = __builtin_elementwise_fma(A2, wl, L[2][2 * e4]); L[2][2 * e4 + 1] = __builtin_elementwise_fma(A2, wh, L[2][2 * e4 + 1]);
                            L[3][2 * e4] = __builtin_elementwise_fma(A3, wl, L[3][2 * e4]); L[3][2 * e4 + 1] = __builtin_elementwise_fma(A3, wh, L[3][2 * e4 + 1]); }
                    }
#pragma unroll
                for (int rr = 0; rr < 2; ++rr)
#pragma unroll
                    for (int e = 0; e < 8; ++e) { l0[16 * rr + 2 * e] = L[rr][e].x; l0[16 * rr + 2 * e + 1] = L[rr][e].y; l1[16 * rr + 2 * e] = L[2 + rr][e].x; l1[16 * rr + 2 * e + 1] = L[2 + rr][e].y; }
            }
#define RS_STEP(N, OFF) { const bool up = (lane & (OFF)) != 0; _Pragma("unroll") for (int k = 0; k < (N); ++k) { \
                const float s0 = up ? l0[k] : l0[k + (N)], k0 = up ? l0[k + (N)] : l0[k]; l0[k] = k0 + shx<(OFF)>(s0, lane); \
                const float s1 = up ? l1[k] : l1[k + (N)], k1 = up ? l1[k + (N)] : l1[k]; l1[k] = k1 + shx<(OFF)>(s1, lane); } }
            RS_STEP(16, 32) RS_STEP(8, 16) RS_STEP(4, 8) RS_STEP(2, 4) RS_STEP(1, 2)
#undef RS_STEP
            const float g0 = l0[0] + shx<1>(l0[0], lane), g1 = l1[0] + shx<1>(l1[0], lane);
            const int idx = lane >> 1, rr = idx >> 4, e_own = (idx & 15) + 16 * half; const float rbv = rb[e_own];
            if ((lane & 1) == 0) { lgs[rr * 32 + e_own] = g0 + rbv; lgs[(2 + rr) * 32 + e_own] = g1 + rbv; }
        }
        LDS_WAIT(); asm volatile("" ::: "memory");
        if (lane < 4) {
            float v[32];
#pragma unroll
            for (int e = 0; e < 32; ++e) v[e] = lgs[lane * 32 + e];
            float tv[4]; int ti[4];
#pragma unroll
            for (int k = 0; k < 4; ++k) {
                float best = -INFINITY; int bi = 0;
#pragma unroll
                for (int e = 0; e < 32; ++e) { const bool gt = v[e] > best; best = gt ? v[e] : best; bi = gt ? e : bi; }
                tv[k] = best; ti[k] = bi;
#pragma unroll
                for (int e = 0; e < 32; ++e) v[e] = (e == bi) ? -INFINITY : v[e];
            }
            const float e1 = __expf(tv[1] - tv[0]), e2 = __expf(tv[2] - tv[0]), e3 = __expf(tv[3] - tv[0]);
            const float inv = 1.f / (1.f + e1 + e2 + e3);
            const float w[4] = {inv, e1 * inv, e2 * inv, e3 * inv};
            const int tl = F.wave * 16 + rp * 4 + lane;
#pragma unroll
            for (int k = 0; k < 4; ++k) {
                const unsigned pl = __hip_atomic_fetch_add(lcnt + ti[k], 1u, __ATOMIC_RELAXED, __HIP_MEMORY_SCOPE_WORKGROUP);
                pend_e[tl * 4 + k] = ((unsigned)ti[k] << 16) | pl; pend_w[tl * 4 + k] = w[k];
            }
        }
        LDS_WAIT(); asm volatile("" ::: "memory");
    }
    __syncthreads();
    unsigned* gcnt = F.ctl() + CW_CNT + 64 * layer;
    if (tid < 32) lbase[tid] = __hip_atomic_fetch_add(gcnt + tid, lcnt[tid], __ATOMIC_RELAXED, __HIP_MEMORY_SCOPE_AGENT);
    __syncthreads();
    {
        const int tl = tid >> 2, k = tid & 3; const unsigned pe = pend_e[tid]; const unsigned e = pe >> 16, pos = lbase[e] + (pe & 0xffffu);
        const unsigned token = (unsigned)(F.bx * 128 + tl);
        F.LIST()[(size_t)e * T + pos] = token; F.LISTW()[(size_t)e * T + pos] = pend_w[tid]; F.TOKSLOT()[(size_t)token * 4 + k] = (e << 16) | pos;
    }
    __syncthreads();
}

DI void load_expert_tables(Frame& F, int layer, int npn) {
    LAS unsigned* ext = (LAS unsigned*)(F.lds + EXT_OFF);
    if (F.tid < 32) ext[F.tid] = __hip_atomic_load(F.ctl() + CW_CNT + 64 * layer + F.tid, __ATOMIC_RELAXED, __HIP_MEMORY_SCOPE_AGENT);
    __syncthreads();
    if (F.tid == 0) { unsigned o = 0, u = 0; for (int e = 0; e < 32; ++e) { const unsigned c = ext[e]; ext[32 + e] = o; ext[64 + e] = u; o += c; u += ((c + 255u) >> 8) * (unsigned)npn; } ext[96] = u; }
    __syncthreads();
}

template <bool FINAL> DI void combine_phase(Frame& F, int layer) {
    load_expert_tables(F, layer, 1);
    const LAS unsigned* offs = (const LAS unsigned*)(F.lds + EXT_OFF) + 32;
    const int gw = F.bx * NWAVES + F.wave, lane = F.lane, b = gw >> 7;
    const float* gate = F.MODV() + ((size_t)(layer * 2 + 1) * 16 + b) * 3072 + 2048;
    f32x4 G[4];
#pragma unroll
    for (int j = 0; j < 4; ++j) G[j] = *(const f32x4*)(gate + 4 * lane + 256 * j);
    f32x4 A1[4], B1[4], A2[4], B2[4];
    if (FINAL) {
#pragma unroll
        for (int j = 0; j < 4; ++j) A1[j] = *(const f32x4*)(F.final_g() + 4 * lane + 256 * j);
    } else {
        const float* m2 = F.MODV() + ((size_t)2 * 16 + b) * 3072; load_mod(F.norm_g() + 2 * D, m2 + 1024, m2, lane, A1, B1);
        const float* m4 = F.MODV() + (size_t)4 * 16 * 3072 + (size_t)b * 2048; load_mod(F.kv_norm_g(), m4 + 1024, m4, lane, A2, B2);
    }
    for (int rr = 0; rr < 16; ++rr) {
        const size_t row = (size_t)gw * 16 + rr;
        const u32x4 ts = *(const u32x4*)(F.TOKSLOT() + row * 4);
        const unsigned sl[4] = {offs[ts.x >> 16] + (ts.x & 0xffffu), offs[ts.y >> 16] + (ts.y & 0xffffu), offs[ts.z >> 16] + (ts.z & 0xffffu), offs[ts.w >> 16] + (ts.w & 0xffffu)};
        f32x4 y[4];
#pragma unroll
        for (int j = 0; j < 4; ++j) y[j] = (f32x4){0.f, 0.f, 0.f, 0.f};
#pragma unroll
        for (int k = 0; k < 4; ++k)
#pragma unroll
            for (int j = 0; j < 4; ++j) { const u32x2 o = *(const u32x2*)(F.OUTB() + (size_t)sl[k] * D + 4 * lane + 256 * j);
                y[j].x += bf_lo(o.x); y[j].y += bf_hi(o.x); y[j].z += bf_lo(o.y); y[j].w += bf_hi(o.y); }
        f32x4 h[4];
#pragma unroll
        for (int j = 0; j < 4; ++j) h[j] = *(const f32x4*)(F.H() + row * D + 4 * lane + 256 * j) + G[j] * y[j];
        const float rstd = 1.0f / sqrtf(row_ss(h) * (1.f / D) + NORM_EPS);
        if (FINAL) {
#pragma unroll
            for (int j = 0; j < 4; ++j) *(f32x4*)(F.out() + row * D + 4 * lane + 256 * j) = h[j] * rstd * A1[j];
        } else {
#pragma unroll
            for (int j = 0; j < 4; ++j) *(f32x4*)(F.H() + row * D + 4 * lane + 256 * j) = h[j];
            f32x4 ya[4], yb[4];
#pragma unroll
            for (int j = 0; j < 4; ++j) { const f32x4 n = h[j] * rstd; ya[j] = n * A1[j] + B1[j]; yb[j] = n * A2[j] + B2[j]; }
            store_bf16_row(F.HN() + row * D, lane, ya); store_bf16_row(F.HN2() + row * D, lane, yb);
        }
    }
}
namespace pg8 {
constexpr int BM = 256, BK = 64, HALF = 128, HTB = HALF * BK * 2, STAGE_BYTES = 8 * HTB, KD = 1024;
DI int lds_byte(int r, int c) { const int st = (r >> 4) * 2 + (c >> 5), rr = r & 15, cc = c & 31, ob = rr * 64 + cc * 2; return st * 1024 + (ob ^ (((ob >> 9) & 1) << 5)); }
DI void stage_rc(int b, int& R, int& C) { const int st = b / 1024, sb = b % 1024, swz = sb ^ (((sb >> 9) & 1) << 5); R = (st >> 1) * 16 + swz / 64; C = (st & 1) * 32 + (swz % 64) / 2; }
DI int perm32(int rho) { const int n = rho >> 4, i = rho & 15; return 8 * (i >> 2) + 4 * n + (i & 3); }

struct Unit {
    const char* A;
    const char* B0;
    unsigned bh;
    int type, r0, c0, nvalid, aux;
};

template <class Pol>
DI void gemm_phase(LAS unsigned char* lds, const Pol& P, int wave_id, int lane_id) {
    const int wid = wave_id, lane = lane_id, tid = wid * 64 + lane, wr = wid >> 2, wc = wid & 3, fr = lane & 15, fq = lane >> 4;
    constexpr int K = KD, nt = K / BK;
    unsigned voffB[2];
#pragma unroll
    for (int i = 0; i < 2; ++i) { int R, C; stage_rc(tid * 16 + i * 8192, R, C); const int Rb = Pol::PERM ? ((R & ~31) + perm32(R & 31)) : R; voffB[i] = (unsigned)(Rb * K + C) * 2u; }
    const size_t kstep = (size_t)(BK * 2);
    const unsigned ldsw = (unsigned)wid * 1024u;
    const int aoff = lds_byte(wr * 64 + fr, fq * 8), boff = lds_byte(wc * 32 + fr, fq * 8);
#define PG8_SA(b, h) (((b) * 2 + (h)) * HTB)
#define PG8_SB(b, h) ((4 + (b) * 2 + (h)) * HTB)
#define PG8_STAGE_A(bufoff, gbase, va, h) do { _Pragma("unroll") for (int _i = 0; _i < 2; ++_i) \
        __builtin_amdgcn_global_load_lds((const unsigned*)((const char*)(gbase) + (va)[h][_i]), (LAS unsigned*)(lds + (bufoff) + ldsw + _i * 8192), 16, 0, 0); } while (0)
#define PG8_STAGE_B(bufoff, gbase) do { _Pragma("unroll") for (int _i = 0; _i < 2; ++_i) \
        __builtin_amdgcn_global_load_lds((const unsigned*)((const char*)(gbase) + voffB[_i]), (LAS unsigned*)(lds + (bufoff) + ldsw + _i * 8192), 16, 0, 0); } while (0)
#define PG8_LDA(dst, b, h) do { _Pragma("unroll") for (int m = 0; m < 4; ++m) _Pragma("unroll") for (int k = 0; k < 2; ++k) dst[m][k] = *(const LAS bf16x8*)(lds + PG8_SA(b, h) + aoff + m * 2048 + k * 1024); } while (0)
#define PG8_LDB(dst, b, h) do { _Pragma("unroll") for (int n = 0; n < 2; ++n) _Pragma("unroll") for (int k = 0; k < 2; ++k) dst[n][k] = *(const LAS bf16x8*)(lds + PG8_SB(b, h) + boff + n * 2048 + k * 1024); } while (0)
#define PG8_MMA(ai, bj, At, Bt) do { __builtin_amdgcn_s_setprio(1); _Pragma("unroll") for (int m = 0; m < 4; ++m) _Pragma("unroll") for (int n = 0; n < 2; ++n) _Pragma("unroll") for (int k = 0; k < 2; ++k) \
        acc[ai][bj][m][n] = __builtin_amdgcn_mfma_f32_16x16x32_bf16(Bt[n][k], At[m][k], acc[ai][bj][m][n], 0, 0, 0); __builtin_amdgcn_s_setprio(0); } while (0)
#define PG8_WAIT_V(n) asm volatile("s_waitcnt vmcnt(" #n ")" ::: "memory")
#define PG8_WAIT_L(n) asm volatile("s_waitcnt lgkmcnt(" #n ")" ::: "memory")
#define PG8_BAR __builtin_amdgcn_s_barrier()
#define PG8_SCHED __builtin_amdgcn_sched_barrier(0)
    Unit cur, nxt; int ui = 0; int pub_e = -1, pub_mt = 0;
    if (!P.next(0, cur)) return;
    unsigned vaC[2][2], vaN[2][2];
    P.aoff(cur, wid * 64, tid, vaC);
    bool has_next = P.next(1, nxt);
    if (has_next) P.aoff(nxt, wid * 64, tid, vaN);
    else { vaN[0][0] = vaC[0][0]; vaN[0][1] = vaC[0][1]; vaN[1][0] = vaC[1][0]; vaN[1][1] = vaC[1][1]; }
    if constexpr (Pol::COUNTED) __syncthreads();
    if (Pol::GATHER) asm volatile("" : "+v"(vaC[0][0]), "+v"(vaC[0][1]), "+v"(vaC[1][0]), "+v"(vaC[1][1]), "+v"(vaN[0][0]), "+v"(vaN[0][1]), "+v"(vaN[1][0]), "+v"(vaN[1][1]));
    f32x4 acc[2][2][4][2];
    { const int l2 = fresh_lane(); P.init(acc, cur, wr, wc, l2 & 15, l2 >> 4); }
    bf16x8 At[4][2], B0[2][2], B1[2][2];
    const char* cA = cur.A; const char* cB = cur.B0; unsigned cbh = cur.bh;
    PG8_STAGE_B(PG8_SB(0, 0), cB); PG8_STAGE_A(PG8_SA(0, 0), cA, vaC, 0); PG8_STAGE_B(PG8_SB(0, 1), cB + cbh); PG8_STAGE_A(PG8_SA(0, 1), cA, vaC, 1);
    if (wr == 1) PG8_BAR;
    PG8_WAIT_V(4); PG8_BAR;
    PG8_STAGE_B(PG8_SB(1, 0), cB + kstep); PG8_STAGE_A(PG8_SA(1, 0), cA + kstep, vaC, 0); PG8_STAGE_B(PG8_SB(1, 1), cB + cbh + kstep);
    PG8_WAIT_V(6); PG8_BAR;
    for (;;) {
        const char* nA = has_next ? nxt.A : cA; const char* nB = has_next ? nxt.B0 : cB; const unsigned nbh = has_next ? nxt.bh : cbh;
        for (int t = 0; t < nt; t += 2) {
            const bool last = (t == nt - 2);
            const char* a1 = cA + (size_t)(t + 1) * kstep;
            const char* a2 = last ? nA : cA + (size_t)(t + 2) * kstep; const char* b2 = last ? nB : cB + (size_t)(t + 2) * kstep;
            const char* a3 = a2 + kstep; const char* b3 = b2 + kstep;
            const unsigned bh2 = last ? nbh : cbh;
            unsigned va2[2][2];
            if (Pol::GATHER) { va2[0][0] = last ? vaN[0][0] : vaC[0][0]; va2[0][1] = last ? vaN[0][1] : vaC[0][1]; va2[1][0] = last ? vaN[1][0] : vaC[1][0]; va2[1][1] = last ? vaN[1][1] : vaC[1][1]; }
            else { va2[0][0] = vaC[0][0]; va2[0][1] = vaC[0][1]; va2[1][0] = vaC[1][0]; va2[1][1] = vaC[1][1]; }
            PG8_LDB(B0, 0, 0); PG8_SCHED; PG8_LDA(At, 0, 0); PG8_STAGE_A(PG8_SA(1, 1), a1, vaC, 1);
            PG8_WAIT_L(8); PG8_BAR; PG8_WAIT_L(0); PG8_MMA(0, 0, At, B0); PG8_BAR; PG8_SCHED;
            PG8_LDB(B1, 0, 1); PG8_STAGE_B(PG8_SB(0, 0), b2);
            PG8_BAR; PG8_WAIT_L(0); PG8_MMA(0, 1, At, B1); PG8_BAR;
            PG8_LDA(At, 0, 1); PG8_STAGE_A(PG8_SA(0, 0), a2, va2, 0);
            PG8_BAR; PG8_WAIT_L(0); PG8_MMA(1, 0, At, B0); PG8_BAR; PG8_SCHED;
            PG8_STAGE_B(PG8_SB(0, 1), b2 + bh2);
            PG8_WAIT_V(6); PG8_BAR; PG8_MMA(1, 1, At, B1); PG8_BAR;
            PG8_LDB(B0, 1, 0); PG8_SCHED; PG8_LDA(At, 1, 0); PG8_STAGE_A(PG8_SA(0, 1), a2, va2, 1);
            PG8_WAIT_L(8); PG8_BAR; PG8_WAIT_L(0); PG8_MMA(0, 0, At, B0); PG8_BAR; PG8_SCHED;
            PG8_LDB(B1, 1, 1); PG8_STAGE_B(PG8_SB(1, 0), b3);
            PG8_BAR; PG8_WAIT_L(0); PG8_MMA(0, 1, At, B1); PG8_BAR;
            PG8_LDA(At, 1, 1); PG8_STAGE_A(PG8_SA(1, 0), a3, va2, 0);
            PG8_BAR; PG8_WAIT_L(0); PG8_MMA(1, 0, At, B0); PG8_BAR; PG8_SCHED;
            PG8_STAGE_B(PG8_SB(1, 1), b3 + bh2);
            PG8_WAIT_V(6); PG8_BAR; PG8_MMA(1, 1, At, B1); PG8_BAR;
        }
        if constexpr (Pol::GATHER) {
            Unit nn; bool has_nn = false; unsigned tokNN[2][2] = {{0u, 0u}, {0u, 0u}};
            if (has_next) { has_nn = P.next(ui + 2, nn); if (has_nn) P.aoff_load(nn, wid * 64, tokNN); }
            f32x4 bvN[4] = {};
            if (has_next) P.bias_load(nxt, wc, fresh_lane() >> 4, bvN);
            if constexpr (Pol::PUBLISH) { if (pub_e >= 0) P.publish(pub_e, pub_mt); pub_e = cur.aux; pub_mt = cur.type; }
            { const int l2 = fresh_lane(); P.epi(acc, cur, wr, wc, l2 & 15, l2 >> 4); }
            if (!has_next) break;
            { _Pragma("unroll") for (int a_ = 0; a_ < 2; ++a_) _Pragma("unroll") for (int m_ = 0; m_ < 4; ++m_) { acc[a_][0][m_][0] = bvN[0]; acc[a_][0][m_][1] = bvN[1]; acc[a_][1][m_][0] = bvN[2]; acc[a_][1][m_][1] = bvN[3]; } }
            cur = nxt; cA = nA; cB = nB; cbh = nbh; ++ui;
            vaC[0][0] = vaN[0][0]; vaC[0][1] = vaN[0][1]; vaC[1][0] = vaN[1][0]; vaC[1][1] = vaN[1][1];
            has_next = has_nn; nxt = nn;
            asm volatile("" : "+v"(tokNN[0][0]), "+v"(tokNN[0][1]), "+v"(tokNN[1][0]), "+v"(tokNN[1][1]));
            if (has_next) { P.aoff_calc(wid * 64, tokNN, vaN); asm volatile("" : "+v"(vaN[0][0]), "+v"(vaN[0][1]), "+v"(vaN[1][0]), "+v"(vaN[1][1])); }
        } else {
            f32x4 bvN[4] = {};
            if constexpr (Pol::PREBIAS) { if (has_next) P.bias_load(nxt, wc, fresh_lane() >> 4, bvN); }
            { const int l2 = fresh_lane(); P.epi(acc, cur, wr, wc, l2 & 15, l2 >> 4); }
            if (!has_next) break;
            if constexpr (Pol::PREBIAS) { _Pragma("unroll") for (int a_ = 0; a_ < 2; ++a_) _Pragma("unroll") for (int m_ = 0; m_ < 4; ++m_) { acc[a_][0][m_][0] = bvN[0]; acc[a_][0][m_][1] = bvN[1]; acc[a_][1][m_][0] = bvN[2]; acc[a_][1][m_][1] = bvN[3]; } }
            else { const int l2 = fresh_lane(); P.init(acc, nxt, wr, wc, l2 & 15, l2 >> 4); }
            cur = nxt; cA = nA; cB = nB; cbh = nbh; ++ui;
            vaC[0][0] = vaN[0][0]; vaC[0][1] = vaN[0][1]; vaC[1][0] = vaN[1][0]; vaC[1][1] = vaN[1][1];
            has_next = P.next(ui + 1, nxt);
            if (has_next) P.aoff(nxt, wid * 64, tid, vaN);
        }
    }
    PG8_WAIT_V(0);
    if constexpr (Pol::PUBLISH) { if (pub_e >= 0) P.publish(pub_e, pub_mt); }
    if (wr == 0) PG8_BAR;
    PG8_BAR;
#undef PG8_SA
#undef PG8_SB
#undef PG8_STAGE_A
#undef PG8_STAGE_B
#undef PG8_LDA
#undef PG8_LDB
#undef PG8_MMA
#undef PG8_WAIT_V
#undef PG8_WAIT_L
#undef PG8_BAR
#undef PG8_SCHED
}
DI void aoff_std(int tid, unsigned (&va)[2][2]) {
#pragma unroll
    for (int i = 0; i < 2; ++i) { int R, C; stage_rc(tid * 16 + i * 8192, R, C);
#pragma unroll
        for (int h = 0; h < 2; ++h) va[h][i] = (unsigned)((h * HALF + R) * KD + C) * 2u; }
}
}

DI float vmin_raw(float x, float hi) { float r; asm("v_min_f32 %0, %1, %2" : "=v"(r) : "v"(x), "v"(hi)); return r; }
DI float vmed3_raw(float x, float lo, float hi) { float r; asm("v_med3_f32 %0, %1, %2, %3" : "=v"(r) : "v"(x), "v"(lo), "v"(hi)); return r; }
typedef f32x4 AccT[2][2][4][2];
DI void acc_zero(AccT& acc) {
#pragma unroll
    for (int a = 0; a < 2; ++a)
#pragma unroll
        for (int b = 0; b < 2; ++b)
#pragma unroll
            for (int m = 0; m < 4; ++m)
#pragma unroll
                for (int n = 0; n < 2; ++n) acc[a][b][m][n] = (f32x4){0.f, 0.f, 0.f, 0.f};
}
DI void acc_colbias(AccT& acc, const f32x4& b00, const f32x4& b01, const f32x4& b10, const f32x4& b11) {
#pragma unroll
    for (int a = 0; a < 2; ++a)
#pragma unroll
        for (int m = 0; m < 4; ++m) { acc[a][0][m][0] = b00; acc[a][0][m][1] = b01; acc[a][1][m][0] = b10; acc[a][1][m][1] = b11; }
}

struct RopeRow { f32x4 c0, c1, s0, s1; };
DI RopeRow rope_load(const float* rope_row) { RopeRow q; q.c0 = *(const f32x4*)(rope_row); q.c1 = *(const f32x4*)(rope_row + 4); q.s0 = *(const f32x4*)(rope_row + 8); q.s1 = *(const f32x4*)(rope_row + 12); return q; }
DI void rope8(f32x4& v0, f32x4& v1, const RopeRow& q, int fq) {
    const f32x4 c0 = q.c0, c1 = q.c1, s0 = q.s0, s1 = q.s1;
    f32x4 p0, p1;
#pragma unroll
    for (int i = 0; i < 4; ++i) { p0[i] = shx<16>(v0[i], 0); p1[i] = shx<16>(v1[i], 0); }
    const float sg = (fq == 0) ? -1.f : 1.f;
    v0 = v0 * c0 + p0 * (s0 * sg); v1 = v1 * c1 + p1 * (s1 * sg);
}
DI void store8_bf16(bf16_t* p, const f32x4& v0, const f32x4& v1) {
    u32x4 w; w.x = pk2(v0[0], v0[1]); w.y = pk2(v0[2], v0[3]); w.z = pk2(v1[0], v1[1]); w.w = pk2(v1[2], v1[3]); *(u32x4*)p = w;
}
constexpr int ST_OFF = 131072, ST_STRIDE = 528;
DI void st_realign(int wr) { if (wr == 0) __builtin_amdgcn_s_barrier(); }
DI void st_restagger(int wr) { if (wr == 1) __builtin_amdgcn_s_barrier(); }
DI void st_put(LAS unsigned char* lds, int rowl, int colb, const f32x4& v0, const f32x4& v1) {
    u32x4 w; w.x = pk2(v0[0], v0[1]); w.y = pk2(v0[2], v0[3]); w.z = pk2(v1[0], v1[1]); w.w = pk2(v1[2], v1[3]);
    *(LAS u32x4*)(lds + ST_OFF + rowl * ST_STRIDE + colb) = w;
}
template <int ROWB, bool CHECK = true> DI void st_flush(LAS unsigned char* lds, int tid, bf16_t* out_pass, size_t ld, int nvalid_rel) {
    asm volatile("s_waitcnt lgkmcnt(0)" ::: "memory"); __builtin_amdgcn_s_barrier(); asm volatile("" ::: "memory");
    if (ROWB == 512) {
#pragma unroll
        for (int k = 0; k < 2; ++k) { const int rowl = (tid >> 5) + 16 * k, c = tid & 31, rel = 64 * (rowl >> 4) + (rowl & 15);
            const u32x4 v = *(const LAS u32x4*)(lds + ST_OFF + rowl * ST_STRIDE + c * 16);
            if (!CHECK || rel < nvalid_rel) *(u32x4*)(out_pass + (size_t)rel * ld + c * 8) = v; }
    } else {
        const int rowl = tid >> 4, c = tid & 15, rel = 64 * (rowl >> 4) + (rowl & 15);
        const u32x4 v = *(const LAS u32x4*)(lds + ST_OFF + rowl * ST_STRIDE + c * 16);
        if (!CHECK || rel < nvalid_rel) *(u32x4*)(out_pass + (size_t)rel * ld + c * 8) = v;
    }
    asm volatile("s_waitcnt lgkmcnt(0)" ::: "memory"); __builtin_amdgcn_s_barrier(); asm volatile("" ::: "memory");
}

constexpr int ST_STRIDE_GU = 272;
DI void st_put_gu(LAS unsigned char* lds, int rowl, int colb, const f32x4& v0, const f32x4& v1) {
    u32x4 w; w.x = pk2(v0[0], v0[1]); w.y = pk2(v0[2], v0[3]); w.z = pk2(v1[0], v1[1]); w.w = pk2(v1[2], v1[3]);
    *(LAS u32x4*)(lds + ST_OFF + rowl * ST_STRIDE_GU + colb) = w;
}
DI void st_flush_gu(LAS unsigned char* lds, int tid, bf16_t* out_pass, size_t ld, int nvalid_rel) {
    asm volatile("s_waitcnt lgkmcnt(0)" ::: "memory"); __builtin_amdgcn_s_barrier(); asm volatile("" ::: "memory");
#pragma unroll
    for (int k = 0; k < 2; ++k) { const int rowl = (tid >> 4) + 32 * k, c = tid & 15, rel = 64 * ((rowl >> 4) & 1) + 16 * (rowl >> 5) + (rowl & 15);
        const u32x4 v = *(const LAS u32x4*)(lds + ST_OFF + rowl * ST_STRIDE_GU + c * 16);
        if (rel < nvalid_rel) *(u32x4*)(out_pass + (size_t)rel * ld + c * 8) = v; }
    asm volatile("s_waitcnt lgkmcnt(0)" ::: "memory"); __builtin_amdgcn_s_barrier(); asm volatile("" ::: "memory");
}

struct PolProj0 {
    static constexpr bool PERM = true, GATHER = false, PREBIAS = false, COUNTED = false, PUBLISH = false;
    const bf16_t *HN, *WINT; bf16_t *Q, *KV, *VT; float* GATES; const float* ROPE; int vcu; LAS unsigned char* lds;
    DI bool next(int i, pg8::Unit& u) const {
        const int L = i * GRID + vcu; if (L >= 1280) return false;
        if (L < 1024) { const int pm = L >> 3, pn = L & 7; u.type = 0; u.A = (const char*)(HN + (size_t)pm * 256 * D); u.B0 = (const char*)(WINT + (size_t)pn * 256 * D); u.bh = 128 * D * 2; u.r0 = pm * 256; u.c0 = pn * 256; u.aux = pn; u.nvalid = 256; }
        else { const int l2 = L - 1024, pm = l2 >> 7, pn = l2 & 127; u.type = 1; u.A = (const char*)(WINT + (size_t)(2304 + pm * 256) * D); u.B0 = (const char*)(HN + (size_t)pn * 256 * D); u.bh = 128 * D * 2; u.r0 = pm * 256; u.c0 = pn * 256; u.aux = 0; u.nvalid = 256; }
        return true;
    }
    DI void aoff(const pg8::Unit&, int, int tid, unsigned (&va)[2][2]) const { pg8::aoff_std(tid, va); }
    DI void init(AccT& acc, const pg8::Unit&, int, int, int, int) const { acc_zero(acc); }
    DI void epi(const AccT& acc, const pg8::Unit& u, int wr, int wc, int fr, int fq) const {
        const int pn = u.aux;
        const int tid = (wr * 4 + wc) * 64 + fq * 16 + fr, rowl = wr * 16 + fr;
        if (u.type == 1) {
            st_realign(wr);
#pragma unroll
            for (int ai = 0; ai < 2; ++ai)
#pragma unroll
                for (int m = 0; m < 4; ++m) {
#pragma unroll
                    for (int bj = 0; bj < 2; ++bj) st_put(lds, rowl, (bj * 128 + wc * 32 + 8 * fq) * 2, acc[ai][bj][m][0], acc[ai][bj][m][1]);
                    st_flush<512, false>(lds, tid, VT + (size_t)(u.r0 + ai * 128 + m * 16) * T + u.c0, T, 256); }
            st_restagger(wr);
            return;
        }
        const bool is_q = pn < 4, do_rope = (pn != 4 && pn != 5);
        bf16_t* dst = is_q ? Q + pn * 256 : KV + (pn - 4) * 256;
        const float sc = is_q ? QSCALE : 1.f;
        const bool rl = do_rope && ((wc & 1) == 0) && fq < 2;
        const bool rw = do_rope && (wc & 1) == 0;
        RopeRow rr = rope_load(ROPE + (size_t)(u.r0 + wr * 64 + fr) * 16);
        st_realign(wr);
#pragma unroll
        for (int ai = 0; ai < 2; ++ai)
#pragma unroll
            for (int m = 0; m < 4; ++m) {
                const int nx = (ai * 4 + m + 1) & 7;
                const RopeRow rn = rope_load(ROPE + (size_t)(u.r0 + (nx >> 2) * 128 + wr * 64 + (nx & 3) * 16 + fr) * 16);
#pragma unroll
                for (int bj = 0; bj < 2; ++bj) { f32x4 v0 = acc[ai][bj][m][0], v1 = acc[ai][bj][m][1];
                    if (rw) { f32x4 r0 = v0, r1 = v1; rope8(r0, r1, rr, fq); if (rl) { v0 = r0; v1 = r1; } }
                    v0 = v0 * sc; v1 = v1 * sc;
                    st_put(lds, rowl, (bj * 128 + wc * 32 + 8 * fq) * 2, v0, v1); }
                st_flush<512, false>(lds, tid, dst + (size_t)(u.r0 + ai * 128 + m * 16) * D, D, 256);
                rr = rn; }
        st_restagger(wr);
    }
};

struct PolOut {
    static constexpr bool PERM = false, GATHER = false, PREBIAS = false, COUNTED = false, PUBLISH = false;
    const bf16_t *O, *WT; const float *base, *gate_mv, *bias; float* H; int vcu;
    DI bool next(int i, pg8::Unit& u) const {
        const int L = i * GRID + vcu; if (L >= 512) return false;
        const int pm = L >> 2, pn = L & 3; u.type = 0; u.A = (const char*)(O + (size_t)pm * 256 * D); u.B0 = (const char*)(WT + (size_t)pn * 256 * D); u.bh = 128 * D * 2; u.r0 = pm * 256; u.c0 = pn * 256; u.aux = 0; u.nvalid = 256;
        return true;
    }
    DI void aoff(const pg8::Unit&, int, int tid, unsigned (&va)[2][2]) const { pg8::aoff_std(tid, va); }
    DI void init(AccT& acc, const pg8::Unit& u, int, int wc, int, int fq) const {
        if (!bias) { acc_zero(acc); return; }
        const float* bp = bias + u.c0 + wc * 32 + 4 * fq;
        acc_colbias(acc, *(const f32x4*)bp, *(const f32x4*)(bp + 16), *(const f32x4*)(bp + 128), *(const f32x4*)(bp + 144));
    }
    DI void epi(const AccT& acc, const pg8::Unit& u, int wr, int wc, int fr, int fq) const {
        const int b = u.r0 >> 11; const float* gv = gate_mv + (size_t)b * 3072 + 2048;
        const size_t row0 = (size_t)(u.r0 + wr * 64 + fr) * D + u.c0 + wc * 32 + 4 * fq;
        f32x4 xa[8], xb[8], ga, gb;
#define PO_LOAD(q, X, G) { const int co = ((q) >> 1) * 128 + ((q) & 1) * 16; G = *(const f32x4*)(gv + u.c0 + wc * 32 + 4 * fq + co); \
            _Pragma("unroll") for (int ai = 0; ai < 2; ++ai) _Pragma("unroll") for (int m = 0; m < 4; ++m) X[ai * 4 + m] = *(const f32x4*)(base + row0 + (size_t)(ai * 128 + m * 16) * D + co); }
#define PO_STORE(q, X, G) { const int co = ((q) >> 1) * 128 + ((q) & 1) * 16; \
            _Pragma("unroll") for (int ai = 0; ai < 2; ++ai) _Pragma("unroll") for (int m = 0; m < 4; ++m) *(f32x4*)(H + row0 + (size_t)(ai * 128 + m * 16) * D + co) = X[ai * 4 + m] + G * acc[ai][(q) >> 1][m][(q) & 1]; }
        PO_LOAD(0, xa, ga) PO_LOAD(1, xb, gb) PO_STORE(0, xa, ga) PO_LOAD(2, xa, ga) PO_STORE(1, xb, gb) PO_LOAD(3, xb, gb) PO_STORE(2, xa, ga) PO_STORE(3, xb, gb)
#undef PO_LOAD
#undef PO_STORE
    }
};

DI bool moe_unit(const LAS unsigned* ext, int L, int npn, int& e, int& mt, int& pn, int& nvalid, unsigned& slot0) {
    if ((unsigned)L >= (unsigned)__builtin_amdgcn_readfirstlane((int)ext[96])) return false;
    int ee = 0;
    for (int k = 1; k < 32; ++k) ee = ((unsigned)L >= ext[64 + k]) ? k : ee;
    ee = __builtin_amdgcn_readfirstlane(ee);
    const int local = L - __builtin_amdgcn_readfirstlane((int)ext[64 + ee]); mt = local / npn; pn = local % npn; e = ee;
    const int cnt = __builtin_amdgcn_readfirstlane((int)ext[ee]); nvalid = cnt - mt * 256; nvalid = nvalid > 256 ? 256 : nvalid;
    slot0 = (unsigned)__builtin_amdgcn_readfirstlane((int)ext[32 + ee]) + (unsigned)mt * 256u;
    return true;
}
template <bool NOEPI = false> struct PolGateUpT {
    static constexpr bool PERM = true, GATHER = true, PREBIAS = true, COUNTED = false, PUBLISH = true;
    const bf16_t *HN, *WGUT; const float* bgu; const unsigned* LIST; bf16_t* ACT; const LAS unsigned* ext; int vcu; LAS unsigned char* lds; unsigned* panel; int xi;
    DI bool next(int i, pg8::Unit& u) const {
        int e, mt, pn, nv; unsigned s0;
        const int aff = xi >> 16, xcc = (xi >> 8) & 255, xrank = xi & 255;
        const int k_ = i * 32 + xrank, L_ = aff ? ((xcc + 8 * (k_ >> 3)) * 8 + (k_ & 7)) : (i * GRID + vcu);
        if (!moe_unit(ext, L_, 8, e, mt, pn, nv, s0)) return false;
        u.type = mt; u.A = (const char*)HN; u.B0 = (const char*)(WGUT + ((size_t)e * 2048 + pn * 128) * D); u.bh = 1024u * D * 2u; u.r0 = (int)s0; u.c0 = pn * 128; u.nvalid = nv; u.aux = e;
        return true;
    }
    DI void aoff(const pg8::Unit& u, int wbase, int, unsigned (&va)[2][2]) const { unsigned tok[2][2]; aoff_load(u, wbase, tok); aoff_calc(wbase, tok, va); }
    DI void aoff_load(const pg8::Unit& u, int wbase, unsigned (&tok)[2][2]) const {
        const unsigned* lp = LIST + (size_t)u.aux * T + (size_t)u.type * 256;
        const int t = wbase | fresh_lane();
#pragma unroll
        for (int i = 0; i < 2; ++i) { int R, C; pg8::stage_rc(t * 16 + i * 8192, R, C);
#pragma unroll
            for (int h = 0; h < 2; ++h) { int r = h * 128 + R; r = r < u.nvalid ? r : u.nvalid - 1; tok[h][i] = lp[r]; } }
    }
    DI void aoff_calc(int wbase, const unsigned (&tok)[2][2], unsigned (&va)[2][2]) const {
        const int t = wbase | fresh_lane();
#pragma unroll
        for (int i = 0; i < 2; ++i) { int R, C; pg8::stage_rc(t * 16 + i * 8192, R, C);
#pragma unroll
            for (int h = 0; h < 2; ++h) va[h][i] = tok[h][i] * (unsigned)(D * 2) + (unsigned)C * 2u; }
    }
    DI void init(AccT& acc, const pg8::Unit& u, int, int wc, int, int fq) const {
        const float* bp = bgu + (size_t)u.aux * 2048 + u.c0 + wc * 32 + 8 * fq;
        acc_colbias(acc, *(const f32x4*)bp, *(const f32x4*)(bp + 4), *(const f32x4*)(bp + 1024), *(const f32x4*)(bp + 1028));
    }
    DI void bias_load(const pg8::Unit& u, int wc, int fq, f32x4 (&bv)[4]) const {
        const float* bp = bgu + (size_t)u.aux * 2048 + u.c0 + wc * 32 + 8 * fq;
        bv[0] = *(const f32x4*)bp; bv[1] = *(const f32x4*)(bp + 4); bv[2] = *(const f32x4*)(bp + 1024); bv[3] = *(const f32x4*)(bp + 1028);
    }
    DI void epi(const AccT& acc, const pg8::Unit& u, int wr, int wc, int fr, int fq) const {
        if (NOEPI) {
#pragma unroll
            for (int ai = 0; ai < 2; ++ai)
#pragma unroll
                for (int bj = 0; bj < 2; ++bj) asm volatile("" :: "v"(acc[ai][bj][0][0]), "v"(acc[ai][bj][0][1]), "v"(acc[ai][bj][1][0]), "v"(acc[ai][bj][1][1]), "v"(acc[ai][bj][2][0]), "v"(acc[ai][bj][2][1]), "v"(acc[ai][bj][3][0]), "v"(acc[ai][bj][3][1]));
            return;
        }
        st_realign(wr);
#pragma unroll
        for (int ai = 0; ai < 2; ++ai)
#pragma unroll
            for (int m = 0; m < 4; ++m) {
                const f32x4 g0 = acc[ai][0][m][0], g1 = acc[ai][0][m][1], l0 = acc[ai][1][m][0], l1 = acc[ai][1][m][1]; f32x4 a0, a1;
#pragma unroll
                for (int i = 0; i < 4; ++i) {
                    typedef float f32x2 __attribute__((ext_vector_type(2)));
                    const f32x2 x = {vmin_raw(g0[i], 7.f), vmin_raw(g1[i], 7.f)}, y = {vmed3_raw(l0[i], -7.f, 7.f), vmed3_raw(l1[i], -7.f, 7.f)};
                    const f32x2 t = x * (f32x2){-1.702f * LOG2E, -1.702f * LOG2E};
                    const f32x2 d = (f32x2){ex2(t.x), ex2(t.y)} + (f32x2){1.f, 1.f};
                    const float rr = rcpf(d.x * d.y);
                    const f32x2 o = x * ((f32x2){d.y, d.x} * (f32x2){rr, rr}) * (y + (f32x2){1.f, 1.f});
                    a0[i] = o.x; a1[i] = o.y; }
                st_put_gu(lds, (m & 1) * 32 + wr * 16 + fr, (wc * 32 + 8 * fq) * 2, a0, a1);
                if (m & 1) st_flush_gu(lds, (wr * 4 + wc) * 64 + fq * 16 + fr, ACT + (size_t)(u.r0 + ai * 128 + (m - 1) * 16) * D + u.c0, D, u.nvalid - (ai * 128 + (m - 1) * 16)); }
        st_restagger(wr);
    }
    DI void publish(int e, int mt) const {
        if (fresh_lane() == 0) __hip_atomic_fetch_add(panel + (ext[64 + e] >> 3) + (unsigned)mt, 1u, __ATOMIC_RELAXED, __HIP_MEMORY_SCOPE_AGENT);
    }
};
typedef PolGateUpT<false> PolGateUp;
template <bool NOEPI = false> struct PolDownT {
    static constexpr bool PERM = true, GATHER = false, PREBIAS = true, COUNTED = true, PUBLISH = false;
    const bf16_t *ACT, *WDNT; const float *bdn, *LISTW; bf16_t* OUTB; const LAS unsigned* ext; int vcu; LAS unsigned char* lds; const unsigned* panel; int wave, xi;
    DI bool next(int i, pg8::Unit& u) const {
        int e, mt, pn, nv; unsigned s0;
        int L_ = i * GRID + vcu; const int aff = xi >> 16, xcc = (xi >> 8) & 255, xrank = xi & 255;
        if (aff) {
            const int ptot = (int)((unsigned)__builtin_amdgcn_readfirstlane((int)ext[96]) >> 2), npx = ptot > xcc ? (ptot - xcc + 7) >> 3 : 0, ngu = 8 * npx;
            const int i0 = ngu > xrank ? (ngu - xrank + 31) >> 5 : 0, k_ = (i0 + i) * 32 + xrank - ngu;
            L_ = (xcc + 8 * (k_ >> 2)) * 4 + (k_ & 3);
        }
        if (!moe_unit(ext, L_, 4, e, mt, pn, nv, s0)) return false;
        if (aff && wave == 0) {
            const unsigned* cp = panel + (__builtin_amdgcn_readfirstlane((int)ext[64 + e]) >> 2) + mt;
            for (unsigned spins = 0; spins < (1u << 22); ++spins) { if (__hip_atomic_load(cp, __ATOMIC_RELAXED, __HIP_MEMORY_SCOPE_AGENT) >= 64u) break; __builtin_amdgcn_s_sleep(2); }
            __builtin_amdgcn_fence(__ATOMIC_ACQUIRE, "agent");
        }
        u.type = mt; u.A = (const char*)(ACT + (size_t)s0 * D); u.B0 = (const char*)(WDNT + ((size_t)e * 1024 + pn * 256) * D); u.bh = 128 * D * 2; u.r0 = (int)s0; u.c0 = pn * 256; u.nvalid = nv; u.aux = e;
        return true;
    }
    DI void aoff(const pg8::Unit&, int, int tid, unsigned (&va)[2][2]) const { pg8::aoff_std(tid, va); }
    DI void init(AccT& acc, const pg8::Unit& u, int, int wc, int, int fq) const {
        const float* bp = bdn + (size_t)u.aux * 1024 + u.c0 + wc * 32 + 8 * fq;
        acc_colbias(acc, *(const f32x4*)bp, *(const f32x4*)(bp + 4), *(const f32x4*)(bp + 128), *(const f32x4*)(bp + 132));
    }
    DI void bias_load(const pg8::Unit& u, int wc, int fq, f32x4 (&bv)[4]) const {
        const float* bp = bdn + (size_t)u.aux * 1024 + u.c0 + wc * 32 + 8 * fq;
        bv[0] = *(const f32x4*)bp; bv[1] = *(const f32x4*)(bp + 4); bv[2] = *(const f32x4*)(bp + 128); bv[3] = *(const f32x4*)(bp + 132);
    }
    DI void epi(const AccT& acc, const pg8::Unit& u, int wr, int wc, int fr, int fq) const {
        if (NOEPI) {
#pragma unroll
            for (int ai = 0; ai < 2; ++ai)
#pragma unroll
                for (int bj = 0; bj < 2; ++bj) asm volatile("" :: "v"(acc[ai][bj][0][0]), "v"(acc[ai][bj][0][1]), "v"(acc[ai][bj][1][0]), "v"(acc[ai][bj][1][1]), "v"(acc[ai][bj][2][0]), "v"(acc[ai][bj][2][1]), "v"(acc[ai][bj][3][0]), "v"(acc[ai][bj][3][1]));
            return;
        }
        const float* wp = LISTW + (size_t)u.aux * T + (size_t)u.type * 256;
        float wv[2][4];
#pragma unroll
        for (int ai = 0; ai < 2; ++ai)
#pragma unroll
            for (int m = 0; m < 4; ++m) { const int rl = ai * 128 + wr * 64 + m * 16 + fr; wv[ai][m] = wp[rl < u.nvalid ? rl : u.nvalid - 1]; }
        st_realign(wr);
#pragma unroll
        for (int ai = 0; ai < 2; ++ai)
#pragma unroll
            for (int m = 0; m < 4; ++m) {
                const float w = wv[ai][m];
#pragma unroll
                for (int bj = 0; bj < 2; ++bj) st_put(lds, wr * 16 + fr, (bj * 128 + wc * 32 + 8 * fq) * 2, acc[ai][bj][m][0] * w, acc[ai][bj][m][1] * w);
                st_flush<512>(lds, (wr * 4 + wc) * 64 + fq * 16 + fr, OUTB + (size_t)(u.r0 + ai * 128 + m * 16) * D + u.c0, D, u.nvalid - (ai * 128 + m * 16)); }
        st_restagger(wr);
    }
};

typedef PolDownT<false> PolDown;
template <int MODE> struct PolProj1T {
    static constexpr bool PERM = true, GATHER = false, PREBIAS = false, COUNTED = false, PUBLISH = false;
    unsigned char* ws; const float *bq, *kvb; int vcu; LAS unsigned char* lds;
#define PJ1(name, type, off) DI type* name() const { return (type*)(ws + (off)); }
    PJ1(HN, const bf16_t, WS_HN) PJ1(HN2, const bf16_t, WS_HN2) PJ1(WBQT, const bf16_t, WS_WBQT) PJ1(WKVT, const bf16_t, WS_WKVT) PJ1(ROPE, const float, WS_ROPE)
    PJ1(Q, bf16_t, WS_Q) PJ1(K1, bf16_t, WS_KV) PJ1(VT1, bf16_t, WS_VT)
#undef PJ1
    DI bool next(int i, pg8::Unit& u) const {
        const int L = (MODE == 0 ? 0 : 512) + i * GRID + vcu; if (L >= (MODE == 0 ? 512 : 768)) return false;
        u.bh = 128 * D * 2; u.nvalid = 256; u.aux = 0;
        if (MODE == 0) { const int pm = L >> 2, pn = L & 3; u.type = 0; u.A = (const char*)(HN() + (size_t)pm * 256 * D); u.B0 = (const char*)(WBQT() + (size_t)pn * 256 * D); u.r0 = pm * 256; u.c0 = pn * 256; }
        else if (L < 640) { const int pm = L - 512; u.type = 1; u.A = (const char*)(HN2() + (size_t)pm * 256 * D); u.B0 = (const char*)WKVT(); u.r0 = pm * 256; u.c0 = 0; }
        else { const int pn = L - 640; u.type = 2; u.A = (const char*)WKVT(); u.B0 = (const char*)(HN2() + (size_t)pn * 256 * D); u.r0 = 0; u.c0 = pn * 256; }
        return true;
    }
    DI void aoff(const pg8::Unit&, int, int tid, unsigned (&va)[2][2]) const { pg8::aoff_std(tid, va); }
    DI void init(AccT& acc, const pg8::Unit& u, int wr, int wc, int fr, int fq) const {
        if (MODE == 1 && u.type == 2) {
#pragma unroll
            for (int a = 0; a < 2; ++a)
#pragma unroll
                for (int m = 0; m < 4; ++m) { const float bs = kvb[a * 128 + wr * 64 + m * 16 + fr];
#pragma unroll
                    for (int b = 0; b < 2; ++b)
#pragma unroll
                        for (int n = 0; n < 2; ++n) acc[a][b][m][n] = (f32x4){bs, bs, bs, bs}; }
            return;
        }
        const float* bp = (MODE == 0 ? bq + u.c0 : kvb) + wc * 32 + 8 * fq;
        acc_colbias(acc, *(const f32x4*)bp, *(const f32x4*)(bp + 4), *(const f32x4*)(bp + 128), *(const f32x4*)(bp + 132));
    }
    DI void epi(const AccT& acc, const pg8::Unit& u, int wr, int wc, int fr, int fq) const {
        const int tid = (wr * 4 + wc) * 64 + fq * 16 + fr, rowl = wr * 16 + fr;
        if (MODE == 1 && u.type == 2) {
            st_realign(wr);
#pragma unroll
            for (int m = 0; m < 4; ++m) {
#pragma unroll
                for (int bj = 0; bj < 2; ++bj) st_put(lds, rowl, (bj * 128 + wc * 32 + 8 * fq) * 2, acc[1][bj][m][0], acc[1][bj][m][1]);
                st_flush<512, false>(lds, tid, VT1() + (size_t)(m * 16) * T + u.c0, T, 256); }
            st_restagger(wr);
            return;
        }
        constexpr bool isq = (MODE == 0); const bool rl = ((wc & 1) == 0) && fq < 2; const float sc = isq ? QSCALE : 1.f;
        RopeRow rr = rope_load(ROPE() + (size_t)(u.r0 + wr * 64 + fr) * 16);
        st_realign(wr);
#pragma unroll
        for (int ai = 0; ai < 2; ++ai)
#pragma unroll
            for (int m = 0; m < 4; ++m) {
                const int nx = (ai * 4 + m + 1) & 7;
                const RopeRow rn = rope_load(ROPE() + (size_t)(u.r0 + (nx >> 2) * 128 + wr * 64 + (nx & 3) * 16 + fr) * 16);
#pragma unroll
                for (int bj = 0; bj < 2; ++bj) {
                    if (!isq && bj == 1) continue;
                    f32x4 v0 = acc[ai][bj][m][0], v1 = acc[ai][bj][m][1];
                    if ((wc & 1) == 0) { f32x4 r0 = v0, r1 = v1; rope8(r0, r1, rr, fq); if (rl) { v0 = r0; v1 = r1; } }
                    v0 = v0 * sc; v1 = v1 * sc;
                    st_put(lds, rowl, (bj * 128 + wc * 32 + 8 * fq) * 2, v0, v1); }
                if (isq) st_flush<512, false>(lds, tid, Q() + (size_t)(u.r0 + ai * 128 + m * 16) * D + u.c0, D, 256);
                else st_flush<256, false>(lds, tid, K1() + (size_t)(u.r0 + ai * 128 + m * 16) * 128, 128, 256);
                rr = rn; }
        st_restagger(wr);
    }
};

template <class Base> struct NoEpi : Base {
    DI void epi(const AccT& acc, const pg8::Unit&, int, int, int, int) const {
#pragma unroll
        for (int ai = 0; ai < 2; ++ai)
#pragma unroll
            for (int bj = 0; bj < 2; ++bj) asm volatile("" :: "v"(acc[ai][bj][0][0]), "v"(acc[ai][bj][0][1]), "v"(acc[ai][bj][1][0]), "v"(acc[ai][bj][1][1]), "v"(acc[ai][bj][2][0]), "v"(acc[ai][bj][2][1]), "v"(acc[ai][bj][3][0]), "v"(acc[ai][bj][3][1]));
    }
};
DI float gelu_tanh(float z) {
    const float u = 0.7978845608028654f * (z + 0.044715f * z * z * z);
    const float e = ex2(2.f * LOG2E * u);
    const float th = 1.f - 2.f * rcpf(e + 1.f);
    return 0.5f * z * (1.f + th);
}
DI void compress_phase(Frame& F) {
    const int tid = F.tid, lane = F.lane, r = lane & 31, h = lane >> 5, quad = F.wave >> 2, q = F.wave & 3;
    const int rb = F.bx * 2 + quad, kv = rb >> 8, rem = rb & 255, b = rem >> 4, g = (rem >> 2) & 3, nb = rem & 3;
    const int n = nb * 32 + r, nn = n < 126 ? n : 126;
    constexpr int CW = 0, CX = 36864, CH = 55296;
    LAS unsigned char* lds = F.lds;
    LAS unsigned char* hid = lds + CH + quad * (32 * 272);
    const int wrow = tid >> 3, wch = tid & 7;
    const bf16_t* wsrc = F.CW1T() + ((size_t)kv * 128 + wrow) * 2048 + wch * 8;
    const int xq = tid >> 8, xr = (tid >> 3) & 31, xch = tid & 7;
    const bf16_t* xsrc;
    { const int rbq = F.bx * 2 + xq, remq = rbq & 255, bq = remq >> 4, gq = (remq >> 2) & 3, nbq = remq & 3; const int nq = nbq * 32 + xr, nnq = nq < 126 ? nq : 126;
      xsrc = F.KV() + ((size_t)(bq * SEQ + 16 * nnq)) * D + kv * 256 + gq * 64 + xch * 8; }
    f32x16 acc;
#pragma unroll
    for (int i = 0; i < 16; ++i) acc[i] = 0.f;
    u32x4 w0 = *(const u32x4*)wsrc, w1 = *(const u32x4*)(wsrc + (size_t)64 * 2048), xv = *(const u32x4*)xsrc;
#define CP_WRITE(buf) do { *(LAS u32x4*)(lds + CW + (buf) * 18432 + wrow * 144 + wch * 16) = w0; *(LAS u32x4*)(lds + CW + (buf) * 18432 + (wrow + 64) * 144 + wch * 16) = w1; \
        *(LAS u32x4*)(lds + CX + ((buf) * 2 + xq) * 4608 + xr * 144 + xch * 16) = xv; } while (0)
    CP_WRITE(0);
    __syncthreads();
#pragma unroll 2
    for (int c = 0; c < 32; ++c) {
        const int buf = c & 1;
        if (c + 1 < 32) { w0 = *(const u32x4*)(wsrc + 64 * (c + 1)); w1 = *(const u32x4*)(wsrc + (size_t)64 * 2048 + 64 * (c + 1)); xv = *(const u32x4*)(xsrc + (size_t)(c + 1) * D); }
        const LAS unsigned char* ap = lds + CW + buf * 18432 + (32 * q + r) * 144 + 16 * h;
        const LAS unsigned char* bp = lds + CX + (buf * 2 + quad) * 4608 + r * 144 + 16 * h;
#pragma unroll
        for (int s = 0; s < 4; ++s) { const bf16x8 a = *(const LAS bf16x8*)(ap + 32 * s); const bf16x8 bb = *(const LAS bf16x8*)(bp + 32 * s); acc = MFMA32(a, bb, acc); }
        if (c + 1 < 32) CP_WRITE(buf ^ 1);
        __syncthreads();
    }
#undef CP_WRITE
    {
        const float* cb = F.CMPB() + kv * 128 + 32 * q;
#pragma unroll
        for (int q4 = 0; q4 < 4; ++q4) {
            float v[4];
#pragma unroll
            for (int i = 0; i < 4; ++i) v[i] = gelu_tanh(acc[4 * q4 + i] + cb[8 * q4 + 4 * h + i]);
            u32x2 o; o.x = pk2(v[0], v[1]); o.y = pk2(v[2], v[3]);
            *(LAS u32x2*)(hid + r * 272 + (32 * q + 8 * q4 + 4 * h) * 2) = o;
        }
    }
    __syncthreads();
    if (q < 2) {
        const int db = q;
        f32x16 o2;
#pragma unroll
        for (int i = 0; i < 16; ++i) o2[i] = 0.f;
        const bf16_t* w2p = F.CW2T() + ((size_t)kv * 64 + 32 * db + r) * 128 + 8 * h;
#pragma unroll
        for (int s = 0; s < 8; ++s) {
            const bf16x8 a = *(const bf16x8*)(w2p + 16 * s);
            const bf16x8 bb = *(const LAS bf16x8*)(hid + r * 272 + (16 * s + 8 * h) * 2);
            o2 = MFMA32(a, bb, o2);
        }
        const bool valid = n < 127;
        if (kv == 0) {
            if (db == 0) {
                const float* rp = F.ROPE() + (size_t)(b * SEQ + 16 * nn + 31) * 16 + 4 * h;
                const f32x4 c = *(const f32x4*)rp, sn = *(const f32x4*)(rp + 8);
#pragma unroll
                for (int i = 0; i < 4; ++i) { const float x1 = o2[i], x2 = o2[4 + i]; o2[i] = x1 * c[i] - x2 * sn[i]; o2[4 + i] = x2 * c[i] + x1 * sn[i]; }
            }
            bf16_t* kp = F.KC() + ((size_t)((b * 4 + g) * 128 + n)) * 64 + 32 * db + 4 * h;
#pragma unroll
            for (int q4 = 0; q4 < 4; ++q4) { u32x2 o; o.x = valid ? pk2(o2[4 * q4], o2[4 * q4 + 1]) : 0u; o.y = valid ? pk2(o2[4 * q4 + 2], o2[4 * q4 + 3]) : 0u; *(u32x2*)(kp + 8 * q4) = o; }
        } else {
#pragma unroll
            for (int i = 0; i < 16; ++i) { const int d = 32 * db + crow(i, h);
                F.VCT()[((size_t)((b * 4 + g) * 64 + d)) * 128 + n] = valid ? (bf16_t)(pk2(o2[i], 0.f) & 0xffffu) : (bf16_t)0; }
        }
    }
    __syncthreads();
}

constexpr int AT_KT = 0, AT_VT = 18432  , AT_KC = 46080, AT_VC = 64512, AT_IMPP = 81408, AT_IMPS = 114176, AT_SELM = 122368;
#define NEG_INF (-INFINITY)

constexpr int AT_BG = 122880, BG_PER_WAVE = 96;
struct BgCvt { KPtr kp; LAS float* tile; int gw, cnt, st; f32x4 r[4]; };
DI void bg_decode(const BgCvt& g, const float*& src, bf16_t*& dst, int& ld) {
    const int it = g.gw + g.cnt * (GRID * NWAVES);
    unsigned char* ws = *(unsigned char* const __attribute__((address_space(4)))*)(g.kp + 8 * 29);
    if (it < 131072) { const int mat = it >> 11, q = it & 2047, kb = q >> 6, nb = q & 63;
        src = *(const float* const __attribute__((address_space(4)))*)(g.kp + 8 * 24) + (size_t)mat * (D * 2048) + (size_t)(32 * kb) * 2048 + 32 * nb; ld = 2048;
        dst = (bf16_t*)(ws + WS_WGUT) + (size_t)mat * (2048 * D) + (size_t)(32 * nb) * D + 32 * kb; }
    else { const int i2 = it - 131072, mat = i2 >> 10, q = i2 & 1023, kb = q >> 5, nb = q & 31;
        src = *(const float* const __attribute__((address_space(4)))*)(g.kp + 8 * 26) + (size_t)mat * (D * D) + (size_t)(32 * kb) * D + 32 * nb; ld = D;
        dst = (bf16_t*)(ws + WS_WDNT) + (size_t)mat * (D * D) + (size_t)(32 * nb) * D + 32 * kb; }
}
DI void bg_issue(BgCvt& g, int lane) {
    const float* src; bf16_t* dst; int ld; bg_decode(g, src, dst, ld);
    const float* p = src + (size_t)(lane >> 3) * ld + 4 * (lane & 7);
#pragma unroll
    for (int i = 0; i < 4; ++i) g.r[i] = __builtin_nontemporal_load((const f32x4*)(p + (size_t)(8 * i) * ld));
}
DI void bg_finish(BgCvt& g, int lane) {
    const float* src; bf16_t* dst; int ld; bg_decode(g, src, dst, ld);
    LAS float* w = g.tile + (lane >> 3) * 33 + 4 * (lane & 7);
#pragma unroll
    for (int i = 0; i < 4; ++i) { LAS float* q = w + (8 * i) * 33; q[0] = g.r[i].x; q[1] = g.r[i].y; q[2] = g.r[i].z; q[3] = g.r[i].w; }
    LDS_WAIT(); asm volatile("" ::: "memory");
    const int n = lane >> 1, kh = lane & 1; const LAS float* s = g.tile + (16 * kh) * 33 + n;
    u32x4 o0, o1;
    o0.x = pk2(s[0 * 33], s[1 * 33]); o0.y = pk2(s[2 * 33], s[3 * 33]); o0.z = pk2(s[4 * 33], s[5 * 33]); o0.w = pk2(s[6 * 33], s[7 * 33]);
    o1.x = pk2(s[8 * 33], s[9 * 33]); o1.y = pk2(s[10 * 33], s[11 * 33]); o1.z = pk2(s[12 * 33], s[13 * 33]); o1.w = pk2(s[14 * 33], s[15 * 33]);
    bf16_t* d = dst + (size_t)n * D + 16 * kh;
    __builtin_nontemporal_store(o0, (u32x4*)d); __builtin_nontemporal_store(o1, (u32x4*)(d + 8));
    LDS_WAIT(); asm volatile("" ::: "memory");
    ++g.cnt;
}

DI void bg_start(BgCvt& g, int lane) { if (g.st == 0 && g.cnt < BG_PER_WAVE) { bg_issue(g, lane); g.st = 1; } }
DI void bg_end(BgCvt& g, int lane) { if (g.st == 2) { bg_finish(g, lane); g.st = 0; } else if (g.st == 1) g.st = 2; else if (g.st == 3) g.st = 0; }
DI void bg_flush(BgCvt& g, int lane) { if (g.st == 1 || g.st == 2) bg_finish(g, lane); g.st = 0; }

constexpr float AT_THR = 24.0f;
DI float max3f(float a, float b, float c) { float r; asm("v_max3_f32 %0, %1, %2, %3" : "=v"(r) : "v"(a), "v"(b), "v"(c)); return r; }
DI void qk_tile(const LAS unsigned char* kt, const bf16x8 (&qf)[4], f32x16& s0, f32x16& s1, int r, int h) {
    const LAS unsigned char* kp = kt + r * 144 + h * 16;
    f32x16 z;
#pragma unroll
    for (int i = 0; i < 16; ++i) z[i] = 0.f;
    { const bf16x8 a0 = *(const LAS bf16x8*)(kp), a1 = *(const LAS bf16x8*)(kp + 32 * 144); s0 = MFMA32(a0, qf[0], z); s1 = MFMA32(a1, qf[0], z); }
#pragma unroll
    for (int s = 1; s < 4; ++s) {
        const bf16x8 a0 = *(const LAS bf16x8*)(kp + s * 32), a1 = *(const LAS bf16x8*)(kp + 32 * 144 + s * 32);
        s0 = MFMA32(a0, qf[s], s0); s1 = MFMA32(a1, qf[s], s1);
    }
}
DI void v_frags(const LAS unsigned char* vt, bf16x8 (&vf)[2][2][2], int r, int h) {
    const LAS unsigned char* vp = vt + r * 144 + h * 16;
#pragma unroll
    for (int db = 0; db < 2; ++db)
#pragma unroll
        for (int kb = 0; kb < 2; ++kb)
#pragma unroll
            for (int s2 = 0; s2 < 2; ++s2) vf[db][kb][s2] = *(const LAS bf16x8*)(vp + db * 32 * 144 + kb * 64 + s2 * 32);
}
DI void pv_mma(const bf16x8 (&vf)[2][2][2], const u32x4 (&pb)[2][2], f32x16 (&O)[2]) {
#pragma unroll
    for (int db = 0; db < 2; ++db)
#pragma unroll
        for (int kb = 0; kb < 2; ++kb)
#pragma unroll
            for (int s2 = 0; s2 < 2; ++s2) O[db] = MFMA32(vf[db][kb][s2], __builtin_bit_cast(bf16x8, pb[kb][s2]), O[db]);
}
DI void pv_tile(const LAS unsigned char* vt, const u32x4 (&pb)[2][2], f32x16 (&O)[2], int r, int h) {
    bf16x8 vf[2][2][2]; v_frags(vt, vf, r, h); pv_mma(vf, pb, O);
}
DI void make_mask(int lo, int hi, int h, unsigned& w0, unsigned& w1) {
    const int a = lo + 1 < 0 ? 0 : lo + 1, b = hi > 63 ? 63 : hi;
    unsigned long long mk = (a <= b) ? ((~0ull >> (63 - b)) & (~0ull << a)) : 0ull;
    mk >>= 4 * h;
    w0 = (unsigned)mk; w1 = (unsigned)(mk >> 32);
}
DI unsigned bitm(unsigned w, int q) { unsigned r_; asm("v_bfe_i32 %0, %1, %2, 1" : "=v"(r_) : "v"(w), "n"((q & 3) + 8 * (q >> 2))); return r_; }
DI float msel(float s, unsigned mk) { return __uint_as_float((__float_as_uint(s) & mk) | (0xff800000u & ~mk)); }
template <bool MASKED> DI float tile_max(const f32x16& S0, const f32x16& S1, unsigned w0, unsigned w1) {
    float mx = NEG_INF;
    if (!MASKED) {
#pragma unroll
        for (int q = 0; q < 16; q += 2) mx = max3f(mx, max3f(S0[q], S0[q + 1], S1[q]), S1[q + 1]);
    } else {
#pragma unroll
        for (int q = 0; q < 16; ++q) mx = max3f(mx, msel(S0[q], bitm(w0, q)), msel(S1[q], bitm(w1, q)));
    }
    return mx;
}
template <bool MASKED, bool SUB> DI float tile_exp(const f32x16& S0, const f32x16& S1, unsigned w0, unsigned w1, float m, u32x4 (&pb)[2][2]) {
    float ls = 0.f;
#pragma unroll
    for (int s2 = 0; s2 < 2; ++s2)
#pragma unroll
        for (int w = 0; w < 4; ++w) {
            const int q = 8 * s2 + 2 * w;
            float a0 = SUB ? ex2(S0[q] - m) : ex2(S0[q]), a1 = SUB ? ex2(S0[q + 1] - m) : ex2(S0[q + 1]), b0 = SUB ? ex2(S1[q] - m) : ex2(S1[q]), b1 = SUB ? ex2(S1[q + 1] - m) : ex2(S1[q + 1]);
            if (MASKED) { a0 = __uint_as_float(__float_as_uint(a0) & bitm(w0, q)); a1 = __uint_as_float(__float_as_uint(a1) & bitm(w0, q + 1));
                          b0 = __uint_as_float(__float_as_uint(b0) & bitm(w1, q)); b1 = __uint_as_float(__float_as_uint(b1) & bitm(w1, q + 1)); }
            ls += (a0 + a1) + (b0 + b1);
            pb[0][s2][w] = pk2(a0, a1); pb[1][s2][w] = pk2(b0, b1);
        }
    return ls;
}
#define AT_WRITE_K(buf, kreg) do { *(LAS u32x4*)(lds + AT_KT + (buf) * 9216 + (tid >> 3) * 144 + (tid & 7) * 16) = (kreg); } while (0)
#define AT_WRITE_V(buf, vreg) do {   \
        LAS unsigned char* _vp = lds + AT_VT + (buf) * 9216 + (tid >> 3) * 144 + ((tid & 7) >> 1) * 32 + (tid & 1) * 8; *(LAS u32x2*)_vp = (u32x2){(vreg).x, (vreg).y}; *(LAS u32x2*)(_vp + 16) = (u32x2){(vreg).z, (vreg).w}; } while (0)

template <class Seq, int DBG = 0>
DI void attn_stream(LAS unsigned char* lds, int tid, int r, int h, const Seq& seq, const bf16_t* kbase, size_t ktile, const bf16_t* vbase,
                    const bf16x8 (&qf)[4], f32x16 (&O)[2], float& m, float& l, BgCvt& bg) {
    const bool late = __builtin_amdgcn_readfirstlane(tid >> 8) != 0;
    int j = seq.first(), j1 = seq.next(j), j2 = (j1 >= 0) ? seq.next(j1) : -1;
    u32x4 krA, krB, vrA, vrB;
    krA = *(const u32x4*)(kbase + (size_t)j * ktile); vrA = *(const u32x4*)(vbase + 64 * j);
    krB = krA; vrB = vrA;
    if (j1 >= 0) { krB = *(const u32x4*)(kbase + (size_t)j1 * ktile); vrB = *(const u32x4*)(vbase + 64 * j1); }
    AT_WRITE_K(0, krA); AT_WRITE_V(0, vrA);
    if (j2 >= 0) { krA = *(const u32x4*)(kbase + (size_t)j2 * ktile); vrA = *(const u32x4*)(vbase + 64 * j2); }
    __syncthreads();
    f32x16 sa0, sa1, sb0, sb1;
    qk_tile(lds + AT_KT, qf, sa0, sa1, r, h);
    sb0 = sa0; sb1 = sa1;
    if (j1 >= 0) { AT_WRITE_K(1, krB); AT_WRITE_V(1, vrB); }
    __syncthreads();
    int vcur = 0;
#define AT_STEP(SA0, SA1, SB0, SB1, PAR, KR, VR, KS, VS) { \
        const int j3 = (j2 >= 0) ? seq.next(j2) : -1; \
        if (j3 >= 0 && !(DBG & 4)) { KS = *(const u32x4*)(kbase + (size_t)j3 * ktile); VS = *(const u32x4*)(vbase + 64 * j3); } \
        bg_start(bg, tid & 63); \
        if (!late && j1 >= 0 && !(DBG & 2)) qk_tile(lds + AT_KT + ((PAR) ^ 1) * 9216, qf, SB0, SB1, r, h);        \
        __builtin_amdgcn_sched_barrier(0); \
        bf16x8 vf[2][2][2]; if (!(DBG & 2)) v_frags(lds + AT_VT + vcur * 9216, vf, r, h); \
        const bool allow = seq.allow(j); \
        float mx = (DBG & 1) ? 0.f : tile_max<false>(SA0, SA1, 0u, 0u); \
        if (!(DBG & 1)) mx = fmaxf(mx, __shfl_xor(mx, 32)); if (Seq::HAS_ALLOW) mx = allow ? mx : NEG_INF; \
        if (__any(mx - m > AT_THR)) { \
            const float mn = fmaxf(m, mx), alpha = ex2(m - mn); \
            m = mn; l *= alpha; O[0] = O[0] * alpha; O[1] = O[1] * alpha; \
        } \
        u32x4 pb[2][2]; float ls; \
        if (DBG & 1) { ls = 1.f; _Pragma("unroll") for (int a_ = 0; a_ < 2; ++a_) _Pragma("unroll") for (int b_ = 0; b_ < 2; ++b_) pb[a_][b_] = (u32x4){__float_as_uint(SA0[a_]), __float_as_uint(SA0[2 + b_]), __float_as_uint(SA1[a_]), __float_as_uint(SA1[3])}; } \
        else if (__any(m != 0.f)) ls = tile_exp<false, true>(SA0, SA1, 0u, 0u, m, pb); \
        else ls = tile_exp<false, false>(SA0, SA1, 0u, 0u, m, pb); \
        if (Seq::HAS_ALLOW) { const unsigned km = allow ? 0xffffffffu : 0u; ls = allow ? ls : 0.f; \
            _Pragma("unroll") for (int a_ = 0; a_ < 2; ++a_) _Pragma("unroll") for (int b_ = 0; b_ < 2; ++b_) { pb[a_][b_].x &= km; pb[a_][b_].y &= km; pb[a_][b_].z &= km; pb[a_][b_].w &= km; } } \
        l += ls; \
        if (!(DBG & 2)) pv_mma(vf, pb, O); else { O[0][0] += __uint_as_float(pb[0][0].x); O[1][0] += __uint_as_float(pb[1][1].w); } \
        __builtin_amdgcn_sched_barrier(0); \
        if (late && j1 >= 0 && !(DBG & 2)) qk_tile(lds + AT_KT + ((PAR) ^ 1) * 9216, qf, SB0, SB1, r, h);         \
        { const int vw = vcur >= 1 ? vcur - 1 : 2;        \
          if (j2 >= 0 && !(DBG & 4)) { AT_WRITE_K((PAR), KR); AT_WRITE_V(vw, VR); } }     \
        vcur = vcur == 2 ? 0 : vcur + 1; \
        bg_end(bg, tid & 63); \
        if (!(DBG & 8)) __syncthreads(); \
        if (j1 < 0) break; \
        j = j1; j1 = j2; j2 = j3; }
    for (;;) {
        AT_STEP(sa0, sa1, sb0, sb1, 0, krA, vrA, krB, vrB)
        AT_STEP(sb0, sb1, sa0, sa1, 1, krB, vrB, krA, vrA)
    }
#undef AT_STEP
}
DI void attn_tile_masked(LAS unsigned char* lds, int tid, int r, int h, const bf16_t* kptr, const bf16_t* vptr, const bf16x8 (&qf)[4], f32x16 (&O)[2], float& m, float& l, int lo, int hi, BgCvt& bg) {
    const u32x4 kr = *(const u32x4*)kptr, vr = *(const u32x4*)vptr;
    bg_start(bg, tid & 63);
    AT_WRITE_K(0, kr); AT_WRITE_V(0, vr);
    __syncthreads();
    f32x16 s0, s1;
    qk_tile(lds + AT_KT, qf, s0, s1, r, h);
    unsigned w0, w1; make_mask(lo, hi, h, w0, w1);
    float mx = tile_max<true>(s0, s1, w0, w1);
    mx = fmaxf(mx, __shfl_xor(mx, 32));
    if (__any(mx - m > AT_THR)) {
        const float mn = fmaxf(m, mx), alpha = ex2(m - mn);
        m = mn; l *= alpha; O[0] = O[0] * alpha; O[1] = O[1] * alpha;
    }
    u32x4 pb[2][2];
    l += tile_exp<true, true>(s0, s1, w0, w1, m, pb);
    pv_tile(lds + AT_VT, pb, O, r, h);
    bg_end(bg, tid & 63);
    __syncthreads();
}
struct SeqSel { static constexpr bool HAS_ALLOW = true; unsigned need, myselm;
    DI int first() const { return __builtin_ctz(need); }
    DI int next(int j) const { const unsigned rest = need & ~((2u << j) - 1u); return rest ? __builtin_ctz(rest) : -1; }
    DI bool allow(int j) const { return (myselm >> j) & 1u; }
};
struct SeqRange { static constexpr bool HAS_ALLOW = false; int j0, j1;
    DI int first() const { return j0; }
    DI int next(int j) const { return j < j1 ? j + 1 : -1; }
    DI bool allow(int) const { return true; }
};

DI void nsa_attn_phase(Frame& F) {
    LAS unsigned char* lds = F.lds;
    const int tid0 = F.tid, wave = F.wave, hh = wave & 3, th = wave >> 2;
    const int bg = F.bx & 63, b = bg >> 2, g = bg & 3, s4 = F.bx >> 6;
    LAS float* impP = (LAS float*)(lds + AT_IMPP);
    LAS float* impS = (LAS float*)(lds + AT_IMPS);
    LAS unsigned* selm = (LAS unsigned*)(lds + AT_SELM);
    const int head = g * 4 + hh;
    BgCvt bgc; bgc.kp = F.kp; bgc.tile = (LAS float*)(lds + AT_BG) + wave * 1056; bgc.gw = F.bx * NWAVES + wave; bgc.cnt = 0; bgc.st = 0;
    {
#pragma unroll
        for (int i = 0; i < 2; ++i) { const int idx = tid0 + 512 * i, row = idx >> 3, ch = idx & 7;
            *(LAS u32x4*)(lds + AT_KC + row * 144 + ch * 16) = *(const u32x4*)(F.KC() + ((size_t)((b * 4 + g) * 128 + row)) * 64 + ch * 8); }
#pragma unroll
        for (int i = 0; i < 2; ++i) { const int idx = tid0 + 512 * i, d = idx >> 4, ch = idx & 15;
            const u32x4 v = *(const u32x4*)(F.VCT() + ((size_t)((b * 4 + g) * 64 + d)) * 128 + ch * 8);
            LAS u32x2* vp = (LAS u32x2*)(lds + AT_VC + d * 264 + ch * 16); vp[0] = (u32x2){v.x, v.y}; vp[1] = (u32x2){v.z, v.w}; }
        __syncthreads();
    }
    for (int ui = 0; ui < 8; ++ui) {
        int tid = tid0; asm volatile("" : "+v"(tid));
        const int lane = tid & 63, r = lane & 31, h = lane >> 5, tl = th * 32 + r;
        const int pp = s4 + 4 * (ui >> 1), qt = (ui & 1) ? 31 - pp : pp;
        const int t = qt * 64 + tl; const size_t tokrow = (size_t)b * SEQ + t;
        bf16x8 qf[4];
#pragma unroll
        for (int s = 0; s < 4; ++s) qf[s] = *(const bf16x8*)(F.Q() + tokrow * D + head * 64 + 16 * s + 8 * h);
        const float* gatep = F.GATES() + tokrow * 64 + head * 3;
        const float gc = gatep[0], gs = gatep[1], gw = gatep[2];
        if (tid < 64) selm[tid] = 0u;
        f32x16 Ot[2];
#pragma unroll
        for (int i = 0; i < 16; ++i) { Ot[0][i] = 0.f; Ot[1][i] = 0.f; }
#ifndef NO_CMP
        {
            const int nmax = (t - 31) >> 4;
            float mrun = NEG_INF, lrun = 0.f;
#pragma unroll 1
            for (int kb = 0; kb < 4; ++kb) {
                f32x16 sc;
#pragma unroll
                for (int i = 0; i < 16; ++i) sc[i] = 0.f;
#pragma unroll
                for (int s = 0; s < 4; ++s) { const bf16x8 a = *(const LAS bf16x8*)(lds + AT_KC + (kb * 32 + r) * 144 + s * 32 + h * 16); sc = MFMA32(a, qf[s], sc); }
                float bm = NEG_INF;
#pragma unroll
                for (int i = 0; i < 16; ++i) { const int nn = kb * 32 + crow(i, h); sc[i] = (nn <= nmax) ? sc[i] : NEG_INF; bm = fmaxf(bm, sc[i]); }
                const float mn = fmaxf(mrun, bm), mu = (mn == NEG_INF) ? 0.f : mn;
                float ls = 0.f;
#pragma unroll
                for (int i = 0; i < 16; ++i) ls += ex2(sc[i] - mu);
                lrun = lrun * ex2(mrun - mu) + ls; mrun = mn;
            }
            float mu, inv;
            { const float mo = __shfl_xor(mrun, 32), lo_ = __shfl_xor(lrun, 32); const float mt = fmaxf(mrun, mo); mu = (mt == NEG_INF) ? 0.f : mt;
              const float lt = lrun * ex2(mrun - mu) + lo_ * ex2(mo - mu); inv = lt > 0.f ? 1.f / lt : 0.f; }
            f32x16 Oc[2];
#pragma unroll
            for (int i = 0; i < 16; ++i) { Oc[0][i] = 0.f; Oc[1][i] = 0.f; }
            LAS float* ip = impP + ((hh * 64 + tl) * 32);
            float carry = 0.f;
#pragma unroll 1
            for (int kb = 0; kb < 4; ++kb) {
                f32x16 sc;
#pragma unroll
                for (int i = 0; i < 16; ++i) sc[i] = 0.f;
#pragma unroll
                for (int s = 0; s < 4; ++s) { const bf16x8 a = *(const LAS bf16x8*)(lds + AT_KC + (kb * 32 + r) * 144 + s * 32 + h * 16); sc = MFMA32(a, qf[s], sc); }
#pragma unroll
                for (int i = 0; i < 16; ++i) { const int nn = kb * 32 + crow(i, h); sc[i] = (nn <= nmax) ? ex2(sc[i] - mu) * inv : 0.f; }
                float Lo[4];
#pragma unroll
                for (int q4 = 0; q4 < 4; ++q4) Lo[q4] = __shfl_xor(sc[4 * q4 + 3], 32);
#pragma unroll
                for (int q4 = 0; q4 < 4; ++q4) {
                    const float G = (sc[4 * q4] + sc[4 * q4 + 1]) + (sc[4 * q4 + 2] + sc[4 * q4 + 3]);
                    const float prev0 = (q4 > 0) ? Lo[q4 > 0 ? q4 - 1 : 0] : carry;
                    const float Lp = (h == 1) ? Lo[q4] : prev0;
                    ip[8 * kb + 2 * q4 + h] = G + Lp;
                }
                carry = Lo[3];
#pragma unroll
                for (int s2 = 0; s2 < 2; ++s2) {
                    u32x4 p;
                    p.x = pk2(sc[8 * s2 + 0], sc[8 * s2 + 1]); p.y = pk2(sc[8 * s2 + 2], sc[8 * s2 + 3]); p.z = pk2(sc[8 * s2 + 4], sc[8 * s2 + 5]); p.w = pk2(sc[8 * s2 + 6], sc[8 * s2 + 7]);
                    const bf16x8 pb = __builtin_bit_cast(bf16x8, p);
#pragma unroll
                    for (int db = 0; db < 2; ++db) {
                        const LAS unsigned char* a = lds + AT_VC + (db * 32 + r) * 264 + (kb * 32 + 16 * s2 + 4 * h) * 2;
                        const s16x4 lo4 = *(const LAS s16x4*)a, hi4 = *(const LAS s16x4*)(a + 16);
                        const bf16x8 va = __builtin_shufflevector(lo4, hi4, 0, 1, 2, 3, 4, 5, 6, 7);
                        Oc[db] = MFMA32(va, pb, Oc[db]);
                    }
                }
            }
#pragma unroll
            for (int i = 0; i < 16; ++i) { Ot[0][i] = gc * Oc[0][i]; Ot[1][i] = gc * Oc[1][i]; }
        }
#endif
        __syncthreads();
        {
            const int tok = tid >> 3, sub = tid & 7;
#pragma unroll
            for (int jj = 0; jj < 4; ++jj) { const int j = sub * 4 + jj;
                impS[tok * 32 + j] = ((impP[(0 * 64 + tok) * 32 + j] + impP[(1 * 64 + tok) * 32 + j]) + impP[(2 * 64 + tok) * 32 + j]) + impP[(3 * 64 + tok) * 32 + j]; }
        }
        __syncthreads();
#ifndef NO_TOPK
        {
            const int tok = tid >> 3, sub = tid & 7;
            if (qt < 16) { if (sub == 0) selm[tok] = (2u << qt) - 1u; }
            else {
                float vj[4]; int rank[4];
#pragma unroll
                for (int jj = 0; jj < 4; ++jj) { vj[jj] = impS[tok * 32 + sub * 4 + jj]; rank[jj] = 0; }
#pragma unroll 1
                for (int i = 1; i <= qt - 2; ++i) { const float vi = impS[tok * 32 + i];
#pragma unroll
                    for (int jj = 0; jj < 4; ++jj) { const int j = sub * 4 + jj; rank[jj] += ((vi > vj[jj]) || (vi == vj[jj] && i < j)) ? 1 : 0; } }
                unsigned bits = 0u;
#pragma unroll
                for (int jj = 0; jj < 4; ++jj) { const int j = sub * 4 + jj;
                    const bool forced = (j == 0 || j == qt || j == qt - 1);
                    const bool sel = forced || (j <= qt - 2 && rank[jj] < 13);
                    bits |= sel ? (1u << j) : 0u; }
                if (bits) __hip_atomic_fetch_or(selm + tok, bits, __ATOMIC_RELAXED, __HIP_MEMORY_SCOPE_WORKGROUP);
            }
        }
#endif
        __syncthreads();
        LAS unsigned* park = (LAS unsigned*)(lds + AT_IMPP) + wave * 1024 + lane;
#pragma unroll
        for (int i = 0; i < 8; ++i) { park[i * 64] = pk2(Ot[0][2 * i], Ot[0][2 * i + 1]); park[(8 + i) * 64] = pk2(Ot[1][2 * i], Ot[1][2 * i + 1]); }
        const unsigned myselm = selm[tl];
        unsigned need;
        { unsigned w = selm[lane];
#pragma unroll
            for (int o = 1; o < 64; o <<= 1) w |= (unsigned)__shfl_xor((int)w, o);
            need = (unsigned)__builtin_amdgcn_readfirstlane((int)w) & ((2u << qt) - 1u); }
#ifdef REPEAT_SEL
        { f32x16 O2[2]; float m2 = 0.f, l2 = 0.f;
#pragma unroll
          for (int i = 0; i < 16; ++i) { O2[0][i] = 0.f; O2[1][i] = 0.f; }
          const bf16_t* kbase = F.KV() + ((size_t)b * SEQ + (tid >> 3)) * D + 512 + g * 64 + (tid & 7) * 8;
          const bf16_t* vbase = F.VT() + ((size_t)(g * 64 + (tid >> 3))) * T + (size_t)b * SEQ + (tid & 7) * 8;
          const unsigned inner = need & ~(1u << qt);
          if (inner) { const SeqSel seq{inner, myselm}; attn_stream<SeqSel, REPEAT_SEL>(lds, tid, r, h, seq, kbase, (size_t)64 * D, vbase, qf, O2, m2, l2, bgc); }
          attn_tile_masked(lds, tid, r, h, kbase + (size_t)qt * 64 * D, vbase + 64 * qt, qf, O2, m2, l2, -1, tl, bgc);
          asm volatile("" :: "v"(O2[0]), "v"(O2[1]), "v"(l2)); }
#endif
#ifndef NO_SEL
        {
            f32x16 O[2];
#pragma unroll
            for (int i = 0; i < 16; ++i) { O[0][i] = 0.f; O[1][i] = 0.f; }
            float m = 0.f, l = 0.f;
            const bf16_t* kbase = F.KV() + ((size_t)b * SEQ + (tid >> 3)) * D + 512 + g * 64 + (tid & 7) * 8;
            const bf16_t* vbase = F.VT() + ((size_t)(g * 64 + (tid >> 3))) * T + (size_t)b * SEQ + (tid & 7) * 8;
            const unsigned inner = need & ~(1u << qt);
            if (inner) { const SeqSel seq{inner, myselm}; attn_stream(lds, tid, r, h, seq, kbase, (size_t)64 * D, vbase, qf, O, m, l, bgc); }
            attn_tile_masked(lds, tid, r, h, kbase + (size_t)qt * 64 * D, vbase + 64 * qt, qf, O, m, l, -1, tl, bgc);
            l += __shfl_xor(l, 32);
            const float sc = l > 0.f ? gs / l : 0.f;
#pragma unroll
            for (int i = 0; i < 8; ++i) { const unsigned a = park[i * 64], c = park[(8 + i) * 64];
                park[i * 64] = pk2(bf_lo(a) + sc * O[0][2 * i], bf_hi(a) + sc * O[0][2 * i + 1]); park[(8 + i) * 64] = pk2(bf_lo(c) + sc * O[1][2 * i], bf_hi(c) + sc * O[1][2 * i + 1]); }
        }
#endif
#ifdef REPEAT_SWA
        { f32x16 O2[2]; float m2 = 0.f, l2 = 0.f;
#pragma unroll
          for (int i = 0; i < 16; ++i) { O2[0][i] = 0.f; O2[1][i] = 0.f; }
          const bf16_t* kbase = F.KV() + ((size_t)b * SEQ + (tid >> 3)) * D + 768 + g * 64 + (tid & 7) * 8;
          const bf16_t* vbase = F.VT() + ((size_t)(256 + g * 64 + (tid >> 3))) * T + (size_t)b * SEQ + (tid & 7) * 8;
          if (qt >= 8) attn_tile_masked(lds, tid, r, h, kbase + (size_t)(qt - 8) * 64 * D, vbase + 64 * (qt - 8), qf, O2, m2, l2, tl, 64, bgc);
          const int i0 = qt > 7 ? qt - 7 : 0;
          if (i0 <= qt - 1) { const SeqRange seq{i0, qt - 1}; attn_stream(lds, tid, r, h, seq, kbase, (size_t)64 * D, vbase, qf, O2, m2, l2, bgc); }
          attn_tile_masked(lds, tid, r, h, kbase + (size_t)qt * 64 * D, vbase + 64 * qt, qf, O2, m2, l2, -1, tl, bgc);
          asm volatile("" :: "v"(O2[0]), "v"(O2[1]), "v"(l2)); }
#endif
#ifndef NO_SWA
        {
            f32x16 O[2];
#pragma unroll
            for (int i = 0; i < 16; ++i) { O[0][i] = 0.f; O[1][i] = 0.f; }
            float m = 0.f, l = 0.f;
            const bf16_t* kbase = F.KV() + ((size_t)b * SEQ + (tid >> 3)) * D + 768 + g * 64 + (tid & 7) * 8;
            const bf16_t* vbase = F.VT() + ((size_t)(256 + g * 64 + (tid >> 3))) * T + (size_t)b * SEQ + (tid & 7) * 8;
            if (qt >= 8) attn_tile_masked(lds, tid, r, h, kbase + (size_t)(qt - 8) * 64 * D, vbase + 64 * (qt - 8), qf, O, m, l, tl, 64, bgc);
            const int i0 = qt > 7 ? qt - 7 : 0;
            if (i0 <= qt - 1) { const SeqRange seq{i0, qt - 1}; attn_stream(lds, tid, r, h, seq, kbase, (size_t)64 * D, vbase, qf, O, m, l, bgc); }
            attn_tile_masked(lds, tid, r, h, kbase + (size_t)qt * 64 * D, vbase + 64 * qt, qf, O, m, l, -1, tl, bgc);
            l += __shfl_xor(l, 32);
            const float sc = l > 0.f ? gw / l : 0.f;
#pragma unroll
            for (int i = 0; i < 8; ++i) { const unsigned a = park[i * 64], c = park[(8 + i) * 64];
                Ot[0][2 * i] = bf_lo(a) + sc * O[0][2 * i]; Ot[0][2 * i + 1] = bf_hi(a) + sc * O[0][2 * i + 1]; Ot[1][2 * i] = bf_lo(c) + sc * O[1][2 * i]; Ot[1][2 * i + 1] = bf_hi(c) + sc * O[1][2 * i + 1]; }
        }
#endif
        {
            bf16_t* op = F.O() + tokrow * D + head * 64 + 4 * h;
#pragma unroll
            for (int db = 0; db < 2; ++db)
#pragma unroll
                for (int q4 = 0; q4 < 4; ++q4) { u32x2 o; o.x = pk2(Ot[db][4 * q4], Ot[db][4 * q4 + 1]); o.y = pk2(Ot[db][4 * q4 + 2], Ot[db][4 * q4 + 3]); *(u32x2*)(op + db * 32 + 8 * q4) = o; }
        }
        __syncthreads();
    }
#ifdef PROBE_TAIL
    const int pt_rem = BG_PER_WAVE - bgc.cnt; const unsigned long long pt_t0 = __builtin_amdgcn_s_memrealtime();
#endif
    bg_flush(bgc, tid0 & 63);
    while (bgc.cnt < BG_PER_WAVE) { bg_issue(bgc, tid0 & 63); bg_finish(bgc, tid0 & 63); }
#ifdef PROBE_TAIL
    if (F.bx == PROBE_BLK && wave == 0) { const unsigned long long t1 = __builtin_amdgcn_s_memrealtime();
        const unsigned long long until = t1 + (PROBE_TAIL == 1 ? (unsigned long long)pt_rem * 10000ull : (t1 - pt_t0) * 100ull);
        while (__builtin_amdgcn_s_memrealtime() < until) __builtin_amdgcn_s_sleep(8); }
#endif
}

DI void swa_sink_phase(Frame& F) {
    LAS unsigned char* lds = F.lds;
    const int tid = F.tid, lane = F.lane, wave = F.wave, r = lane & 31, h = lane >> 5;
    const bf16_t* Qp = F.Q(); const bf16_t* Kp = F.KV(); const bf16_t* Vp = F.VT(); bf16_t* Op = F.O(); const float* sk = F.b_sinks();
    int ui = 0, q32 = F.vcu & 63, kvh = (F.vcu >> 6) & 1, b = F.vcu >> 7;
    int j1 = (32 * q32 + 31) >> 6, j = ((32 * q32 - 127) > 0 ? (32 * q32 - 127) : 0) >> 6;
    bf16x8 qf[4];
#pragma unroll
    for (int s = 0; s < 4; ++s) qf[s] = *(const bf16x8*)(Qp + ((size_t)b * SEQ + q32 * 32 + r) * D + (kvh * 8 + wave) * 64 + 16 * s + 8 * h);
    u32x4 kr = *(const u32x4*)(Kp + ((size_t)b * SEQ + 64 * j + (tid >> 3)) * 128 + kvh * 64 + (tid & 7) * 8);
    u32x4 vr = *(const u32x4*)(Vp + ((size_t)(kvh * 64 + (tid >> 3))) * T + (size_t)b * SEQ + 64 * j + (tid & 7) * 8);
    AT_WRITE_K(0, kr); AT_WRITE_V(0, vr);
    __syncthreads();
    f32x16 O[2];
#pragma unroll
    for (int i = 0; i < 16; ++i) { O[0][i] = 0.f; O[1][i] = 0.f; }
    const float skm0 = sk[wave] * LOG2E, skm1 = sk[8 + wave] * LOG2E;
    float m = kvh ? skm1 : skm0, l = (h == 0) ? 1.f : 0.f;
    int buf = 0;
    for (;;) {
        const bool last_tile = (j == j1);
        int nq32 = q32, nkvh = kvh, nb = b, nj = j + 1; bool has = true;
        if (last_tile) { has = (ui + 1) < 8;
            if (has) { const int u = (ui + 1) * GRID + F.vcu; nq32 = u & 63; nkvh = (u >> 6) & 1; nb = u >> 7; nj = ((32 * nq32 - 127) > 0 ? (32 * nq32 - 127) : 0) >> 6; } }
        bf16x8 qn[4];
        if (has) {
            kr = *(const u32x4*)(Kp + ((size_t)nb * SEQ + 64 * nj + (tid >> 3)) * 128 + nkvh * 64 + (tid & 7) * 8);
            vr = *(const u32x4*)(Vp + ((size_t)(nkvh * 64 + (tid >> 3))) * T + (size_t)nb * SEQ + 64 * nj + (tid & 7) * 8);
            if (last_tile) {
#pragma unroll
                for (int s = 0; s < 4; ++s) qn[s] = *(const bf16x8*)(Qp + ((size_t)nb * SEQ + nq32 * 32 + r) * D + (nkvh * 8 + wave) * 64 + 16 * s + 8 * h);
            }
        }
        {
            const int hi = q32 * 32 + r - 64 * j;
            f32x16 s0, s1;
            qk_tile(lds + AT_KT + buf * 9216, qf, s0, s1, r, h);
            unsigned w0, w1; make_mask(hi - 128, hi, h, w0, w1);
            float mx = tile_max<true>(s0, s1, w0, w1);
            mx = fmaxf(mx, __shfl_xor(mx, 32));
            if (__any(mx - m > AT_THR)) { const float mn = fmaxf(m, mx), alpha = ex2(m - mn); m = mn; l *= alpha; O[0] = O[0] * alpha; O[1] = O[1] * alpha; }
            u32x4 pb[2][2];
            l += tile_exp<true, true>(s0, s1, w0, w1, m, pb);
            pv_tile(lds + AT_VT + buf * 9216, pb, O, r, h);
        }
        if (has) { AT_WRITE_K(buf ^ 1, kr); AT_WRITE_V(buf ^ 1, vr); }
        __syncthreads();
        buf ^= 1;
        if (last_tile) {
            l += __shfl_xor(l, 32);
            const float sc = 1.f / l;
            bf16_t* op = Op + ((size_t)b * SEQ + q32 * 32 + r) * D + (kvh * 8 + wave) * 64 + 4 * h;
#pragma unroll
            for (int db = 0; db < 2; ++db)
#pragma unroll
                for (int q4 = 0; q4 < 4; ++q4) { u32x2 o; o.x = pk2(O[db][4 * q4] * sc, O[db][4 * q4 + 1] * sc); o.y = pk2(O[db][4 * q4 + 2] * sc, O[db][4 * q4 + 3] * sc); *(u32x2*)(op + db * 32 + 8 * q4) = o; }
            if (!has) break;
#pragma unroll
            for (int i = 0; i < 16; ++i) { O[0][i] = 0.f; O[1][i] = 0.f; }
#pragma unroll
            for (int s = 0; s < 4; ++s) qf[s] = qn[s];
            ++ui; q32 = nq32; kvh = nkvh; b = nb; j1 = (32 * q32 + 31) >> 6;
            m = kvh ? skm1 : skm0; l = (h == 0) ? 1.f : 0.f;
        }
        j = nj;
    }
}
#ifndef N_LAUNCHES
#define N_LAUNCHES 1
#endif
constexpr int N_PHASES = 17;
__global__ void __launch_bounds__(NTHR, 2) fwd_kernel(Args args) {
    extern __shared__ __attribute__((aligned(16))) unsigned char lds_raw[];
    LAS unsigned char* const lds = (LAS unsigned char*)lds_raw;
    const int wave0 = __builtin_amdgcn_readfirstlane((int)(threadIdx.x >> 6));
    for (int u = threadIdx.x; u < 256; u += NTHR) ((LAS unsigned*)(lds + MISC_OFF))[u] = 0u;
    __syncthreads();
#if N_LAUNCHES == 1
    { Frame F = make_frame(lds, wave0); (void)xcd_barrier_post(F.ctl() + CW_BAR, (volatile LAS unsigned*)(lds + MISC_OFF)); }
    if (threadIdx.x == 0) { Frame F = make_frame(lds, wave0); const unsigned x_ = xb_xcc_id();
        LAS unsigned* xa = (LAS unsigned*)(lds + XAFF_OFF); xa[0] = x_; xa[1] = __hip_atomic_fetch_add(F.ctl() + CW_XRANK + x_, 1u, __ATOMIC_RELAXED, __HIP_MEMORY_SCOPE_AGENT); }
#define IN(k) true
#define SEAM(k) do { Frame Fb = make_frame(lds, wave0); XcdBarrier _b; _b.bar = Fb.ctl() + CW_BAR; _b.x = xb_xcc_id(); _b.st = (volatile LAS unsigned*)(lds + MISC_OFF); xcd_barrier(_b); } while (0)
#else
#ifdef ONLY_PHASE
#define IN(k) ((k) == ONLY_PHASE && args.ph_lo <= (k) && (k) < args.ph_hi)
#else
#define IN(k) (args.ph_lo <= (k) && (k) < args.ph_hi)
#endif
#define SEAM(k) do { } while (0)
#endif
    const LAS unsigned* ext = (const LAS unsigned*)(lds + EXT_OFF);
#ifndef REPEAT_MASK
#define REPEAT_MASK 0
#endif
#define PH(k, ...) do { if (IN(k)) { __VA_ARGS__ } if ((((REPEAT_MASK) >> (k)) & 1) && IN(k)) { __VA_ARGS__ } } while (0)

    PH(0, Frame F = make_frame(lds, wave0); p0_prologue(F);); SEAM(0);
#if N_LAUNCHES == 1
    {
        if (threadIdx.x == 0) { Frame F = make_frame(lds, wave0); bool ok = true;
            for (int x_ = 0; x_ < 8; ++x_) ok = ok && (__hip_atomic_load(F.ctl() + CW_XRANK + x_, __ATOMIC_RELAXED, __HIP_MEMORY_SCOPE_AGENT) == (unsigned)(GRID / 8));
            LAS unsigned* xa = (LAS unsigned*)(lds + XAFF_OFF); xa[2] = ok ? 1u : 0u; xa[3] = ((ok ? 1u : 0u) << 16) | (xa[0] << 8) | xa[1]; }
        __syncthreads();
    }
#endif
#define XAFF(i_) __builtin_amdgcn_readfirstlane((int)((const LAS unsigned*)(lds + XAFF_OFF))[i_])
    PH(1, Frame F = make_frame(lds, wave0); norm_plain_phase(F);); SEAM(1);
#ifdef PROBE_SEAMS
    for (int q_ = 0; q_ < PROBE_SEAMS; ++q_) { SEAM(1); }
#endif
    PH(2, Frame F = make_frame(lds, wave0); PolProj0 P{F.HN(), F.WINT(), F.Q(), F.KV(), F.VT(), F.GATES(), F.ROPE(), F.vcu, lds}; pg8::gemm_phase(lds, P, F.wave, F.lane);); SEAM(2);
    PH(3, Frame F = make_frame(lds, wave0); compress_phase(F);); SEAM(3);
    PH(4, Frame F = make_frame(lds, wave0); nsa_attn_phase(F);); SEAM(4);
#ifdef PROBE_OUT
    { Frame F = make_frame(lds, wave0); NoEpi<PolOut> P{{F.O(), F.WAOT(), F.x(), F.MODV(), nullptr, F.H(), F.vcu}};
      for (int rep = 0; rep < PROBE_OUT; ++rep) pg8::gemm_phase(lds, P, F.wave, F.lane); }
#endif
    PH(5, Frame F = make_frame(lds, wave0); PolOut P{F.O(), F.WAOT(), F.x(), F.MODV() + (size_t)0 * 16 * 3072, nullptr, F.H(), F.vcu}; pg8::gemm_phase(lds, P, F.wave, F.lane);); SEAM(5);
    PH(6, Frame F = make_frame(lds, wave0); norm_router_phase(F, 0);); SEAM(6);
#ifdef PROBE_GU_NOEPI
    { Frame F = make_frame(lds, wave0); load_expert_tables(F, 0, 8); PolGateUpT<true> P{F.HN(), F.WGUT(), F.b_gate_up(), F.LIST(), F.ACT(), ext, F.vcu, lds, F.ctl() + CW_PANEL, XAFF(3)}; pg8::gemm_phase(lds, P, F.wave, F.lane); }
#endif
#ifdef PROBE_CLOCK
    unsigned long long pc_t0 = __builtin_amdgcn_s_memtime(), pc_r0 = __builtin_amdgcn_s_memrealtime();
#endif
    PH(7, Frame F = make_frame(lds, wave0); load_expert_tables(F, 0, 8); PolGateUp P{F.HN(), F.WGUT(), F.b_gate_up(), F.LIST(), F.ACT(), ext, F.vcu, lds, F.ctl() + CW_PANEL, XAFF(3)}; pg8::gemm_phase(lds, P, F.wave, F.lane););
#ifdef PROBE_CLOCK
    {
        const unsigned long long t1 = __builtin_amdgcn_s_memtime(), r1 = __builtin_amdgcn_s_memrealtime();
        if (blockIdx.x == 0) { const unsigned long long f = (t1 - pc_t0) / (r1 - pc_r0);
            const unsigned long long until = r1 + f * 1000ull;
            while (__builtin_amdgcn_s_memrealtime() < until) __builtin_amdgcn_s_sleep(8); }
    }
#endif
    if (!XAFF(2)) SEAM(7);
#ifdef PROBE_DN
    { Frame F = make_frame(lds, wave0); load_expert_tables(F, 0, 4); PolDownT<(PROBE_DN == 1)> P{F.ACT(), F.WDNT(), F.b_down(), F.LISTW(), F.OUTB(), ext, F.vcu, lds, F.ctl() + CW_PANEL, F.wave, 0}; pg8::gemm_phase(lds, P, F.wave, F.lane); }
#endif
    PH(8, Frame F = make_frame(lds, wave0); load_expert_tables(F, 0, 4); PolDown P{F.ACT(), F.WDNT(), F.b_down(), F.LISTW(), F.OUTB(), ext, F.vcu, lds, F.ctl() + CW_PANEL, F.wave, XAFF(3)}; pg8::gemm_phase(lds, P, F.wave, F.lane);); SEAM(8);
    PH(9, Frame F = make_frame(lds, wave0); combine_phase<false>(F, 0);); SEAM(9);
    PH(10, Frame F = make_frame(lds, wave0); { PolProj1T<0> P{F.wsp(), F.b_b_q(), F.kv_b(), F.vcu, lds}; pg8::gemm_phase(lds, P, F.wave, F.lane); } { Frame G = make_frame(lds, wave0); PolProj1T<1> P{G.wsp(), G.b_b_q(), G.kv_b(), G.vcu, lds}; pg8::gemm_phase(lds, P, G.wave, G.lane); }); SEAM(10);
    PH(11, Frame F = make_frame(lds, wave0); swa_sink_phase(F);); SEAM(11);
    PH(12, Frame F = make_frame(lds, wave0); PolOut P{F.O(), F.WBOT(), F.H(), F.MODV() + (size_t)2 * 16 * 3072, F.b_b_out(), F.H(), F.vcu}; pg8::gemm_phase(lds, P, F.wave, F.lane);); SEAM(12);
    PH(13, Frame F = make_frame(lds, wave0); norm_router_phase(F, 1);); SEAM(13);
    PH(14, Frame F = make_frame(lds, wave0); load_expert_tables(F, 1, 8); PolGateUp P{F.HN(), F.WGUT() + (size_t)32 * 2048 * D, F.b_gate_up() + 32 * 2048, F.LIST(), F.ACT(), ext, F.vcu, lds, F.ctl() + CW_PANEL + 1024, XAFF(3)}; pg8::gemm_phase(lds, P, F.wave, F.lane);); if (!XAFF(2)) SEAM(14);
    PH(15, Frame F = make_frame(lds, wave0); load_expert_tables(F, 1, 4); PolDown P{F.ACT(), F.WDNT() + (size_t)32 * D * D, F.b_down() + 32 * 1024, F.LISTW(), F.OUTB(), ext, F.vcu, lds, F.ctl() + CW_PANEL + 1024, F.wave, XAFF(3)}; pg8::gemm_phase(lds, P, F.wave, F.lane);); SEAM(15);
    PH(16, Frame F = make_frame(lds, wave0); combine_phase<true>(F, 1););
#undef IN
#undef SEAM
}

extern "C" void kernel_launch(void* const* d_in, const int* in_sizes, int n_in, void* d_out, int out_size, void* d_ws, size_t ws_size, hipStream_t stream) {
    static int ready = 0;
    if (ready == 0) {
        if (n_in != 28 || out_size != T * D || ws_size < WS_END) { fprintf(stderr, "kernel_launch: unexpected shapes (n_in %d out %d ws %zu)\n", n_in, out_size, ws_size); ready = -1; return; }
        int dev = 0, cus = 0, per_cu = 0;
        if (hipGetDevice(&dev) != hipSuccess || hipDeviceGetAttribute(&cus, hipDeviceAttributeMultiprocessorCount, dev) != hipSuccess) { ready = -1; return; }
        if (hipFuncSetAttribute((const void*)fwd_kernel, hipFuncAttributeMaxDynamicSharedMemorySize, LDS_BYTES) != hipSuccess) { fprintf(stderr, "kernel_launch: hipFuncSetAttribute failed\n"); ready = -1; return; }
        if (hipOccupancyMaxActiveBlocksPerMultiprocessor(&per_cu, (const void*)fwd_kernel, NTHR, LDS_BYTES) != hipSuccess || per_cu < 1) fprintf(stderr, "kernel_launch: occupancy query reports %d\n", per_cu);
        (void)hipGetLastError();
        if (cus < GRID) { fprintf(stderr, "kernel_launch: needs %d CUs, device has %d\n", GRID, cus); ready = -1; return; }
        ready = 1;
    }
    if (ready < 0) return;
    (void)hipMemsetAsync((char*)d_ws + WS_CTL, 0, CTL_ZERO_BYTES, stream);
    Args a{};
    for (int i = 0; i < 28; ++i) a.in[i] = d_in[i];
    a.out = (float*)d_out; a.ws = (unsigned char*)d_ws;
    if (N_LAUNCHES == 1) {
        a.ph_lo = 0; a.ph_hi = N_PHASES;
        hipLaunchKernelGGL(fwd_kernel, dim3(GRID), dim3(NTHR), LDS_BYTES, stream, a);
    } else {
        for (int p = 0; p < N_PHASES; ++p) { a.ph_lo = p; a.ph_hi = p + 1; hipLaunchKernelGGL(fwd_kernel, dim3(GRID), dim3(NTHR), LDS_BYTES, stream, a); }
    }
}
```

```cpp
#include <hip/hip_runtime.h>
#include <cstdio>
#include <cstdint>

#define DI __device__ __forceinline__
#define LAS __attribute__((address_space(3)))
#define GAS __attribute__((address_space(1)))
typedef unsigned short bf16_t;
typedef short bf16x8 __attribute__((ext_vector_type(8)));
typedef short s16x4 __attribute__((ext_vector_type(4)));
typedef float f32x2 __attribute__((ext_vector_type(2)));
typedef float f32x4 __attribute__((ext_vector_type(4)));
typedef float f32x16 __attribute__((ext_vector_type(16)));
typedef unsigned u32x4 __attribute__((ext_vector_type(4)));
typedef unsigned u32x2 __attribute__((ext_vector_type(2)));

constexpr int NB = 16, SEQ = 2048, T = NB * SEQ, D = 1024, HD = 64;
constexpr int NEXP = 32, TOPK = 4;
constexpr int A_PROJ = 2608;
constexpr float NORM_EPS = 1e-5f;
constexpr float QSCALE = 0.125f * 1.4426950408889634f;
constexpr float LOG2E = 1.4426950408889634f;
constexpr int NWAVES = 8, NTHR = 512, GRID = 256;
constexpr int MODN = 4 * 16 * 3072 + 16 * 2048;

constexpr size_t MiB = (size_t)1 << 20;
constexpr size_t WS_CTL = 0, CTL_ZERO_BYTES = 40 * 1024;
constexpr size_t WS_MODV = 1 * MiB;
constexpr size_t WS_ROPE = 2 * MiB;
constexpr size_t WS_CMPB = 4 * MiB;
constexpr size_t WS_CW1T = 5 * MiB;
constexpr size_t WS_CW2T = 6 * MiB;
constexpr size_t WS_WINT = 7 * MiB;
constexpr size_t WS_WAOT = 13 * MiB;
constexpr size_t WS_WBQT = 15 * MiB;
constexpr size_t WS_WBOT = 17 * MiB;
constexpr size_t WS_WKVT = 19 * MiB;
constexpr size_t WS_KC = 20 * MiB;
constexpr size_t WS_VCT = 21 * MiB;
constexpr size_t WS_TOKSLOT = 22 * MiB;
constexpr size_t WS_GATES = 24 * MiB;
constexpr size_t WS_LIST = 32 * MiB;
constexpr size_t WS_LISTW = 36 * MiB;
constexpr size_t WS_VT = 40 * MiB;
constexpr size_t WS_WGUT = 72 * MiB;
constexpr size_t WS_WDNT = 328 * MiB;
constexpr size_t WS_H = 456 * MiB;
constexpr size_t WS_HN = 584 * MiB;
constexpr size_t WS_HN2 = 648 * MiB;
constexpr size_t WS_Q = 712 * MiB;
constexpr size_t WS_KV = 776 * MiB;
constexpr size_t WS_O = 840 * MiB;
constexpr size_t WS_ACT = 904 * MiB;
constexpr size_t WS_OUTB = 1161 * MiB;
constexpr size_t WS_MODP = 1417 * MiB;
constexpr size_t WS_DUMMY = 1425 * MiB;
constexpr size_t WS_END = 1428 * MiB;
constexpr int CW_BAR = 1024;
constexpr int CW_CNT = 8192;

constexpr int LDS_BYTES = 163840;
constexpr int MISC_OFF = LDS_BYTES - 1024;
constexpr int EXT_OFF = MISC_OFF + 64;

DI unsigned pk2(float lo, float hi) {
    typedef __bf16 bf2 __attribute__((ext_vector_type(2)));
    f32x2 v = {lo, hi}; bf2 b = __builtin_convertvector(v, bf2); return __builtin_bit_cast(unsigned, b);
}
DI float bf_lo(unsigned u) { return __uint_as_float(u << 16); }
DI float bf_hi(unsigned u) { return __uint_as_float(u & 0xffff0000u); }
DI float ex2(float x) { return __builtin_amdgcn_exp2f(x); }
DI float rcpf(float x) { return __builtin_amdgcn_rcpf(x); }
DI void halves32(unsigned x, unsigned& lo, unsigned& hi) { const auto r = __builtin_amdgcn_permlane32_swap(x, x, false, false); lo = r[0]; hi = r[1]; }
DI void halves32(float x, float& lo, float& hi) { unsigned a, b; halves32(__float_as_uint(x), a, b); lo = __uint_as_float(a); hi = __uint_as_float(b); }
DI float max_xor32(float x) { float a, b; halves32(x, a, b); return fmaxf(a, b); }
DI float sum_xor32(float x) { float a, b; halves32(x, a, b); return a + b; }
template <int O> DI unsigned shx_u(unsigned x, int lane) {
    if constexpr (O == 32) { unsigned a, b; halves32(x, a, b); return (lane & 32) ? a : b; }
    else return (unsigned)__builtin_amdgcn_ds_swizzle((int)x, (O << 10) | 0x1f);
}
template <int O> DI float shx(float x, int lane) { return __uint_as_float(shx_u<O>(__float_as_uint(x), lane)); }
DI float wave_sum(float v) {
    v += shx<1>(v, 0); v += shx<2>(v, 0); v += shx<4>(v, 0); v += shx<8>(v, 0); v += shx<16>(v, 0);
    return sum_xor32(v);
}
DI int crow(int reg, int h) { return (reg & 3) + 8 * (reg >> 2) + 4 * h; }
#define MFMA32(a, b, c) __builtin_amdgcn_mfma_f32_32x32x16_bf16((a), (b), (c), 0, 0, 0)
#define LDS_WAIT() asm volatile("s_waitcnt lgkmcnt(0)" ::: "memory")
#define VM_WAIT() asm volatile("s_waitcnt vmcnt(0)" ::: "memory")

#define XB_TMO      128
#define XB_XCNT(j)  (256  + 64 * (j))
#define XB_XSUB(j)  (1280 + 64 * (j))
#define XB_XGEN(j)  (2304 + 64 * (j))
#define XB_TOP      3328
#define XB_TOPGEN   3392
#define XCD_BAR_WORDS 3456
#define XB_SPIN_CAP (1u << 21)

DI unsigned xb_ld(unsigned* p)              { return __hip_atomic_load(p, __ATOMIC_RELAXED, __HIP_MEMORY_SCOPE_AGENT); }
DI unsigned xb_add(unsigned* p, unsigned v) { return __hip_atomic_fetch_add(p, v, __ATOMIC_RELAXED, __HIP_MEMORY_SCOPE_AGENT); }
DI unsigned xb_xcc_id() { return (unsigned)__builtin_amdgcn_s_getreg((3 << 11) | 20) & 0xFu; }
#define XB_SPIN(cond, bar) do { unsigned _sp = 0; while (cond) { __builtin_amdgcn_s_sleep(1); \
    if ((++_sp & 255u) == 0u) { if (xb_ld(&(bar)[XB_TMO])) break; if (_sp > XB_SPIN_CAP) { atomicAdd(&(bar)[XB_TMO], 1u); break; } } } } while (0)

struct XcdBarrier { unsigned* bar; unsigned x; volatile LAS unsigned* st; };

DI XcdBarrier xcd_barrier_post(unsigned* bar, volatile LAS unsigned* st) {
    XcdBarrier b; b.bar = bar; b.x = xb_xcc_id(); b.st = st;
    if (threadIdx.x == 0) (void)xb_add(&bar[XB_XCNT(b.x)], 1u);
    return b;
}
DI void xcd_barrier_complete(unsigned* bar, unsigned x, unsigned& nloc, unsigned& nx) {
    const unsigned G = gridDim.x * gridDim.y * gridDim.z;
    unsigned sum, cnt, mine, sp = 0u;
    for (;;) {
        sum = 0u; cnt = 0u; mine = 0u;
#pragma unroll
        for (unsigned j = 0; j < 16; ++j) { const unsigned c = xb_ld(&bar[XB_XCNT(j)]); sum += c; cnt += (c > 0u) ? 1u : 0u; mine = (j == x) ? c : mine; }
        if (sum == G) break;
        __builtin_amdgcn_s_sleep(1);
        if ((++sp & 255u) == 0u) { if (xb_ld(&bar[XB_TMO])) break; if (sp > XB_SPIN_CAP) { atomicAdd(&bar[XB_TMO], 1u); break; } }
    }
    nloc = mine > 0u ? mine : 1u; nx = cnt > 0u ? cnt : 1u;
}
DI void xcd_barrier(const XcdBarrier& b) {
    asm volatile("s_waitcnt vmcnt(0)" ::: "memory");
    __syncthreads();
    if (threadIdx.x == 0) {
        unsigned* bar = b.bar;
        __builtin_amdgcn_s_waitcnt(0);
        unsigned nloc = b.st[0], nx = b.st[1];
        if (nloc == 0u) { xcd_barrier_complete(bar, b.x, nloc, nx); b.st[0] = nloc; b.st[1] = nx; }
        const unsigned old = xb_add(&bar[XB_XSUB(b.x)], 1u);
        const unsigned gen = old / nloc;
        if (old + 1u == (gen + 1u) * nloc) {
            __builtin_amdgcn_fence(__ATOMIC_RELEASE, "agent");
            asm volatile("s_waitcnt vmcnt(0)" ::: "memory");
            const unsigned og = xb_add(&bar[XB_TOP], 1u);
            const unsigned tg = og / nx;
            if (og + 1u == (tg + 1u) * nx) xb_add(&bar[XB_TOPGEN], 1u);
            else XB_SPIN(xb_ld(&bar[XB_TOPGEN]) == tg, bar);
            __builtin_amdgcn_fence(__ATOMIC_ACQUIRE, "agent");
            xb_add(&bar[XB_XGEN(b.x)], 1u);
            asm volatile("s_waitcnt vmcnt(0)" ::: "memory");
        } else {
            XB_SPIN(xb_ld(&bar[XB_XGEN(b.x)]) == gen, bar);
            __builtin_amdgcn_fence(__ATOMIC_ACQUIRE, "agent");
            asm volatile("s_waitcnt vmcnt(0)" ::: "memory");
        }
    }
    __syncthreads();
}

struct Args { const void* in[28]; float* out; unsigned char* ws; int ph_lo, ph_hi; };

typedef const __attribute__((address_space(4))) unsigned char* KPtr;
struct Frame {
    LAS unsigned char* lds; KPtr kp; int tid, lane, wave, vcu, bx;
    DI void* arg(int i) const { return *(void* const __attribute__((address_space(4)))*)(kp + 8 * i); }
    DI unsigned char* wsp() const { return (unsigned char*)arg(29); }
    DI unsigned* ctl() const { return (unsigned*)(wsp() + WS_CTL); }
    DI float* out() const { return (float*)arg(28); }
    DI const float* x() const { return (const float*)arg(0); }
    DI const float* c() const { return (const float*)arg(1); }
    DI const int* positions() const { return (const int*)arg(2); }
    DI const float* mod_w() const { return (const float*)arg(3); }
    DI const float* mod_b() const { return (const float*)arg(4); }
    DI const float* norm_g() const { return (const float*)arg(5); }
    DI const float* final_g() const { return (const float*)arg(6); }
    DI const float* a_w_in() const { return (const float*)arg(7); }
    DI const float* cmp_pe() const { return (const float*)arg(8); }
    DI const float* cmp_w1() const { return (const float*)arg(9); }
    DI const float* cmp_w2() const { return (const float*)arg(10); }
    DI const float* a_w_out() const { return (const float*)arg(11); }
    DI const float* kv_norm_g() const { return (const float*)arg(12); }
    DI const float* kv_mod_w() const { return (const float*)arg(13); }
    DI const float* kv_mod_b() const { return (const float*)arg(14); }
    DI const float* kv_w() const { return (const float*)arg(15); }
    DI const float* kv_b() const { return (const float*)arg(16); }
    DI const float* b_w_q() const { return (const float*)arg(17); }
    DI const float* b_b_q() const { return (const float*)arg(18); }
    DI const float* b_sinks() const { return (const float*)arg(19); }
    DI const float* b_w_out() const { return (const float*)arg(20); }
    DI const float* b_b_out() const { return (const float*)arg(21); }
    DI const float* router_w() const { return (const float*)arg(22); }
    DI const float* router_b() const { return (const float*)arg(23); }
    DI const float* w_gate_up() const { return (const float*)arg(24); }
    DI const float* b_gate_up() const { return (const float*)arg(25); }
    DI const float* w_down() const { return (const float*)arg(26); }
    DI const float* b_down() const { return (const float*)arg(27); }
    DI float* MODV() const { return (float*)(wsp() + WS_MODV); }
    DI float* MODP() const { return (float*)(wsp() + WS_MODP); }
    DI float* ROPE() const { return (float*)(wsp() + WS_ROPE); }
    DI float* CMPB() const { return (float*)(wsp() + WS_CMPB); }
    DI float* GATES() const { return (float*)(wsp() + WS_GATES); }
    DI float* LISTW() const { return (float*)(wsp() + WS_LISTW); }
    DI float* H() const { return (float*)(wsp() + WS_H); }
    DI bf16_t* Hb() const { return (bf16_t*)(wsp() + WS_H); }
    DI bf16_t* CW1T() const { return (bf16_t*)(wsp() + WS_CW1T); }
    DI bf16_t* CW2T() const { return (bf16_t*)(wsp() + WS_CW2T); }
    DI bf16_t* WINT() const { return (bf16_t*)(wsp() + WS_WINT); }
    DI bf16_t* WAOT() const { return (bf16_t*)(wsp() + WS_WAOT); }
    DI bf16_t* WBQT() const { return (bf16_t*)(wsp() + WS_WBQT); }
    DI bf16_t* WBOT() const { return (bf16_t*)(wsp() + WS_WBOT); }
    DI bf16_t* WKVT() const { return (bf16_t*)(wsp() + WS_WKVT); }
    DI bf16_t* KC() const { return (bf16_t*)(wsp() + WS_KC); }
    DI bf16_t* VCT() const { return (bf16_t*)(wsp() + WS_VCT); }
    DI bf16_t* VT() const { return (bf16_t*)(wsp() + WS_VT); }
    DI bf16_t* WGUT() const { return (bf16_t*)(wsp() + WS_WGUT); }
    DI bf16_t* WDNT() const { return (bf16_t*)(wsp() + WS_WDNT); }
    DI bf16_t* HN() const { return (bf16_t*)(wsp() + WS_HN); }
    DI bf16_t* HN2() const { return (bf16_t*)(wsp() + WS_HN2); }
    DI bf16_t* Q() const { return (bf16_t*)(wsp() + WS_Q); }
    DI bf16_t* KV() const { return (bf16_t*)(wsp() + WS_KV); }
    DI bf16_t* O() const { return (bf16_t*)(wsp() + WS_O); }
    DI bf16_t* ACT() const { return (bf16_t*)(wsp() + WS_ACT); }
    DI bf16_t* OUTB() const { return (bf16_t*)(wsp() + WS_OUTB); }
    DI unsigned* TOKSLOT() const { return (unsigned*)(wsp() + WS_TOKSLOT); }
    DI unsigned* LIST() const { return (unsigned*)(wsp() + WS_LIST); }
};
DI int vcu_of(int bx) { return (bx & 7) * (GRID / 8) + (bx >> 3); }
DI int fresh_lane() { int l; asm volatile("v_mbcnt_lo_u32_b32 %0, -1, 0\n\tv_mbcnt_hi_u32_b32 %0, -1, %0" : "=&v"(l)); return l; }
DI Frame make_frame(LAS unsigned char* lds, int wave_sgpr) {
    Frame F; F.lds = lds;
    KPtr kp = (KPtr)__builtin_amdgcn_kernarg_segment_ptr(); asm volatile("" : "+s"(kp)); F.kp = kp;
    int wv = wave_sgpr; asm volatile("" : "+s"(wv)); F.wave = wv; F.lane = fresh_lane(); F.tid = wv * 64 + F.lane;
    int bx = (int)blockIdx.x; asm volatile("" : "+s"(bx)); F.bx = bx; F.vcu = vcu_of(bx);
    return F;
}
DI void transpose_item(const float* W, int ld, int K, bf16_t* WT, int drow0, int k0, int n0, LAS float* scr, int lane) {
    f32x4 v[16];
    const float* src = W + (size_t)(k0 + (lane >> 4)) * ld + n0 + 4 * (lane & 15);
#pragma unroll
    for (int i = 0; i < 16; ++i) v[i] = __builtin_nontemporal_load((const f32x4*)(src + (size_t)(4 * i) * ld));
    LAS float* wp = scr + (lane >> 4) * 65 + 4 * (lane & 15);
#pragma unroll
    for (int i = 0; i < 16; ++i) { LAS float* q = wp + (4 * i) * 65; q[0] = v[i].x; q[1] = v[i].y; q[2] = v[i].z; q[3] = v[i].w; }
    LDS_WAIT(); asm volatile("" ::: "memory");
    const int c = lane & 7;
#pragma unroll
    for (int j = 0; j < 8; ++j) { const int n = (lane >> 3) + 8 * j; const LAS float* s = scr + (8 * c) * 65 + n;
        u32x4 o; o.x = pk2(s[0 * 65], s[1 * 65]); o.y = pk2(s[2 * 65], s[3 * 65]); o.z = pk2(s[4 * 65], s[5 * 65]); o.w = pk2(s[6 * 65], s[7 * 65]);
        __builtin_nontemporal_store(o, (u32x4*)(WT + (size_t)(drow0 + n) * K + k0 + 8 * c)); }
    LDS_WAIT(); asm volatile("" ::: "memory");
}

DI void p0_prologue(Frame& F) {
    const int gw = F.bx * NWAVES + F.wave, NGW = GRID * NWAVES, lane = F.lane;
    const int gtid = F.bx * NTHR + F.tid, NGT = GRID * NTHR;
    LAS float* cact = (LAS float*)(F.lds + 73728);
#pragma unroll 1
    for (int i0 = 0; i0 < (NB * D) / NTHR; i0 += 16) {
        float cv[16];
#pragma unroll
        for (int i = 0; i < 16; ++i) cv[i] = F.c()[F.tid + (i0 + i) * NTHR];
#pragma unroll
        for (int i = 0; i < 16; ++i) { const int idx = F.tid + (i0 + i) * NTHR, b = idx / D, k = idx % D; const float v = cv[i]; cact[k * 16 + b] = v / (1.f + __expf(-v)); }
    }
    __syncthreads();
    if (gw < 1792) {
        const int seg = gw / 224, it = gw % 224; const float* W; float* outp; int ld; int chunk;
        if (it < 192) { const int set = it / 48; chunk = it % 48; W = F.mod_w() + (size_t)set * D * 3072; ld = 3072; outp = F.MODP() + (size_t)seg * MODN + (size_t)set * 16 * 3072; }
        else { chunk = it - 192; W = F.kv_mod_w(); ld = 2048; outp = F.MODP() + (size_t)seg * MODN + (size_t)4 * 16 * 3072; }
        const int col = chunk * 64 + lane;
        float acc[16];
#pragma unroll
        for (int b = 0; b < 16; ++b) acc[b] = 0.f;
#pragma unroll 8
        for (int kk = 0; kk < 128; ++kk) {
            const int k = seg * 128 + kk;
            const float w = W[(size_t)k * ld + col];
            const LAS f32x4* cp = (const LAS f32x4*)(cact + k * 16);
            const f32x4 c0 = cp[0], c1 = cp[1], c2 = cp[2], c3 = cp[3];
            acc[0] += c0.x * w; acc[1] += c0.y * w; acc[2] += c0.z * w; acc[3] += c0.w * w;
            acc[4] += c1.x * w; acc[5] += c1.y * w; acc[6] += c1.z * w; acc[7] += c1.w * w;
            acc[8] += c2.x * w; acc[9] += c2.y * w; acc[10] += c2.z * w; acc[11] += c2.w * w;
            acc[12] += c3.x * w; acc[13] += c3.y * w; acc[14] += c3.z * w; acc[15] += c3.w * w;
        }
#pragma unroll
        for (int b = 0; b < 16; ++b) outp[(size_t)b * ld + col] = acc[b];
    }
    if (gw < 256) {
        const int kv = gw / 128, e = gw % 128; float s = 0.f;
        for (int j = 0; j < 32; ++j) { const int k = lane + 64 * j; s += F.cmp_pe()[kv * 2048 + k] * F.cmp_w1()[((size_t)kv * 2048 + k) * 128 + e]; }
        s = wave_sum(s);
        if (lane == 0) F.CMPB()[gw] = s;
    }
    for (int idx = gtid; idx < T * 8; idx += NGT) {
        const int tok = idx >> 3, i = idx & 7;
        const float inv = (float)pow(500000.0, -(double)(2 * i) / 16.0);
        const float ang = (float)F.positions()[tok] * inv;
        double a = (double)ang; const double twopi = 6.283185307179586476925286766559;
        a -= twopi * rint(a / twopi);
        const float ar = (float)a;
        F.ROPE()[(size_t)tok * 16 + i] = cosf(ar); F.ROPE()[(size_t)tok * 16 + 8 + i] = sinf(ar);
    }
    for (int idx = gtid; idx < 256 * D; idx += NGT) {
        const int row = idx / D, k = idx % D;
        const float v = row < 48 ? F.a_w_in()[(size_t)k * A_PROJ + 2560 + row] : 0.f;
        F.WINT()[(size_t)(2048 + row) * D + k] = (bf16_t)(pk2(v, 0.f) & 0xffffu);
    }
#ifdef PROBE_COPY
    {
        const f32x4* src = (const f32x4*)F.w_gate_up(); u32x4* dst = (u32x4*)F.ACT();
        const size_t n8 = (size_t)2 * 32 * D * 2048 / 8 + (size_t)2 * 32 * D * D / 8;
        const size_t n8a = (size_t)2 * 32 * D * 2048 / 8;
        const f32x4* src2 = (const f32x4*)F.w_down();
        for (size_t i = (size_t)gtid; i < n8; i += (size_t)NGT * 4) {
#pragma unroll
            for (int u = 0; u < 4; ++u) { const size_t k = i + (size_t)u * NGT; if (k < n8) {
                const f32x4* s = k < n8a ? src + 2 * k : src2 + 2 * (k - n8a);
                const f32x4 a = __builtin_nontemporal_load(s), b = __builtin_nontemporal_load(s + 1);
                u32x4 o; o.x = pk2(a.x, a.y); o.y = pk2(a.z, a.w); o.z = pk2(b.x, b.y); o.w = pk2(b.z, b.w);
                __builtin_nontemporal_store(o, dst + k); } }
        }
    }
#endif
    __syncthreads();
    LAS float* scr = (LAS float*)(F.lds + F.wave * 16640);
#ifdef CONV_IN_P0
    constexpr int J0 = 32768, J1 = 16384;
#else
    constexpr int J0 = 0, J1 = 0;
#endif
    constexpr int J2 = 640, J3 = 256, J6 = 64, J7 = 128, J8 = 4;
    constexpr int NITEMS = J0 + J1 + J2 + 3 * J3 + J6 + J7 + J8;
    for (int it = gw; it < NITEMS; it += NGW) {
        int r = it;
#ifdef CONV_IN_P0
        if (r < J0) { const int mat = r >> 9, q = r & 511, kb = q >> 5, nb = q & 31;
            transpose_item(F.w_gate_up() + (size_t)mat * D * 2048, 2048, D, F.WGUT() + (size_t)mat * 2048 * D, 64 * nb, 64 * kb, 64 * nb, scr, lane); continue; }
        r -= J0;
        if (r < J1) { const int mat = r >> 8, q = r & 255, kb = q >> 4, nb = q & 15;
            transpose_item(F.w_down() + (size_t)mat * D * D, D, D, F.WDNT() + (size_t)mat * D * D, 64 * nb, 64 * kb, 64 * nb, scr, lane); continue; }
        r -= J1;
#endif
        if (r < J2) { const int kb = r / 40, nb = r % 40, n0 = 64 * nb;
            const int dr = n0 < 1792 ? n0 : (n0 < 2048 ? 2304 + (n0 - 1792) : (n0 < 2304 ? 1792 + (n0 - 2048) : 2560 + (n0 - 2304)));
            transpose_item(F.a_w_in(), A_PROJ, D, F.WINT(), dr, 64 * kb, n0, scr, lane); continue; }
        r -= J2;
        if (r < J3) { const int kb = r >> 4, nb = r & 15; transpose_item(F.a_w_out(), D, D, F.WAOT(), 64 * nb, 64 * kb, 64 * nb, scr, lane); continue; }
        r -= J3;
        if (r < J3) { const int kb = r >> 4, nb = r & 15; transpose_item(F.b_w_q(), D, D, F.WBQT(), 64 * nb, 64 * kb, 64 * nb, scr, lane); continue; }
        r -= J3;
        if (r < J3) { const int kb = r >> 4, nb = r & 15; transpose_item(F.b_w_out(), D, D, F.WBOT(), 64 * nb, 64 * kb, 64 * nb, scr, lane); continue; }
        r -= J3;
        if (r < J6) { const int kb = r >> 2, nb = r & 3; transpose_item(F.kv_w(), 256, D, F.WKVT(), 64 * nb, 64 * kb, 64 * nb, scr, lane); continue; }
        r -= J6;
        if (r < J7) { const int kv = r >> 6, q = r & 63, kb = q >> 1, nb = q & 1;
            transpose_item(F.cmp_w1() + (size_t)kv * 2048 * 128, 128, 2048, F.CW1T() + (size_t)kv * 128 * 2048, 64 * nb, 64 * kb, 64 * nb, scr, lane); continue; }
        r -= J7;
        { const int kv = r >> 1, kb = r & 1;
            transpose_item(F.cmp_w2() + (size_t)kv * 128 * 64, 64, 128, F.CW2T() + (size_t)kv * 64 * 128, 0, 64 * kb, 0, scr, lane); }
    }
}

DI void load_mod(const float* g, const float* scale, const float* shift, int lane, f32x4 (&A)[4], f32x4 (&Bv)[4]) {
#pragma unroll
    for (int j = 0; j < 4; ++j) { const int c = 4 * lane + 256 * j;
        const f32x4 gg = *(const f32x4*)(g + c), sc = *(const f32x4*)(scale + c), sh = *(const f32x4*)(shift + c);
        A[j] = gg * (sc + 1.f); Bv[j] = sh; }
}
DI float row_ss(const f32x4 (&v)[4]) {
    float s = 0.f;
#pragma unroll
    for (int j = 0; j < 4; ++j) s += (v[j].x * v[j].x + v[j].y * v[j].y) + (v[j].z * v[j].z + v[j].w * v[j].w);
    return wave_sum(s);
}
DI void store_bf16_row(bf16_t* dst, int lane, const f32x4 (&y)[4]) {
#pragma unroll
    for (int j = 0; j < 4; ++j) { u32x2 o; o.x = pk2(y[j].x, y[j].y); o.y = pk2(y[j].z, y[j].w); *(u32x2*)(dst + 4 * lane + 256 * j) = o; }
}

DI f32x4 modsum(const float* modp, size_t flat, const float* bias4) {
    f32x4 s = *(const f32x4*)bias4, p[8];
#pragma unroll
    for (int seg = 0; seg < 8; ++seg) p[seg] = *(const f32x4*)(modp + (size_t)seg * MODN + flat);
    __builtin_amdgcn_sched_barrier(0);
#pragma unroll
    for (int seg = 0; seg < 8; ++seg) s = s + p[seg];
    return s;
}
DI void modsum2(const float* modp, size_t flatA, const float* biasA, size_t flatB, const float* biasB, f32x4& ra, f32x4& rb) {
    f32x4 sa = *(const f32x4*)biasA, sb = *(const f32x4*)biasB, pa[8], pb[8];
#pragma unroll
    for (int seg = 0; seg < 8; ++seg) { pa[seg] = *(const f32x4*)(modp + (size_t)seg * MODN + flatA); pb[seg] = *(const f32x4*)(modp + (size_t)seg * MODN + flatB); }
    __builtin_amdgcn_sched_barrier(0);
#pragma unroll
    for (int seg = 0; seg < 8; ++seg) { sa = sa + pa[seg]; sb = sb + pb[seg]; }
    asm volatile("" : "+v"(sa), "+v"(sb) :: "memory");
    ra = sa; rb = sb;
}
constexpr int NP_GSTRIDE = 2064;
DI void norm_plain_phase(Frame& F) {
    const int gw = F.bx * NWAVES + F.wave, lane = F.lane, b = gw >> 7;
    {
        u32x4 gv[12];
#pragma unroll
        for (int it = 0; it < 12; ++it) { const int idx = F.tid + it * NTHR, row = idx >> 7, ch = idx & 127; gv[it] = *(const u32x4*)(F.WINT() + (size_t)(2048 + row) * D + ch * 8); }
#pragma unroll
        for (int it = 0; it < 12; ++it) { const int idx = F.tid + it * NTHR, row = idx >> 7, ch = idx & 127; *(LAS u32x4*)(F.lds + row * NP_GSTRIDE + ch * 16) = gv[it]; }
    }
    __syncthreads();
    f32x4 A[4], Bv[4];
#pragma unroll
    for (int j = 0; j < 4; ++j) { const int c = 4 * lane + 256 * j;
        const f32x4 gg = *(const f32x4*)(F.norm_g() + c); f32x4 sc, sh;
        modsum2(F.MODP(), (size_t)b * 3072 + 1024 + c, F.mod_b() + 1024 + c, (size_t)b * 3072 + c, F.mod_b() + c, sc, sh);
        A[j] = gg * (sc + 1.f); Bv[j] = sh; }
    if (F.tid < 224) { const size_t flat = ((size_t)F.bx * 224 + F.tid) * 4;
        const float* bias4 = flat < (size_t)4 * 16 * 3072 ? F.mod_b() + (flat / (16 * 3072)) * 3072 + (flat % 3072) : F.kv_mod_b() + ((flat - (size_t)4 * 16 * 3072) % 2048);
        *(f32x4*)(F.MODV() + flat) = modsum(F.MODP(), flat, bias4); }
    for (int rr = 0; rr < 16; ++rr) {
        const size_t row = (size_t)gw * 16 + rr;
        f32x4 v[4];
#pragma unroll
        for (int j = 0; j < 4; ++j) v[j] = __builtin_nontemporal_load((const f32x4*)(F.x() + row * D + 4 * lane + 256 * j));
        const float rstd = 1.0f / sqrtf(row_ss(v) * (1.f / D) + NORM_EPS);
        f32x4 y[4];
#pragma unroll
        for (int j = 0; j < 4; ++j) y[j] = v[j] * rstd * A[j] + Bv[j];
        store_bf16_row(F.HN() + row * D, lane, y);
    }
    asm volatile("s_waitcnt vmcnt(0)" ::: "memory");
    {
        const int l2 = fresh_lane(), fr = l2 & 15, fq = l2 >> 4;
        const bf16_t* arow = F.HN() + ((size_t)gw * 16 + fr) * D + 8 * fq;
        const LAS unsigned char* bimg = F.lds + fr * NP_GSTRIDE + fq * 16;
        f32x4 g0 = {0.f, 0.f, 0.f, 0.f}, g1 = g0, g2 = g0;
#pragma unroll 8
        for (int kk = 0; kk < 32; ++kk) {
            const bf16x8 a = *(const bf16x8*)(arow + 32 * kk);
            const bf16x8 b0 = *(const LAS bf16x8*)(bimg + kk * 64), b1 = *(const LAS bf16x8*)(bimg + 16 * NP_GSTRIDE + kk * 64), b2 = *(const LAS bf16x8*)(bimg + 32 * NP_GSTRIDE + kk * 64);
            g0 = __builtin_amdgcn_mfma_f32_16x16x32_bf16(a, b0, g0, 0, 0, 0); g1 = __builtin_amdgcn_mfma_f32_16x16x32_bf16(a, b1, g1, 0, 0, 0); g2 = __builtin_amdgcn_mfma_f32_16x16x32_bf16(a, b2, g2, 0, 0, 0);
        }
        float* gp = F.GATES() + ((size_t)gw * 16 + 4 * fq) * 64 + fr;
#pragma unroll
        for (int i = 0; i < 4; ++i) { gp[i * 64] = rcpf(1.f + ex2(-g0[i] * LOG2E)); gp[i * 64 + 16] = rcpf(1.f + ex2(-g1[i] * LOG2E)); gp[i * 64 + 32] = rcpf(1.f + ex2(-g2[i] * LOG2E)); }
    }
}

constexpr int RT_IMG = 0, RT_LGS = 147456, RT_PE = 151552, RT_PW = 153600, RT_LCNT = 155648, RT_LBASE = 155776;

DI void norm_router_phase(Frame& F, int layer) {
    const int gw = F.bx * NWAVES + F.wave, lane = F.lane, tid = F.tid, b = gw >> 7;
    LAS float* img = (LAS float*)(F.lds + RT_IMG);
    LAS float* lgs = (LAS float*)(F.lds + RT_LGS) + F.wave * 128;
    LAS unsigned* pend_e = (LAS unsigned*)(F.lds + RT_PE);
    LAS float* pend_w = (LAS float*)(F.lds + RT_PW);
    LAS unsigned* lcnt = (LAS unsigned*)(F.lds + RT_LCNT);
    LAS unsigned* lbase = (LAS unsigned*)(F.lds + RT_LBASE);
    const float* rw = F.router_w() + (size_t)layer * D * NEXP;
#pragma unroll
    for (int it = 0; it < (D * NEXP / 4) / NTHR; ++it) { const int idx = tid + it * NTHR, col = idx >> 3, e4 = idx & 7;
        const int rho = (col & 3) * 64 + ((col >> 2) & 63) + 256 * (col >> 8); *(LAS f32x4*)(img + rho * 36 + 4 * e4) = *(const f32x4*)(rw + 4 * idx); }
    if (tid < 32) lcnt[tid] = 0u;
    __syncthreads();
    const int set = layer * 2 + 1;
    const float* mv = F.MODV() + ((size_t)set * 16 + b) * 3072;
    f32x4 A[4], Bv[4]; load_mod(F.norm_g() + (layer * 2 + 1) * D, mv + 1024, mv, lane, A, Bv);
    const float* rb = F.router_b() + layer * NEXP;
    for (int rp = 0; rp < 4; ++rp) {
        const size_t row0 = (size_t)gw * 16 + rp * 4;
        f32x4 y[4][4];
        {
            f32x4 v[4][4];
#pragma unroll
            for (int rr = 0; rr < 4; ++rr)
#pragma unroll
                for (int j = 0; j < 4; ++j) { const u32x2 t_ = __builtin_nontemporal_load((const u32x2*)(F.Hb() + (row0 + rr) * D + 4 * lane + 256 * j)); v[rr][j] = (f32x4){bf_lo(t_.x), bf_hi(t_.x), bf_lo(t_.y), bf_hi(t_.y)}; }
#pragma unroll
            for (int rr = 0; rr < 4; ++rr) { const float rs = 1.0f / sqrtf(row_ss(v[rr]) * (1.f / D) + NORM_EPS);
#pragma unroll
                for (int j = 0; j < 4; ++j) y[rr][j] = v[rr][j] * rs * A[j] + Bv[j]; }
        }
#pragma unroll
        for (int rr = 0; rr < 4; ++rr) store_bf16_row(F.HN() + (row0 + rr) * D, lane, y[rr]);
#pragma unroll 1
        for (int half = 0; half < 2; ++half) {
            float l0[32], l1[32];
            {
                typedef float f32x2 __attribute__((ext_vector_type(2)));
                f32x2 L[4][8];
#pragma unroll
                for (int rr = 0; rr < 4; ++rr)
#pragma unroll
                    for (int e = 0; e < 8; ++e) L[rr][e] = (f32x2){0.f, 0.f};
#pragma unroll
                for (int j = 0; j < 4; ++j)
#pragma unroll
                    for (int i = 0; i < 4; ++i) {
                        const f32x2 A0 = {y[0][j][i], y[0][j][i]}, A1 = {y[1][j][i], y[1][j][i]}, A2 = {y[2][j][i], y[2][j][i]}, A3 = {y[3][j][i], y[3][j][i]};
                        const LAS f32x4* wp = (const LAS f32x4*)(img + (i * 64 + lane + 256 * j) * 36 + 16 * half);
#pragma unroll
                        for (int e4 = 0; e4 < 4; ++e4) { const f32x4 w = wp[e4]; const f32x2 wl = {w.x, w.y}, wh = {w.z, w.w};
                            L[0][2 * e4] = __builtin_elementwise_fma(A0, wl, L[0][2 * e4]); L[0][2 * e4 + 1] = __builtin_elementwise_fma(A0, wh, L[0][2 * e4 + 1]);
                            L[1][2 * e4] = __builtin_elementwise_fma(A1, wl, L[1][2 * e4]); L[1][2 * e4 + 1] = __builtin_elementwise_fma(A1, wh, L[1][2 * e4 + 1]);
                            L[2][2 * e4] = __builtin_elementwise_fma(A2, wl, L[2][2 * e4]); L[2][2 * e4 + 1] = __builtin_elementwise_fma(A2, wh, L[2][2 * e4 + 1]);
                            L[3][2 * e4] = __builtin_elementwise_fma(A3, wl, L[3][2 * e4]); L[3][2 * e4 + 1] = __builtin_elementwise_fma(A3, wh, L[3][2 * e4 + 1]); }
                    }
#pragma unroll
                for (int rr = 0; rr < 2; ++rr)
#pragma unroll
                    for (int e = 0; e < 8; ++e) { l0[16 * rr + 2 * e] = L[rr][e].x; l0[16 * rr + 2 * e + 1] = L[rr][e].y; l1[16 * rr + 2 * e] = L[2 + rr][e].x; l1[16 * rr + 2 * e + 1] = L[2 + rr][e].y; }
            }
#define RS_STEP(N, OFF) { const bool up = (lane & (OFF)) != 0; _Pragma("unroll") for (int k = 0; k < (N); ++k) { \
                const float s0 = up ? l0[k] : l0[k + (N)], k0 = up ? l0[k + (N)] : l0[k]; l0[k] = k0 + shx<(OFF)>(s0, lane); \
                const float s1 = up ? l1[k] : l1[k + (N)], k1 = up ? l1[k + (N)] : l1[k]; l1[k] = k1 + shx<(OFF)>(s1, lane); } }
            RS_STEP(16, 32) RS_STEP(8, 16) RS_STEP(4, 8) RS_STEP(2, 4) RS_STEP(1, 2)
#undef RS_STEP
            const float g0 = l0[0] + shx<1>(l0[0], lane), g1 = l1[0] + shx<1>(l1[0], lane);
            const int idx = lane >> 1, rr = idx >> 4, e_own = (idx & 15) + 16 * half; const float rbv = rb[e_own];
            if ((lane & 1) == 0) { lgs[rr * 32 + e_own] = g0 + rbv; lgs[(2 + rr) * 32 + e_own] = g1 + rbv; }
        }
        LDS_WAIT(); asm volatile("" ::: "memory");
        if (lane < 4) {
            float v[32];
#pragma unroll
            for (int e = 0; e < 32; ++e) v[e] = lgs[lane * 32 + e];
            float tv[4]; int ti[4];
#pragma unroll
            for (int k = 0; k < 4; ++k) {
                float best = -INFINITY; int bi = 0;
#pragma unroll
                for (int e = 0; e < 32; ++e) { const bool gt = v[e] > best; best = gt ? v[e] : best; bi = gt ? e : bi; }
                tv[k] = best; ti[k] = bi;
#pragma unroll
                for (int e = 0; e < 32; ++e) v[e] = (e == bi) ? -INFINITY : v[e];
            }
            const float e1 = __expf(tv[1] - tv[0]), e2 = __expf(tv[2] - tv[0]), e3 = __expf(tv[3] - tv[0]);
            const float inv = 1.f / (1.f + e1 + e2 + e3);
            const float w[4] = {inv, e1 * inv, e2 * inv, e3 * inv};
            const int tl = F.wave * 16 + rp * 4 + lane;
#pragma unroll
            for (int k = 0; k < 4; ++k) {
                const unsigned pl = __hip_atomic_fetch_add(lcnt + ti[k], 1u, __ATOMIC_RELAXED, __HIP_MEMORY_SCOPE_WORKGROUP);
                pend_e[tl * 4 + k] = ((unsigned)ti[k] << 16) | pl; pend_w[tl * 4 + k] = w[k];
            }
        }
        LDS_WAIT(); asm volatile("" ::: "memory");
    }
    __syncthreads();
    unsigned* gcnt = F.ctl() + CW_CNT + 64 * layer;
    if (tid < 32) lbase[tid] = __hip_atomic_fetch_add(gcnt + tid, lcnt[tid], __ATOMIC_RELAXED, __HIP_MEMORY_SCOPE_AGENT);
    __syncthreads();
    {
        const int tl = tid >> 2, k = tid & 3; const unsigned pe = pend_e[tid]; const unsigned e = pe >> 16, pos = lbase[e] + (pe & 0xffffu);
        const unsigned token = (unsigned)(F.bx * 128 + tl);
        F.LIST()[(size_t)e * T + pos] = token; F.LISTW()[(size_t)e * T + pos] = pend_w[tid]; F.TOKSLOT()[(size_t)token * 4 + k] = (e << 16) | pos;
    }
    __syncthreads();
}

DI void load_expert_tables(Frame& F, int layer, int npn) {
    LAS unsigned* ext = (LAS unsigned*)(F.lds + EXT_OFF);
    if (F.tid < 32) ext[F.tid] = __hip_atomic_load(F.ctl() + CW_CNT + 64 * layer + F.tid, __ATOMIC_RELAXED, __HIP_MEMORY_SCOPE_AGENT);
    __syncthreads();
    if (F.tid == 0) { unsigned o = 0, u = 0; for (int e = 0; e < 32; ++e) { const unsigned c = ext[e]; ext[32 + e] = o; ext[64 + e] = u; o += c; u += ((c + 255u) >> 8) * (unsigned)npn; } ext[96] = u; }
    __syncthreads();
}

template <bool FINAL> DI void combine_phase(Frame& F, int layer) {
    load_expert_tables(F, layer, 1);
    const LAS unsigned* offs = (const LAS unsigned*)(F.lds + EXT_OFF) + 32;
    const int gw = F.bx * NWAVES + F.wave, lane = F.lane, b = gw >> 7;
    const float* gate = F.MODV() + ((size_t)(layer * 2 + 1) * 16 + b) * 3072 + 2048;
    f32x4 G[4];
#pragma unroll
    for (int j = 0; j < 4; ++j) G[j] = *(const f32x4*)(gate + 4 * lane + 256 * j);
    f32x4 A1[4], B1[4], A2[4], B2[4];
    if (FINAL) {
#pragma unroll
        for (int j = 0; j < 4; ++j) A1[j] = *(const f32x4*)(F.final_g() + 4 * lane + 256 * j);
    } else {
        const float* m2 = F.MODV() + ((size_t)2 * 16 + b) * 3072; load_mod(F.norm_g() + 2 * D, m2 + 1024, m2, lane, A1, B1);
        const float* m4 = F.MODV() + (size_t)4 * 16 * 3072 + (size_t)b * 2048; load_mod(F.kv_norm_g(), m4 + 1024, m4, lane, A2, B2);
    }
    for (int rr = 0; rr < 16; ++rr) {
        const size_t row = (size_t)gw * 16 + rr;
        const u32x4 ts = *(const u32x4*)(F.TOKSLOT() + row * 4);
        const unsigned sl[4] = {offs[ts.x >> 16] + (ts.x & 0xffffu), offs[ts.y >> 16] + (ts.y & 0xffffu), offs[ts.z >> 16] + (ts.z & 0xffffu), offs[ts.w >> 16] + (ts.w & 0xffffu)};
        f32x4 y[4];
#pragma unroll
        for (int j = 0; j < 4; ++j) y[j] = (f32x4){0.f, 0.f, 0.f, 0.f};
#pragma unroll
        for (int k = 0; k < 4; ++k)
#pragma unroll
            for (int j = 0; j < 4; ++j) { const u32x2 o = __builtin_nontemporal_load((const u32x2*)(F.OUTB() + (size_t)sl[k] * D + 4 * lane + 256 * j));
                y[j].x += bf_lo(o.x); y[j].y += bf_hi(o.x); y[j].z += bf_lo(o.y); y[j].w += bf_hi(o.y); }
        f32x4 h[4];
#pragma unroll
        for (int j = 0; j < 4; ++j) { const u32x2 t_ = __builtin_nontemporal_load((const u32x2*)(F.Hb() + row * D + 4 * lane + 256 * j)); h[j] = (f32x4){bf_lo(t_.x), bf_hi(t_.x), bf_lo(t_.y), bf_hi(t_.y)} + G[j] * y[j]; }
        const float rstd = 1.0f / sqrtf(row_ss(h) * (1.f / D) + NORM_EPS);
        if (FINAL) {
#pragma unroll
            for (int j = 0; j < 4; ++j) *(f32x4*)(F.out() + row * D + 4 * lane + 256 * j) = h[j] * rstd * A1[j];
        } else {
#pragma unroll
            for (int j = 0; j < 4; ++j) { u32x2 o_; o_.x = pk2(h[j].x, h[j].y); o_.y = pk2(h[j].z, h[j].w); *(u32x2*)(F.Hb() + row * D + 4 * lane + 256 * j) = o_; }
            f32x4 ya[4], yb[4];
#pragma unroll
            for (int j = 0; j < 4; ++j) { const f32x4 n = h[j] * rstd; ya[j] = n * A1[j] + B1[j]; yb[j] = n * A2[j] + B2[j]; }
            store_bf16_row(F.HN() + row * D, lane, ya); store_bf16_row(F.HN2() + row * D, lane, yb);
        }
    }
}
namespace pg8 {
constexpr int BM = 256, BK = 64, HALF = 128, HTB = HALF * BK * 2, STAGE_BYTES = 8 * HTB, KD = 1024;
DI int lds_byte(int r, int c) { const int st = (r >> 4) * 2 + (c >> 5), rr = r & 15, cc = c & 31, ob = rr * 64 + cc * 2; return st * 1024 + (ob ^ (((ob >> 9) & 1) << 5)); }
DI void stage_rc(int b, int& R, int& C) { const int st = b / 1024, sb = b % 1024, swz = sb ^ (((sb >> 9) & 1) << 5); R = (st >> 1) * 16 + swz / 64; C = (st & 1) * 32 + (swz % 64) / 2; }
DI int perm32(int rho) { const int n = rho >> 4, i = rho & 15; return 8 * (i >> 2) + 4 * n + (i & 3); }

struct Unit {
    const char* A;
    const char* B0;
    unsigned bh;
    int type, r0, c0, nvalid, aux;
};

template <class Pol>
DI void gemm_phase(LAS unsigned char* lds, const Pol& P, int wave_id, int lane_id) {
    const int wid = wave_id, lane = lane_id, tid = wid * 64 + lane, wr = wid >> 2, wc = wid & 3, fr = lane & 15, fq = lane >> 4;
    constexpr int K = KD, nt = K / BK;
    unsigned voffB[2];
#pragma unroll
    for (int i = 0; i < 2; ++i) { int R, C; stage_rc(tid * 16 + i * 8192, R, C); const int Rb = Pol::PERM ? ((R & ~31) + perm32(R & 31)) : R; voffB[i] = (unsigned)(Rb * K + C) * 2u; }
    const size_t kstep = (size_t)(BK * 2);
    const unsigned ldsw = (unsigned)wid * 1024u;
    const int aoff = lds_byte(wr * 64 + fr, fq * 8), boff = lds_byte(wc * 32 + fr, fq * 8);
#define PG8_SA(b, h) (((b) * 2 + (h)) * HTB)
#define PG8_SB(b, h) ((4 + (b) * 2 + (h)) * HTB)
#define PG8_STAGE_A(bufoff, gbase, va, h) do { _Pragma("unroll") for (int _i = 0; _i < 2; ++_i) \
        __builtin_amdgcn_global_load_lds((const unsigned*)((const char*)(gbase) + (va)[h][_i]), (LAS unsigned*)(lds + (bufoff) + ldsw + _i * 8192), 16, 0, 0); } while (0)
#define PG8_STAGE_B(bufoff, gbase) do { _Pragma("unroll") for (int _i = 0; _i < 2; ++_i) \
        __builtin_amdgcn_global_load_lds((const unsigned*)((const char*)(gbase) + voffB[_i]), (LAS unsigned*)(lds + (bufoff) + ldsw + _i * 8192), 16, 0, 0); } while (0)
#define PG8_LDA(dst, b, h) do { _Pragma("unroll") for (int m = 0; m < 4; ++m) _Pragma("unroll") for (int k = 0; k < 2; ++k) dst[m][k] = *(const LAS bf16x8*)(lds + PG8_SA(b, h) + aoff + m * 2048 + k * 1024); } while (0)
#define PG8_LDB(dst, b, h) do { _Pragma("unroll") for (int n = 0; n < 2; ++n) _Pragma("unroll") for (int k = 0; k < 2; ++k) dst[n][k] = *(const LAS bf16x8*)(lds + PG8_SB(b, h) + boff + n * 2048 + k * 1024); } while (0)
#define PG8_MMA(ai, bj, At, Bt) do { __builtin_amdgcn_s_setprio(1); _Pragma("unroll") for (int m = 0; m < 4; ++m) _Pragma("unroll") for (int n = 0; n < 2; ++n) _Pragma("unroll") for (int k = 0; k < 2; ++k) \
        acc[ai][bj][m][n] = __builtin_amdgcn_mfma_f32_16x16x32_bf16(Bt[n][k], At[m][k], acc[ai][bj][m][n], 0, 0, 0); __builtin_amdgcn_s_setprio(0); } while (0)
#define PG8_WAIT_V(n) asm volatile("s_waitcnt vmcnt(" #n ")" ::: "memory")
#define PG8_WAIT_L(n) asm volatile("s_waitcnt lgkmcnt(" #n ")" ::: "memory")
#define PG8_BAR __builtin_amdgcn_s_barrier()
#define PG8_SCHED __builtin_amdgcn_sched_barrier(0)
    Unit cur, nxt; int ui = 0;
    if (!P.next(0, cur)) return;
    unsigned vaC[2][2], vaN[2][2];
    P.aoff(cur, wid * 64, tid, vaC);
    bool has_next = P.next(1, nxt);
    if (has_next) P.aoff(nxt, wid * 64, tid, vaN);
    else { vaN[0][0] = vaC[0][0]; vaN[0][1] = vaC[0][1]; vaN[1][0] = vaC[1][0]; vaN[1][1] = vaC[1][1]; }
    if (Pol::GATHER) asm volatile("" : "+v"(vaC[0][0]), "+v"(vaC[0][1]), "+v"(vaC[1][0]), "+v"(vaC[1][1]), "+v"(vaN[0][0]), "+v"(vaN[0][1]), "+v"(vaN[1][0]), "+v"(vaN[1][1]));
    f32x4 acc[2][2][4][2];
    { const int l2 = fresh_lane(); P.init(acc, cur, wr, wc, l2 & 15, l2 >> 4); }
    bf16x8 At[4][2], B0[2][2], B1[2][2];
    const char* cA = cur.A; const char* cB = cur.B0; unsigned cbh = cur.bh;
    PG8_STAGE_B(PG8_SB(0, 0), cB); PG8_STAGE_A(PG8_SA(0, 0), cA, vaC, 0); PG8_STAGE_B(PG8_SB(0, 1), cB + cbh); PG8_STAGE_A(PG8_SA(0, 1), cA, vaC, 1);
    if (wr == 1) PG8_BAR;
    PG8_WAIT_V(4); PG8_BAR;
    PG8_STAGE_B(PG8_SB(1, 0), cB + kstep); PG8_STAGE_A(PG8_SA(1, 0), cA + kstep, vaC, 0); PG8_STAGE_B(PG8_SB(1, 1), cB + cbh + kstep);
    PG8_WAIT_V(6); PG8_BAR;
    for (;;) {
        const char* nA = has_next ? nxt.A : cA; const char* nB = has_next ? nxt.B0 : cB; const unsigned nbh = has_next ? nxt.bh : cbh;
        for (int t = 0; t < nt; t += 2) {
            const bool last = (t == nt - 2);
            const char* a1 = cA + (size_t)(t + 1) * kstep;
            const char* a2 = last ? nA : cA + (size_t)(t + 2) * kstep; const char* b2 = last ? nB : cB + (size_t)(t + 2) * kstep;
            const char* a3 = a2 + kstep; const char* b3 = b2 + kstep;
            const unsigned bh2 = last ? nbh : cbh;
            unsigned va2[2][2];
            if (Pol::GATHER) { va2[0][0] = last ? vaN[0][0] : vaC[0][0]; va2[0][1] = last ? vaN[0][1] : vaC[0][1]; va2[1][0] = last ? vaN[1][0] : vaC[1][0]; va2[1][1] = last ? vaN[1][1] : vaC[1][1]; }
            else { va2[0][0] = vaC[0][0]; va2[0][1] = vaC[0][1]; va2[1][0] = vaC[1][0]; va2[1][1] = vaC[1][1]; }
            PG8_LDB(B0, 0, 0); PG8_SCHED; PG8_LDA(At, 0, 0); PG8_STAGE_A(PG8_SA(1, 1), a1, vaC, 1);
            PG8_WAIT_L(8); PG8_BAR; PG8_WAIT_L(0); PG8_MMA(0, 0, At, B0); PG8_BAR; PG8_SCHED;
            PG8_LDB(B1, 0, 1); PG8_STAGE_B(PG8_SB(0, 0), b2);
            PG8_BAR; PG8_WAIT_L(0); PG8_MMA(0, 1, At, B1); PG8_BAR;
            PG8_LDA(At, 0, 1); PG8_STAGE_A(PG8_SA(0, 0), a2, va2, 0);
            PG8_BAR; PG8_WAIT_L(0); PG8_MMA(1, 0, At, B0); PG8_BAR; PG8_SCHED;
            PG8_STAGE_B(PG8_SB(0, 1), b2 + bh2);
            PG8_WAIT_V(6); PG8_BAR; PG8_MMA(1, 1, At, B1); PG8_BAR;
            PG8_LDB(B0, 1, 0); PG8_SCHED; PG8_LDA(At, 1, 0); PG8_STAGE_A(PG8_SA(0, 1), a2, va2, 1);
            PG8_WAIT_L(8); PG8_BAR; PG8_WAIT_L(0); PG8_MMA(0, 0, At, B0); PG8_BAR; PG8_SCHED;
            PG8_LDB(B1, 1, 1); PG8_STAGE_B(PG8_SB(1, 0), b3);
            PG8_BAR; PG8_WAIT_L(0); PG8_MMA(0, 1, At, B1); PG8_BAR;
            PG8_LDA(At, 1, 1); PG8_STAGE_A(PG8_SA(1, 0), a3, va2, 0);
            PG8_BAR; PG8_WAIT_L(0); PG8_MMA(1, 0, At, B0); PG8_BAR; PG8_SCHED;
            PG8_STAGE_B(PG8_SB(1, 1), b3 + bh2);
            PG8_WAIT_V(6); PG8_BAR; PG8_MMA(1, 1, At, B1); PG8_BAR;
        }
        if constexpr (Pol::GATHER) {
            Unit nn; bool has_nn = false; unsigned tokNN[2][2] = {{0u, 0u}, {0u, 0u}};
            if (has_next) { has_nn = P.next(ui + 2, nn); if (has_nn) P.aoff_load(nn, wid * 64, tokNN); }
            f32x4 bvN[4] = {};
            if (has_next) P.bias_load(nxt, wc, fresh_lane() >> 4, bvN);
            { const int l2 = fresh_lane(); P.epi(acc, cur, wr, wc, l2 & 15, l2 >> 4); }
            if (!has_next) break;
            { _Pragma("unroll") for (int a_ = 0; a_ < 2; ++a_) _Pragma("unroll") for (int m_ = 0; m_ < 4; ++m_) { acc[a_][0][m_][0] = bvN[0]; acc[a_][0][m_][1] = bvN[1]; acc[a_][1][m_][0] = bvN[2]; acc[a_][1][m_][1] = bvN[3]; } }
            cur = nxt; cA = nA; cB = nB; cbh = nbh; ++ui;
            vaC[0][0] = vaN[0][0]; vaC[0][1] = vaN[0][1]; vaC[1][0] = vaN[1][0]; vaC[1][1] = vaN[1][1];
            has_next = has_nn; nxt = nn;
            asm volatile("" : "+v"(tokNN[0][0]), "+v"(tokNN[0][1]), "+v"(tokNN[1][0]), "+v"(tokNN[1][1]));
            if (has_next) { P.aoff_calc(wid * 64, tokNN, vaN); asm volatile("" : "+v"(vaN[0][0]), "+v"(vaN[0][1]), "+v"(vaN[1][0]), "+v"(vaN[1][1])); }
        } else {
            f32x4 bvN[4] = {};
            if constexpr (Pol::PREBIAS) { if (has_next) P.bias_load(nxt, wc, fresh_lane() >> 4, bvN); }
            { const int l2 = fresh_lane(); P.epi(acc, cur, wr, wc, l2 & 15, l2 >> 4); }
            if (!has_next) break;
            if constexpr (Pol::PREBIAS) { _Pragma("unroll") for (int a_ = 0; a_ < 2; ++a_) _Pragma("unroll") for (int m_ = 0; m_ < 4; ++m_) { acc[a_][0][m_][0] = bvN[0]; acc[a_][0][m_][1] = bvN[1]; acc[a_][1][m_][0] = bvN[2]; acc[a_][1][m_][1] = bvN[3]; } }
            else { const int l2 = fresh_lane(); P.init(acc, nxt, wr, wc, l2 & 15, l2 >> 4); }
            cur = nxt; cA = nA; cB = nB; cbh = nbh; ++ui;
            vaC[0][0] = vaN[0][0]; vaC[0][1] = vaN[0][1]; vaC[1][0] = vaN[1][0]; vaC[1][1] = vaN[1][1];
            has_next = P.next(ui + 1, nxt);
            if (has_next) P.aoff(nxt, wid * 64, tid, vaN);
        }
    }
    PG8_WAIT_V(0);
    if (wr == 0) PG8_BAR;
    PG8_BAR;
#undef PG8_SA
#undef PG8_SB
#undef PG8_STAGE_A
#undef PG8_STAGE_B
#undef PG8_LDA
#undef PG8_LDB
#undef PG8_MMA
#undef PG8_WAIT_V
#undef PG8_WAIT_L
#undef PG8_BAR
#undef PG8_SCHED
}
DI void aoff_std(int tid, unsigned (&va)[2][2]) {
#pragma unroll
    for (int i = 0; i < 2; ++i) { int R, C; stage_rc(tid * 16 + i * 8192, R, C);
#pragma unroll
        for (int h = 0; h < 2; ++h) va[h][i] = (unsigned)((h * HALF + R) * KD + C) * 2u; }
}
}

DI float vmin_raw(float x, float hi) { float r; asm("v_min_f32 %0, %1, %2" : "=v"(r) : "v"(x), "v"(hi)); return r; }
DI float vmed3_raw(float x, float lo, float hi) { float r; asm("v_med3_f32 %0, %1, %2, %3" : "=v"(r) : "v"(x), "v"(lo), "v"(hi)); return r; }
typedef f32x4 AccT[2][2][4][2];
DI void acc_zero(AccT& acc) {
#pragma unroll
    for (int a = 0; a < 2; ++a)
#pragma unroll
        for (int b = 0; b < 2; ++b)
#pragma unroll
            for (int m = 0; m < 4; ++m)
#pragma unroll
                for (int n = 0; n < 2; ++n) acc[a][b][m][n] = (f32x4){0.f, 0.f, 0.f, 0.f};
}
DI void acc_colbias(AccT& acc, const f32x4& b00, const f32x4& b01, const f32x4& b10, const f32x4& b11) {
#pragma unroll
    for (int a = 0; a < 2; ++a)
#pragma unroll
        for (int m = 0; m < 4; ++m) { acc[a][0][m][0] = b00; acc[a][0][m][1] = b01; acc[a][1][m][0] = b10; acc[a][1][m][1] = b11; }
}

struct RopeRow { f32x4 c0, c1, s0, s1; };
DI RopeRow rope_load(const float* rope_row) { RopeRow q; q.c0 = *(const f32x4*)(rope_row); q.c1 = *(const f32x4*)(rope_row + 4); q.s0 = *(const f32x4*)(rope_row + 8); q.s1 = *(const f32x4*)(rope_row + 12); return q; }
DI void rope8(f32x4& v0, f32x4& v1, const RopeRow& q, int fq) {
    const f32x4 c0 = q.c0, c1 = q.c1, s0 = q.s0, s1 = q.s1;
    f32x4 p0, p1;
#pragma unroll
    for (int i = 0; i < 4; ++i) { p0[i] = shx<16>(v0[i], 0); p1[i] = shx<16>(v1[i], 0); }
    const float sg = (fq == 0) ? -1.f : 1.f;
    v0 = v0 * c0 + p0 * (s0 * sg); v1 = v1 * c1 + p1 * (s1 * sg);
}
DI void store8_bf16(bf16_t* p, const f32x4& v0, const f32x4& v1) {
    u32x4 w; w.x = pk2(v0[0], v0[1]); w.y = pk2(v0[2], v0[3]); w.z = pk2(v1[0], v1[1]); w.w = pk2(v1[2], v1[3]); *(u32x4*)p = w;
}
constexpr int ST_OFF = 131072, ST_STRIDE = 528;
DI void st_realign(int wr) { if (wr == 0) __builtin_amdgcn_s_barrier(); }
DI void st_restagger(int wr) { if (wr == 1) __builtin_amdgcn_s_barrier(); }
DI void st_put(LAS unsigned char* lds, int rowl, int colb, const f32x4& v0, const f32x4& v1) {
    u32x4 w; w.x = pk2(v0[0], v0[1]); w.y = pk2(v0[2], v0[3]); w.z = pk2(v1[0], v1[1]); w.w = pk2(v1[2], v1[3]);
    *(LAS u32x4*)(lds + ST_OFF + rowl * ST_STRIDE + colb) = w;
}
template <int ROWB, bool CHECK = true> DI void st_flush(LAS unsigned char* lds, int tid, bf16_t* out_pass, size_t ld, int nvalid_rel) {
    asm volatile("s_waitcnt lgkmcnt(0)" ::: "memory"); __builtin_amdgcn_s_barrier(); asm volatile("" ::: "memory");
    if (ROWB == 512) {
#pragma unroll
        for (int k = 0; k < 2; ++k) { const int rowl = (tid >> 5) + 16 * k, c = tid & 31, rel = 64 * (rowl >> 4) + (rowl & 15);
            const u32x4 v = *(const LAS u32x4*)(lds + ST_OFF + rowl * ST_STRIDE + c * 16);
            if (!CHECK) *(u32x4*)(out_pass + (size_t)rel * ld + c * 8) = v; else if (rel < nvalid_rel) __builtin_nontemporal_store(v, (u32x4*)(out_pass + (size_t)rel * ld + c * 8)); }
    } else {
        const int rowl = tid >> 4, c = tid & 15, rel = 64 * (rowl >> 4) + (rowl & 15);
        const u32x4 v = *(const LAS u32x4*)(lds + ST_OFF + rowl * ST_STRIDE + c * 16);
        if (!CHECK || rel < nvalid_rel) *(u32x4*)(out_pass + (size_t)rel * ld + c * 8) = v;
    }
    asm volatile("s_waitcnt lgkmcnt(0)" ::: "memory"); __builtin_amdgcn_s_barrier(); asm volatile("" ::: "memory");
}

constexpr int ST_STRIDE_GU = 272;
DI void st_put_gu(LAS unsigned char* lds, int rowl, int colb, const f32x4& v0, const f32x4& v1) {
    u32x4 w; w.x = pk2(v0[0], v0[1]); w.y = pk2(v0[2], v0[3]); w.z = pk2(v1[0], v1[1]); w.w = pk2(v1[2], v1[3]);
    *(LAS u32x4*)(lds + ST_OFF + rowl * ST_STRIDE_GU + colb) = w;
}
DI void st_flush_gu(LAS unsigned char* lds, int tid, bf16_t* out_pass, size_t ld, int nvalid_rel) {
    asm volatile("s_waitcnt lgkmcnt(0)" ::: "memory"); __builtin_amdgcn_s_barrier(); asm volatile("" ::: "memory");
#pragma unroll
    for (int k = 0; k < 2; ++k) { const int rowl = (tid >> 4) + 32 * k, c = tid & 15, rel = 64 * ((rowl >> 4) & 1) + 16 * (rowl >> 5) + (rowl & 15);
        const u32x4 v = *(const LAS u32x4*)(lds + ST_OFF + rowl * ST_STRIDE_GU + c * 16);
        if (rel < nvalid_rel) __builtin_nontemporal_store(v, (u32x4*)(out_pass + (size_t)rel * ld + c * 8)); }
    asm volatile("s_waitcnt lgkmcnt(0)" ::: "memory"); __builtin_amdgcn_s_barrier(); asm volatile("" ::: "memory");
}

struct PolProj0 {
    static constexpr bool PERM = true, GATHER = false, PREBIAS = false;
    const bf16_t *HN, *WINT; bf16_t *Q, *KV, *VT; float* GATES; const float* ROPE; int vcu; LAS unsigned char* lds;
    DI bool next(int i, pg8::Unit& u) const {
        const int L = i * GRID + vcu; if (L >= 1280) return false;
        if (L < 1024) { const int pm = L >> 3, pn = L & 7; u.type = 0; u.A = (const char*)(HN + (size_t)pm * 256 * D); u.B0 = (const char*)(WINT + (size_t)pn * 256 * D); u.bh = 128 * D * 2; u.r0 = pm * 256; u.c0 = pn * 256; u.aux = pn; u.nvalid = 256; }
        else { const int l2 = L - 1024, pm = l2 >> 7, pn = l2 & 127; u.type = 1; u.A = (const char*)(WINT + (size_t)(2304 + pm * 256) * D); u.B0 = (const char*)(HN + (size_t)pn * 256 * D); u.bh = 128 * D * 2; u.r0 = pm * 256; u.c0 = pn * 256; u.aux = 0; u.nvalid = 256; }
        return true;
    }
    DI void aoff(const pg8::Unit&, int, int tid, unsigned (&va)[2][2]) const { pg8::aoff_std(tid, va); }
    DI void init(AccT& acc, const pg8::Unit&, int, int, int, int) const { acc_zero(acc); }
    DI void epi(const AccT& acc, const pg8::Unit& u, int wr, int wc, int fr, int fq) const {
        const int pn = u.aux;
        const int tid = (wr * 4 + wc) * 64 + fq * 16 + fr, rowl = wr * 16 + fr;
        if (u.type == 1) {
            st_realign(wr);
#pragma unroll
            for (int ai = 0; ai < 2; ++ai)
#pragma unroll
                for (int m = 0; m < 4; ++m) {
#pragma unroll
                    for (int bj = 0; bj < 2; ++bj) st_put(lds, rowl, (bj * 128 + wc * 32 + 8 * fq) * 2, acc[ai][bj][m][0], acc[ai][bj][m][1]);
                    st_flush<512, false>(lds, tid, VT + (size_t)(u.r0 + ai * 128 + m * 16) * T + u.c0, T, 256); }
            st_restagger(wr);
            return;
        }
        const bool is_q = pn < 4, do_rope = (pn != 4 && pn != 5);
        bf16_t* dst = is_q ? Q + pn * 256 : KV + (pn - 4) * 256;
        const float sc = is_q ? QSCALE : 1.f;
        const bool rl = do_rope && ((wc & 1) == 0) && fq < 2;
        const bool rw = do_rope && (wc & 1) == 0;
        RopeRow rr = rope_load(ROPE + (size_t)(u.r0 + wr * 64 + fr) * 16);
        st_realign(wr);
#pragma unroll
        for (int ai = 0; ai < 2; ++ai)
#pragma unroll
            for (int m = 0; m < 4; ++m) {
                const int nx = (ai * 4 + m + 1) & 7;
                const RopeRow rn = rope_load(ROPE + (size_t)(u.r0 + (nx >> 2) * 128 + wr * 64 + (nx & 3) * 16 + fr) * 16);
#pragma unroll
                for (int bj = 0; bj < 2; ++bj) { f32x4 v0 = acc[ai][bj][m][0], v1 = acc[ai][bj][m][1];
                    if (rw) { f32x4 r0 = v0, r1 = v1; rope8(r0, r1, rr, fq); if (rl) { v0 = r0; v1 = r1; } }
                    v0 = v0 * sc; v1 = v1 * sc;
                    st_put(lds, rowl, (bj * 128 + wc * 32 + 8 * fq) * 2, v0, v1); }
                st_flush<512, false>(lds, tid, dst + (size_t)(u.r0 + ai * 128 + m * 16) * D, D, 256);
                rr = rn; }
        st_restagger(wr);
    }
};

template <bool BASE_BF16> struct PolOutT {
    static constexpr bool PERM = true, GATHER = false, PREBIAS = false;
    const bf16_t *O, *WT; const void* base; const float *gate_mv, *bias; bf16_t* Hout; int vcu;
    DI bool next(int i, pg8::Unit& u) const {
        const int L = i * GRID + vcu; if (L >= 512) return false;
        const int pm = L >> 2, pn = L & 3; u.type = 0; u.A = (const char*)(O + (size_t)pm * 256 * D); u.B0 = (const char*)(WT + (size_t)pn * 256 * D); u.bh = 128 * D * 2; u.r0 = pm * 256; u.c0 = pn * 256; u.aux = 0; u.nvalid = 256;
        return true;
    }
    DI void aoff(const pg8::Unit&, int, int tid, unsigned (&va)[2][2]) const { pg8::aoff_std(tid, va); }
    DI void init(AccT& acc, const pg8::Unit& u, int, int wc, int, int fq) const {
        if (!bias) { acc_zero(acc); return; }
        const float* bp = bias + u.c0 + wc * 32 + 8 * fq;
        acc_colbias(acc, *(const f32x4*)bp, *(const f32x4*)(bp + 4), *(const f32x4*)(bp + 128), *(const f32x4*)(bp + 132));
    }
    DI void epi(const AccT& acc, const pg8::Unit& u, int wr, int wc, int fr, int fq) const {
        const int b = u.r0 >> 11; const float* gv = gate_mv + (size_t)b * 3072 + 2048;
        const size_t row0 = (size_t)(u.r0 + wr * 64 + fr) * D + u.c0 + wc * 32 + 8 * fq;
        f32x4 xa[8], xb[8], ga, gb;
#define PO_LD1(dst, off) { if (BASE_BF16) { const u32x2 t_ = *(const u32x2*)((const bf16_t*)base + (off)); dst = (f32x4){bf_lo(t_.x), bf_hi(t_.x), bf_lo(t_.y), bf_hi(t_.y)}; } else dst = *(const f32x4*)((const float*)base + (off)); }
#define PO_LOAD(q, X, G) { const int co = ((q) >> 1) * 128 + ((q) & 1) * 4; G = *(const f32x4*)(gv + u.c0 + wc * 32 + 8 * fq + co); \
            _Pragma("unroll") for (int ai = 0; ai < 2; ++ai) _Pragma("unroll") for (int m = 0; m < 4; ++m) PO_LD1(X[ai * 4 + m], row0 + (size_t)(ai * 128 + m * 16) * D + co) }
#define PO_STORE(q, X, G) { const int co = ((q) >> 1) * 128 + ((q) & 1) * 4; \
            _Pragma("unroll") for (int ai = 0; ai < 2; ++ai) _Pragma("unroll") for (int m = 0; m < 4; ++m) { const f32x4 r_ = X[ai * 4 + m] + G * acc[ai][(q) >> 1][m][(q) & 1]; \
                u32x2 o_; o_.x = pk2(r_.x, r_.y); o_.y = pk2(r_.z, r_.w); *(u32x2*)(Hout + row0 + (size_t)(ai * 128 + m * 16) * D + co) = o_; } }
        PO_LOAD(0, xa, ga) PO_LOAD(1, xb, gb) PO_STORE(0, xa, ga) PO_LOAD(2, xa, ga) PO_STORE(1, xb, gb) PO_LOAD(3, xb, gb) PO_STORE(2, xa, ga) PO_STORE(3, xb, gb)
#undef PO_LD1
#undef PO_LOAD
#undef PO_STORE
    }
};

DI bool moe_unit(const LAS unsigned* ext, int L, int npn, int& e, int& mt, int& pn, int& nvalid, unsigned& slot0) {
    if ((unsigned)L >= (unsigned)__builtin_amdgcn_readfirstlane((int)ext[96])) return false;
    int ee = 0;
    for (int k = 1; k < 32; ++k) ee = ((unsigned)L >= ext[64 + k]) ? k : ee;
    ee = __builtin_amdgcn_readfirstlane(ee);
    const int local = L - __builtin_amdgcn_readfirstlane((int)ext[64 + ee]); mt = local / npn; pn = local % npn; e = ee;
    const int cnt = __builtin_amdgcn_readfirstlane((int)ext[ee]); nvalid = cnt - mt * 256; nvalid = nvalid > 256 ? 256 : nvalid;
    slot0 = (unsigned)__builtin_amdgcn_readfirstlane((int)ext[32 + ee]) + (unsigned)mt * 256u;
    return true;
}
template <bool NOEPI = false> struct PolGateUpT {
    static constexpr bool PERM = true, GATHER = true, PREBIAS = true;
    const bf16_t *HN, *WGUT; const float* bgu; const unsigned* LIST; bf16_t* ACT; const LAS unsigned* ext; int vcu; LAS unsigned char* lds;
    DI bool next(int i, pg8::Unit& u) const {
        int e, mt, pn, nv; unsigned s0;
        if (!moe_unit(ext, i * GRID + vcu, 8, e, mt, pn, nv, s0)) return false;
        u.type = mt; u.A = (const char*)HN; u.B0 = (const char*)(WGUT + ((size_t)e * 2048 + pn * 128) * D); u.bh = 1024u * D * 2u; u.r0 = (int)s0; u.c0 = pn * 128; u.nvalid = nv; u.aux = e;
        return true;
    }
    DI void aoff(const pg8::Unit& u, int wbase, int, unsigned (&va)[2][2]) const { unsigned tok[2][2]; aoff_load(u, wbase, tok); aoff_calc(wbase, tok, va); }
    DI void aoff_load(const pg8::Unit& u, int wbase, unsigned (&tok)[2][2]) const {
        const unsigned* lp = LIST + (size_t)u.aux * T + (size_t)u.type * 256;
        const int t = wbase | fresh_lane();
#pragma unroll
        for (int i = 0; i < 2; ++i) { int R, C; pg8::stage_rc(t * 16 + i * 8192, R, C);
#pragma unroll
            for (int h = 0; h < 2; ++h) { int r = h * 128 + R; r = r < u.nvalid ? r : u.nvalid - 1; tok[h][i] = lp[r]; } }
    }
    DI void aoff_calc(int wbase, const unsigned (&tok)[2][2], unsigned (&va)[2][2]) const {
        const int t = wbase | fresh_lane();
#pragma unroll
        for (int i = 0; i < 2; ++i) { int R, C; pg8::stage_rc(t * 16 + i * 8192, R, C);
#pragma unroll
            for (int h = 0; h < 2; ++h) va[h][i] = tok[h][i] * (unsigned)(D * 2) + (unsigned)C * 2u; }
    }
    DI void init(AccT& acc, const pg8::Unit& u, int, int wc, int, int fq) const {
        const float* bp = bgu + (size_t)u.aux * 2048 + u.c0 + wc * 32 + 8 * fq;
        acc_colbias(acc, *(const f32x4*)bp, *(const f32x4*)(bp + 4), *(const f32x4*)(bp + 1024), *(const f32x4*)(bp + 1028));
    }
    DI void bias_load(const pg8::Unit& u, int wc, int fq, f32x4 (&bv)[4]) const {
        const float* bp = bgu + (size_t)u.aux * 2048 + u.c0 + wc * 32 + 8 * fq;
        bv[0] = *(const f32x4*)bp; bv[1] = *(const f32x4*)(bp + 4); bv[2] = *(const f32x4*)(bp + 1024); bv[3] = *(const f32x4*)(bp + 1028);
    }
    DI void epi(const AccT& acc, const pg8::Unit& u, int wr, int wc, int fr, int fq) const {
        if (NOEPI) {
#pragma unroll
            for (int ai = 0; ai < 2; ++ai)
#pragma unroll
                for (int bj = 0; bj < 2; ++bj) asm volatile("" :: "v"(acc[ai][bj][0][0]), "v"(acc[ai][bj][0][1]), "v"(acc[ai][bj][1][0]), "v"(acc[ai][bj][1][1]), "v"(acc[ai][bj][2][0]), "v"(acc[ai][bj][2][1]), "v"(acc[ai][bj][3][0]), "v"(acc[ai][bj][3][1]));
            return;
        }
        st_realign(wr);
#pragma unroll
        for (int ai = 0; ai < 2; ++ai)
#pragma unroll
            for (int m = 0; m < 4; ++m) {
                const f32x4 g0 = acc[ai][0][m][0], g1 = acc[ai][0][m][1], l0 = acc[ai][1][m][0], l1 = acc[ai][1][m][1]; f32x4 a0, a1;
#pragma unroll
                for (int i = 0; i < 4; ++i) {
                    typedef float f32x2 __attribute__((ext_vector_type(2)));
                    const f32x2 x = {vmin_raw(g0[i], 7.f), vmin_raw(g1[i], 7.f)}, y = {vmed3_raw(l0[i], -7.f, 7.f), vmed3_raw(l1[i], -7.f, 7.f)};
                    const f32x2 t = x * (f32x2){-1.702f * LOG2E, -1.702f * LOG2E};
                    const f32x2 d = (f32x2){ex2(t.x), ex2(t.y)} + (f32x2){1.f, 1.f};
                    const float rr = rcpf(d.x * d.y);
                    const f32x2 o = x * ((f32x2){d.y, d.x} * (f32x2){rr, rr}) * (y + (f32x2){1.f, 1.f});
                    a0[i] = o.x; a1[i] = o.y; }
                st_put_gu(lds, (m & 1) * 32 + wr * 16 + fr, (wc * 32 + 8 * fq) * 2, a0, a1);
                if (m & 1) st_flush_gu(lds, (wr * 4 + wc) * 64 + fq * 16 + fr, ACT + (size_t)(u.r0 + ai * 128 + (m - 1) * 16) * D + u.c0, D, u.nvalid - (ai * 128 + (m - 1) * 16)); }
        st_restagger(wr);
    }
};
typedef PolGateUpT<false> PolGateUp;
template <bool NOEPI = false> struct PolDownT {
    static constexpr bool PERM = true, GATHER = false, PREBIAS = true;
    const bf16_t *ACT, *WDNT; const float *bdn, *LISTW; bf16_t* OUTB; const LAS unsigned* ext; int vcu; LAS unsigned char* lds;
    DI bool next(int i, pg8::Unit& u) const {
        int e, mt, pn, nv; unsigned s0;
        if (!moe_unit(ext, i * GRID + vcu, 4, e, mt, pn, nv, s0)) return false;
        u.type = mt; u.A = (const char*)(ACT + (size_t)s0 * D); u.B0 = (const char*)(WDNT + ((size_t)e * 1024 + pn * 256) * D); u.bh = 128 * D * 2; u.r0 = (int)s0; u.c0 = pn * 256; u.nvalid = nv; u.aux = e;
        return true;
    }
    DI void aoff(const pg8::Unit&, int, int tid, unsigned (&va)[2][2]) const { pg8::aoff_std(tid, va); }
    DI void init(AccT& acc, const pg8::Unit& u, int, int wc, int, int fq) const {
        const float* bp = bdn + (size_t)u.aux * 1024 + u.c0 + wc * 32 + 8 * fq;
        acc_colbias(acc, *(const f32x4*)bp, *(const f32x4*)(bp + 4), *(const f32x4*)(bp + 128), *(const f32x4*)(bp + 132));
    }
    DI void bias_load(const pg8::Unit& u, int wc, int fq, f32x4 (&bv)[4]) const {
        const float* bp = bdn + (size_t)u.aux * 1024 + u.c0 + wc * 32 + 8 * fq;
        bv[0] = *(const f32x4*)bp; bv[1] = *(const f32x4*)(bp + 4); bv[2] = *(const f32x4*)(bp + 128); bv[3] = *(const f32x4*)(bp + 132);
    }
    DI void epi(const AccT& acc, const pg8::Unit& u, int wr, int wc, int fr, int fq) const {
        if (NOEPI) {
#pragma unroll
            for (int ai = 0; ai < 2; ++ai)
#pragma unroll
                for (int bj = 0; bj < 2; ++bj) asm volatile("" :: "v"(acc[ai][bj][0][0]), "v"(acc[ai][bj][0][1]), "v"(acc[ai][bj][1][0]), "v"(acc[ai][bj][1][1]), "v"(acc[ai][bj][2][0]), "v"(acc[ai][bj][2][1]), "v"(acc[ai][bj][3][0]), "v"(acc[ai][bj][3][1]));
            return;
        }
        const float* wp = LISTW + (size_t)u.aux * T + (size_t)u.type * 256;
        float wv[2][4];
#pragma unroll
        for (int ai = 0; ai < 2; ++ai)
#pragma unroll
            for (int m = 0; m < 4; ++m) { const int rl = ai * 128 + wr * 64 + m * 16 + fr; wv[ai][m] = wp[rl < u.nvalid ? rl : u.nvalid - 1]; }
        st_realign(wr);
#pragma unroll
        for (int ai = 0; ai < 2; ++ai)
#pragma unroll
            for (int m = 0; m < 4; ++m) {
                const float w = wv[ai][m];
#pragma unroll
                for (int bj = 0; bj < 2; ++bj) st_put(lds, wr * 16 + fr, (bj * 128 + wc * 32 + 8 * fq) * 2, acc[ai][bj][m][0] * w, acc[ai][bj][m][1] * w);
                st_flush<512>(lds, (wr * 4 + wc) * 64 + fq * 16 + fr, OUTB + (size_t)(u.r0 + ai * 128 + m * 16) * D + u.c0, D, u.nvalid - (ai * 128 + m * 16)); }
        st_restagger(wr);
    }
};

typedef PolDownT<false> PolDown;
template <int MODE> struct PolProj1T {
    static constexpr bool PERM = true, GATHER = false, PREBIAS = false;
    unsigned char* ws; const float *bq, *kvb; int vcu; LAS unsigned char* lds;
#define PJ1(name, type, off) DI type* name() const { return (type*)(ws + (off)); }
    PJ1(HN, const bf16_t, WS_HN) PJ1(HN2, const bf16_t, WS_HN2) PJ1(WBQT, const bf16_t, WS_WBQT) PJ1(WKVT, const bf16_t, WS_WKVT) PJ1(ROPE, const float, WS_ROPE)
    PJ1(Q, bf16_t, WS_Q) PJ1(K1, bf16_t, WS_KV) PJ1(VT1, bf16_t, WS_VT)
#undef PJ1
    DI bool next(int i, pg8::Unit& u) const {
        const int L = (MODE == 0 ? 0 : 512) + i * GRID + vcu; if (L >= (MODE == 0 ? 512 : 768)) return false;
        u.bh = 128 * D * 2; u.nvalid = 256; u.aux = 0;
        if (MODE == 0) { const int pm = L >> 2, pn = L & 3; u.type = 0; u.A = (const char*)(HN() + (size_t)pm * 256 * D); u.B0 = (const char*)(WBQT() + (size_t)pn * 256 * D); u.r0 = pm * 256; u.c0 = pn * 256; }
        else if (L < 640) { const int pm = L - 512; u.type = 1; u.A = (const char*)(HN2() + (size_t)pm * 256 * D); u.B0 = (const char*)WKVT(); u.r0 = pm * 256; u.c0 = 0; }
        else { const int pn = L - 640; u.type = 2; u.A = (const char*)WKVT(); u.B0 = (const char*)(HN2() + (size_t)pn * 256 * D); u.r0 = 0; u.c0 = pn * 256; }
        return true;
    }
    DI void aoff(const pg8::Unit&, int, int tid, unsigned (&va)[2][2]) const { pg8::aoff_std(tid, va); }
    DI void init(AccT& acc, const pg8::Unit& u, int wr, int wc, int fr, int fq) const {
        if (MODE == 1 && u.type == 2) {
#pragma unroll
            for (int a = 0; a < 2; ++a)
#pragma unroll
                for (int m = 0; m < 4; ++m) { const float bs = kvb[a * 128 + wr * 64 + m * 16 + fr];
#pragma unroll
                    for (int b = 0; b < 2; ++b)
#pragma unroll
                        for (int n = 0; n < 2; ++n) acc[a][b][m][n] = (f32x4){bs, bs, bs, bs}; }
            return;
        }
        const float* bp = (MODE == 0 ? bq + u.c0 : kvb) + wc * 32 + 8 * fq;
        acc_colbias(acc, *(const f32x4*)bp, *(const f32x4*)(bp + 4), *(const f32x4*)(bp + 128), *(const f32x4*)(bp + 132));
    }
    DI void epi(const AccT& acc, const pg8::Unit& u, int wr, int wc, int fr, int fq) const {
        const int tid = (wr * 4 + wc) * 64 + fq * 16 + fr, rowl = wr * 16 + fr;
        if (MODE == 1 && u.type == 2) {
            st_realign(wr);
#pragma unroll
            for (int m = 0; m < 4; ++m) {
#pragma unroll
                for (int bj = 0; bj < 2; ++bj) st_put(lds, rowl, (bj * 128 + wc * 32 + 8 * fq) * 2, acc[1][bj][m][0], acc[1][bj][m][1]);
                st_flush<512, false>(lds, tid, VT1() + (size_t)(m * 16) * T + u.c0, T, 256); }
            st_restagger(wr);
            return;
        }
        constexpr bool isq = (MODE == 0); const bool rl = ((wc & 1) == 0) && fq < 2; const float sc = isq ? QSCALE : 1.f;
        RopeRow rr = rope_load(ROPE() + (size_t)(u.r0 + wr * 64 + fr) * 16);
        st_realign(wr);
#pragma unroll
        for (int ai = 0; ai < 2; ++ai)
#pragma unroll
            for (int m = 0; m < 4; ++m) {
                const int nx = (ai * 4 + m + 1) & 7;
                const RopeRow rn = rope_load(ROPE() + (size_t)(u.r0 + (nx >> 2) * 128 + wr * 64 + (nx & 3) * 16 + fr) * 16);
#pragma unroll
                for (int bj = 0; bj < 2; ++bj) {
                    if (!isq && bj == 1) continue;
                    f32x4 v0 = acc[ai][bj][m][0], v1 = acc[ai][bj][m][1];
                    if ((wc & 1) == 0) { f32x4 r0 = v0, r1 = v1; rope8(r0, r1, rr, fq); if (rl) { v0 = r0; v1 = r1; } }
                    v0 = v0 * sc; v1 = v1 * sc;
                    st_put(lds, rowl, (bj * 128 + wc * 32 + 8 * fq) * 2, v0, v1); }
                if (isq) st_flush<512, false>(lds, tid, Q() + (size_t)(u.r0 + ai * 128 + m * 16) * D + u.c0, D, 256);
                else st_flush<256, false>(lds, tid, K1() + (size_t)(u.r0 + ai * 128 + m * 16) * 128, 128, 256);
                rr = rn; }
        st_restagger(wr);
    }
};

template <class Base> struct NoEpi : Base {
    DI void epi(const AccT& acc, const pg8::Unit&, int, int, int, int) const {
#pragma unroll
        for (int ai = 0; ai < 2; ++ai)
#pragma unroll
            for (int bj = 0; bj < 2; ++bj) asm volatile("" :: "v"(acc[ai][bj][0][0]), "v"(acc[ai][bj][0][1]), "v"(acc[ai][bj][1][0]), "v"(acc[ai][bj][1][1]), "v"(acc[ai][bj][2][0]), "v"(acc[ai][bj][2][1]), "v"(acc[ai][bj][3][0]), "v"(acc[ai][bj][3][1]));
    }
};
DI float gelu_tanh(float z) {
    const float u = 0.7978845608028654f * (z + 0.044715f * z * z * z);
    const float e = ex2(2.f * LOG2E * u);
    const float th = 1.f - 2.f * rcpf(e + 1.f);
    return 0.5f * z * (1.f + th);
}
DI void compress_phase(Frame& F) {
    const int tid = F.tid, lane = F.lane, r = lane & 31, h = lane >> 5, quad = F.wave >> 2, q = F.wave & 3;
    const int rb = F.bx * 2 + quad, kv = rb >> 8, rem = rb & 255, b = rem >> 4, g = (rem >> 2) & 3, nb = rem & 3;
    const int n = nb * 32 + r, nn = n < 126 ? n : 126;
    constexpr int CW = 0, CX = 36864, CH = 55296;
    LAS unsigned char* lds = F.lds;
    LAS unsigned char* hid = lds + CH + quad * (32 * 272);
    const int wrow = tid >> 3, wch = tid & 7;
    const bf16_t* wsrc = F.CW1T() + ((size_t)kv * 128 + wrow) * 2048 + wch * 8;
    const int xq = tid >> 8, xr = (tid >> 3) & 31, xch = tid & 7;
    const bf16_t* xsrc;
    { const int rbq = F.bx * 2 + xq, remq = rbq & 255, bq = remq >> 4, gq = (remq >> 2) & 3, nbq = remq & 3; const int nq = nbq * 32 + xr, nnq = nq < 126 ? nq : 126;
      xsrc = F.KV() + ((size_t)(bq * SEQ + 16 * nnq)) * D + kv * 256 + gq * 64 + xch * 8; }
    f32x16 acc;
#pragma unroll
    for (int i = 0; i < 16; ++i) acc[i] = 0.f;
    u32x4 w0 = *(const u32x4*)wsrc, w1 = *(const u32x4*)(wsrc + (size_t)64 * 2048), xv = *(const u32x4*)xsrc;
#define CP_WRITE(buf) do { *(LAS u32x4*)(lds + CW + (buf) * 18432 + wrow * 144 + wch * 16) = w0; *(LAS u32x4*)(lds + CW + (buf) * 18432 + (wrow + 64) * 144 + wch * 16) = w1; \
        *(LAS u32x4*)(lds + CX + ((buf) * 2 + xq) * 4608 + xr * 144 + xch * 16) = xv; } while (0)
    CP_WRITE(0);
    __syncthreads();
#pragma unroll 2
    for (int c = 0; c < 32; ++c) {
        const int buf = c & 1;
        if (c + 1 < 32) { w0 = *(const u32x4*)(wsrc + 64 * (c + 1)); w1 = *(const u32x4*)(wsrc + (size_t)64 * 2048 + 64 * (c + 1)); xv = *(const u32x4*)(xsrc + (size_t)(c + 1) * D); }
        const LAS unsigned char* ap = lds + CW + buf * 18432 + (32 * q + r) * 144 + 16 * h;
        const LAS unsigned char* bp = lds + CX + (buf * 2 + quad) * 4608 + r * 144 + 16 * h;
#pragma unroll
        for (int s = 0; s < 4; ++s) { const bf16x8 a = *(const LAS bf16x8*)(ap + 32 * s); const bf16x8 bb = *(const LAS bf16x8*)(bp + 32 * s); acc = MFMA32(a, bb, acc); }
        if (c + 1 < 32) CP_WRITE(buf ^ 1);
        __syncthreads();
    }
#undef CP_WRITE
    {
        const float* cb = F.CMPB() + kv * 128 + 32 * q;
#pragma unroll
        for (int q4 = 0; q4 < 4; ++q4) {
            float v[4];
#pragma unroll
            for (int i = 0; i < 4; ++i) v[i] = gelu_tanh(acc[4 * q4 + i] + cb[8 * q4 + 4 * h + i]);
            u32x2 o; o.x = pk2(v[0], v[1]); o.y = pk2(v[2], v[3]);
            *(LAS u32x2*)(hid + r * 272 + (32 * q + 8 * q4 + 4 * h) * 2) = o;
        }
    }
    __syncthreads();
    if (q < 2) {
        const int db = q;
        f32x16 o2;
#pragma unroll
        for (int i = 0; i < 16; ++i) o2[i] = 0.f;
        const bf16_t* w2p = F.CW2T() + ((size_t)kv * 64 + 32 * db + r) * 128 + 8 * h;
#pragma unroll
        for (int s = 0; s < 8; ++s) {
            const bf16x8 a = *(const bf16x8*)(w2p + 16 * s);
            const bf16x8 bb = *(const LAS bf16x8*)(hid + r * 272 + (16 * s + 8 * h) * 2);
            o2 = MFMA32(a, bb, o2);
        }
        const bool valid = n < 127;
        if (kv == 0) {
            if (db == 0) {
                const float* rp = F.ROPE() + (size_t)(b * SEQ + 16 * nn + 31) * 16 + 4 * h;
                const f32x4 c = *(const f32x4*)rp, sn = *(const f32x4*)(rp + 8);
#pragma unroll
                for (int i = 0; i < 4; ++i) { const float x1 = o2[i], x2 = o2[4 + i]; o2[i] = x1 * c[i] - x2 * sn[i]; o2[4 + i] = x2 * c[i] + x1 * sn[i]; }
            }
            bf16_t* kp = F.KC() + ((size_t)((b * 4 + g) * 128 + n)) * 64 + 32 * db + 4 * h;
#pragma unroll
            for (int q4 = 0; q4 < 4; ++q4) { u32x2 o; o.x = valid ? pk2(o2[4 * q4], o2[4 * q4 + 1]) : 0u; o.y = valid ? pk2(o2[4 * q4 + 2], o2[4 * q4 + 3]) : 0u; *(u32x2*)(kp + 8 * q4) = o; }
        } else {
#pragma unroll
            for (int i = 0; i < 16; ++i) { const int d = 32 * db + crow(i, h);
                F.VCT()[((size_t)((b * 4 + g) * 64 + d)) * 128 + n] = valid ? (bf16_t)(pk2(o2[i], 0.f) & 0xffffu) : (bf16_t)0; }
        }
    }
    __syncthreads();
}

constexpr int AT_KT = 0, AT_VT = 18432  , AT_KC = 46080, AT_VC = 64512, AT_IMPP = 81408, AT_IMPS = 114176, AT_SELM = 122368;
#define NEG_INF (-INFINITY)

constexpr int AT_BG = 122880, BG_PER_WAVE = 96;
struct BgCvt { KPtr kp; LAS float* tile; int gw, cnt, st; f32x4 r[4]; };
DI void bg_decode(const BgCvt& g, const float*& src, bf16_t*& dst, int& ld) {
    const int it = g.gw + g.cnt * (GRID * NWAVES);
    unsigned char* ws = *(unsigned char* const __attribute__((address_space(4)))*)(g.kp + 8 * 29);
    if (it < 131072) { const int mat = it >> 11, q = it & 2047, kb = q >> 6, nb = q & 63;
        src = *(const float* const __attribute__((address_space(4)))*)(g.kp + 8 * 24) + (size_t)mat * (D * 2048) + (size_t)(32 * kb) * 2048 + 32 * nb; ld = 2048;
        dst = (bf16_t*)(ws + WS_WGUT) + (size_t)mat * (2048 * D) + (size_t)(32 * nb) * D + 32 * kb; }
    else { const int i2 = it - 131072, mat = i2 >> 10, q = i2 & 1023, kb = q >> 5, nb = q & 31;
        src = *(const float* const __attribute__((address_space(4)))*)(g.kp + 8 * 26) + (size_t)mat * (D * D) + (size_t)(32 * kb) * D + 32 * nb; ld = D;
        dst = (bf16_t*)(ws + WS_WDNT) + (size_t)mat * (D * D) + (size_t)(32 * nb) * D + 32 * kb; }
}
DI void bg_issue(BgCvt& g, int lane) {
    const float* src; bf16_t* dst; int ld; bg_decode(g, src, dst, ld);
    const float* p = src + (size_t)(lane >> 3) * ld + 4 * (lane & 7);
#pragma unroll
    for (int i = 0; i < 4; ++i) g.r[i] = __builtin_nontemporal_load((const f32x4*)(p + (size_t)(8 * i) * ld));
}
DI void bg_finish(BgCvt& g, int lane) {
    const float* src; bf16_t* dst; int ld; bg_decode(g, src, dst, ld);
    LAS float* w = g.tile + (lane >> 3) * 33 + 4 * (lane & 7);
#pragma unroll
    for (int i = 0; i < 4; ++i) { LAS float* q = w + (8 * i) * 33; q[0] = g.r[i].x; q[1] = g.r[i].y; q[2] = g.r[i].z; q[3] = g.r[i].w; }
    LDS_WAIT(); asm volatile("" ::: "memory");
    const int n = lane >> 1, kh = lane & 1; const LAS float* s = g.tile + (16 * kh) * 33 + n;
    u32x4 o0, o1;
    o0.x = pk2(s[0 * 33], s[1 * 33]); o0.y = pk2(s[2 * 33], s[3 * 33]); o0.z = pk2(s[4 * 33], s[5 * 33]); o0.w = pk2(s[6 * 33], s[7 * 33]);
    o1.x = pk2(s[8 * 33], s[9 * 33]); o1.y = pk2(s[10 * 33], s[11 * 33]); o1.z = pk2(s[12 * 33], s[13 * 33]); o1.w = pk2(s[14 * 33], s[15 * 33]);
    bf16_t* d = dst + (size_t)n * D + 16 * kh;
    __builtin_nontemporal_store(o0, (u32x4*)d); __builtin_nontemporal_store(o1, (u32x4*)(d + 8));
    LDS_WAIT(); asm volatile("" ::: "memory");
    ++g.cnt;
}

DI void bg_start(BgCvt& g, int lane) { if (g.st == 0 && g.cnt < BG_PER_WAVE) { bg_issue(g, lane); g.st = 1; } }
DI void bg_end(BgCvt& g, int lane) { if (g.st == 2) { bg_finish(g, lane); g.st = 0; } else if (g.st == 1) g.st = 2; else if (g.st == 3) g.st = 0; }
DI void bg_flush(BgCvt& g, int lane) { if (g.st == 1 || g.st == 2) bg_finish(g, lane); g.st = 0; }

constexpr float AT_THR = 24.0f;
DI float max3f(float a, float b, float c) { float r; asm("v_max3_f32 %0, %1, %2, %3" : "=v"(r) : "v"(a), "v"(b), "v"(c)); return r; }
DI void qk_tile(const LAS unsigned char* kt, const bf16x8 (&qf)[4], f32x16& s0, f32x16& s1, int r, int h) {
    const LAS unsigned char* kp = kt + r * 144 + h * 16;
    f32x16 z;
#pragma unroll
    for (int i = 0; i < 16; ++i) z[i] = 0.f;
    { const bf16x8 a0 = *(const LAS bf16x8*)(kp), a1 = *(const LAS bf16x8*)(kp + 32 * 144); s0 = MFMA32(a0, qf[0], z); s1 = MFMA32(a1, qf[0], z); }
#pragma unroll
    for (int s = 1; s < 4; ++s) {
        const bf16x8 a0 = *(const LAS bf16x8*)(kp + s * 32), a1 = *(const LAS bf16x8*)(kp + 32 * 144 + s * 32);
        s0 = MFMA32(a0, qf[s], s0); s1 = MFMA32(a1, qf[s], s1);
    }
}
DI void v_frags(const LAS unsigned char* vt, bf16x8 (&vf)[2][2][2], int r, int h) {
    const LAS unsigned char* vp = vt + r * 144 + h * 16;
#pragma unroll
    for (int db = 0; db < 2; ++db)
#pragma unroll
        for (int kb = 0; kb < 2; ++kb)
#pragma unroll
            for (int s2 = 0; s2 < 2; ++s2) vf[db][kb][s2] = *(const LAS bf16x8*)(vp + db * 32 * 144 + kb * 64 + s2 * 32);
}
DI void pv_mma(const bf16x8 (&vf)[2][2][2], const u32x4 (&pb)[2][2], f32x16 (&O)[2]) {
#pragma unroll
    for (int db = 0; db < 2; ++db)
#pragma unroll
        for (int kb = 0; kb < 2; ++kb)
#pragma unroll
            for (int s2 = 0; s2 < 2; ++s2) O[db] = MFMA32(vf[db][kb][s2], __builtin_bit_cast(bf16x8, pb[kb][s2]), O[db]);
}
DI void pv_tile(const LAS unsigned char* vt, const u32x4 (&pb)[2][2], f32x16 (&O)[2], int r, int h) {
    bf16x8 vf[2][2][2]; v_frags(vt, vf, r, h); pv_mma(vf, pb, O);
}
DI void make_mask(int lo, int hi, int h, unsigned& w0, unsigned& w1) {
    const int a = lo + 1 < 0 ? 0 : lo + 1, b = hi > 63 ? 63 : hi;
    unsigned long long mk = (a <= b) ? ((~0ull >> (63 - b)) & (~0ull << a)) : 0ull;
    mk >>= 4 * h;
    w0 = (unsigned)mk; w1 = (unsigned)(mk >> 32);
}
DI unsigned bitm(unsigned w, int q) { unsigned r_; asm("v_bfe_i32 %0, %1, %2, 1" : "=v"(r_) : "v"(w), "n"((q & 3) + 8 * (q >> 2))); return r_; }
DI float msel(float s, unsigned mk) { return __uint_as_float((__float_as_uint(s) & mk) | (0xff800000u & ~mk)); }
template <bool MASKED> DI float tile_max(const f32x16& S0, const f32x16& S1, unsigned w0, unsigned w1) {
    float mx = NEG_INF;
    if (!MASKED) {
#pragma unroll
        for (int q = 0; q < 16; q += 2) mx = max3f(mx, max3f(S0[q], S0[q + 1], S1[q]), S1[q + 1]);
    } else {
#pragma unroll
        for (int q = 0; q < 16; ++q) mx = max3f(mx, msel(S0[q], bitm(w0, q)), msel(S1[q], bitm(w1, q)));
    }
    return mx;
}
template <bool MASKED, bool SUB> DI float tile_exp(const f32x16& S0, const f32x16& S1, unsigned w0, unsigned w1, float m, u32x4 (&pb)[2][2]) {
    float ls = 0.f;
#pragma unroll
    for (int s2 = 0; s2 < 2; ++s2)
#pragma unroll
        for (int w = 0; w < 4; ++w) {
            const int q = 8 * s2 + 2 * w;
            float a0 = SUB ? ex2(S0[q] - m) : ex2(S0[q]), a1 = SUB ? ex2(S0[q + 1] - m) : ex2(S0[q + 1]), b0 = SUB ? ex2(S1[q] - m) : ex2(S1[q]), b1 = SUB ? ex2(S1[q + 1] - m) : ex2(S1[q + 1]);
            if (MASKED) { a0 = __uint_as_float(__float_as_uint(a0) & bitm(w0, q)); a1 = __uint_as_float(__float_as_uint(a1) & bitm(w0, q + 1));
                          b0 = __uint_as_float(__float_as_uint(b0) & bitm(w1, q)); b1 = __uint_as_float(__float_as_uint(b1) & bitm(w1, q + 1)); }
            ls += (a0 + a1) + (b0 + b1);
            pb[0][s2][w] = pk2(a0, a1); pb[1][s2][w] = pk2(b0, b1);
        }
    return ls;
}
#define AT_WRITE_K(buf, kreg) do { *(LAS u32x4*)(lds + AT_KT + (buf) * 9216 + (tid >> 3) * 144 + (tid & 7) * 16) = (kreg); } while (0)
#define AT_WRITE_V(buf, vreg) do {   \
        LAS unsigned char* _vp = lds + AT_VT + (buf) * 9216 + (tid >> 3) * 144 + ((tid & 7) >> 1) * 32 + (tid & 1) * 8; *(LAS u32x2*)_vp = (u32x2){(vreg).x, (vreg).y}; *(LAS u32x2*)(_vp + 16) = (u32x2){(vreg).z, (vreg).w}; } while (0)

template <class Seq, int DBG = 0>
DI void attn_stream(LAS unsigned char* lds, int tid, int r, int h, const Seq& seq, const bf16_t* kbase, size_t ktile, const bf16_t* vbase,
                    const bf16x8 (&qf)[4], f32x16 (&O)[2], float& m, float& l, BgCvt& bg) {
    const bool late = __builtin_amdgcn_readfirstlane(tid >> 8) != 0;
    int j = seq.first(), j1 = seq.next(j), j2 = (j1 >= 0) ? seq.next(j1) : -1;
    u32x4 krA, krB, vrA, vrB;
    krA = *(const u32x4*)(kbase + (size_t)j * ktile); vrA = *(const u32x4*)(vbase + 64 * j);
    krB = krA; vrB = vrA;
    if (j1 >= 0) { krB = *(const u32x4*)(kbase + (size_t)j1 * ktile); vrB = *(const u32x4*)(vbase + 64 * j1); }
    AT_WRITE_K(0, krA); AT_WRITE_V(0, vrA);
    if (j2 >= 0) { krA = *(const u32x4*)(kbase + (size_t)j2 * ktile); vrA = *(const u32x4*)(vbase + 64 * j2); }
    __syncthreads();
    f32x16 sa0, sa1, sb0, sb1;
    qk_tile(lds + AT_KT, qf, sa0, sa1, r, h);
    sb0 = sa0; sb1 = sa1;
    if (j1 >= 0) { AT_WRITE_K(1, krB); AT_WRITE_V(1, vrB); }
    __syncthreads();
    int vcur = 0;
#define AT_STEP(SA0, SA1, SB0, SB1, PAR, KR, VR, KS, VS) { \
        const int j3 = (j2 >= 0) ? seq.next(j2) : -1; \
        if (j3 >= 0 && !(DBG & 4)) { KS = *(const u32x4*)(kbase + (size_t)j3 * ktile); VS = *(const u32x4*)(vbase + 64 * j3); } \
        bg_start(bg, tid & 63); \
        if (!late && j1 >= 0 && !(DBG & 2)) qk_tile(lds + AT_KT + ((PAR) ^ 1) * 9216, qf, SB0, SB1, r, h);        \
        __builtin_amdgcn_sched_barrier(0); \
        bf16x8 vf[2][2][2]; if (!(DBG & 2)) v_frags(lds + AT_VT + vcur * 9216, vf, r, h); \
        const bool allow = seq.allow(j); \
        float mx = (DBG & 1) ? 0.f : tile_max<false>(SA0, SA1, 0u, 0u); \
        if (!(DBG & 1)) mx = fmaxf(mx, __shfl_xor(mx, 32)); if (Seq::HAS_ALLOW) mx = allow ? mx : NEG_INF; \
        if (__any(mx - m > AT_THR)) { \
            const float mn = fmaxf(m, mx), alpha = ex2(m - mn); \
            m = mn; l *= alpha; O[0] = O[0] * alpha; O[1] = O[1] * alpha; \
        } \
        u32x4 pb[2][2]; float ls; \
        if (DBG & 1) { ls = 1.f; _Pragma("unroll") for (int a_ = 0; a_ < 2; ++a_) _Pragma("unroll") for (int b_ = 0; b_ < 2; ++b_) pb[a_][b_] = (u32x4){__float_as_uint(SA0[a_]), __float_as_uint(SA0[2 + b_]), __float_as_uint(SA1[a_]), __float_as_uint(SA1[3])}; } \
        else if (__any(m != 0.f)) ls = tile_exp<false, true>(SA0, SA1, 0u, 0u, m, pb); \
        else ls = tile_exp<false, false>(SA0, SA1, 0u, 0u, m, pb); \
        if (Seq::HAS_ALLOW) { const unsigned km = allow ? 0xffffffffu : 0u; ls = allow ? ls : 0.f; \
            _Pragma("unroll") for (int a_ = 0; a_ < 2; ++a_) _Pragma("unroll") for (int b_ = 0; b_ < 2; ++b_) { pb[a_][b_].x &= km; pb[a_][b_].y &= km; pb[a_][b_].z &= km; pb[a_][b_].w &= km; } } \
        l += ls; \
        if (!(DBG & 2)) pv_mma(vf, pb, O); else { O[0][0] += __uint_as_float(pb[0][0].x); O[1][0] += __uint_as_float(pb[1][1].w); } \
        __builtin_amdgcn_sched_barrier(0); \
        if (late && j1 >= 0 && !(DBG & 2)) qk_tile(lds + AT_KT + ((PAR) ^ 1) * 9216, qf, SB0, SB1, r, h);         \
        { const int vw = vcur >= 1 ? vcur - 1 : 2;        \
          if (j2 >= 0 && !(DBG & 4)) { AT_WRITE_K((PAR), KR); AT_WRITE_V(vw, VR); } }     \
        vcur = vcur == 2 ? 0 : vcur + 1; \
        bg_end(bg, tid & 63); \
        if (!(DBG & 8)) __syncthreads(); \
        if (j1 < 0) break; \
        j = j1; j1 = j2; j2 = j3; }
    for (;;) {
        AT_STEP(sa0, sa1, sb0, sb1, 0, krA, vrA, krB, vrB)
        AT_STEP(sb0, sb1, sa0, sa1, 1, krB, vrB, krA, vrA)
    }
#undef AT_STEP
}
DI void attn_tile_masked(LAS unsigned char* lds, int tid, int r, int h, const bf16_t* kptr, const bf16_t* vptr, const bf16x8 (&qf)[4], f32x16 (&O)[2], float& m, float& l, int lo, int hi, BgCvt& bg) {
    const u32x4 kr = *(const u32x4*)kptr, vr = *(const u32x4*)vptr;
    bg_start(bg, tid & 63);
    AT_WRITE_K(0, kr); AT_WRITE_V(0, vr);
    __syncthreads();
    f32x16 s0, s1;
    qk_tile(lds + AT_KT, qf, s0, s1, r, h);
    unsigned w0, w1; make_mask(lo, hi, h, w0, w1);
    float mx = tile_max<true>(s0, s1, w0, w1);
    mx = fmaxf(mx, __shfl_xor(mx, 32));
    if (__any(mx - m > AT_THR)) {
        const float mn = fmaxf(m, mx), alpha = ex2(m - mn);
        m = mn; l *= alpha; O[0] = O[0] * alpha; O[1] = O[1] * alpha;
    }
    u32x4 pb[2][2];
    l += tile_exp<true, true>(s0, s1, w0, w1, m, pb);
    pv_tile(lds + AT_VT, pb, O, r, h);
    bg_end(bg, tid & 63);
    __syncthreads();
}
struct SeqSel { static constexpr bool HAS_ALLOW = true; unsigned need, myselm;
    DI int first() const { return __builtin_ctz(need); }
    DI int next(int j) const { const unsigned rest = need & ~((2u << j) - 1u); return rest ? __builtin_ctz(rest) : -1; }
    DI bool allow(int j) const { return (myselm >> j) & 1u; }
};
struct SeqRange { static constexpr bool HAS_ALLOW = false; int j0, j1;
    DI int first() const { return j0; }
    DI int next(int j) const { return j < j1 ? j + 1 : -1; }
    DI bool allow(int) const { return true; }
};

DI void nsa_attn_phase(Frame& F) {
    LAS unsigned char* lds = F.lds;
    const int tid0 = F.tid, wave = F.wave, hh = wave & 3, th = wave >> 2;
    const int bg = F.bx & 63, b = bg >> 2, g = bg & 3, s4 = F.bx >> 6;
    LAS float* impP = (LAS float*)(lds + AT_IMPP);
    LAS float* impS = (LAS float*)(lds + AT_IMPS);
    LAS unsigned* selm = (LAS unsigned*)(lds + AT_SELM);
    const int head = g * 4 + hh;
    BgCvt bgc; bgc.kp = F.kp; bgc.tile = (LAS float*)(lds + AT_BG) + wave * 1056; bgc.gw = F.bx * NWAVES + wave; bgc.cnt = 0; bgc.st = 0;
    {
#pragma unroll
        for (int i = 0; i < 2; ++i) { const int idx = tid0 + 512 * i, row = idx >> 3, ch = idx & 7;
            *(LAS u32x4*)(lds + AT_KC + row * 144 + ch * 16) = *(const u32x4*)(F.KC() + ((size_t)((b * 4 + g) * 128 + row)) * 64 + ch * 8); }
#pragma unroll
        for (int i = 0; i < 2; ++i) { const int idx = tid0 + 512 * i, d = idx >> 4, ch = idx & 15;
            const u32x4 v = *(const u32x4*)(F.VCT() + ((size_t)((b * 4 + g) * 64 + d)) * 128 + ch * 8);
            LAS u32x2* vp = (LAS u32x2*)(lds + AT_VC + d * 264 + ch * 16); vp[0] = (u32x2){v.x, v.y}; vp[1] = (u32x2){v.z, v.w}; }
        __syncthreads();
    }
    for (int ui = 0; ui < 8; ++ui) {
        int tid = tid0; asm volatile("" : "+v"(tid));
        const int lane = tid & 63, r = lane & 31, h = lane >> 5, tl = th * 32 + r;
        const int pp = s4 + 4 * (ui >> 1), qt = (ui & 1) ? 31 - pp : pp;
        const int t = qt * 64 + tl; const size_t tokrow = (size_t)b * SEQ + t;
        bf16x8 qf[4];
#pragma unroll
        for (int s = 0; s < 4; ++s) qf[s] = *(const bf16x8*)(F.Q() + tokrow * D + head * 64 + 16 * s + 8 * h);
        const float* gatep = F.GATES() + tokrow * 64 + head * 3;
        const float gc = gatep[0], gs = gatep[1], gw = gatep[2];
        if (tid < 64) selm[tid] = 0u;
        f32x16 Ot[2];
#pragma unroll
        for (int i = 0; i < 16; ++i) { Ot[0][i] = 0.f; Ot[1][i] = 0.f; }
#ifndef NO_CMP
        {
            const int nmax = (t - 31) >> 4;
            float mrun = NEG_INF, lrun = 0.f;
#pragma unroll 1
            for (int kb = 0; kb < 4; ++kb) {
                f32x16 sc;
#pragma unroll
                for (int i = 0; i < 16; ++i) sc[i] = 0.f;
#pragma unroll
                for (int s = 0; s < 4; ++s) { const bf16x8 a = *(const LAS bf16x8*)(lds + AT_KC + (kb * 32 + r) * 144 + s * 32 + h * 16); sc = MFMA32(a, qf[s], sc); }
                float bm = NEG_INF;
#pragma unroll
                for (int i = 0; i < 16; ++i) { const int nn = kb * 32 + crow(i, h); sc[i] = (nn <= nmax) ? sc[i] : NEG_INF; bm = fmaxf(bm, sc[i]); }
                const float mn = fmaxf(mrun, bm), mu = (mn == NEG_INF) ? 0.f : mn;
                float ls = 0.f;
#pragma unroll
                for (int i = 0; i < 16; ++i) ls += ex2(sc[i] - mu);
                lrun = lrun * ex2(mrun - mu) + ls; mrun = mn;
            }
            float mu, inv;
            { const float mo = __shfl_xor(mrun, 32), lo_ = __shfl_xor(lrun, 32); const float mt = fmaxf(mrun, mo); mu = (mt == NEG_INF) ? 0.f : mt;
              const float lt = lrun * ex2(mrun - mu) + lo_ * ex2(mo - mu); inv = lt > 0.f ? 1.f / lt : 0.f; }
            f32x16 Oc[2];
#pragma unroll
            for (int i = 0; i < 16; ++i) { Oc[0][i] = 0.f; Oc[1][i] = 0.f; }
            LAS float* ip = impP + ((hh * 64 + tl) * 32);
            float carry = 0.f;
#pragma unroll 1
            for (int kb = 0; kb < 4; ++kb) {
                f32x16 sc;
#pragma unroll
                for (int i = 0; i < 16; ++i) sc[i] = 0.f;
#pragma unroll
                for (int s = 0; s < 4; ++s) { const bf16x8 a = *(const LAS bf16x8*)(lds + AT_KC + (kb * 32 + r) * 144 + s * 32 + h * 16); sc = MFMA32(a, qf[s], sc); }
#pragma unroll
                for (int i = 0; i < 16; ++i) { const int nn = kb * 32 + crow(i, h); sc[i] = (nn <= nmax) ? ex2(sc[i] - mu) * inv : 0.f; }
                float Lo[4];
#pragma unroll
                for (int q4 = 0; q4 < 4; ++q4) Lo[q4] = __shfl_xor(sc[4 * q4 + 3], 32);
#pragma unroll
                for (int q4 = 0; q4 < 4; ++q4) {
                    const float G = (sc[4 * q4] + sc[4 * q4 + 1]) + (sc[4 * q4 + 2] + sc[4 * q4 + 3]);
                    const float prev0 = (q4 > 0) ? Lo[q4 > 0 ? q4 - 1 : 0] : carry;
                    const float Lp = (h == 1) ? Lo[q4] : prev0;
                    ip[8 * kb + 2 * q4 + h] = G + Lp;
                }
                carry = Lo[3];
#pragma unroll
                for (int s2 = 0; s2 < 2; ++s2) {
                    u32x4 p;
                    p.x = pk2(sc[8 * s2 + 0], sc[8 * s2 + 1]); p.y = pk2(sc[8 * s2 + 2], sc[8 * s2 + 3]); p.z = pk2(sc[8 * s2 + 4], sc[8 * s2 + 5]); p.w = pk2(sc[8 * s2 + 6], sc[8 * s2 + 7]);
                    const bf16x8 pb = __builtin_bit_cast(bf16x8, p);
#pragma unroll
                    for (int db = 0; db < 2; ++db) {
                        const LAS unsigned char* a = lds + AT_VC + (db * 32 + r) * 264 + (kb * 32 + 16 * s2 + 4 * h) * 2;
                        const s16x4 lo4 = *(const LAS s16x4*)a, hi4 = *(const LAS s16x4*)(a + 16);
                        const bf16x8 va = __builtin_shufflevector(lo4, hi4, 0, 1, 2, 3, 4, 5, 6, 7);
                        Oc[db] = MFMA32(va, pb, Oc[db]);
                    }
                }
            }
#pragma unroll
            for (int i = 0; i < 16; ++i) { Ot[0][i] = gc * Oc[0][i]; Ot[1][i] = gc * Oc[1][i]; }
        }
#endif
        __syncthreads();
        {
            const int tok = tid >> 3, sub = tid & 7;
#pragma unroll
            for (int jj = 0; jj < 4; ++jj) { const int j = sub * 4 + jj;
                impS[tok * 32 + j] = ((impP[(0 * 64 + tok) * 32 + j] + impP[(1 * 64 + tok) * 32 + j]) + impP[(2 * 64 + tok) * 32 + j]) + impP[(3 * 64 + tok) * 32 + j]; }
        }
        __syncthreads();
#ifndef NO_TOPK
        {
            const int tok = tid >> 3, sub = tid & 7;
            if (qt < 16) { if (sub == 0) selm[tok] = (2u << qt) - 1u; }
            else {
                float vj[4]; int rank[4];
#pragma unroll
                for (int jj = 0; jj < 4; ++jj) { vj[jj] = impS[tok * 32 + sub * 4 + jj]; rank[jj] = 0; }
#pragma unroll 1
                for (int i = 1; i <= qt - 2; ++i) { const float vi = impS[tok * 32 + i];
#pragma unroll
                    for (int jj = 0; jj < 4; ++jj) { const int j = sub * 4 + jj; rank[jj] += ((vi > vj[jj]) || (vi == vj[jj] && i < j)) ? 1 : 0; } }
                unsigned bits = 0u;
#pragma unroll
                for (int jj = 0; jj < 4; ++jj) { const int j = sub * 4 + jj;
                    const bool forced = (j == 0 || j == qt || j == qt - 1);
                    const bool sel = forced || (j <= qt - 2 && rank[jj] < 13);
                    bits |= sel ? (1u << j) : 0u; }
                if (bits) __hip_atomic_fetch_or(selm + tok, bits, __ATOMIC_RELAXED, __HIP_MEMORY_SCOPE_WORKGROUP);
            }
        }
#endif
        __syncthreads();
        LAS unsigned* park = (LAS unsigned*)(lds + AT_IMPP) + wave * 1024 + lane;
#pragma unroll
        for (int i = 0; i < 8; ++i) { park[i * 64] = pk2(Ot[0][2 * i], Ot[0][2 * i + 1]); park[(8 + i) * 64] = pk2(Ot[1][2 * i], Ot[1][2 * i + 1]); }
        const unsigned myselm = selm[tl];
        unsigned need;
        { unsigned w = selm[lane];
#pragma unroll
            for (int o = 1; o < 64; o <<= 1) w |= (unsigned)__shfl_xor((int)w, o);
            need = (unsigned)__builtin_amdgcn_readfirstlane((int)w) & ((2u << qt) - 1u); }
#ifdef REPEAT_SEL
        { f32x16 O2[2]; float m2 = 0.f, l2 = 0.f;
#pragma unroll
          for (int i = 0; i < 16; ++i) { O2[0][i] = 0.f; O2[1][i] = 0.f; }
          const bf16_t* kbase = F.KV() + ((size_t)b * SEQ + (tid >> 3)) * D + 512 + g * 64 + (tid & 7) * 8;
          const bf16_t* vbase = F.VT() + ((size_t)(g * 64 + (tid >> 3))) * T + (size_t)b * SEQ + (tid & 7) * 8;
          const unsigned inner = need & ~(1u << qt);
          if (inner) { const SeqSel seq{inner, myselm}; attn_stream<SeqSel, REPEAT_SEL>(lds, tid, r, h, seq, kbase, (size_t)64 * D, vbase, qf, O2, m2, l2, bgc); }
          attn_tile_masked(lds, tid, r, h, kbase + (size_t)qt * 64 * D, vbase + 64 * qt, qf, O2, m2, l2, -1, tl, bgc);
          asm volatile("" :: "v"(O2[0]), "v"(O2[1]), "v"(l2)); }
#endif
#ifndef NO_SEL
        {
            f32x16 O[2];
#pragma unroll
            for (int i = 0; i < 16; ++i) { O[0][i] = 0.f; O[1][i] = 0.f; }
            float m = 0.f, l = 0.f;
            const bf16_t* kbase = F.KV() + ((size_t)b * SEQ + (tid >> 3)) * D + 512 + g * 64 + (tid & 7) * 8;
            const bf16_t* vbase = F.VT() + ((size_t)(g * 64 + (tid >> 3))) * T + (size_t)b * SEQ + (tid & 7) * 8;
            const unsigned inner = need & ~(1u << qt);
            if (inner) { const SeqSel seq{inner, myselm}; attn_stream(lds, tid, r, h, seq, kbase, (size_t)64 * D, vbase, qf, O, m, l, bgc); }
            attn_tile_masked(lds, tid, r, h, kbase + (size_t)qt * 64 * D, vbase + 64 * qt, qf, O, m, l, -1, tl, bgc);
            l += __shfl_xor(l, 32);
            const float sc = l > 0.f ? gs / l : 0.f;
#pragma unroll
            for (int i = 0; i < 8; ++i) { const unsigned a = park[i * 64], c = park[(8 + i) * 64];
                park[i * 64] = pk2(bf_lo(a) + sc * O[0][2 * i], bf_hi(a) + sc * O[0][2 * i + 1]); park[(8 + i) * 64] = pk2(bf_lo(c) + sc * O[1][2 * i], bf_hi(c) + sc * O[1][2 * i + 1]); }
        }
#endif
#ifdef REPEAT_SWA
        { f32x16 O2[2]; float m2 = 0.f, l2 = 0.f;
#pragma unroll
          for (int i = 0; i < 16; ++i) { O2[0][i] = 0.f; O2[1][i] = 0.f; }
          const bf16_t* kbase = F.KV() + ((size_t)b * SEQ + (tid >> 3)) * D + 768 + g * 64 + (tid & 7) * 8;
          const bf16_t* vbase = F.VT() + ((size_t)(256 + g * 64 + (tid >> 3))) * T + (size_t)b * SEQ + (tid & 7) * 8;
          if (qt >= 8) attn_tile_masked(lds, tid, r, h, kbase + (size_t)(qt - 8) * 64 * D, vbase + 64 * (qt - 8), qf, O2, m2, l2, tl, 64, bgc);
          const int i0 = qt > 7 ? qt - 7 : 0;
          if (i0 <= qt - 1) { const SeqRange seq{i0, qt - 1}; attn_stream(lds, tid, r, h, seq, kbase, (size_t)64 * D, vbase, qf, O2, m2, l2, bgc); }
          attn_tile_masked(lds, tid, r, h, kbase + (size_t)qt * 64 * D, vbase + 64 * qt, qf, O2, m2, l2, -1, tl, bgc);
          asm volatile("" :: "v"(O2[0]), "v"(O2[1]), "v"(l2)); }
#endif
#ifndef NO_SWA
        {
            f32x16 O[2];
#pragma unroll
            for (int i = 0; i < 16; ++i) { O[0][i] = 0.f; O[1][i] = 0.f; }
            float m = 0.f, l = 0.f;
            const bf16_t* kbase = F.KV() + ((size_t)b * SEQ + (tid >> 3)) * D + 768 + g * 64 + (tid & 7) * 8;
            const bf16_t* vbase = F.VT() + ((size_t)(256 + g * 64 + (tid >> 3))) * T + (size_t)b * SEQ + (tid & 7) * 8;
            if (qt >= 8) attn_tile_masked(lds, tid, r, h, kbase + (size_t)(qt - 8) * 64 * D, vbase + 64 * (qt - 8), qf, O, m, l, tl, 64, bgc);
            const int i0 = qt > 7 ? qt - 7 : 0;
            if (i0 <= qt - 1) { const SeqRange seq{i0, qt - 1}; attn_stream(lds, tid, r, h, seq, kbase, (size_t)64 * D, vbase, qf, O, m, l, bgc); }
            attn_tile_masked(lds, tid, r, h, kbase + (size_t)qt * 64 * D, vbase + 64 * qt, qf, O, m, l, -1, tl, bgc);
            l += __shfl_xor(l, 32);
            const float sc = l > 0.f ? gw / l : 0.f;
#pragma unroll
            for (int i = 0; i < 8; ++i) { const unsigned a = park[i * 64], c = park[(8 + i) * 64];
                Ot[0][2 * i] = bf_lo(a) + sc * O[0][2 * i]; Ot[0][2 * i + 1] = bf_hi(a) + sc * O[0][2 * i + 1]; Ot[1][2 * i] = bf_lo(c) + sc * O[1][2 * i]; Ot[1][2 * i + 1] = bf_hi(c) + sc * O[1][2 * i + 1]; }
        }
#endif
        {
            bf16_t* op = F.O() + tokrow * D + head * 64 + 4 * h;
#pragma unroll
            for (int db = 0; db < 2; ++db)
#pragma unroll
                for (int q4 = 0; q4 < 4; ++q4) { u32x2 o; o.x = pk2(Ot[db][4 * q4], Ot[db][4 * q4 + 1]); o.y = pk2(Ot[db][4 * q4 + 2], Ot[db][4 * q4 + 3]); *(u32x2*)(op + db * 32 + 8 * q4) = o; }
        }
        __syncthreads();
    }
#ifdef PROBE_TAIL
    const int pt_rem = BG_PER_WAVE - bgc.cnt; const unsigned long long pt_t0 = __builtin_amdgcn_s_memrealtime();
#endif
    bg_flush(bgc, tid0 & 63);
    while (bgc.cnt < BG_PER_WAVE) { bg_issue(bgc, tid0 & 63); bg_finish(bgc, tid0 & 63); }
#ifdef PROBE_TAIL
    if (F.bx == PROBE_BLK && wave == 0) { const unsigned long long t1 = __builtin_amdgcn_s_memrealtime();
        const unsigned long long until = t1 + (PROBE_TAIL == 1 ? (unsigned long long)pt_rem * 10000ull : (t1 - pt_t0) * 100ull);
        while (__builtin_amdgcn_s_memrealtime() < until) __builtin_amdgcn_s_sleep(8); }
#endif
}

DI void swa_sink_phase(Frame& F) {
    LAS unsigned char* lds = F.lds;
    const int tid = F.tid, lane = F.lane, wave = F.wave, r = lane & 31, h = lane >> 5;
    const bf16_t* Qp = F.Q(); const bf16_t* Kp = F.KV(); const bf16_t* Vp = F.VT(); bf16_t* Op = F.O(); const float* sk = F.b_sinks();
    int ui = 0, q32 = F.vcu & 63, kvh = (F.vcu >> 6) & 1, b = F.vcu >> 7;
    int j1 = (32 * q32 + 31) >> 6, j = ((32 * q32 - 127) > 0 ? (32 * q32 - 127) : 0) >> 6;
    bf16x8 qf[4];
#pragma unroll
    for (int s = 0; s < 4; ++s) qf[s] = *(const bf16x8*)(Qp + ((size_t)b * SEQ + q32 * 32 + r) * D + (kvh * 8 + wave) * 64 + 16 * s + 8 * h);
    u32x4 kr = *(const u32x4*)(Kp + ((size_t)b * SEQ + 64 * j + (tid >> 3)) * 128 + kvh * 64 + (tid & 7) * 8);
    u32x4 vr = *(const u32x4*)(Vp + ((size_t)(kvh * 64 + (tid >> 3))) * T + (size_t)b * SEQ + 64 * j + (tid & 7) * 8);
    AT_WRITE_K(0, kr); AT_WRITE_V(0, vr);
    __syncthreads();
    f32x16 O[2];
#pragma unroll
    for (int i = 0; i < 16; ++i) { O[0][i] = 0.f; O[1][i] = 0.f; }
    const float skm0 = sk[wave] * LOG2E, skm1 = sk[8 + wave] * LOG2E;
    float m = kvh ? skm1 : skm0, l = (h == 0) ? 1.f : 0.f;
    int buf = 0;
    for (;;) {
        const bool last_tile = (j == j1);
        int nq32 = q32, nkvh = kvh, nb = b, nj = j + 1; bool has = true;
        if (last_tile) { has = (ui + 1) < 8;
            if (has) { const int u = (ui + 1) * GRID + F.vcu; nq32 = u & 63; nkvh = (u >> 6) & 1; nb = u >> 7; nj = ((32 * nq32 - 127) > 0 ? (32 * nq32 - 127) : 0) >> 6; } }
        bf16x8 qn[4];
        if (has) {
            kr = *(const u32x4*)(Kp + ((size_t)nb * SEQ + 64 * nj + (tid >> 3)) * 128 + nkvh * 64 + (tid & 7) * 8);
            vr = *(const u32x4*)(Vp + ((size_t)(nkvh * 64 + (tid >> 3))) * T + (size_t)nb * SEQ + 64 * nj + (tid & 7) * 8);
            if (last_tile) {
#pragma unroll
                for (int s = 0; s < 4; ++s) qn[s] = *(const bf16x8*)(Qp + ((size_t)nb * SEQ + nq32 * 32 + r) * D + (nkvh * 8 + wave) * 64 + 16 * s + 8 * h);
            }
        }
        {
            const int hi = q32 * 32 + r - 64 * j;
            f32x16 s0, s1;
            qk_tile(lds + AT_KT + buf * 9216, qf, s0, s1, r, h);
            unsigned w0, w1; make_mask(hi - 128, hi, h, w0, w1);
            float mx = tile_max<true>(s0, s1, w0, w1);
            mx = fmaxf(mx, __shfl_xor(mx, 32));
            if (__any(mx - m > AT_THR)) { const float mn = fmaxf(m, mx), alpha = ex2(m - mn); m = mn; l *= alpha; O[0] = O[0] * alpha; O[1] = O[1] * alpha; }
            u32x4 pb[2][2];
            l += tile_exp<true, true>(s0, s1, w0, w1, m, pb);
            pv_tile(lds + AT_VT + buf * 9216, pb, O, r, h);
        }
        if (has) { AT_WRITE_K(buf ^ 1, kr); AT_WRITE_V(buf ^ 1, vr); }
        __syncthreads();
        buf ^= 1;
        if (last_tile) {
            l += __shfl_xor(l, 32);
            const float sc = 1.f / l;
            bf16_t* op = Op + ((size_t)b * SEQ + q32 * 32 + r) * D + (kvh * 8 + wave) * 64 + 4 * h;
#pragma unroll
            for (int db = 0; db < 2; ++db)
#pragma unroll
                for (int q4 = 0; q4 < 4; ++q4) { u32x2 o; o.x = pk2(O[db][4 * q4] * sc, O[db][4 * q4 + 1] * sc); o.y = pk2(O[db][4 * q4 + 2] * sc, O[db][4 * q4 + 3] * sc); *(u32x2*)(op + db * 32 + 8 * q4) = o; }
            if (!has) break;
#pragma unroll
            for (int i = 0; i < 16; ++i) { O[0][i] = 0.f; O[1][i] = 0.f; }
#pragma unroll
            for (int s = 0; s < 4; ++s) qf[s] = qn[s];
            ++ui; q32 = nq32; kvh = nkvh; b = nb; j1 = (32 * q32 + 31) >> 6;
            m = kvh ? skm1 : skm0; l = (h == 0) ? 1.f : 0.f;
        }
        j = nj;
    }
}
#ifndef N_LAUNCHES
#define N_LAUNCHES 1
#endif
constexpr int N_PHASES = 17;
__global__ void __launch_bounds__(NTHR, 2) fwd_kernel(Args args) {
    extern __shared__ __attribute__((aligned(16))) unsigned char lds_raw[];
    LAS unsigned char* const lds = (LAS unsigned char*)lds_raw;
    const int wave0 = __builtin_amdgcn_readfirstlane((int)(threadIdx.x >> 6));
    for (int u = threadIdx.x; u < 256; u += NTHR) ((LAS unsigned*)(lds + MISC_OFF))[u] = 0u;
    __syncthreads();
#if N_LAUNCHES == 1
    { Frame F = make_frame(lds, wave0); (void)xcd_barrier_post(F.ctl() + CW_BAR, (volatile LAS unsigned*)(lds + MISC_OFF)); }
#define IN(k) true
#define SEAM(k) do { Frame Fb = make_frame(lds, wave0); XcdBarrier _b; _b.bar = Fb.ctl() + CW_BAR; _b.x = xb_xcc_id(); _b.st = (volatile LAS unsigned*)(lds + MISC_OFF); xcd_barrier(_b); } while (0)
#else
#ifdef ONLY_PHASE
#define IN(k) ((k) == ONLY_PHASE && args.ph_lo <= (k) && (k) < args.ph_hi)
#else
#define IN(k) (args.ph_lo <= (k) && (k) < args.ph_hi)
#endif
#define SEAM(k) do { } while (0)
#endif
    const LAS unsigned* ext = (const LAS unsigned*)(lds + EXT_OFF);
#ifndef REPEAT_MASK
#define REPEAT_MASK 0
#endif
#define PH(k, ...) do { if (IN(k)) { __VA_ARGS__ } if ((((REPEAT_MASK) >> (k)) & 1) && IN(k)) { __VA_ARGS__ } } while (0)

    PH(0, Frame F = make_frame(lds, wave0); p0_prologue(F);); SEAM(0);
    PH(1, Frame F = make_frame(lds, wave0); norm_plain_phase(F);); SEAM(1);
#ifdef PROBE_SEAMS
    for (int q_ = 0; q_ < PROBE_SEAMS; ++q_) { SEAM(1); }
#endif
    PH(2, Frame F = make_frame(lds, wave0); PolProj0 P{F.HN(), F.WINT(), F.Q(), F.KV(), F.VT(), F.GATES(), F.ROPE(), F.vcu, lds}; pg8::gemm_phase(lds, P, F.wave, F.lane);); SEAM(2);
    PH(3, Frame F = make_frame(lds, wave0); compress_phase(F);); SEAM(3);
    PH(4, Frame F = make_frame(lds, wave0); nsa_attn_phase(F);); SEAM(4);
#ifdef PROBE_OUT
    { Frame F = make_frame(lds, wave0); NoEpi<PolOutT<false>> P{{F.O(), F.WAOT(), F.x(), F.MODV(), nullptr, F.Hb(), F.vcu}};
      for (int rep = 0; rep < PROBE_OUT; ++rep) pg8::gemm_phase(lds, P, F.wave, F.lane); }
#endif
    PH(5, Frame F = make_frame(lds, wave0); PolOutT<false> P{F.O(), F.WAOT(), F.x(), F.MODV() + (size_t)0 * 16 * 3072, nullptr, F.Hb(), F.vcu}; pg8::gemm_phase(lds, P, F.wave, F.lane);); SEAM(5);
    PH(6, Frame F = make_frame(lds, wave0); norm_router_phase(F, 0);); SEAM(6);
#ifdef PROBE_GU_NOEPI
    { Frame F = make_frame(lds, wave0); load_expert_tables(F, 0, 8); PolGateUpT<true> P{F.HN(), F.WGUT(), F.b_gate_up(), F.LIST(), F.ACT(), ext, F.vcu, lds}; pg8::gemm_phase(lds, P, F.wave, F.lane); }
#endif
#ifdef PROBE_CLOCK
    unsigned long long pc_t0 = __builtin_amdgcn_s_memtime(), pc_r0 = __builtin_amdgcn_s_memrealtime();
#endif
    PH(7, Frame F = make_frame(lds, wave0); load_expert_tables(F, 0, 8); PolGateUp P{F.HN(), F.WGUT(), F.b_gate_up(), F.LIST(), F.ACT(), ext, F.vcu, lds}; pg8::gemm_phase(lds, P, F.wave, F.lane););
#ifdef PROBE_CLOCK
    {
        const unsigned long long t1 = __builtin_amdgcn_s_memtime(), r1 = __builtin_amdgcn_s_memrealtime();
        if (blockIdx.x == 0) { const unsigned long long f = (t1 - pc_t0) / (r1 - pc_r0);
            const unsigned long long until = r1 + f * 1000ull;
            while (__builtin_amdgcn_s_memrealtime() < until) __builtin_amdgcn_s_sleep(8); }
    }
#endif
    SEAM(7);
#ifdef PROBE_DN
    { Frame F = make_frame(lds, wave0); load_expert_tables(F, 0, 4); PolDownT<(PROBE_DN == 1)> P{F.ACT(), F.WDNT(), F.b_down(), F.LISTW(), F.OUTB(), ext, F.vcu, lds}; pg8::gemm_phase(lds, P, F.wave, F.lane); }
#endif
    PH(8, Frame F = make_frame(lds, wave0); load_expert_tables(F, 0, 4); PolDown P{F.ACT(), F.WDNT(), F.b_down(), F.LISTW(), F.OUTB(), ext, F.vcu, lds}; pg8::gemm_phase(lds, P, F.wave, F.lane);); SEAM(8);
    PH(9, Frame F = make_frame(lds, wave0); combine_phase<false>(F, 0);); SEAM(9);
    PH(10, Frame F = make_frame(lds, wave0); { PolProj1T<0> P{F.wsp(), F.b_b_q(), F.kv_b(), F.vcu, lds}; pg8::gemm_phase(lds, P, F.wave, F.lane); } { Frame G = make_frame(lds, wave0); PolProj1T<1> P{G.wsp(), G.b_b_q(), G.kv_b(), G.vcu, lds}; pg8::gemm_phase(lds, P, G.wave, G.lane); }); SEAM(10);
    PH(11, Frame F = make_frame(lds, wave0); swa_sink_phase(F);); SEAM(11);
    PH(12, Frame F = make_frame(lds, wave0); PolOutT<true> P{F.O(), F.WBOT(), F.Hb(), F.MODV() + (size_t)2 * 16 * 3072, F.b_b_out(), F.Hb(), F.vcu}; pg8::gemm_phase(lds, P, F.wave, F.lane);); SEAM(12);
    PH(13, Frame F = make_frame(lds, wave0); norm_router_phase(F, 1);); SEAM(13);
    PH(14, Frame F = make_frame(lds, wave0); load_expert_tables(F, 1, 8); PolGateUp P{F.HN(), F.WGUT() + (size_t)32 * 2048 * D, F.b_gate_up() + 32 * 2048, F.LIST(), F.ACT(), ext, F.vcu, lds}; pg8::gemm_phase(lds, P, F.wave, F.lane);); SEAM(14);
    PH(15, Frame F = make_frame(lds, wave0); load_expert_tables(F, 1, 4); PolDown P{F.ACT(), F.WDNT() + (size_t)32 * D * D, F.b_down() + 32 * 1024, F.LISTW(), F.OUTB(), ext, F.vcu, lds}; pg8::gemm_phase(lds, P, F.wave, F.lane);); SEAM(15);
    PH(16, Frame F = make_frame(lds, wave0); combine_phase<true>(F, 1););
#undef IN
#undef SEAM
}

extern "C" void kernel_launch(void* const* d_in, const int* in_sizes, int n_in, void* d_out, int out_size, void* d_ws, size_t ws_size, hipStream_t stream) {
    static int ready = 0;
    if (ready == 0) {
        if (n_in != 28 || out_size != T * D || ws_size < WS_END) { fprintf(stderr, "kernel_launch: unexpected shapes (n_in %d out %d ws %zu)\n", n_in, out_size, ws_size); ready = -1; return; }
        int dev = 0, cus = 0, per_cu = 0;
        if (hipGetDevice(&dev) != hipSuccess || hipDeviceGetAttribute(&cus, hipDeviceAttributeMultiprocessorCount, dev) != hipSuccess) { ready = -1; return; }
        if (hipFuncSetAttribute((const void*)fwd_kernel, hipFuncAttributeMaxDynamicSharedMemorySize, LDS_BYTES) != hipSuccess) { fprintf(stderr, "kernel_launch: hipFuncSetAttribute failed\n"); ready = -1; return; }
        if (hipOccupancyMaxActiveBlocksPerMultiprocessor(&per_cu, (const void*)fwd_kernel, NTHR, LDS_BYTES) != hipSuccess || per_cu < 1) fprintf(stderr, "kernel_launch: occupancy query reports %d\n", per_cu);
        (void)hipGetLastError();
        if (cus < GRID) { fprintf(stderr, "kernel_launch: needs %d CUs, device has %d\n", GRID, cus); ready = -1; return; }
        ready = 1;
    }
    if (ready < 0) return;
    (void)hipMemsetAsync((char*)d_ws + WS_CTL, 0, CTL_ZERO_BYTES, stream);
    Args a{};
    for (int i = 0; i < 28; ++i) a.in[i] = d_in[i];
    a.out = (float*)d_out; a.ws = (unsigned char*)d_ws;
    if (N_LAUNCHES == 1) {
        a.ph_lo = 0; a.ph_hi = N_PHASES;
        hipLaunchKernelGGL(fwd_kernel, dim3(GRID), dim3(NTHR), LDS_BYTES, stream, a);
    } else {
        for (int p = 0; p < N_PHASES; ++p) { a.ph_lo = p; a.ph_hi = p + 1; hipLaunchKernelGGL(fwd_kernel, dim3(GRID), dim3(NTHR), LDS_BYTES, stream, a); }
    }
}
```
